# Optimizing an MI355X kernel written in HIP

```python
import jax, jax.numpy as jnp
from jax import lax
import numpy as np

D_MODEL = 2048
BATCH = 1
SEQ = 16384
DEPTH = 2

GRID_W = 64
CTX_LEN = 256
N_DIR = 2
NORM_EPS = 1e-6
RWKV_HEADS = 8
RWKV_HEAD_DIM = 64
RWKV_WIDTH = RWKV_HEADS * RWKV_HEAD_DIM
DECAY_LORA = 32
ICLR_LORA = 32
VRES_LORA = 32
GATE_LORA = 96
DECAY_SCALE = 0.606531
GN_EPS = 64e-5
SHIFT_WIDTH = 3
LRU_BLOCKS = 8
LRU_BLOCK_DIM = 64
LRU_WIDTH = LRU_BLOCKS * LRU_BLOCK_DIM
LRU_CONV_WIDTH = 4
LRU_CONV_LEFT = 2
LRU_C = 8.0
LRU_A_MIN = 0.9
LRU_A_MAX = 0.999
MLA_HEADS = 8
MLA_NOPE = 128
MLA_ROPE = 64
MLA_V = 128
MLA_Q_RANK = 512
MLA_KV_RANK = 256
MLA_WIDTH = MLA_HEADS * MLA_V
MLA_SCALE = (MLA_NOPE + MLA_ROPE) ** -0.5
ROPE_THETA = 10000.0
Q_BLOCK = 128
MIX_WIDTH = RWKV_WIDTH + LRU_WIDTH + MLA_WIDTH
RWKV_COLS = 3 * RWKV_WIDTH + N_DIR * DECAY_LORA + N_DIR * ICLR_LORA + GATE_LORA
LRU_COLS = 2 * LRU_WIDTH
MLA_COLS = MLA_Q_RANK + MLA_KV_RANK + MLA_ROPE
IN_COLS = RWKV_COLS + LRU_COLS + MLA_COLS
D_FF = 5632
FFN_CONV_WIDTH = 3

kernel_name = 'hybrid_rwkv7_rglru_mla_prefix_dit'


def rms_norm(x, g):
    xf = x.astype(jnp.float32)
    y = xf * lax.rsqrt(jnp.mean(xf * xf, axis=-1, keepdims=True) + NORM_EPS)
    return (y * g.astype(jnp.float32)).astype(x.dtype)


def modulate(x, shift, scale):
    return x * (1.0 + scale) + shift


def dwconv(x, w, b, left):
    width, n = w.shape[0], x.shape[1]
    xp = jnp.pad(x, ((0, 0), (left, width - 1 - left), (0, 0)))
    y = b + xp[:, 0:n] * w[0]
    for j in range(1, width):
        y = y + xp[:, j:j + n] * w[j]
    return y


def axial_rope_tables(rows):
    n_freq = MLA_ROPE // 4
    row = jnp.repeat(jnp.arange(rows, dtype=jnp.float32), GRID_W)
    col = jnp.tile(jnp.arange(GRID_W, dtype=jnp.float32), rows)
    inv_freq = ROPE_THETA ** (-jnp.arange(n_freq, dtype=jnp.float32) / n_freq)
    ang = jnp.stack([row[:, None] * inv_freq, col[:, None] * inv_freq], axis=1)
    return jnp.cos(ang), jnp.sin(ang)


def apply_axial_rope(x, cos, sin):
    n_freq = MLA_ROPE // 4
    xs = x.astype(jnp.float32).reshape(x.shape[:-1] + (2, 2, n_freq))
    a, b = xs[..., 0, :], xs[..., 1, :]
    out = jnp.stack([a * cos - b * sin, a * sin + b * cos], axis=-2)
    return out.reshape(x.shape).astype(x.dtype)


def rwkv_prepare(h, cols, v_first, lp):
    B, L, _ = h.shape
    f32 = jnp.float32
    u = dwconv(cols, lp['rw_conv'], lp['rw_conv_b'], SHIFT_WIDTH // 2)
    splits = np.cumsum([RWKV_WIDTH, RWKV_WIDTH, RWKV_WIDTH, N_DIR * DECAY_LORA, N_DIR * ICLR_LORA]).tolist()
    r, k, v, wd, ad, gd = jnp.split(u, splits, axis=-1)
    wd = wd.reshape(B, L, N_DIR, DECAY_LORA)
    ad = ad.reshape(B, L, N_DIR, ICLR_LORA)
    z_w = lp['rw_w0'] + jnp.einsum('blde,dec->bldc', jnp.tanh(wd), lp['rw_w_up'])
    decay = jnp.exp(-DECAY_SCALE * jax.nn.sigmoid(z_w.astype(f32)))
    iclr = jax.nn.sigmoid((lp['rw_a0'] + jnp.einsum('blde,dec->bldc', ad, lp['rw_a_up'])).astype(f32))
    g = jax.nn.sigmoid(gd) @ lp['rw_g_up']
    if v_first is not None:
        mix = jax.nn.sigmoid(lp['rw_v0'] + (h @ lp['rw_v_down']) @ lp['rw_v_up'])
        v = v + (v_first - v) * mix
    heads = lambda t: t.reshape(t.shape[:-1] + (RWKV_HEADS, RWKV_HEAD_DIM))
    kk = heads(k * lp['rw_k_k']).astype(f32)
    kk = kk * lax.rsqrt(jnp.maximum(jnp.sum(kk * kk, axis=-1, keepdims=True), 1e-24))
    k_dir = heads(k[:, :, None].astype(f32) * (1.0 + (iclr - 1.0) * lp['rw_k_a']))
    b_dir = kk[:, :, None] * heads(iclr)
    return heads(r).astype(f32), heads(decay), k_dir, heads(v).astype(f32), -kk, b_dir, g, v


def rwkv_scan(state0, decay, k, v, a_in, b_in, r, reverse):
    def step(S, inp):
        w_t, k_t, v_t, a_t, b_t = inp[:5]
        sa = jnp.einsum('bhvk,bhk->bhv', S, a_t)
        S = S * w_t[:, :, None, :] + sa[..., None] * b_t[:, :, None, :] + v_t[..., None] * k_t[:, :, None, :]
        y = jnp.einsum('bhvk,bhk->bhv', S, inp[5]) if len(inp) == 6 else None
        return S, y
    xs = (decay, k, v, a_in, b_in) + (() if r is None else (r,))
    S, ys = lax.scan(step, state0, tuple(jnp.moveaxis(t, 1, 0) for t in xs), reverse=reverse)
    return S, (None if r is None else jnp.moveaxis(ys, 0, 1))


def rwkv_output(y, r, k_dir, v, g, lp):
    B, L = y.shape[:2]
    mu = jnp.mean(y, axis=-1, keepdims=True)
    var = jnp.mean(jnp.square(y - mu), axis=-1, keepdims=True)
    yn = ((y - mu) * lax.rsqrt(var + GN_EPS)).reshape(B, L, RWKV_WIDTH) * lp['rw_ln_g'] + lp['rw_ln_b']
    coef = jnp.sum(jnp.sum(r[:, :, None] * k_dir * lp['rw_r_k'], axis=-1, keepdims=True), axis=2)
    out = (yn + (coef * v).reshape(B, L, RWKV_WIDTH)) * g
    return out.astype(g.dtype)


def rwkv_mixer(h_ctx, cols_ctx, h_lat, cols_lat, vf_ctx, vf_lat, lp, emit_ctx):
    rc, wc, kc, vc, ac, bc, gc, v_ctx = rwkv_prepare(h_ctx, cols_ctx, vf_ctx, lp)
    rl, wl, kl, vl, al, bl, gl, v_lat = rwkv_prepare(h_lat, cols_lat, vf_lat, lp)
    state0 = jnp.zeros((h_lat.shape[0], RWKV_HEADS, RWKV_HEAD_DIM, RWKV_HEAD_DIM), jnp.float32)
    ys_c, ys_l = [], []
    for d in range(N_DIR):
        rev = d == 1
        S_c, y_c = rwkv_scan(state0, wc[:, :, d], kc[:, :, d], vc, ac, bc[:, :, d], rc if emit_ctx else None, rev)
        _, y_l = rwkv_scan(S_c, wl[:, :, d], kl[:, :, d], vl, al, bl[:, :, d], rl, rev)
        ys_c.append(y_c)
        ys_l.append(y_l)
    out_lat = rwkv_output(ys_l[0] + ys_l[1], rl, kl, vl, gl, lp)
    out_ctx = rwkv_output(ys_c[0] + ys_c[1], rc, kc, vc, gc, lp) if emit_ctx else None
    return out_ctx, out_lat, v_ctx, v_lat


def lru_prepare(x_cols, lp):
    B, L, _ = x_cols.shape
    f32 = jnp.float32
    xb = dwconv(x_cols, lp['lru_conv'], lp['lru_conv_b'], LRU_CONV_LEFT)
    xh = xb.reshape(B, L, LRU_BLOCKS, LRU_BLOCK_DIM)
    def block_diag(w, b):
        return jnp.einsum('blhi,dhij->bldhj', xh, w).reshape(B, L, N_DIR, LRU_WIDTH) + b
    gate_r = jax.nn.sigmoid(block_diag(lp['lru_wa'], lp['lru_ba']).astype(f32))
    gate_i = jax.nn.sigmoid(block_diag(lp['lru_wx'], lp['lru_bx']).astype(f32))
    log_a = -LRU_C * gate_r * jax.nn.softplus(-lp['lru_lambda'].astype(f32))
    a = jnp.exp(log_a)
    b = jnp.sqrt(-jnp.expm1(2.0 * log_a)) * gate_i * xb[:, :, None].astype(f32)
    return a, b


def linear_scan(a, b, h0, reverse):
    def combine(e1, e2):
        return e1[0] * e2[0], e2[0] * e1[1] + e2[1]
    a_cum, b_cum = lax.associative_scan(combine, (a, b), reverse=reverse, axis=1)
    return a_cum * h0[:, None] + b_cum


def lru_mixer(cols_ctx, cols_lat, lp, emit_ctx):
    x_c, gate_c = jnp.split(cols_ctx, 2, axis=-1)
    x_l, gate_l = jnp.split(cols_lat, 2, axis=-1)
    a_c, b_c = lru_prepare(x_c, lp)
    a_l, b_l = lru_prepare(x_l, lp)
    h0 = jnp.zeros((cols_ctx.shape[0], LRU_WIDTH), jnp.float32)
    hs_c, hs_l = [], []
    for d in range(N_DIR):
        rev = d == 1
        h_c = linear_scan(a_c[:, :, d], b_c[:, :, d], h0, rev)
        h_end = h_c[:, 0] if rev else h_c[:, -1]
        hs_l.append(linear_scan(a_l[:, :, d], b_l[:, :, d], h_end, rev))
        hs_c.append(h_c)
    out_lat = ((hs_l[0] + hs_l[1]) * jax.nn.gelu(gate_l.astype(jnp.float32))).astype(cols_lat.dtype)
    out_ctx = None
    if emit_ctx:
        out_ctx = ((hs_c[0] + hs_c[1]) * jax.nn.gelu(gate_c.astype(jnp.float32))).astype(cols_ctx.dtype)
    return out_ctx, out_lat


def mla_attend(q_nope, q_rope, k_nope, k_rope, v):
    s = (jnp.einsum('bqhd,bkhd->bhqk', q_nope, k_nope)
         + jnp.einsum('bqhr,bkr->bhqk', q_rope, k_rope)).astype(jnp.float32) * MLA_SCALE
    p = jax.nn.softmax(s, axis=-1).astype(v.dtype)
    return jnp.einsum('bhqk,bkhd->bqhd', p, v)


def blocked_attention(q_nope, q_rope, k_nope, k_rope, v):
    B, L = q_nope.shape[:2]
    n_blocks = L // Q_BLOCK
    def blocks(t):
        return jnp.moveaxis(t.reshape((B, n_blocks, Q_BLOCK) + t.shape[2:]), 1, 0)
    out = lax.map(lambda qb: mla_attend(qb[0], qb[1], k_nope, k_rope, v), (blocks(q_nope), blocks(q_rope)))
    return jnp.moveaxis(out, 0, 1).reshape(B, L, MLA_WIDTH)


def mla_mixer(cols_ctx, cols_lat, lp, cos, sin, emit_ctx):
    def project(cols, with_q):
        B, L, _ = cols.shape
        p_q, c_kv, k_rope = jnp.split(cols, [MLA_Q_RANK, MLA_Q_RANK + MLA_KV_RANK], axis=-1)
        kv = (rms_norm(c_kv, lp['mla_kv_norm']) @ lp['mla_w_kvb']).reshape(B, L, MLA_HEADS, MLA_NOPE + MLA_V)
        k_nope, v = kv[..., :MLA_NOPE], kv[..., MLA_NOPE:]
        if not with_q:
            return None, None, k_nope, k_rope, v
        q = (rms_norm(p_q, lp['mla_q_norm']) @ lp['mla_w_qb']).reshape(B, L, MLA_HEADS, MLA_NOPE + MLA_ROPE)
        return q[..., :MLA_NOPE], q[..., MLA_NOPE:], k_nope, k_rope, v
    qn_c, qr_c, kn_c, kr_c, v_c = project(cols_ctx, emit_ctx)
    qn_l, qr_l, kn_l, kr_l, v_l = project(cols_lat, True)
    qr_l = apply_axial_rope(qr_l, cos[:, None], sin[:, None])
    kr_l = apply_axial_rope(kr_l, cos, sin)
    out_lat = blocked_attention(qn_l, qr_l,
                                jnp.concatenate([kn_c, kn_l], axis=1),
                                jnp.concatenate([kr_c, kr_l], axis=1),
                                jnp.concatenate([v_c, v_l], axis=1))
    out_ctx = None
    if emit_ctx:
        B, Lc = cols_ctx.shape[:2]
        out_ctx = mla_attend(qn_c, qr_c, kn_c, kr_c, v_c).reshape(B, Lc, MLA_WIDTH)
    return out_ctx, out_lat


def conv_ffn(h, lp):
    gate = dwconv(h @ lp['ffn_w_gate'], lp['ffn_conv'], lp['ffn_conv_b'], FFN_CONV_WIDTH // 2)
    return (jax.nn.silu(gate) * (h @ lp['ffn_w_up'])) @ lp['ffn_w_down']


def setup_inputs(seed: int = 0) -> dict:
    f32 = jnp.float32
    keys = iter(jax.random.split(jax.random.key(seed), 64))
    def normal(shape, scale):
        return jax.random.normal(next(keys), shape, f32) * scale
    def gain(shape):
        return 1.0 + normal(shape, 0.05)
    def uniform(shape, lo, hi):
        return jax.random.uniform(next(keys), shape, f32, lo, hi)
    nv = max(DEPTH - 1, 0)
    lam_u = uniform((DEPTH, N_DIR, LRU_WIDTH), LRU_A_MIN ** (1.0 / LRU_C), LRU_A_MAX ** (1.0 / LRU_C))
    return {
        'x': normal((BATCH, SEQ, D_MODEL), 1.0),
        'c': normal((BATCH, D_MODEL), 1.0),
        'ctx': normal((BATCH, CTX_LEN, D_MODEL), 1.0),
        'c_ctx': normal((D_MODEL,), 1.0),
        'ada_w': normal((DEPTH, D_MODEL, 6 * D_MODEL), 0.5 * D_MODEL ** -0.5),
        'ada_b': normal((DEPTH, 6 * D_MODEL), 0.01),
        'norm1': gain((DEPTH, D_MODEL)),
        'norm2': gain((DEPTH, D_MODEL)),
        'w_in': normal((DEPTH, D_MODEL, IN_COLS), D_MODEL ** -0.5),
        'w_out': normal((DEPTH, MIX_WIDTH, D_MODEL), MIX_WIDTH ** -0.5),
        'rw_conv': normal((DEPTH, SHIFT_WIDTH, RWKV_COLS), SHIFT_WIDTH ** -0.5),
        'rw_conv_b': normal((DEPTH, RWKV_COLS), 0.01),
        'rw_w0': uniform((DEPTH, N_DIR, RWKV_WIDTH), -6.0, 1.0),
        'rw_w_up': normal((DEPTH, N_DIR, DECAY_LORA, RWKV_WIDTH), 0.5 * DECAY_LORA ** -0.5),
        'rw_a0': normal((DEPTH, N_DIR, RWKV_WIDTH), 0.5),
        'rw_a_up': normal((DEPTH, N_DIR, ICLR_LORA, RWKV_WIDTH), 0.5 * ICLR_LORA ** -0.5),
        'rw_g_up': normal((DEPTH, GATE_LORA, RWKV_WIDTH), GATE_LORA ** -0.5),
        'rw_k_k': 0.85 + normal((DEPTH, RWKV_WIDTH), 0.05),
        'rw_k_a': gain((DEPTH, RWKV_WIDTH)),
        'rw_r_k': normal((DEPTH, RWKV_HEADS, RWKV_HEAD_DIM), 0.1),
        'rw_ln_g': gain((DEPTH, RWKV_WIDTH)),
        'rw_ln_b': normal((DEPTH, RWKV_WIDTH), 0.01),
        'rw_v0': normal((nv, RWKV_WIDTH), 0.5),
        'rw_v_down': normal((nv, D_MODEL, VRES_LORA), D_MODEL ** -0.5),
        'rw_v_up': normal((nv, VRES_LORA, RWKV_WIDTH), 0.5 * VRES_LORA ** -0.5),
        'lru_conv': normal((DEPTH, LRU_CONV_WIDTH, LRU_WIDTH), LRU_CONV_WIDTH ** -0.5),
        'lru_conv_b': normal((DEPTH, LRU_WIDTH), 0.01),
        'lru_wa': normal((DEPTH, N_DIR, LRU_BLOCKS, LRU_BLOCK_DIM, LRU_BLOCK_DIM), LRU_BLOCK_DIM ** -0.5),
        'lru_ba': normal((DEPTH, N_DIR, LRU_WIDTH), 0.01),
        'lru_wx': normal((DEPTH, N_DIR, LRU_BLOCKS, LRU_BLOCK_DIM, LRU_BLOCK_DIM), LRU_BLOCK_DIM ** -0.5),
        'lru_bx': normal((DEPTH, N_DIR, LRU_WIDTH), 0.01),
        'lru_lambda': jnp.log(lam_u) - jnp.log1p(-lam_u),
        'mla_q_norm': gain((DEPTH, MLA_Q_RANK)),
        'mla_w_qb': normal((DEPTH, MLA_Q_RANK, MLA_HEADS * (MLA_NOPE + MLA_ROPE)), MLA_Q_RANK ** -0.5),
        'mla_kv_norm': gain((DEPTH, MLA_KV_RANK)),
        'mla_w_kvb': normal((DEPTH, MLA_KV_RANK, MLA_HEADS * (MLA_NOPE + MLA_V)), MLA_KV_RANK ** -0.5),
        'ffn_w_gate': normal((DEPTH, D_MODEL, D_FF), D_MODEL ** -0.5),
        'ffn_w_up': normal((DEPTH, D_MODEL, D_FF), D_MODEL ** -0.5),
        'ffn_conv': normal((DEPTH, FFN_CONV_WIDTH, D_FF), FFN_CONV_WIDTH ** -0.5),
        'ffn_conv_b': normal((DEPTH, D_FF), 0.01),
        'ffn_w_down': normal((DEPTH, D_FF, D_MODEL), D_FF ** -0.5),
        'final_norm': gain((D_MODEL,)),
    }


def reference(x, c, ctx, c_ctx, ada_w, ada_b, norm1, norm2, w_in, w_out,
              rw_conv, rw_conv_b, rw_w0, rw_w_up, rw_a0, rw_a_up, rw_g_up, rw_k_k, rw_k_a, rw_r_k,
              rw_ln_g, rw_ln_b, rw_v0, rw_v_down, rw_v_up,
              lru_conv, lru_conv_b, lru_wa, lru_ba, lru_wx, lru_bx, lru_lambda,
              mla_q_norm, mla_w_qb, mla_kv_norm, mla_w_kvb,
              ffn_w_gate, ffn_w_up, ffn_conv, ffn_conv_b, ffn_w_down, final_norm):
    n_tokens = x.shape[1]
    rows = n_tokens // GRID_W
    cos, sin = axial_rope_tables(rows)
    col_splits = [RWKV_COLS, RWKV_COLS + LRU_COLS]
    vf_ctx, vf_lat = None, None
    for i in range(DEPTH):
        lp = {
            'rw_conv': rw_conv[i], 'rw_conv_b': rw_conv_b[i], 'rw_w0': rw_w0[i], 'rw_w_up': rw_w_up[i],
            'rw_a0': rw_a0[i], 'rw_a_up': rw_a_up[i], 'rw_g_up': rw_g_up[i], 'rw_k_k': rw_k_k[i],
            'rw_k_a': rw_k_a[i], 'rw_r_k': rw_r_k[i], 'rw_ln_g': rw_ln_g[i], 'rw_ln_b': rw_ln_b[i],
            'lru_conv': lru_conv[i], 'lru_conv_b': lru_conv_b[i], 'lru_wa': lru_wa[i], 'lru_ba': lru_ba[i],
            'lru_wx': lru_wx[i], 'lru_bx': lru_bx[i], 'lru_lambda': lru_lambda[i],
            'mla_q_norm': mla_q_norm[i], 'mla_w_qb': mla_w_qb[i], 'mla_kv_norm': mla_kv_norm[i],
            'mla_w_kvb': mla_w_kvb[i],
            'ffn_w_gate': ffn_w_gate[i], 'ffn_w_up': ffn_w_up[i], 'ffn_conv': ffn_conv[i],
            'ffn_conv_b': ffn_conv_b[i], 'ffn_w_down': ffn_w_down[i],
        }
        if i > 0:
            lp['rw_v0'] = rw_v0[i - 1]
            lp['rw_v_down'] = rw_v_down[i - 1]
            lp['rw_v_up'] = rw_v_up[i - 1]
        emit_ctx = i < DEPTH - 1
        mod_lat = jax.nn.silu(c) @ ada_w[i] + ada_b[i]
        mod_ctx = jax.nn.silu(c_ctx) @ ada_w[i] + ada_b[i]
        sh1_l, sc1_l, g1_l, sh2_l, sc2_l, g2_l = [m[:, None] for m in jnp.split(mod_lat, 6, axis=-1)]
        sh1_c, sc1_c, g1_c, sh2_c, sc2_c, g2_c = jnp.split(mod_ctx, 6, axis=-1)
        h_lat = modulate(rms_norm(x, norm1[i]), sh1_l, sc1_l)
        h_ctx = modulate(rms_norm(ctx, norm1[i]), sh1_c, sc1_c)
        rw_l, lru_l, mla_l = jnp.split(h_lat @ w_in[i], col_splits, axis=-1)
        rw_c, lru_c, mla_c = jnp.split(h_ctx @ w_in[i], col_splits, axis=-1)
        o_rw_c, o_rw_l, v_c, v_l = rwkv_mixer(h_ctx, rw_c, h_lat, rw_l, vf_ctx, vf_lat, lp, emit_ctx)
        if i == 0:
            vf_ctx, vf_lat = v_c, v_l
        o_lru_c, o_lru_l = lru_mixer(lru_c, lru_l, lp, emit_ctx)
        o_mla_c, o_mla_l = mla_mixer(mla_c, mla_l, lp, cos, sin, emit_ctx)
        x = x + g1_l * (jnp.concatenate([o_rw_l, o_lru_l, o_mla_l], axis=-1) @ w_out[i])
        x = x + g2_l * conv_ffn(modulate(rms_norm(x, norm2[i]), sh2_l, sc2_l), lp)
        if emit_ctx:
            ctx = ctx + g1_c * (jnp.concatenate([o_rw_c, o_lru_c, o_mla_c], axis=-1) @ w_out[i])
            ctx = ctx + g2_c * conv_ffn(modulate(rms_norm(ctx, norm2[i]), sh2_c, sc2_c), lp)
    return rms_norm(x, final_norm)
```

```cpp
#include <hip/hip_runtime.h>
#include <hip/hip_cooperative_groups.h>
#include <cstdio>
#include <cstdint>
namespace pg8 {
#define PG8_LAS __attribute__((address_space(3)))
typedef unsigned short bf16_t;
typedef short bf16x8 __attribute__((ext_vector_type(8)));
typedef float f32x4 __attribute__((ext_vector_type(4)));
typedef unsigned u32x4 __attribute__((ext_vector_type(4)));
constexpr int BM = 256, BK = 64, HALF = 128, HTB = HALF * BK * 2  , STAGE_BYTES = 8 * HTB, NXCD = 8, WGM = 8;

__host__ __device__ __forceinline__ int lds_byte(int r, int c) { const int st = (r >> 4) * 2 + (c >> 5), rr = r & 15, cc = c & 31, ob = rr * 64 + cc * 2; return st * 1024 + (ob ^ (((ob >> 9) & 1) << 5)); }
__host__ __device__ __forceinline__ void stage_rc(int b, int& R, int& C) { const int st = b / 1024, sb = b % 1024, swz = sb ^ (((sb >> 9) & 1) << 5); R = (st >> 1) * 16 + swz / 64; C = (st & 1) * 32 + (swz % 64) / 2; }
__host__ __device__ __forceinline__ int perm32(int rho) { const int n = rho >> 4, i = rho & 15; return 8 * (i >> 2) + 4 * n + (i & 3); }

struct Unit { int pm, pn; };
struct Gemm { const bf16_t* A; const bf16_t* Bt; int M, N, K; };

struct StaticOrder {
    int nM, nN, nwg, G, c;
    __host__ __device__ void init(int M, int N, int G_, int c_) { nM = M / BM; nN = N / BM; nwg = nM * nN; G = G_; c = c_; }
    __host__ __device__ bool next(int i, Unit& u) const {
        const long L = (long)i * G + c; if (L >= nwg) return false;
        int wgid = (int)L; { const int q = nwg / NXCD, r = nwg % NXCD, xcd = wgid % NXCD, off = wgid / NXCD; wgid = (xcd < r ? xcd * (q + 1) : r * (q + 1) + (xcd - r) * q) + off; }
        const int nig = WGM * nN, gid = wgid / nig, fm = gid * WGM, gsz = (nM - fm) < WGM ? (nM - fm) : WGM;
        u.pm = fm + ((wgid % nig) % gsz); u.pn = (wgid % nig) / gsz; return true;
    }
    __device__ __forceinline__ void a_ready(const Unit&) const {}
    __device__ __forceinline__ void done(const Unit&) const {}
};
__device__ __forceinline__ unsigned cvt_pk_bf16(float lo, float hi) { unsigned r; asm volatile("v_cvt_pk_bf16_f32 %0, %1, %2" : "=v"(r) : "v"(lo), "v"(hi)); return r; }
typedef float f32x2 __attribute__((ext_vector_type(2)));
template <class Epi, class Sched, bool STAMP = false>
__device__ __forceinline__ void gemm_phase(PG8_LAS unsigned char* lds, const Gemm g, const Sched& S, const Epi& E, unsigned long long* stamps) {
    const int tid = threadIdx.x, wid = __builtin_amdgcn_readfirstlane(tid >> 6), lane = tid & 63, wr = wid >> 2, wc = wid & 3, fr = lane & 15, fq = lane >> 4;
    const int K = g.K, nt = K / BK;
    int ts_lo = 0, ts_hi = 0, nts = 0; const unsigned long long rt_entry = STAMP ? (unsigned long long)wall_clock64() : 0ull;
#define PG8_STAMP() do { if (STAMP && wid == 0 && nts < 64) { const unsigned long long _c = (unsigned long long)clock64(); \
        ts_lo = (lane == nts) ? (int)(unsigned)_c : ts_lo; ts_hi = (lane == nts) ? (int)(unsigned)(_c >> 32) : ts_hi; ++nts; } } while (0)
    PG8_STAMP();
    unsigned voffA[2], voffB[2];
#pragma unroll
    for (int i = 0; i < 2; ++i) { int R, C; stage_rc(tid * 16 + i * 8192, R, C); const int Rb = Epi::PERM ? ((R & ~31) + perm32(R & 31)) : R;
        voffA[i] = (unsigned)(R * K + C) * 2u; voffB[i] = (unsigned)(Rb * K + C) * 2u; }
    const size_t kstep = (size_t)(BK * 2);
    const size_t hstep = (size_t)HALF * K * 2;
    const size_t tstep = 2 * hstep;
    const unsigned ldsw = (unsigned)wid * 1024u;
    const int aoff = lds_byte(wr * 64 + fr, fq * 8), boff = lds_byte(wc * 32 + fr, fq * 8);
#define PG8_SA(b, h) (((b) * 2 + (h)) * HTB)
#define PG8_SB(b, h) ((4 + (b) * 2 + (h)) * HTB)
#define PG8_STAGE(bufoff, gbase, voff) do { _Pragma("unroll") for (int _i = 0; _i < 2; ++_i) \
        __builtin_amdgcn_global_load_lds((const unsigned*)((const char*)(gbase) + (voff)[_i]), (PG8_LAS unsigned*)(lds + (bufoff) + ldsw + _i * 8192), 16, 0, 0); } while (0)
#define PG8_LDA(dst, b, h) do { _Pragma("unroll") for (int m = 0; m < 4; ++m) _Pragma("unroll") for (int k = 0; k < 2; ++k) dst[m][k] = *(const PG8_LAS bf16x8*)(lds + PG8_SA(b, h) + aoff + m * 2048 + k * 1024); } while (0)
#define PG8_LDB(dst, b, h) do { _Pragma("unroll") for (int n = 0; n < 2; ++n) _Pragma("unroll") for (int k = 0; k < 2; ++k) dst[n][k] = *(const PG8_LAS bf16x8*)(lds + PG8_SB(b, h) + boff + n * 2048 + k * 1024); } while (0)
#define PG8_MMA(ai, bj, At, Bt) do { __builtin_amdgcn_s_setprio(1); _Pragma("unroll") for (int m = 0; m < 4; ++m) _Pragma("unroll") for (int n = 0; n < 2; ++n) _Pragma("unroll") for (int k = 0; k < 2; ++k) \
        acc[ai][bj][m][n] = __builtin_amdgcn_mfma_f32_16x16x32_bf16(Bt[n][k], At[m][k], acc[ai][bj][m][n], 0, 0, 0); __builtin_amdgcn_s_setprio(0); } while (0)
#define PG8_WAIT_V(n) asm volatile("s_waitcnt vmcnt(" #n ")" ::: "memory")
#define PG8_WAIT_L(n) asm volatile("s_waitcnt lgkmcnt(" #n ")" ::: "memory")
#define PG8_BAR __builtin_amdgcn_s_barrier()
#define PG8_SCHED __builtin_amdgcn_sched_barrier(0)
    Unit cur, nxt; int ui = 0;
    if (!S.next(0, cur)) return;
    f32x4 acc[2][2][4][2];
#pragma unroll
    for (int a = 0; a < 2; ++a)
#pragma unroll
        for (int b = 0; b < 2; ++b)
#pragma unroll
            for (int m = 0; m < 4; ++m)
#pragma unroll
                for (int n = 0; n < 2; ++n) acc[a][b][m][n] = (f32x4){0.f, 0.f, 0.f, 0.f};
    bf16x8 At[4][2], B0[2][2], B1[2][2];
    const char* cA = (const char*)g.A + (size_t)cur.pm * tstep; const char* cB = (const char*)g.Bt + (size_t)cur.pn * tstep;
    S.a_ready(cur);
    PG8_STAGE(PG8_SB(0, 0), cB, voffB); PG8_STAGE(PG8_SA(0, 0), cA, voffA); PG8_STAGE(PG8_SB(0, 1), cB + hstep, voffB); PG8_STAGE(PG8_SA(0, 1), cA + hstep, voffA);
    if (wr == 1) PG8_BAR;
    PG8_WAIT_V(4); PG8_BAR;
    PG8_STAGE(PG8_SB(1, 0), cB + kstep, voffB); PG8_STAGE(PG8_SA(1, 0), cA + kstep, voffA); PG8_STAGE(PG8_SB(1, 1), cB + hstep + kstep, voffB);
    PG8_WAIT_V(6); PG8_BAR;
    PG8_STAMP();
    for (;;) {
        const bool has_next = S.next(ui + 1, nxt);
        const char* nA = has_next ? (const char*)g.A + (size_t)nxt.pm * tstep : cA; const char* nB = has_next ? (const char*)g.Bt + (size_t)nxt.pn * tstep : cB;
        for (int t = 0; t < nt; t += 2) {
            const bool last = (t == nt - 2);
            const char* a1 = cA + (size_t)(t + 1) * kstep;
            const char* a2 = last ? nA : cA + (size_t)(t + 2) * kstep; const char* b2 = last ? nB : cB + (size_t)(t + 2) * kstep;
            const char* a3 = a2 + kstep; const char* b3 = b2 + kstep;
            if (last && has_next) S.a_ready(nxt);
            PG8_LDB(B0, 0, 0); PG8_SCHED; PG8_LDA(At, 0, 0); PG8_STAGE(PG8_SA(1, 1), a1 + hstep, voffA);
            PG8_WAIT_L(8); PG8_BAR; PG8_WAIT_L(0); PG8_MMA(0, 0, At, B0); PG8_BAR; PG8_SCHED;
            PG8_LDB(B1, 0, 1); PG8_STAGE(PG8_SB(0, 0), b2, voffB);
            PG8_BAR; PG8_WAIT_L(0); PG8_MMA(0, 1, At, B1); PG8_BAR;
            PG8_LDA(At, 0, 1); PG8_STAGE(PG8_SA(0, 0), a2, voffA);
            PG8_BAR; PG8_WAIT_L(0); PG8_MMA(1, 0, At, B0); PG8_BAR; PG8_SCHED;
            PG8_STAGE(PG8_SB(0, 1), b2 + hstep, voffB);
            PG8_WAIT_V(6); PG8_BAR; PG8_MMA(1, 1, At, B1); PG8_BAR;
            PG8_LDB(B0, 1, 0); PG8_SCHED; PG8_LDA(At, 1, 0); PG8_STAGE(PG8_SA(0, 1), a2 + hstep, voffA);
            PG8_WAIT_L(8); PG8_BAR; PG8_WAIT_L(0); PG8_MMA(0, 0, At, B0); PG8_BAR; PG8_SCHED;
            PG8_LDB(B1, 1, 1); PG8_STAGE(PG8_SB(1, 0), b3, voffB);
            PG8_BAR; PG8_WAIT_L(0); PG8_MMA(0, 1, At, B1); PG8_BAR;
            PG8_LDA(At, 1, 1); PG8_STAGE(PG8_SA(1, 0), a3, voffA);
            PG8_BAR; PG8_WAIT_L(0); PG8_MMA(1, 0, At, B0); PG8_BAR; PG8_SCHED;
            PG8_STAGE(PG8_SB(1, 1), b3 + hstep, voffB);
            PG8_WAIT_V(6); PG8_BAR; PG8_MMA(1, 1, At, B1); PG8_BAR;
        }
        PG8_STAMP();
        if constexpr (!Epi::AFTER_DRAIN) { E(acc, cur, wr, wc, fr, fq); S.done(cur); }
        PG8_STAMP();
        if (!has_next) break;
#pragma unroll
        for (int a = 0; a < 2; ++a)
#pragma unroll
            for (int b = 0; b < 2; ++b)
#pragma unroll
                for (int m = 0; m < 4; ++m)
#pragma unroll
                    for (int n = 0; n < 2; ++n) acc[a][b][m][n] = (f32x4){0.f, 0.f, 0.f, 0.f};
        cur = nxt; cA = nA; cB = nB; ++ui;
    }
    PG8_WAIT_V(0);
    if (wr == 0) PG8_BAR;
    PG8_BAR;
    if constexpr (Epi::AFTER_DRAIN) { E.fused(acc, cur, wr, wc, fr, fq, lds, wid, lane); S.done(cur); }
    PG8_STAMP();
    if (STAMP && wid == 0) { stamps[lane] = lane < nts ? (((unsigned long long)(unsigned)ts_hi << 32) | (unsigned)ts_lo) : 0ull;
        if (lane == 62) stamps[62] = rt_entry; if (lane == 63) stamps[63] = (unsigned long long)wall_clock64(); }
#undef PG8_STAMP
#undef PG8_SA
#undef PG8_SB
#undef PG8_STAGE
#undef PG8_LDA
#undef PG8_LDB
#undef PG8_MMA
#undef PG8_WAIT_V
#undef PG8_WAIT_L
#undef PG8_BAR
#undef PG8_SCHED
}
}

namespace cg = cooperative_groups;
typedef unsigned short bf16_t;
typedef short bf16x8 __attribute__((ext_vector_type(8)));
typedef short s16x4 __attribute__((ext_vector_type(4)));
typedef float f32x4 __attribute__((ext_vector_type(4)));
typedef float f32x8 __attribute__((ext_vector_type(8)));
typedef float f32x16 __attribute__((ext_vector_type(16)));
typedef unsigned u32x4 __attribute__((ext_vector_type(4)));
typedef unsigned u32x2 __attribute__((ext_vector_type(2)));

constexpr int T = 16640, NCTX = 256, DM = 2048, NTH = 512;
constexpr int NIN = 3840;
constexpr int DFF = 5632, NGU = 2 * DFF;
constexpr int C_LRU = 1760, C_MLA = 2784, C_VD = 3616;
constexpr int RECB = 896;
constexpr int LDS_BYTES = 135168;

constexpr size_t al256(size_t x) { return (x + 255) / 256 * 256; }
constexpr size_t WS_MOD = 0;
constexpr size_t WS_XC = al256(WS_MOD + 2 * 2 * 12288 * 4);
constexpr size_t WS_H = al256(WS_XC + (size_t)NCTX * DM * 4);
constexpr size_t WS_VF = al256(WS_H + (size_t)T * DM * 2);
constexpr size_t WS_WIN = al256(WS_VF + (size_t)T * 512 * 2);
constexpr size_t WS_WOUT = al256(WS_WIN + (size_t)NIN * DM * 2);
constexpr size_t WS_WQ = al256(WS_WOUT + (size_t)DM * DM * 2);
constexpr size_t WS_WKV = al256(WS_WQ + (size_t)1536 * 512 * 2);
constexpr size_t WS_WGU = al256(WS_WKV + (size_t)2048 * 256 * 2);
constexpr size_t WS_WDN = al256(WS_WGU + (size_t)NGU * DM * 2);
constexpr size_t WS_R = al256(WS_WDN + (size_t)DM * DFF * 2);
constexpr size_t WS_COLS = WS_R;
constexpr size_t WS_Q = WS_COLS;
constexpr size_t WS_KV = al256(WS_Q + (size_t)T * 1536 * 2);
constexpr size_t WS_REC = al256(WS_COLS + (size_t)T * NIN * 2);
constexpr size_t WS_Y = al256(WS_REC + (size_t)16 * T * RECB);
constexpr size_t WS_LAB = al256(WS_Y + (size_t)2 * T * 512 * 4);
constexpr size_t WS_GG = al256(WS_LAB + (size_t)T * 2048 * 2);
constexpr size_t WS_QN = al256(WS_GG + (size_t)T * 512 * 2);
constexpr size_t WS_KVN = al256(WS_QN + (size_t)T * 512 * 2);
constexpr size_t WS_KR = al256(WS_KVN + (size_t)T * 256 * 2);
constexpr size_t WS_RG = al256(WS_KR + (size_t)T * 64 * 2);
constexpr size_t WS_CV = al256(WS_RG + (size_t)T * 512 * 2);
constexpr size_t WS_AGG = al256(WS_CV + (size_t)T * 512 * 2);
constexpr size_t WS_MIX_END = al256(WS_AGG + (size_t)260 * 2048 * 4);
constexpr size_t WS_GU = WS_R;
constexpr size_t WS_ACT = al256(WS_GU + (size_t)T * NGU * 2);
constexpr size_t WS_FFN_END = al256(WS_ACT + (size_t)T * DFF * 2);
constexpr size_t WS_END = WS_MIX_END > WS_FFN_END ? WS_MIX_END : WS_FFN_END;
static_assert(WS_KV + (size_t)T * 2048 * 2 <= WS_REC, "Q|KV must fit in the cols buffer");

struct Params { const float* in[42]; float* out; unsigned char* ws; int ph_lo, ph_hi; };

enum { I_X = 0, I_C, I_CTX, I_CCTX, I_ADAW, I_ADAB, I_NORM1, I_NORM2, I_WIN, I_WOUT, I_RWCONV, I_RWCONVB, I_RWW0, I_RWWUP, I_RWA0, I_RWAUP, I_RWGUP,
       I_RWKK, I_RWKA, I_RWRK, I_RWLNG, I_RWLNB, I_RWV0, I_RWVDOWN, I_RWVUP, I_LRUCONV, I_LRUCONVB, I_LRUWA, I_LRUBA, I_LRUWX, I_LRUBX, I_LRULAM,
       I_QNORM, I_WQB, I_KVNORM, I_WKVB, I_WGATE, I_WUP, I_FCONV, I_FCONVB, I_WDOWN, I_FNORM };

__device__ __forceinline__ float bf2f(bf16_t b) { return __uint_as_float(((unsigned)b) << 16); }
__device__ __forceinline__ unsigned cvtpk(float lo, float hi) { unsigned r; asm volatile("v_cvt_pk_bf16_f32 %0, %1, %2" : "=v"(r) : "v"(lo), "v"(hi)); return r; }
__device__ __forceinline__ bf16_t f2bf(float f) { return (bf16_t)(cvtpk(f, 0.f) & 0xffffu); }
__device__ __forceinline__ float sigmoidf_(float x) { return 1.0f / (1.0f + __expf(-x)); }
__device__ __forceinline__ float siluf_(float x) { return x * sigmoidf_(x); }
__device__ __forceinline__ float gelu_tanh(float x) { const float u = 0.7978845608028654f * (x + 0.044715f * x * x * x); return 0.5f * x * (1.0f + tanhf(u)); }
__device__ __forceinline__ float wave_sum(float v) {
#pragma unroll
  for (int o = 32; o >= 1; o >>= 1) v += __shfl_xor(v, o);
  return v;
}
template <int CTRL> __device__ __forceinline__ float dpp_add(float x) {
  const int xi = __float_as_int(x);
  const int yi = __builtin_amdgcn_update_dpp(xi, xi, CTRL, 0xF, 0xF, false);
  return x + __int_as_float(yi);
}
__device__ __forceinline__ float row16_sum(float x) {
  x = dpp_add<0xB1>(x);
  x = dpp_add<0x4E>(x);
  x = dpp_add<0x141>(x);
  x = dpp_add<0x140>(x);
  return x;
}
__device__ __forceinline__ const float* resid_src(const Params& P, int layer, int t) {
  if (layer == 0) return t < NCTX ? P.in[I_CTX] + (size_t)t * DM : P.in[I_X] + (size_t)(t - NCTX) * DM;
  return t < NCTX ? (const float*)(P.ws + WS_XC) + (size_t)t * DM : P.out + (size_t)(t - NCTX) * DM;
}
__device__ __forceinline__ float* resid_dst(const Params& P, int t) {
  return t < NCTX ? (float*)(P.ws + WS_XC) + (size_t)t * DM : P.out + (size_t)(t - NCTX) * DM;
}
__device__ __forceinline__ int scan_pos_rev(int t) { return t < NCTX ? (NCTX - 1 - t) : (T + NCTX - 1 - t); }

__device__ void phase_mod(const Params& P, float* lds) {
  const int tid = threadIdx.x, cgp = tid & 15, rg = tid >> 4;
  float* mod = (float*)(P.ws + WS_MOD);
  for (int item = blockIdx.x; item < 2 * 192; item += gridDim.x) {
    const int layer = item / 192, col0 = (item % 192) * 64;
    const float* W = P.in[I_ADAW] + (size_t)layer * DM * 12288 + col0 + cgp * 4;
    f32x4 al = {0.f, 0.f, 0.f, 0.f}, ac = {0.f, 0.f, 0.f, 0.f};
    for (int r = 0; r < 64; ++r) {
      const int row = rg * 64 + r;
      const f32x4 wv = *(const f32x4*)(W + (size_t)row * 12288);
      const float sl = siluf_(P.in[I_C][row]), sc = siluf_(P.in[I_CCTX][row]);
      al += sl * wv; ac += sc * wv;
    }
#pragma unroll
    for (int i = 0; i < 4; ++i) { lds[(rg * 2 + 0) * 64 + cgp * 4 + i] = al[i]; lds[(rg * 2 + 1) * 64 + cgp * 4 + i] = ac[i]; }
    __syncthreads();
    if (tid < 128) {
      const int which = tid >> 6, col = tid & 63; float s = 0.f;
      for (int g = 0; g < 32; ++g) s += lds[(g * 2 + which) * 64 + col];
      mod[(size_t)(layer * 2 + which) * 12288 + col0 + col] = s + P.in[I_ADAB][(size_t)layer * 12288 + col0 + col];
    }
    __syncthreads();
  }
}

__device__ void cvt_tile(const float* src, bf16_t* dst, int K, int N, int ld, int kt, int ntile, float* lds) {
  const int tid = threadIdx.x, k0 = kt * 64, n0 = ntile * 64;
  const int kr = tid >> 4, nc = (tid & 15) * 4;
#pragma unroll
  for (int i = 0; i < 2; ++i) {
    const int k = kr + 32 * i;
    f32x4 v = {0.f, 0.f, 0.f, 0.f};
    if (n0 + nc < N) v = *(const f32x4*)(src + (size_t)(k0 + k) * ld + n0 + nc);
    lds[(nc + 0) * 65 + k] = v[0]; lds[(nc + 1) * 65 + k] = v[1]; lds[(nc + 2) * 65 + k] = v[2]; lds[(nc + 3) * 65 + k] = v[3];
  }
  __syncthreads();
  const int n = tid >> 3, kc = (tid & 7) * 8;
  if (n0 + n < N) {
    const float* p = lds + n * 65 + kc;
    u32x4 w; w.x = cvtpk(p[0], p[1]); w.y = cvtpk(p[2], p[3]); w.z = cvtpk(p[4], p[5]); w.w = cvtpk(p[6], p[7]);
    *(u32x4*)(dst + (size_t)(n0 + n) * K + k0 + kc) = w;
  }
  __syncthreads();
}

__device__ void phase_convert(const Params& P, int layer, float* lds) {
  const float* src[8]; bf16_t* dst[8]; int K[8], N[8];
  src[0] = P.in[I_WIN] + (size_t)layer * DM * 3616;  dst[0] = (bf16_t*)(P.ws + WS_WIN);                      K[0] = DM;  N[0] = 3616;
  src[1] = P.in[I_RWVDOWN];                           dst[1] = (bf16_t*)(P.ws + WS_WIN) + (size_t)C_VD * DM;  K[1] = DM;  N[1] = (layer == 0) ? 0 : 32;
  src[2] = P.in[I_WOUT] + (size_t)layer * DM * DM;    dst[2] = (bf16_t*)(P.ws + WS_WOUT);                     K[2] = DM;  N[2] = DM;
  src[3] = P.in[I_WQB] + (size_t)layer * 512 * 1536;  dst[3] = (bf16_t*)(P.ws + WS_WQ);                       K[3] = 512; N[3] = 1536;
  src[4] = P.in[I_WKVB] + (size_t)layer * 256 * 2048; dst[4] = (bf16_t*)(P.ws + WS_WKV);                      K[4] = 256; N[4] = 2048;
  src[5] = P.in[I_WGATE] + (size_t)layer * DM * DFF;  dst[5] = (bf16_t*)(P.ws + WS_WGU);                      K[5] = DM;  N[5] = DFF;
  src[6] = P.in[I_WUP] + (size_t)layer * DM * DFF;    dst[6] = (bf16_t*)(P.ws + WS_WGU) + (size_t)DFF * DM;   K[6] = DM;  N[6] = DFF;
  src[7] = P.in[I_WDOWN] + (size_t)layer * DFF * DM;  dst[7] = (bf16_t*)(P.ws + WS_WDN);                      K[7] = DFF; N[7] = DM;
  int base = 0;
#pragma unroll
  for (int j = 0; j < 8; ++j) {
    const int nkt = K[j] / 64, nnt = (N[j] + 63) / 64, nt = nkt * nnt;
    int first = ((int)blockIdx.x - base % (int)gridDim.x + (int)gridDim.x) % (int)gridDim.x;
    for (int tl = first; tl < nt; tl += gridDim.x) cvt_tile(src[j], dst[j], K[j], N[j], N[j], tl % nkt, tl / nkt, lds);
    base += nt;
  }
}

__device__ void phase_norm(const Params& P, int layer, int which, bool skip_ctx) {
  const int lane = threadIdx.x & 63, wave = threadIdx.x >> 6;
  const float* g = P.in[which ? I_NORM2 : I_NORM1] + (size_t)layer * DM;
  const float* mod = (const float*)(P.ws + WS_MOD) + (size_t)layer * 2 * 12288;
  bf16_t* H = (bf16_t*)(P.ws + WS_H);
  const int soff = which ? 6144 : 0;
  for (int row = blockIdx.x * 8 + wave; row < T; row += gridDim.x * 8) {
    if (skip_ctx && row < NCTX) continue;
    const float* xr = (which == 0) ? resid_src(P, layer, row) : (const float*)resid_dst(P, row);
    const float* m = mod + (row < NCTX ? 12288 : 0) + soff;
    f32x4 v[8]; float ss = 0.f;
#pragma unroll
    for (int i = 0; i < 8; ++i) { v[i] = *(const f32x4*)(xr + i * 256 + lane * 4); ss += v[i][0] * v[i][0] + v[i][1] * v[i][1] + v[i][2] * v[i][2] + v[i][3] * v[i][3]; }
    ss = wave_sum(ss);
    const float rstd = rsqrtf(ss * (1.0f / DM) + 1e-6f);
#pragma unroll
    for (int i = 0; i < 8; ++i) {
      const int c = i * 256 + lane * 4;
      const f32x4 gv = *(const f32x4*)(g + c), sh = *(const f32x4*)(m + c), sc = *(const f32x4*)(m + 2048 + c);
      float o[4];
#pragma unroll
      for (int q = 0; q < 4; ++q) o[q] = (v[i][q] * rstd * gv[q]) * (1.0f + sc[q]) + sh[q];
      u32x2 w; w.x = cvtpk(o[0], o[1]); w.y = cvtpk(o[2], o[3]);
      *(u32x2*)(H + (size_t)row * DM + c) = w;
    }
  }
}

__device__ void phase_final_norm(const Params& P) {
  const int lane = threadIdx.x & 63, wave = threadIdx.x >> 6;
  const float* g = P.in[I_FNORM];
  for (int row = blockIdx.x * 8 + wave; row < T - NCTX; row += gridDim.x * 8) {
    float* xr = P.out + (size_t)row * DM;
    f32x4 v[8]; float ss = 0.f;
#pragma unroll
    for (int i = 0; i < 8; ++i) { v[i] = *(const f32x4*)(xr + i * 256 + lane * 4); ss += v[i][0] * v[i][0] + v[i][1] * v[i][1] + v[i][2] * v[i][2] + v[i][3] * v[i][3]; }
    ss = wave_sum(ss);
    const float rstd = rsqrtf(ss * (1.0f / DM) + 1e-6f);
#pragma unroll
    for (int i = 0; i < 8; ++i) { const int c = i * 256 + lane * 4; const f32x4 gv = *(const f32x4*)(g + c); *(f32x4*)(xr + c) = v[i] * rstd * gv; }
  }
}

struct EpiStore {
  static constexpr bool PERM = true, AFTER_DRAIN = false;
  bf16_t* O; int ldc;
  __device__ __forceinline__ void operator()(const f32x4 (&acc)[2][2][4][2], const pg8::Unit& u, int wr, int wc, int fr, int fq) const {
    const int row0 = u.pm * 256 + wr * 64 + fr, col0 = u.pn * 256 + wc * 32 + 8 * fq;
#pragma unroll
    for (int ai = 0; ai < 2; ++ai)
#pragma unroll
      for (int m = 0; m < 4; ++m) { bf16_t* rowp = O + (size_t)(row0 + ai * 128 + m * 16) * ldc + col0;
#pragma unroll
        for (int bj = 0; bj < 2; ++bj) { const f32x4 v0 = acc[ai][bj][m][0], v1 = acc[ai][bj][m][1];
          u32x4 w; w.x = cvtpk(v0[0], v0[1]); w.y = cvtpk(v0[2], v0[3]); w.z = cvtpk(v1[0], v1[1]); w.w = cvtpk(v1[2], v1[3]);
          *(u32x4*)(rowp + bj * 128) = w; } }
  }
};
struct EpiResid {
  static constexpr bool PERM = false, AFTER_DRAIN = false;
  const float* src_c; const float* src_l; float* dst_c; float* dst_l; const float* gate_c; const float* gate_l; int row_off;
  __device__ __forceinline__ void operator()(const f32x4 (&acc)[2][2][4][2], const pg8::Unit& u, int wr, int wc, int fr, int fq) const {
    const int t0 = row_off + u.pm * 256;
    const bool isc = t0 < NCTX;
    const float* src = isc ? src_c : src_l - (size_t)NCTX * DM; float* dst = isc ? dst_c : dst_l - (size_t)NCTX * DM; const float* gate = isc ? gate_c : gate_l;
    const int row0 = t0 + wr * 64 + fr, col0 = u.pn * 256 + wc * 32 + 4 * fq;
    f32x4 gv[2][2];
#pragma unroll
    for (int bj = 0; bj < 2; ++bj)
#pragma unroll
      for (int n = 0; n < 2; ++n) gv[bj][n] = *(const f32x4*)(gate + col0 + bj * 128 + n * 16);
#pragma unroll
    for (int ai = 0; ai < 2; ++ai)
#pragma unroll
      for (int m = 0; m < 4; ++m) { const size_t off = (size_t)(row0 + ai * 128 + m * 16) * DM + col0;
#pragma unroll
        for (int bj = 0; bj < 2; ++bj)
#pragma unroll
          for (int n = 0; n < 2; ++n) { const f32x4 xs = *(const f32x4*)(src + off + bj * 128 + n * 16);
            *(f32x4*)(dst + off + bj * 128 + n * 16) = xs + gv[bj][n] * acc[ai][bj][m][n]; } }
  }
};

template <class Epi>
__device__ __forceinline__ void run_gemm(unsigned char* lds, const bf16_t* A, const bf16_t* Bt, int M, int N, int K, const Epi& E) {
  pg8::Gemm g{A, Bt, M, N, K}; pg8::StaticOrder S; S.init(M, N, (int)gridDim.x, (int)blockIdx.x);
  pg8::gemm_phase<Epi, pg8::StaticOrder, false>((PG8_LAS unsigned char*)lds, g, S, E, nullptr);
}

__device__ __forceinline__ float colv(const bf16_t* cols, int t, int c) { return bf2f(cols[(size_t)t * NIN + c]); }
__device__ __forceinline__ float rwconv3(const bf16_t* cols, const float* cw, const float* cb, int t, int c, int lo, int hi) {
  float u = cb[c] + cw[1760 + c] * colv(cols, t, c);
  if (t - 1 >= lo) u += cw[c] * colv(cols, t - 1, c);
  if (t + 1 < hi) u += cw[2 * 1760 + c] * colv(cols, t + 1, c);
  return u;
}

__device__ void phase_prep(const Params& P, int layer, float* lds) {
  const int tid = threadIdx.x, lane = tid & 63, wave = tid >> 6;
  float* lin = lds;
  float* xs = lds + 8 * 256;
  const bf16_t* cols = (const bf16_t*)(P.ws + WS_COLS);
  const float* cw = P.in[I_RWCONV] + (size_t)layer * 3 * 1760; const float* cb = P.in[I_RWCONVB] + (size_t)layer * 1760;
  const float* lcw = P.in[I_LRUCONV] + (size_t)layer * 4 * 512; const float* lcb = P.in[I_LRUCONVB] + (size_t)layer * 512;
  const int c = tid, hd = c >> 6, n = c & 63;
  bf16_t* VF = (bf16_t*)(P.ws + WS_VF); bf16_t* RG = (bf16_t*)(P.ws + WS_RG); bf16_t* CV = (bf16_t*)(P.ws + WS_CV);
  bf16_t* LAB = (bf16_t*)(P.ws + WS_LAB); bf16_t* GG = (bf16_t*)(P.ws + WS_GG);
  bf16_t* QN = (bf16_t*)(P.ws + WS_QN); bf16_t* KVN = (bf16_t*)(P.ws + WS_KVN); bf16_t* KR = (bf16_t*)(P.ws + WS_KR);
  unsigned char* REC = P.ws + WS_REC;
  const float w0_0 = P.in[I_RWW0][(layer * 2 + 0) * 512 + c], w0_1 = P.in[I_RWW0][(layer * 2 + 1) * 512 + c];
  const float a0_0 = P.in[I_RWA0][(layer * 2 + 0) * 512 + c], a0_1 = P.in[I_RWA0][(layer * 2 + 1) * 512 + c];
  const float kkc = P.in[I_RWKK][layer * 512 + c], kac = P.in[I_RWKA][layer * 512 + c], rkc = P.in[I_RWRK][layer * 512 + c];
  const float v0c = (layer > 0) ? P.in[I_RWV0][c] : 0.f;
  const float* wup = P.in[I_RWWUP] + (size_t)layer * 2 * 32 * 512 + c; const float* aup = P.in[I_RWAUP] + (size_t)layer * 2 * 32 * 512 + c;
  const float* gup = P.in[I_RWGUP] + (size_t)layer * 96 * 512 + c; const float* vup = P.in[I_RWVUP] + c;
  const float* lwa = P.in[I_LRUWA] + (size_t)layer * 2 * 8 * 4096 + (size_t)hd * 4096 + n; const float* lwx = P.in[I_LRUWX] + (size_t)layer * 2 * 8 * 4096 + (size_t)hd * 4096 + n;
  const float lba0 = P.in[I_LRUBA][(layer * 2 + 0) * 512 + c], lba1 = P.in[I_LRUBA][(layer * 2 + 1) * 512 + c];
  const float lbx0 = P.in[I_LRUBX][(layer * 2 + 0) * 512 + c], lbx1 = P.in[I_LRUBX][(layer * 2 + 1) * 512 + c];
  const float lam0 = P.in[I_LRULAM][(layer * 2 + 0) * 512 + c], lam1 = P.in[I_LRULAM][(layer * 2 + 1) * 512 + c];
  const float sp0 = log1pf(__expf(-lam0)), sp1 = log1pf(__expf(-lam1));

  for (int tile = blockIdx.x; tile < T / 8; tile += gridDim.x) {
    const int t0 = tile * 8;
    const int lo = t0 < NCTX ? 0 : NCTX, hi = t0 < NCTX ? NCTX : T;
#pragma unroll
    for (int i = 0; i < 4; ++i) {
      const int idx = tid + 512 * i, tt = idx >> 8, e = idx & 255, t = t0 + tt; float v;
      if (e < 224) { v = rwconv3(cols, cw, cb, t, 1536 + e, lo, hi); if (e < 64) v = tanhf(v); else if (e >= 128) v = sigmoidf_(v); }
      else v = (layer > 0) ? colv(cols, t, C_VD + e - 224) : 0.f;
      lin[tt * 256 + e] = v;
    }
#pragma unroll
    for (int tt = 0; tt < 8; ++tt) {
      const int t = t0 + tt; float u = lcb[c];
#pragma unroll
      for (int j = 0; j < 4; ++j) { const int ts = t + j - 2; if (ts >= lo && ts < hi) u += lcw[j * 512 + c] * colv(cols, ts, C_LRU + c); }
      xs[tt * 512 + c] = u;
    }
    {
      const int t = t0 + wave; const bf16_t* cr = cols + (size_t)t * NIN;
      float q[8]; float ss = 0.f;
      { const bf16x8 raw = *(const bf16x8*)(cr + C_MLA + lane * 8);
#pragma unroll
        for (int i = 0; i < 8; ++i) { q[i] = bf2f((bf16_t)raw[i]); ss += q[i] * q[i]; } }
      ss = wave_sum(ss); float rstd = rsqrtf(ss * (1.0f / 512.0f) + 1e-6f);
      { const float* gq = P.in[I_QNORM] + layer * 512 + lane * 8; u32x4 w;
        w.x = cvtpk(q[0] * rstd * gq[0], q[1] * rstd * gq[1]); w.y = cvtpk(q[2] * rstd * gq[2], q[3] * rstd * gq[3]);
        w.z = cvtpk(q[4] * rstd * gq[4], q[5] * rstd * gq[5]); w.w = cvtpk(q[6] * rstd * gq[6], q[7] * rstd * gq[7]);
        *(u32x4*)(QN + (size_t)t * 512 + lane * 8) = w; }
      float k4[4]; ss = 0.f;
      { const s16x4 raw = *(const s16x4*)(cr + C_MLA + 512 + lane * 4);
#pragma unroll
        for (int i = 0; i < 4; ++i) { k4[i] = bf2f((bf16_t)raw[i]); ss += k4[i] * k4[i]; } }
      ss = wave_sum(ss); rstd = rsqrtf(ss * (1.0f / 256.0f) + 1e-6f);
      { const float* gk = P.in[I_KVNORM] + layer * 256 + lane * 4; u32x2 w;
        w.x = cvtpk(k4[0] * rstd * gk[0], k4[1] * rstd * gk[1]); w.y = cvtpk(k4[2] * rstd * gk[2], k4[3] * rstd * gk[3]);
        *(u32x2*)(KVN + (size_t)t * 256 + lane * 4) = w; }
      const float own = bf2f(cr[C_MLA + 768 + lane]); const float oth = __shfl_xor(own, 16);
      float res = own;
      if (t >= NCTX) {
        const int tl = t - NCTX, axis = lane >> 5, half = (lane >> 4) & 1, f = lane & 15;
        const float pos = (float)(axis == 0 ? (tl >> 6) : (tl & 63));
        const float inv = exp2f(-(float)f * (13.287712379549449f / 16.0f));
        const float sn = __sinf(pos * inv), cs = __cosf(pos * inv);
        res = half == 0 ? own * cs - oth * sn : oth * sn + own * cs;
      }
      KR[(size_t)t * 64 + lane] = f2bf(res);
    }
    __syncthreads();
    {
      float zw0[8], zw1[8], za0[8], za1[8], gg[8], mx[8];
#pragma unroll
      for (int tt = 0; tt < 8; ++tt) { zw0[tt] = 0.f; zw1[tt] = 0.f; za0[tt] = 0.f; za1[tt] = 0.f; gg[tt] = 0.f; mx[tt] = 0.f; }
#pragma unroll 1
      for (int e = 0; e < 32; e += 4) {
        float wa[4], wb[4], aa[4], ab[4], vv[4];
#pragma unroll
        for (int i = 0; i < 4; ++i) { wa[i] = wup[(size_t)(e + i) * 512]; wb[i] = wup[(size_t)(32 + e + i) * 512]; aa[i] = aup[(size_t)(e + i) * 512]; ab[i] = aup[(size_t)(32 + e + i) * 512];
          vv[i] = (layer > 0) ? vup[(size_t)(e + i) * 512] : 0.f; }
#pragma unroll
        for (int tt = 0; tt < 8; ++tt) {
          const f32x4 x0 = *(const f32x4*)(lin + tt * 256 + e), x1 = *(const f32x4*)(lin + tt * 256 + 32 + e), y0 = *(const f32x4*)(lin + tt * 256 + 64 + e),
                      y1 = *(const f32x4*)(lin + tt * 256 + 96 + e), hv = *(const f32x4*)(lin + tt * 256 + 224 + e);
#pragma unroll
          for (int i = 0; i < 4; ++i) { zw0[tt] += x0[i] * wa[i]; zw1[tt] += x1[i] * wb[i]; za0[tt] += y0[i] * aa[i]; za1[tt] += y1[i] * ab[i]; mx[tt] += hv[i] * vv[i]; }
        }
      }
#pragma unroll 1
      for (int e = 0; e < 96; e += 4) {
        float gw[4];
#pragma unroll
        for (int i = 0; i < 4; ++i) gw[i] = gup[(size_t)(e + i) * 512];
#pragma unroll
        for (int tt = 0; tt < 8; ++tt) { const f32x4 s = *(const f32x4*)(lin + tt * 256 + 128 + e);
#pragma unroll
          for (int i = 0; i < 4; ++i) gg[tt] += s[i] * gw[i]; }
      }
#pragma unroll
      for (int tt = 0; tt < 8; ++tt) {
        const int t = t0 + tt;
        const float r = rwconv3(cols, cw, cb, t, c, lo, hi), k = rwconv3(cols, cw, cb, t, 512 + c, lo, hi); float v = rwconv3(cols, cw, cb, t, 1024 + c, lo, hi);
        const float wd0 = __expf(-0.606531f * sigmoidf_(w0_0 + zw0[tt])), wd1 = __expf(-0.606531f * sigmoidf_(w0_1 + zw1[tt]));
        const float ic0 = sigmoidf_(a0_0 + za0[tt]), ic1 = sigmoidf_(a0_1 + za1[tt]);
        if (layer > 0) { const float mixv = sigmoidf_(v0c + mx[tt]); const float vf = bf2f(VF[(size_t)t * 512 + c]); v = v + (vf - v) * mixv; }
        else VF[(size_t)t * 512 + c] = f2bf(v);
        float kk = k * kkc; const float ssq = wave_sum(kk * kk); kk *= rsqrtf(fmaxf(ssq, 1e-24f));
        const float kd0 = k * (1.0f + (ic0 - 1.0f) * kac), kd1 = k * (1.0f + (ic1 - 1.0f) * kac);
        const float b0 = kk * ic0, b1 = kk * ic1;
        const float coef = wave_sum(r * (kd0 + kd1) * rkc);
        RG[(size_t)t * 512 + c] = f2bf(gg[tt]); CV[(size_t)t * 512 + c] = f2bf(coef * v);
        const bf16_t ab_ = f2bf(-kk), rb_ = f2bf(r), vb_ = f2bf(v);
        { unsigned char* rp = REC + ((size_t)(0 * 8 + hd) * T + t) * RECB;
          ((float*)rp)[n] = wd0; bf16_t* q = (bf16_t*)(rp + 256); q[n] = f2bf(kd0); q[64 + n] = ab_; q[128 + n] = f2bf(b0); q[192 + n] = rb_; q[256 + n] = vb_; }
        { unsigned char* rp = REC + ((size_t)(1 * 8 + hd) * T + scan_pos_rev(t)) * RECB;
          ((float*)rp)[n] = wd1; bf16_t* q = (bf16_t*)(rp + 256); q[n] = f2bf(kd1); q[64 + n] = ab_; q[128 + n] = f2bf(b1); q[192 + n] = rb_; q[256 + n] = vb_; }
        asm volatile("" ::: "memory");
      }
    }
    {
      float pa0[8], pa1[8], px0[8], px1[8];
#pragma unroll
      for (int tt = 0; tt < 8; ++tt) { pa0[tt] = 0.f; pa1[tt] = 0.f; px0[tt] = 0.f; px1[tt] = 0.f; }
#pragma unroll 1
      for (int i0 = 0; i0 < 64; i0 += 4) {
        float a0w[4], a1w[4], x0w[4], x1w[4];
#pragma unroll
        for (int i = 0; i < 4; ++i) { a0w[i] = lwa[(size_t)(i0 + i) * 64]; a1w[i] = lwa[(size_t)8 * 4096 + (size_t)(i0 + i) * 64]; x0w[i] = lwx[(size_t)(i0 + i) * 64]; x1w[i] = lwx[(size_t)8 * 4096 + (size_t)(i0 + i) * 64]; }
#pragma unroll
        for (int tt = 0; tt < 8; ++tt) { const f32x4 x = *(const f32x4*)(xs + tt * 512 + hd * 64 + i0);
#pragma unroll
          for (int i = 0; i < 4; ++i) { pa0[tt] += x[i] * a0w[i]; pa1[tt] += x[i] * a1w[i]; px0[tt] += x[i] * x0w[i]; px1[tt] += x[i] * x1w[i]; } }
      }
#pragma unroll
      for (int tt = 0; tt < 8; ++tt) {
        const int t = t0 + tt; const float xb = xs[tt * 512 + c];
        const float la0 = -8.0f * sigmoidf_(pa0[tt] + lba0) * sp0, la1 = -8.0f * sigmoidf_(pa1[tt] + lba1) * sp1;
        const float bb0 = sqrtf(fmaxf(-expm1f(2.0f * la0), 0.f)) * sigmoidf_(px0[tt] + lbx0) * xb;
        const float bb1 = sqrtf(fmaxf(-expm1f(2.0f * la1), 0.f)) * sigmoidf_(px1[tt] + lbx1) * xb;
        bf16_t* lp = LAB + (size_t)t * 2048;
        lp[c] = f2bf(la0); lp[512 + c] = f2bf(bb0); lp[1024 + c] = f2bf(la1); lp[1536 + c] = f2bf(bb1);
        GG[(size_t)t * 512 + c] = f2bf(gelu_tanh(colv(cols, t, C_LRU + 512 + c)));
        asm volatile("" ::: "memory");
      }
    }
    __syncthreads();
  }
}

__device__ void phase_lru_agg(const Params& P) {
  const int c = threadIdx.x; const bf16_t* LAB = (const bf16_t*)(P.ws + WS_LAB); float* AGG = (float*)(P.ws + WS_AGG);
  for (int ck = blockIdx.x; ck < T / 64; ck += gridDim.x) {
    float A0 = 1.f, B0 = 0.f, A1 = 1.f, B1 = 0.f;
    for (int tt = 0; tt < 64; ++tt) {
      const bf16_t* lp = LAB + (size_t)(ck * 64 + tt) * 2048;
      const float a0 = __expf(bf2f(lp[c])), b0 = bf2f(lp[512 + c]), a1 = __expf(bf2f(lp[1024 + c])), b1 = bf2f(lp[1536 + c]);
      A0 = a0 * A0; B0 = a0 * B0 + b0;
      B1 = B1 + A1 * b1; A1 = A1 * a1;
    }
    float* ap = AGG + (size_t)ck * 2048; ap[c] = A0; ap[512 + c] = B0; ap[1024 + c] = A1; ap[1536 + c] = B1;
  }
}
__device__ void phase_lru_out(const Params& P, int layer, float* lds) {
  const int c = threadIdx.x; const bf16_t* LAB = (const bf16_t*)(P.ws + WS_LAB); const float* AGG = (const float*)(P.ws + WS_AGG);
  const bf16_t* GG = (const bf16_t*)(P.ws + WS_GG); bf16_t* MIX = (bf16_t*)(P.ws + WS_H);
  const int ck_lo = (layer == 1) ? 4 : 0;
  for (int ck = ck_lo + blockIdx.x; ck < T / 64; ck += gridDim.x) {
    float h0 = 0.f, h1 = 0.f;
#pragma unroll 4
    for (int q = 0; q < ck; ++q) { const float* ap = AGG + (size_t)q * 2048; h0 = ap[c] * h0 + ap[512 + c]; }
    if (ck < 4) {
      for (int q = 3; q > ck; --q) { const float* ap = AGG + (size_t)q * 2048; h1 = ap[1024 + c] * h1 + ap[1536 + c]; }
    } else {
      for (int q = 3; q >= 0; --q) { const float* ap = AGG + (size_t)q * 2048; h1 = ap[1024 + c] * h1 + ap[1536 + c]; }
#pragma unroll 4
      for (int q = T / 64 - 1; q > ck; --q) { const float* ap = AGG + (size_t)q * 2048; h1 = ap[1024 + c] * h1 + ap[1536 + c]; }
    }
    for (int tt = 0; tt < 64; ++tt) { const bf16_t* lp = LAB + (size_t)(ck * 64 + tt) * 2048; h0 = __expf(bf2f(lp[c])) * h0 + bf2f(lp[512 + c]); lds[tt * 512 + c] = h0; }
    for (int tt = 63; tt >= 0; --tt) { const int t = ck * 64 + tt; const bf16_t* lp = LAB + (size_t)t * 2048; h1 = __expf(bf2f(lp[1024 + c])) * h1 + bf2f(lp[1536 + c]);
      MIX[(size_t)t * DM + 512 + c] = f2bf((lds[tt * 512 + c] + h1) * bf2f(GG[(size_t)t * 512 + c])); }
  }
}

__device__ void rwkv_scan(const Params& P, int s, float* lds) {
  const int d = s >> 4, h = (s >> 1) & 7, half = s & 1;
  const int tid = threadIdx.x, lane = tid & 63, wave = tid >> 6, rgp = lane >> 4, j = lane & 15, row = half * 32 + wave * 4 + rgp;
  const unsigned char* rec = P.ws + WS_REC + (size_t)(d * 8 + h) * T * RECB;
  float* Y = (float*)(P.ws + WS_Y) + (size_t)d * T * 512 + h * 64 + row;
  int goff[4], loff[4]; bool isw[4], val[4];
#pragma unroll
  for (int i = 0; i < 4; ++i) { const int q = tid + 512 * i; val[i] = q < 1792; const int rc = q / 56, pr = q % 56; goff[i] = rc * RECB + pr * 16; isw[i] = pr < 16;
    loff[i] = rc * 384 + (isw[i] ? pr * 4 : 64 + ((pr - 16) >> 3) * 64 + ((pr - 16) & 7) * 8); }
  u32x4 st[4];
#define RS_LOAD(ch) do { _Pragma("unroll") for (int i = 0; i < 4; ++i) if (val[i]) st[i] = *(const u32x4*)(rec + (size_t)(ch) * 32 * RECB + goff[i]); } while (0)
#define RS_WRITE(buf) do { _Pragma("unroll") for (int i = 0; i < 4; ++i) if (val[i]) { float* dp = (buf) + loff[i]; \
    if (isw[i]) { *(u32x4*)dp = st[i]; } else { u32x4 lo_, hi_; lo_.x = st[i].x << 16; lo_.y = st[i].x & 0xffff0000u; lo_.z = st[i].y << 16; lo_.w = st[i].y & 0xffff0000u; \
      hi_.x = st[i].z << 16; hi_.y = st[i].z & 0xffff0000u; hi_.z = st[i].w << 16; hi_.w = st[i].w & 0xffff0000u; *(u32x4*)dp = lo_; *(u32x4*)(dp + 4) = hi_; } } } while (0)
  f32x4 S = {0.f, 0.f, 0.f, 0.f}; float ykeep = 0.f;
  constexpr int NCH = T / 32;
  RS_LOAD(0); RS_WRITE(lds); __syncthreads();
  for (int ch = 0; ch < NCH; ++ch) {
    if (ch + 1 < NCH) RS_LOAD(ch + 1);
    const float* buf = lds + (ch & 1) * 12288;
#pragma unroll 4
    for (int stp = 0; stp < 32; ++stp) {
      const float* sp = buf + stp * 384;
      const f32x4 w4 = *(const f32x4*)(sp + j * 4), kd4 = *(const f32x4*)(sp + 64 + j * 4), a4 = *(const f32x4*)(sp + 128 + j * 4),
                  b4 = *(const f32x4*)(sp + 192 + j * 4), r4 = *(const f32x4*)(sp + 256 + j * 4);
      const float v = sp[320 + row];
      float sa = S[0] * a4[0] + S[1] * a4[1] + S[2] * a4[2] + S[3] * a4[3];
      sa = row16_sum(sa);
      S = S * w4 + (sa * b4 + v * kd4);
      float y = S[0] * r4[0] + S[1] * r4[1] + S[2] * r4[2] + S[3] * r4[3];
      y = row16_sum(y);
      ykeep = ((stp & 15) == j) ? y : ykeep;
      if ((stp & 15) == 15) { const int p = ch * 32 + (stp - 15) + j; const int tok = d ? scan_pos_rev(p) : p; Y[(size_t)tok * 512] = ykeep; }
    }
    if (ch + 1 < NCH) RS_WRITE(lds + ((ch + 1) & 1) * 12288);
    __syncthreads();
  }
#undef RS_LOAD
#undef RS_WRITE
}

__device__ void phase_rwkv_out(const Params& P, int layer) {
  const int c = threadIdx.x;
  const float* Y0 = (const float*)(P.ws + WS_Y); const float* Y1 = Y0 + (size_t)T * 512;
  const bf16_t* RG = (const bf16_t*)(P.ws + WS_RG); const bf16_t* CV = (const bf16_t*)(P.ws + WS_CV); bf16_t* MIX = (bf16_t*)(P.ws + WS_H);
  const float lg = P.in[I_RWLNG][layer * 512 + c], lb = P.in[I_RWLNB][layer * 512 + c];
  for (int t = (layer == 1 ? NCTX : 0) + blockIdx.x; t < T; t += gridDim.x) {
    const float y = Y0[(size_t)t * 512 + c] + Y1[(size_t)t * 512 + c];
    const float mu = wave_sum(y) * (1.0f / 64.0f); const float dlt = y - mu; const float var = wave_sum(dlt * dlt) * (1.0f / 64.0f);
    const float yn = dlt * rsqrtf(var + 64e-5f) * lg + lb;
    MIX[(size_t)t * DM + c] = f2bf((yn + bf2f(CV[(size_t)t * 512 + c])) * bf2f(RG[(size_t)t * 512 + c]));
  }
}

__device__ void phase_ffn_act(const Params& P, int layer) {
  const bf16_t* GU = (const bf16_t*)(P.ws + WS_GU); bf16_t* ACT = (bf16_t*)(P.ws + WS_ACT);
  const float* fw = P.in[I_FCONV] + (size_t)layer * 3 * DFF; const float* fb = P.in[I_FCONVB] + (size_t)layer * DFF;
  const int run_lo = (layer == 1) ? NCTX / 32 : 0, nruns = T / 32 - run_lo;
  for (int idx = blockIdx.x * NTH + threadIdx.x; idx < nruns * 704; idx += gridDim.x * NTH) {
    const int cgp = idx % 704, run = run_lo + idx / 704, c0 = cgp * 8, t0 = run * 32;
    const int lo = t0 < NCTX ? 0 : NCTX, hi = t0 < NCTX ? NCTX : T;
    float w0[8], w1[8], w2[8], bb[8];
#pragma unroll
    for (int i = 0; i < 8; ++i) { w0[i] = fw[c0 + i]; w1[i] = fw[DFF + c0 + i]; w2[i] = fw[2 * DFF + c0 + i]; bb[i] = fb[c0 + i]; }
    const bf16x8 zero = {0, 0, 0, 0, 0, 0, 0, 0};
    bf16x8 prev = (t0 - 1 >= lo) ? *(const bf16x8*)(GU + (size_t)(t0 - 1) * NGU + c0) : zero;
    bf16x8 cur = *(const bf16x8*)(GU + (size_t)t0 * NGU + c0);
    for (int tt = 0; tt < 32; ++tt) {
      const int t = t0 + tt;
      const bf16x8 nxt = (t + 1 < hi) ? *(const bf16x8*)(GU + (size_t)(t + 1) * NGU + c0) : zero;
      const bf16x8 up = *(const bf16x8*)(GU + (size_t)t * NGU + DFF + c0);
      float o[8];
#pragma unroll
      for (int i = 0; i < 8; ++i) { const float g = bb[i] + w0[i] * bf2f((bf16_t)prev[i]) + w1[i] * bf2f((bf16_t)cur[i]) + w2[i] * bf2f((bf16_t)nxt[i]); o[i] = siluf_(g) * bf2f((bf16_t)up[i]); }
      u32x4 w; w.x = cvtpk(o[0], o[1]); w.y = cvtpk(o[2], o[3]); w.z = cvtpk(o[4], o[5]); w.w = cvtpk(o[6], o[7]);
      *(u32x4*)(ACT + (size_t)t * DFF + c0) = w;
      prev = cur; cur = nxt;
    }
  }
}

namespace at2 {
constexpr int DQK = 192, DV = 128, QBLK = 32, KVBLK = 64;
constexpr float SCALE = 0.07216878364870322f;
constexpr float THR = 8.f;
#ifndef ATT_NQREG
#define ATT_NQREG 6
#endif
constexpr int NQREG = ATT_NQREG;
constexpr int SHM_V = KVBLK * DV * 2, SHM_K = KVBLK * DQK * 2, SHM_ATTN = 2 * SHM_V + 2 * SHM_K + 8 * 64 * 4, SHM_TOTAL = SHM_ATTN + (12 - NQREG) * 8192;
#define KSWZ(row, colB) ((row) * 384 + ((colB) ^ (((row) & 7) << 4)))
#define SBAR() __builtin_amdgcn_sched_barrier(0)
__device__ __forceinline__ int crow(int r, int hi) { return (r & 3) + 8 * (r >> 2) + 4 * hi; }

__device__ __forceinline__ void partialSM(f32x16& p0, f32x16& p1, float& m_reg, float& mn, float& alpha) {
  constexpr float C = SCALE * 1.4426950408889634f;
  float pmax = p0[0];
#pragma unroll
  for (int r = 1; r < 16; ++r) pmax = fmaxf(pmax, p0[r]);
#pragma unroll
  for (int r = 0; r < 16; ++r) pmax = fmaxf(pmax, p1[r]);
  { auto rr = __builtin_amdgcn_permlane32_swap(__float_as_uint(pmax), __float_as_uint(pmax), false, false);
    pmax = fmaxf(__uint_as_float(rr[0]), __uint_as_float(rr[1])); }
  if (__builtin_expect(__all(pmax - m_reg <= THR / SCALE), 1)) { mn = m_reg; alpha = 1.f; }
  else { mn = fmaxf(m_reg, pmax); alpha = __builtin_amdgcn_exp2f((m_reg - mn) * C); m_reg = mn; }
  const float mnC = -mn * C;
#pragma unroll
  for (int r = 0; r < 16; ++r) p0[r] = fmaf(p0[r], C, mnC);
#pragma unroll
  for (int r = 0; r < 16; ++r) p1[r] = fmaf(p1[r], C, mnC);
#pragma unroll
  for (int r = 0; r < 16; ++r) p0[r] = __builtin_amdgcn_exp2f(p0[r]);
}
__device__ __forceinline__ void finishSM(f32x16& p0, f32x16& p1, float alpha, float& l_reg, bf16x8& pa0, bf16x8& pa1, bf16x8& pa2, bf16x8& pa3) {
#pragma unroll
  for (int r = 0; r < 16; ++r) p1[r] = __builtin_amdgcn_exp2f(p1[r]);
  float ps = 0;
#pragma unroll
  for (int r = 0; r < 16; ++r) ps += p0[r];
#pragma unroll
  for (int r = 0; r < 16; ++r) ps += p1[r];
  { auto rr = __builtin_amdgcn_permlane32_swap(__float_as_uint(ps), __float_as_uint(ps), false, false);
    ps = __uint_as_float(rr[0]) + __uint_as_float(rr[1]); }
  l_reg = l_reg * alpha + ps;
#define PK4(P, BASE, OUT) do { unsigned a0 = cvtpk(P[BASE + 0], P[BASE + 1]), a1 = cvtpk(P[BASE + 2], P[BASE + 3]);   \
    unsigned b0 = cvtpk(P[BASE + 4], P[BASE + 5]), b1 = cvtpk(P[BASE + 6], P[BASE + 7]);                              \
    auto r0 = __builtin_amdgcn_permlane32_swap(a0, b0, false, false); auto r1 = __builtin_amdgcn_permlane32_swap(a1, b1, false, false); \
    u32x4 w = {r0[0], r1[0], r0[1], r1[1]}; OUT = *reinterpret_cast<bf16x8*>(&w); } while (0)
  PK4(p0, 0, pa0); PK4(p0, 8, pa1); PK4(p1, 0, pa2); PK4(p1, 8, pa3);
#undef PK4
}
__device__ __forceinline__ void qkt(f32x16& p0, f32x16& p1, const char* Ks, const bf16x8* qr, const char* qsp, int r32, int hi) {
  p0 = f32x16{}; p1 = f32x16{};
#pragma unroll
  for (int d0 = 0; d0 < 12; ++d0) { const int cb = (d0 * 16 + hi * 8) * 2;
    const bf16x8 b0 = *reinterpret_cast<const bf16x8*>(Ks + KSWZ(r32, cb));
    const bf16x8 b1 = *reinterpret_cast<const bf16x8*>(Ks + KSWZ(32 + r32, cb));
    const bf16x8 qv = (d0 < NQREG) ? qr[d0 < NQREG ? d0 : 0] : *reinterpret_cast<const bf16x8*>(qsp + (d0 - NQREG) * 8192);
    p0 = __builtin_amdgcn_mfma_f32_32x32x16_bf16(b0, qv, p0, 0, 0, 0);
    p1 = __builtin_amdgcn_mfma_f32_32x32x16_bf16(b1, qv, p1, 0, 0, 0); }
}
__device__ __forceinline__ int v_st(int k, int c) { const int kk = (k & ~0xC) | ((k & 4) << 1) | ((k & 8) >> 1); return ((kk >> 3) * 4 + (c >> 5)) * 512 + ((kk & 7) * 32 + (c & 31)) * 2; }
__device__ __forceinline__ int v_rd_base(int lane) { return ((lane & 3) << 3) | (((lane >> 2) & 3) << 6) | (((lane >> 4) & 1) << 5) | (((lane >> 5) & 1) << 8); }
constexpr int v_rd_off(int d0, int ks, int half) { return d0 * 512 + ks * 4096 + half * 2048; }
template <int OFF> __device__ __forceinline__ s16x4 tr_read(int vb) {
  s16x4 r; asm volatile("ds_read_b64_tr_b16 %0, %1 offset:%2" : "=&v"(r) : "v"(vb), "i"(OFF) : "memory"); return r;
}
template <int D0> __device__ __forceinline__ void pv_one(f32x16& od, int vb, bf16x8 pa0, bf16x8 pa1, bf16x8 pa2, bf16x8 pa3) {
  const s16x4 l0 = tr_read<v_rd_off(D0, 0, 0)>(vb), h0 = tr_read<v_rd_off(D0, 0, 1)>(vb), l1 = tr_read<v_rd_off(D0, 1, 0)>(vb), h1 = tr_read<v_rd_off(D0, 1, 1)>(vb);
  const s16x4 l2 = tr_read<v_rd_off(D0, 2, 0)>(vb), h2 = tr_read<v_rd_off(D0, 2, 1)>(vb), l3 = tr_read<v_rd_off(D0, 3, 0)>(vb), h3 = tr_read<v_rd_off(D0, 3, 1)>(vb);
  asm volatile("s_waitcnt lgkmcnt(0)" ::: "memory"); SBAR();
#define PK(L, H) (bf16x8){L[0], L[1], L[2], L[3], H[0], H[1], H[2], H[3]}
  od = __builtin_amdgcn_mfma_f32_32x32x16_bf16(pa0, PK(l0, h0), od, 0, 0, 0);
  od = __builtin_amdgcn_mfma_f32_32x32x16_bf16(pa1, PK(l1, h1), od, 0, 0, 0);
  od = __builtin_amdgcn_mfma_f32_32x32x16_bf16(pa2, PK(l2, h2), od, 0, 0, 0);
  od = __builtin_amdgcn_mfma_f32_32x32x16_bf16(pa3, PK(l3, h3), od, 0, 0, 0);
#undef PK
}
__device__ __forceinline__ void pv_d0(f32x16* o, int vb, bf16x8 pa0, bf16x8 pa1, bf16x8 pa2, bf16x8 pa3) {
  pv_one<0>(o[0], vb, pa0, pa1, pa2, pa3); pv_one<1>(o[1], vb, pa0, pa1, pa2, pa3); pv_one<2>(o[2], vb, pa0, pa1, pa2, pa3); pv_one<3>(o[3], vb, pa0, pa1, pa2, pa3);
}
__device__ __forceinline__ void rope_pair(bf16x8& A, bf16x8& B, float pos, int hi) {
  float oa[8], ob[8];
#pragma unroll
  for (int e = 0; e < 8; ++e) {
    const float inv = exp2f(-(float)(hi * 8 + e) * (13.287712379549449f / 16.0f));
    const float sn = __sinf(pos * inv), cs = __cosf(pos * inv);
    const float a = bf2f((bf16_t)A[e]), b = bf2f((bf16_t)B[e]);
    oa[e] = a * cs - b * sn; ob[e] = a * sn + b * cs;
  }
  u32x4 wa = {cvtpk(oa[0], oa[1]), cvtpk(oa[2], oa[3]), cvtpk(oa[4], oa[5]), cvtpk(oa[6], oa[7])};
  u32x4 wb = {cvtpk(ob[0], ob[1]), cvtpk(ob[2], ob[3]), cvtpk(ob[4], ob[5]), cvtpk(ob[6], ob[7])};
  A = *reinterpret_cast<bf16x8*>(&wa); B = *reinterpret_cast<bf16x8*>(&wb);
}

__device__ __forceinline__ void attn_unit(const bf16_t* __restrict__ Q, const bf16_t* __restrict__ KV, const bf16_t* __restrict__ KR, bf16_t* __restrict__ MIX,
                                          int q0, int h, int seq, bool rope_q, char* lds) {
  const int tid = threadIdx.x, wid = tid >> 6, lane = tid & 63, r32 = lane & 31, hi = lane >> 5;
  char* V_lds = lds; char* K_lds = lds + 2 * SHM_V;
  float* ws = (float*)(lds + 2 * SHM_V + 2 * SHM_K) + wid * 64; float* li_l = ws; float* al_l = ws + 32;
  float m_reg = -1e30f, l_reg = 0; f32x16 o[4] = {}; bf16x8 qr[12];
  const int qrow = q0 + wid * QBLK + r32;
  const bf16_t* Qw = Q + (size_t)qrow * 1536 + h * DQK + hi * 8;
#pragma unroll
  for (int d0 = 0; d0 < 12; ++d0) qr[d0] = *reinterpret_cast<const bf16x8*>(Qw + d0 * 16);
  if (rope_q) { const int tl = qrow - NCTX; rope_pair(qr[8], qr[9], (float)(tl >> 6), hi); rope_pair(qr[10], qr[11], (float)(tl & 63), hi); }
  char* qsp = lds + SHM_ATTN + tid * 16;
#pragma unroll
  for (int d0 = NQREG; d0 < 12; ++d0) *reinterpret_cast<bf16x8*>(qsp + (d0 - NQREG) * 8192) = qr[d0];
  const bf16_t* Kh = KV + h * 256; const bf16_t* Vh = KV + h * 256 + 128;
  const int sr = tid >> 4, sc = (tid & 15) * 8, vst0 = v_st(sr, sc), vst1 = v_st(32 + sr, sc);
  const int rr = tid >> 3, rc = (tid & 7) * 8;
  const int vb0 = (int)(uintptr_t)V_lds + v_rd_base(lane);
  bf16x8 vs0, vs1, ks0, ks1, ks2;
#define SLOAD(k0) do { vs0 = *(const bf16x8*)(Vh + (size_t)((k0) + sr) * 2048 + sc); vs1 = *(const bf16x8*)(Vh + (size_t)((k0) + 32 + sr) * 2048 + sc); \
    ks0 = *(const bf16x8*)(Kh + (size_t)((k0) + sr) * 2048 + sc); ks1 = *(const bf16x8*)(Kh + (size_t)((k0) + 32 + sr) * 2048 + sc); \
    ks2 = *(const bf16x8*)(KR + (size_t)((k0) + rr) * 64 + rc); } while (0)
#define SWRITE(b) do { *(bf16x8*)(V_lds + (b) * SHM_V + vst0) = vs0; *(bf16x8*)(V_lds + (b) * SHM_V + vst1) = vs1; const int kc = sc * 2; \
    *(bf16x8*)(K_lds + (b) * SHM_K + KSWZ(sr, kc)) = ks0; *(bf16x8*)(K_lds + (b) * SHM_K + KSWZ(32 + sr, kc)) = ks1; \
    *(bf16x8*)(K_lds + (b) * SHM_K + KSWZ(rr, 256 + rc * 2)) = ks2; } while (0)
#define SWAIT() asm volatile("s_waitcnt vmcnt(0)" ::: "memory")
#define RESC(a) do { if (__any((a) < 1.f)) { if (hi == 0) al_l[r32] = (a); asm volatile("s_waitcnt lgkmcnt(0)" ::: "memory"); \
    _Pragma("unroll") for (int d = 0; d < 4; ++d) _Pragma("unroll") for (int r = 0; r < 16; ++r) o[d][r] *= al_l[crow(r, hi)]; } } while (0)
  f32x16 pA0, pA1, pB0, pB1; float mnA, mnB, alA, alB; bf16x8 pa0, pa1, pa2, pa3; const int NT = seq / KVBLK;
  SLOAD(0); SWAIT(); SWRITE(0); __syncthreads();
  qkt(pA0, pA1, K_lds, qr, qsp, r32, hi); partialSM(pA0, pA1, m_reg, mnA, alA);
  SLOAD(KVBLK);
  SWAIT(); SWRITE(1); __syncthreads();
  for (int j = 1; j + 1 < NT; j += 2) {
    SBAR(); qkt(pB0, pB1, K_lds + SHM_K, qr, qsp, r32, hi);
    finishSM(pA0, pA1, alA, l_reg, pa0, pa1, pa2, pa3); SBAR();
    pv_d0(o, vb0, pa0, pa1, pa2, pa3); SBAR(); SLOAD((j + 1) * KVBLK); SBAR(); partialSM(pB0, pB1, m_reg, mnB, alB);
    __syncthreads(); SWAIT(); SWRITE(0);
    RESC(alB); __syncthreads();
    SBAR(); qkt(pA0, pA1, K_lds, qr, qsp, r32, hi);
    finishSM(pB0, pB1, alB, l_reg, pa0, pa1, pa2, pa3); SBAR();
    pv_d0(o, vb0 + SHM_V, pa0, pa1, pa2, pa3); SBAR(); SLOAD((j + 2) * KVBLK); SBAR(); partialSM(pA0, pA1, m_reg, mnA, alA);
    __syncthreads(); SWAIT(); SWRITE(1);
    RESC(alA); __syncthreads();
  }
  SBAR(); qkt(pB0, pB1, K_lds + SHM_K, qr, qsp, r32, hi);
  finishSM(pA0, pA1, alA, l_reg, pa0, pa1, pa2, pa3); SBAR();
  pv_d0(o, vb0, pa0, pa1, pa2, pa3); partialSM(pB0, pB1, m_reg, mnB, alB);
  __syncthreads(); RESC(alB);
  finishSM(pB0, pB1, alB, l_reg, pa0, pa1, pa2, pa3); SBAR();
  pv_d0(o, vb0 + SHM_V, pa0, pa1, pa2, pa3);
  if (hi == 0) li_l[r32] = l_reg; asm volatile("s_waitcnt lgkmcnt(0)" ::: "memory");
  float rli[16];
#pragma unroll
  for (int r = 0; r < 16; ++r) rli[r] = __builtin_amdgcn_rcpf(li_l[crow(r, hi)]);
  bf16_t* Ow = MIX + (size_t)(q0 + wid * QBLK) * DM + 1024 + h * DV;
#pragma unroll
  for (int r = 0; r < 16; ++r) { const int orow = crow(r, hi);
#pragma unroll
    for (int d0 = 0; d0 < 4; ++d0) Ow[(size_t)orow * DM + d0 * 32 + r32] = f2bf(o[d0][r] * rli[r]); }
  __syncthreads();
#undef SLOAD
#undef SWRITE
#undef SWAIT
#undef RESC
}
}

__device__ void phase_attention(const Params& P, int layer, char* lds, int wg, int nwg) {
  const bf16_t* Q = (const bf16_t*)(P.ws + WS_Q); const bf16_t* KV = (const bf16_t*)(P.ws + WS_KV); const bf16_t* KR = (const bf16_t*)(P.ws + WS_KR);
  bf16_t* MIX = (bf16_t*)(P.ws + WS_H);
  const int nunits = (layer == 0) ? 520 : 512;
  for (int u = wg; u < nunits; u += nwg) {
    if (u < 512) at2::attn_unit(Q, KV, KR, MIX, NCTX + (u & 63) * 256, u >> 6, T, true, lds);
    else at2::attn_unit(Q, KV, KR, MIX, 0, u - 512, NCTX, false, lds);
  }
}

#ifndef N_SCAN_WG
#define N_SCAN_WG 32
#endif
#define LB __launch_bounds__(NTH)
extern __shared__ __attribute__((aligned(16))) unsigned char lds[];
__global__ void LB k_p0(Params P) { phase_mod(P, (float*)lds); phase_convert(P, 0, (float*)lds); }
__global__ void LB k_cvt(Params P, int layer) { phase_convert(P, layer, (float*)lds); }
__global__ void LB k_norm(Params P, int layer, int which, int skip) { phase_norm(P, layer, which, skip != 0); }
__global__ void LB k_gemm_store(const bf16_t* A, const bf16_t* Bt, bf16_t* O, int M, int N, int K) { EpiStore E{O, N}; run_gemm(lds, A, Bt, M, N, K, E); }
__global__ void LB k_gemm_resid(Params P, int layer, int which) {
  const bool last = (layer == 1);
  const float* mod_l = (const float*)(P.ws + WS_MOD) + (size_t)(layer * 2 + 0) * 12288; const float* mod_c = mod_l + 12288;
  if (which == 0) {
    EpiResid E{P.in[I_CTX], P.in[I_X], (float*)(P.ws + WS_XC), P.out, mod_c + 4096, mod_l + 4096, last ? NCTX : 0};
    if (layer > 0) { E.src_c = (const float*)(P.ws + WS_XC); E.src_l = P.out; }
    run_gemm(lds, (const bf16_t*)(P.ws + WS_H) + (last ? (size_t)NCTX * DM : 0), (const bf16_t*)(P.ws + WS_WOUT), last ? T - NCTX : T, DM, DM, E);
  } else {
    EpiResid E{(const float*)(P.ws + WS_XC), P.out, (float*)(P.ws + WS_XC), P.out, mod_c + 10240, mod_l + 10240, last ? NCTX : 0};
    run_gemm(lds, (const bf16_t*)(P.ws + WS_ACT) + (last ? (size_t)NCTX * DFF : 0), (const bf16_t*)(P.ws + WS_WDN), last ? T - NCTX : T, DM, DFF, E);
  }
}
__global__ void LB k_prep(Params P, int layer) { phase_prep(P, layer, (float*)lds); }
__global__ void LB k_lru_agg(Params P) { phase_lru_agg(P); }
__global__ void LB k_mix(Params P, int layer) {
  const int G = gridDim.x;
  const int vcu = (G % 8 == 0) ? ((int)blockIdx.x % 8) * (G / 8) + (int)blockIdx.x / 8 : (int)blockIdx.x;
  if (vcu < N_SCAN_WG) { for (int s = vcu; s < 32; s += N_SCAN_WG) rwkv_scan(P, s, (float*)lds); }
  else phase_attention(P, layer, (char*)lds, vcu - N_SCAN_WG, G - N_SCAN_WG);
  __syncthreads();
  phase_lru_out(P, layer, (float*)lds);
}
__global__ void LB k_rwout(Params P, int layer) { phase_rwkv_out(P, layer); }
__global__ void LB k_act(Params P, int layer) { phase_ffn_act(P, layer); }
__global__ void LB k_final(Params P) { phase_final_norm(P); }

extern "C" void kernel_launch(void* const* d_in, const int* in_sizes, int n_in, void* d_out, int out_size, void* d_ws, size_t ws_size, hipStream_t stream) {
  static int grid = 0;
  if (grid == 0) {
    if (n_in != 42 || out_size != (T - NCTX) * DM || ws_size < WS_END) { fprintf(stderr, "kernel_launch: unexpected shapes (n_in %d out %d ws %zu need %zu)\n", n_in, out_size, ws_size, (size_t)WS_END); grid = -1; return; }
    int dev = 0, cus = 0;
    (void)hipGetDevice(&dev); (void)hipDeviceGetAttribute(&cus, hipDeviceAttributeMultiprocessorCount, dev);
    bool ok = true;
#define SETA(k) ok = ok && (hipFuncSetAttribute((const void*)k, hipFuncAttributeMaxDynamicSharedMemorySize, LDS_BYTES) == hipSuccess)
    SETA(k_p0); SETA(k_cvt); SETA(k_norm); SETA(k_gemm_store); SETA(k_gemm_resid); SETA(k_prep); SETA(k_lru_agg); SETA(k_mix); SETA(k_rwout); SETA(k_act); SETA(k_final);
#undef SETA
    if (!ok) { fprintf(stderr, "kernel_launch: hipFuncSetAttribute failed\n"); grid = -1; return; }
    grid = cus > 0 ? cus : 256;
  }
  if (grid < 0) return;
  Params p{};
  for (int i = 0; i < 42; ++i) p.in[i] = (const float*)d_in[i];
  p.out = (float*)d_out; p.ws = (unsigned char*)d_ws; p.ph_lo = 0; p.ph_hi = 0;
  unsigned char* ws = (unsigned char*)d_ws;
  const dim3 g(grid), b(NTH);
#define L(k, ...) hipLaunchKernelGGL(k, g, b, LDS_BYTES, stream, __VA_ARGS__)
  L(k_p0, p);
  for (int layer = 0; layer < 2; ++layer) {
    const bool last = layer == 1; const size_t ro = last ? NCTX : 0; const int M2 = last ? T - NCTX : T;
    if (layer > 0) L(k_cvt, p, layer);
    L(k_norm, p, layer, 0, 0);
    L(k_gemm_store, (const bf16_t*)(ws + WS_H), (const bf16_t*)(ws + WS_WIN), (bf16_t*)(ws + WS_COLS), T, NIN, DM);
    L(k_prep, p, layer);
    L(k_gemm_store, (const bf16_t*)(ws + WS_QN), (const bf16_t*)(ws + WS_WQ), (bf16_t*)(ws + WS_Q), T, 1536, 512);
    L(k_gemm_store, (const bf16_t*)(ws + WS_KVN), (const bf16_t*)(ws + WS_WKV), (bf16_t*)(ws + WS_KV), T, 2048, 256);
    L(k_lru_agg, p);
    L(k_mix, p, layer);
    L(k_rwout, p, layer);
    L(k_gemm_resid, p, layer, 0);
    L(k_norm, p, layer, 1, last ? 1 : 0);
    L(k_gemm_store, (const bf16_t*)(ws + WS_H) + ro * DM, (const bf16_t*)(ws + WS_WGU), (bf16_t*)(ws + WS_GU) + ro * NGU, M2, NGU, DM);
    L(k_act, p, layer);
    L(k_gemm_resid, p, layer, 1);
  }
  L(k_final, p);
#undef L
}
```

```cpp
#include <hip/hip_runtime.h>
#include <hip/hip_cooperative_groups.h>
#include <cstdio>
#include <cstdint>
__device__ __forceinline__ int mk_tid() { int t = (int)threadIdx.x; asm volatile("" : "+v"(t)); return t; }
__device__ __forceinline__ int mk_bid() { int b = (int)blockIdx.x; asm volatile("" : "+s"(b)); return b; }
__device__ __forceinline__ int mk_nblk() { int g = (int)gridDim.x; asm volatile("" : "+s"(g)); return g; }
template <int OFF> __device__ __forceinline__ unsigned long long kp_load() {
  unsigned long long r; auto kp = __builtin_amdgcn_kernarg_segment_ptr();
  asm volatile("s_load_dwordx2 %0, %1, %2\n\ts_waitcnt lgkmcnt(0)" : "=s"(r) : "s"(kp), "i"(OFF));
  return r;
}
#define PIN(i) ((const float*)kp_load<8 * (i)>())
#define POUT() ((float*)kp_load<8 * 42>())
#define PWS() ((unsigned char*)kp_load<8 * 43>())
namespace pg8 {
#define PG8_LAS __attribute__((address_space(3)))
typedef unsigned short bf16_t;
typedef short bf16x8 __attribute__((ext_vector_type(8)));
typedef float f32x4 __attribute__((ext_vector_type(4)));
typedef unsigned u32x4 __attribute__((ext_vector_type(4)));
constexpr int BM = 256, BK = 64, HALF = 128, HTB = HALF * BK * 2  , STAGE_BYTES = 8 * HTB, NXCD = 8, WGM = 8;

__host__ __device__ __forceinline__ int lds_byte(int r, int c) { const int st = (r >> 4) * 2 + (c >> 5), rr = r & 15, cc = c & 31, ob = rr * 64 + cc * 2; return st * 1024 + (ob ^ (((ob >> 9) & 1) << 5)); }
__host__ __device__ __forceinline__ void stage_rc(int b, int& R, int& C) { const int st = b / 1024, sb = b % 1024, swz = sb ^ (((sb >> 9) & 1) << 5); R = (st >> 1) * 16 + swz / 64; C = (st & 1) * 32 + (swz % 64) / 2; }
__host__ __device__ __forceinline__ int perm32(int rho) { const int n = rho >> 4, i = rho & 15; return 8 * (i >> 2) + 4 * n + (i & 3); }

struct Unit { int pm, pn; };
struct Gemm { const bf16_t* A; const bf16_t* Bt; int M, N, K; int ld; int ksplit; };

struct StaticOrder {
    int nM, nN, nwg, G, c;
    __host__ __device__ void init(int M, int N, int G_, int c_) { nM = M / BM; nN = N / BM; nwg = nM * nN; G = G_; c = c_; }
    __host__ __device__ bool next(int i, Unit& u) const {
        const long L = (long)i * G + c; if (L >= nwg) return false;
        int wgid = (int)L; { const int q = nwg / NXCD, r = nwg % NXCD, xcd = wgid % NXCD, off = wgid / NXCD; wgid = (xcd < r ? xcd * (q + 1) : r * (q + 1) + (xcd - r) * q) + off; }
        const int nig = WGM * nN, gid = wgid / nig, fm = gid * WGM, gsz = (nM - fm) < WGM ? (nM - fm) : WGM;
        u.pm = fm + ((wgid % nig) % gsz); u.pn = (wgid % nig) / gsz; return true;
    }
    __device__ __forceinline__ void a_ready(const Unit&) const {}
    __device__ __forceinline__ void done(const Unit&) const {}
};
__device__ __forceinline__ unsigned cvt_pk_bf16(float lo, float hi) { unsigned r; asm volatile("v_cvt_pk_bf16_f32 %0, %1, %2" : "=v"(r) : "v"(lo), "v"(hi)); return r; }
typedef float f32x2 __attribute__((ext_vector_type(2)));
template <class Epi, class Sched, bool STAMP = false>
__device__ __forceinline__ void gemm_phase(PG8_LAS unsigned char* lds, const Gemm g, const Sched& S, const Epi& E, unsigned long long* stamps) {
    const int tid = mk_tid(), wid = __builtin_amdgcn_readfirstlane(tid >> 6), lane = tid & 63, wr = wid >> 2, wc = wid & 3, fr = lane & 15, fq = lane >> 4;
    const int K = g.K, nt = K / BK, LD = g.ld; const size_t ksb = (size_t)g.ksplit * 2;
    int ts_lo = 0, ts_hi = 0, nts = 0; const unsigned long long rt_entry = STAMP ? (unsigned long long)wall_clock64() : 0ull;
#define PG8_STAMP() do { if (STAMP && wid == 0 && nts < 64) { const unsigned long long _c = (unsigned long long)clock64(); \
        ts_lo = (lane == nts) ? (int)(unsigned)_c : ts_lo; ts_hi = (lane == nts) ? (int)(unsigned)(_c >> 32) : ts_hi; ++nts; } } while (0)
    PG8_STAMP();
    unsigned voffA[2], voffB[2];
#pragma unroll
    for (int i = 0; i < 2; ++i) { int R, C; stage_rc(tid * 16 + i * 8192, R, C); const int Rb = Epi::PERM ? ((R & ~31) + perm32(R & 31)) : R;
        voffA[i] = (unsigned)(R * LD + C) * 2u; voffB[i] = (unsigned)(Rb * LD + C) * 2u; }
    const size_t kstep = (size_t)(BK * 2);
    const size_t hstep = (size_t)HALF * LD * 2;
    const size_t tstep = 2 * hstep;
    const unsigned ldsw = (unsigned)wid * 1024u;
    const int aoff = lds_byte(wr * 64 + fr, fq * 8), boff = lds_byte(wc * 32 + fr, fq * 8);
#define PG8_SA(b, h) (((b) * 2 + (h)) * HTB)
#define PG8_SB(b, h) ((4 + (b) * 2 + (h)) * HTB)
#define PG8_STAGE(bufoff, gbase, voff) do { _Pragma("unroll") for (int _i = 0; _i < 2; ++_i) \
        __builtin_amdgcn_global_load_lds((const unsigned*)((const char*)(gbase) + (voff)[_i]), (PG8_LAS unsigned*)(lds + (bufoff) + ldsw + _i * 8192), 16, 0, 0); } while (0)
#define PG8_LDA(dst, b, h) do { _Pragma("unroll") for (int m = 0; m < 4; ++m) _Pragma("unroll") for (int k = 0; k < 2; ++k) dst[m][k] = *(const PG8_LAS bf16x8*)(lds + PG8_SA(b, h) + aoff + m * 2048 + k * 1024); } while (0)
#define PG8_LDB(dst, b, h) do { _Pragma("unroll") for (int n = 0; n < 2; ++n) _Pragma("unroll") for (int k = 0; k < 2; ++k) dst[n][k] = *(const PG8_LAS bf16x8*)(lds + PG8_SB(b, h) + boff + n * 2048 + k * 1024); } while (0)
#define PG8_MMA(ai, bj, At, Bt) do { __builtin_amdgcn_s_setprio(1); _Pragma("unroll") for (int m = 0; m < 4; ++m) _Pragma("unroll") for (int n = 0; n < 2; ++n) _Pragma("unroll") for (int k = 0; k < 2; ++k) \
        acc[ai][bj][m][n] = __builtin_amdgcn_mfma_f32_16x16x32_bf16(Bt[n][k], At[m][k], acc[ai][bj][m][n], 0, 0, 0); __builtin_amdgcn_s_setprio(0); } while (0)
#define PG8_WAIT_V(n) asm volatile("s_waitcnt vmcnt(" #n ")" ::: "memory")
#define PG8_WAIT_L(n) asm volatile("s_waitcnt lgkmcnt(" #n ")" ::: "memory")
#define PG8_BAR __builtin_amdgcn_s_barrier()
#define PG8_SCHED __builtin_amdgcn_sched_barrier(0)
    Unit cur, nxt; int ui = 0;
    if (!S.next(0, cur)) return;
    f32x4 acc[2][2][4][2];
#pragma unroll
    for (int a = 0; a < 2; ++a)
#pragma unroll
        for (int b = 0; b < 2; ++b)
#pragma unroll
            for (int m = 0; m < 4; ++m)
#pragma unroll
                for (int n = 0; n < 2; ++n) acc[a][b][m][n] = (f32x4){0.f, 0.f, 0.f, 0.f};
    bf16x8 At[4][2], B0[2][2], B1[2][2];
    const char* cA = (const char*)g.A + (ksb ? (size_t)cur.pm * ksb : (size_t)cur.pm * tstep); const char* cB = (const char*)g.Bt + (size_t)cur.pn * tstep + (size_t)cur.pm * ksb;
    S.a_ready(cur);
    PG8_STAGE(PG8_SB(0, 0), cB, voffB); PG8_STAGE(PG8_SA(0, 0), cA, voffA); PG8_STAGE(PG8_SB(0, 1), cB + hstep, voffB); PG8_STAGE(PG8_SA(0, 1), cA + hstep, voffA);
    if (wr == 1) PG8_BAR;
    PG8_WAIT_V(4); PG8_BAR;
    PG8_STAGE(PG8_SB(1, 0), cB + kstep, voffB); PG8_STAGE(PG8_SA(1, 0), cA + kstep, voffA); PG8_STAGE(PG8_SB(1, 1), cB + hstep + kstep, voffB);
    PG8_WAIT_V(6); PG8_BAR;
    PG8_STAMP();
    for (;;) {
        const bool has_next = S.next(ui + 1, nxt);
        const char* nA = has_next ? (const char*)g.A + (ksb ? (size_t)nxt.pm * ksb : (size_t)nxt.pm * tstep) : cA; const char* nB = has_next ? (const char*)g.Bt + (size_t)nxt.pn * tstep + (size_t)nxt.pm * ksb : cB;
        for (int t = 0; t < nt; t += 2) {
            const bool last = (t == nt - 2);
            const char* a1 = cA + (size_t)(t + 1) * kstep;
            const char* a2 = last ? nA : cA + (size_t)(t + 2) * kstep; const char* b2 = last ? nB : cB + (size_t)(t + 2) * kstep;
            const char* a3 = a2 + kstep; const char* b3 = b2 + kstep;
            if (last && has_next) S.a_ready(nxt);
            PG8_LDB(B0, 0, 0); PG8_SCHED; PG8_LDA(At, 0, 0); PG8_STAGE(PG8_SA(1, 1), a1 + hstep, voffA);
            PG8_WAIT_L(8); PG8_BAR; PG8_WAIT_L(0); PG8_MMA(0, 0, At, B0); PG8_BAR; PG8_SCHED;
            PG8_LDB(B1, 0, 1); PG8_STAGE(PG8_SB(0, 0), b2, voffB);
            PG8_BAR; PG8_WAIT_L(0); PG8_MMA(0, 1, At, B1); PG8_BAR;
            PG8_LDA(At, 0, 1); PG8_STAGE(PG8_SA(0, 0), a2, voffA);
            PG8_BAR; PG8_WAIT_L(0); PG8_MMA(1, 0, At, B0); PG8_BAR; PG8_SCHED;
            PG8_STAGE(PG8_SB(0, 1), b2 + hstep, voffB);
            PG8_WAIT_V(6); PG8_BAR; PG8_MMA(1, 1, At, B1); PG8_BAR;
            PG8_LDB(B0, 1, 0); PG8_SCHED; PG8_LDA(At, 1, 0); PG8_STAGE(PG8_SA(0, 1), a2 + hstep, voffA);
            PG8_WAIT_L(8); PG8_BAR; PG8_WAIT_L(0); PG8_MMA(0, 0, At, B0); PG8_BAR; PG8_SCHED;
            PG8_LDB(B1, 1, 1); PG8_STAGE(PG8_SB(1, 0), b3, voffB);
            PG8_BAR; PG8_WAIT_L(0); PG8_MMA(0, 1, At, B1); PG8_BAR;
            PG8_LDA(At, 1, 1); PG8_STAGE(PG8_SA(1, 0), a3, voffA);
            PG8_BAR; PG8_WAIT_L(0); PG8_MMA(1, 0, At, B0); PG8_BAR; PG8_SCHED;
            PG8_STAGE(PG8_SB(1, 1), b3 + hstep, voffB);
            PG8_WAIT_V(6); PG8_BAR; PG8_MMA(1, 1, At, B1); PG8_BAR;
        }
        PG8_STAMP();
        if constexpr (!Epi::AFTER_DRAIN) { E(acc, cur, wr, wc, fr, fq); S.done(cur); }
        PG8_STAMP();
        if (!has_next) break;
#pragma unroll
        for (int a = 0; a < 2; ++a)
#pragma unroll
            for (int b = 0; b < 2; ++b)
#pragma unroll
                for (int m = 0; m < 4; ++m)
#pragma unroll
                    for (int n = 0; n < 2; ++n) acc[a][b][m][n] = (f32x4){0.f, 0.f, 0.f, 0.f};
        cur = nxt; cA = nA; cB = nB; ++ui;
    }
    PG8_WAIT_V(0);
    if (wr == 0) PG8_BAR;
    PG8_BAR;
    if constexpr (Epi::AFTER_DRAIN) { E.fused(acc, cur, wr, wc, fr, fq, lds, wid, lane); S.done(cur); }
    PG8_STAMP();
    if (STAMP && wid == 0) { stamps[lane] = lane < nts ? (((unsigned long long)(unsigned)ts_hi << 32) | (unsigned)ts_lo) : 0ull;
        if (lane == 62) stamps[62] = rt_entry; if (lane == 63) stamps[63] = (unsigned long long)wall_clock64(); }
#undef PG8_STAMP
#undef PG8_SA
#undef PG8_SB
#undef PG8_STAGE
#undef PG8_LDA
#undef PG8_LDB
#undef PG8_MMA
#undef PG8_WAIT_V
#undef PG8_WAIT_L
#undef PG8_BAR
#undef PG8_SCHED
}
}

namespace cg = cooperative_groups;
typedef unsigned short bf16_t;
typedef short bf16x8 __attribute__((ext_vector_type(8)));
typedef short s16x4 __attribute__((ext_vector_type(4)));
typedef float f32x4 __attribute__((ext_vector_type(4)));
typedef float f32x8 __attribute__((ext_vector_type(8)));
typedef float f32x16 __attribute__((ext_vector_type(16)));
typedef unsigned u32x4 __attribute__((ext_vector_type(4)));
typedef unsigned u32x2 __attribute__((ext_vector_type(2)));

constexpr int T = 16640, NCTX = 256, DM = 2048, NTH = 512;
constexpr int NIN = 3840;
constexpr int DFF = 5632, NGU = 2 * DFF;
constexpr int C_LRU = 1760, C_MLA = 2784, C_VD = 3616;
constexpr int RECB = 896;
constexpr int LDS_BYTES = 150528;

constexpr size_t al256(size_t x) { return (x + 255) / 256 * 256; }
constexpr size_t WS_BAR = 0;
constexpr size_t WS_MOD = 256;
constexpr size_t WS_XC = al256(WS_MOD + 2 * 2 * 12288 * 4);
constexpr size_t WS_H = al256(WS_XC + (size_t)NCTX * DM * 4);
constexpr size_t WS_VF = al256(WS_H + (size_t)T * DM * 2);
constexpr size_t WS_WIN = al256(WS_VF + (size_t)T * 512 * 2);
constexpr size_t WS_WOUT = al256(WS_WIN + (size_t)NIN * DM * 2);
constexpr size_t WS_WQ = al256(WS_WOUT + (size_t)DM * DM * 2);
constexpr size_t WS_WKV = al256(WS_WQ + (size_t)1536 * 512 * 2);
constexpr size_t WS_WGU = al256(WS_WKV + (size_t)2048 * 256 * 2);
constexpr size_t WS_WDN = al256(WS_WGU + (size_t)NGU * DM * 2);
constexpr size_t WS_R = al256(WS_WDN + (size_t)DM * DFF * 2);
constexpr size_t WS_COLS = WS_R;
constexpr size_t WS_Q = WS_COLS;
constexpr size_t WS_KV = al256(WS_Q + (size_t)T * 1536 * 2);
constexpr size_t WS_REC = al256(WS_COLS + (size_t)T * NIN * 2);
constexpr size_t WS_Y = al256(WS_REC + (size_t)16 * T * RECB);
constexpr size_t WS_LAB = al256(WS_Y + (size_t)2 * T * 512 * 4);
constexpr size_t WS_GG = al256(WS_LAB + (size_t)T * 2048 * 2);
constexpr size_t WS_QN = al256(WS_GG + (size_t)T * 512 * 2);
constexpr size_t WS_KVN = al256(WS_QN + (size_t)T * 512 * 2);
constexpr size_t WS_KR = al256(WS_KVN + (size_t)T * 256 * 2);
constexpr size_t WS_RG = al256(WS_KR + (size_t)T * 64 * 2);
constexpr size_t WS_CV = al256(WS_RG + (size_t)T * 512 * 2);
constexpr size_t WS_AGG = al256(WS_CV + (size_t)T * 512 * 2);
constexpr size_t WS_MIX_END = al256(WS_AGG + (size_t)260 * 2048 * 4);
constexpr size_t WS_GU = WS_R;
constexpr size_t WS_ACT = al256(WS_GU + (size_t)T * NGU * 2);
constexpr size_t WS_FFN_END = al256(WS_ACT + (size_t)T * DFF * 2);
constexpr size_t WS_REND = WS_MIX_END > WS_FFN_END ? WS_MIX_END : WS_FFN_END;
constexpr size_t WS_PARTO = WS_REND;
constexpr size_t WS_PARTML = al256(WS_PARTO + (size_t)448 * 256 * 128 * 2);
constexpr size_t WS_END = al256(WS_PARTML + (size_t)448 * 512 * 4);
static_assert(WS_KV + (size_t)T * 2048 * 2 <= WS_REC, "Q|KV must fit in the cols buffer");

struct Params { const float* in[42]; float* out; unsigned char* ws; int ph_lo, ph_hi; };

enum { I_X = 0, I_C, I_CTX, I_CCTX, I_ADAW, I_ADAB, I_NORM1, I_NORM2, I_WIN, I_WOUT, I_RWCONV, I_RWCONVB, I_RWW0, I_RWWUP, I_RWA0, I_RWAUP, I_RWGUP,
       I_RWKK, I_RWKA, I_RWRK, I_RWLNG, I_RWLNB, I_RWV0, I_RWVDOWN, I_RWVUP, I_LRUCONV, I_LRUCONVB, I_LRUWA, I_LRUBA, I_LRUWX, I_LRUBX, I_LRULAM,
       I_QNORM, I_WQB, I_KVNORM, I_WKVB, I_WGATE, I_WUP, I_FCONV, I_FCONVB, I_WDOWN, I_FNORM };

__device__ __forceinline__ float bf2f(bf16_t b) { return __uint_as_float(((unsigned)b) << 16); }
__device__ __forceinline__ unsigned cvtpk(float lo, float hi) { unsigned r; asm volatile("v_cvt_pk_bf16_f32 %0, %1, %2" : "=v"(r) : "v"(lo), "v"(hi)); return r; }
__device__ __forceinline__ bf16_t f2bf(float f) { return (bf16_t)(cvtpk(f, 0.f) & 0xffffu); }
__device__ __forceinline__ float sigmoidf_(float x) { return __builtin_amdgcn_rcpf(1.0f + __expf(-x)); }
__device__ __forceinline__ float tanhf_(float x) { return 1.0f - 2.0f * __builtin_amdgcn_rcpf(1.0f + __expf(2.0f * x)); }
__device__ __forceinline__ float siluf_(float x) { return x * sigmoidf_(x); }
__device__ __forceinline__ float gelu_tanh(float x) { const float u = 0.7978845608028654f * (x + 0.044715f * x * x * x); return 0.5f * x * (1.0f + tanhf_(u)); }
__device__ __forceinline__ float wave_sum(float v) {
#pragma unroll
  for (int o = 32; o >= 1; o >>= 1) v += __shfl_xor(v, o);
  return v;
}
template <int CTRL> __device__ __forceinline__ float dpp_add(float x) {
  const int xi = __float_as_int(x);
  const int yi = __builtin_amdgcn_update_dpp(xi, xi, CTRL, 0xF, 0xF, false);
  return x + __int_as_float(yi);
}
__device__ __forceinline__ float fma_(float a, float b, float c) { float r; asm("v_fma_f32 %0, %1, %2, %3" : "=v"(r) : "v"(a), "v"(b), "v"(c)); return r; }
__device__ __forceinline__ float mul_(float a, float b) { float r; asm("v_mul_f32 %0, %1, %2" : "=v"(r) : "v"(a), "v"(b)); return r; }
__device__ __forceinline__ float add_(float a, float b) { float r; asm("v_add_f32 %0, %1, %2" : "=v"(r) : "v"(a), "v"(b)); return r; }
typedef float f32x2 __attribute__((ext_vector_type(2)));
__device__ __forceinline__ float dot4(f32x4 a, f32x4 b) { const f32x2 t = a.lo * b.lo + a.hi * b.hi; return t.x + t.y; }
__device__ __forceinline__ float row16_sum(float x) {
  x = dpp_add<0xB1>(x);
  x = dpp_add<0x4E>(x);
  x = dpp_add<0x141>(x);
  x = dpp_add<0x140>(x);
  return x;
}
__device__ __forceinline__ const float* resid_src(const Params& P, int layer, int t) {
  if (layer == 0) return t < NCTX ? PIN(I_CTX) + (size_t)t * DM : PIN(I_X) + (size_t)(t - NCTX) * DM;
  return t < NCTX ? (const float*)(PWS() + WS_XC) + (size_t)t * DM : POUT() + (size_t)(t - NCTX) * DM;
}
__device__ __forceinline__ float* resid_dst(const Params& P, int t) {
  return t < NCTX ? (float*)(PWS() + WS_XC) + (size_t)t * DM : POUT() + (size_t)(t - NCTX) * DM;
}
__device__ __forceinline__ int scan_pos_rev(int t) { return t < NCTX ? (NCTX - 1 - t) : (T + NCTX - 1 - t); }

__device__ __forceinline__ void phase_mod(const Params& P, float* lds) {
  const int tid = mk_tid(), cgp = tid & 15, rg = tid >> 4;
  float* mod = (float*)(PWS() + WS_MOD);
  const float* cvec = PIN(I_C); const float* ccvec = PIN(I_CCTX); const float* adaw = PIN(I_ADAW); const float* adab = PIN(I_ADAB);
  for (int item = mk_bid(); item < 2 * 192; item += mk_nblk()) {
    const int layer = item / 192, col0 = (item % 192) * 64;
    const float* W = adaw + (size_t)layer * DM * 12288 + col0 + cgp * 4;
    f32x4 al = {0.f, 0.f, 0.f, 0.f}, ac = {0.f, 0.f, 0.f, 0.f};
#pragma unroll 1
    for (int r0 = 0; r0 < 64; r0 += 8) {
      f32x4 wv[8]; float sl[8], sc[8];
#pragma unroll
      for (int r = 0; r < 8; ++r) { const int row = rg * 64 + r0 + r; wv[r] = *(const f32x4*)(W + (size_t)row * 12288); sl[r] = cvec[row]; sc[r] = ccvec[row]; }
#pragma unroll
      for (int r = 0; r < 8; ++r) { al += siluf_(sl[r]) * wv[r]; ac += siluf_(sc[r]) * wv[r]; }
    }
#pragma unroll
    for (int i = 0; i < 4; ++i) { lds[(rg * 2 + 0) * 64 + cgp * 4 + i] = al[i]; lds[(rg * 2 + 1) * 64 + cgp * 4 + i] = ac[i]; }
    __syncthreads();
    if (tid < 128) {
      const int which = tid >> 6, col = tid & 63; float sacc = 0.f;
      for (int g = 0; g < 32; ++g) sacc += lds[(g * 2 + which) * 64 + col];
      mod[(size_t)(layer * 2 + which) * 12288 + col0 + col] = sacc + adab[(size_t)layer * 12288 + col0 + col];
    }
    __syncthreads();
  }
}

struct CvtItem { const float* src; bf16_t* dst; int K, N, kt, ntile; bool valid; };
__device__ __forceinline__ CvtItem cvt_decode(const Params& P, int layer, int it) {
  CvtItem r; r.src = nullptr; r.dst = nullptr; r.K = 64; r.N = 0; r.kt = 0; r.ntile = 0; r.valid = false;
  int base = 0;
#define CVT_JOB(SRC, DST, KK, NN) do { const int nkt_ = (KK) / 64, cnt_ = nkt_ * (((NN) + 63) / 64); \
    if (!r.valid && it < base + cnt_) { const int tl_ = it - base; r.src = (SRC); r.dst = (DST); r.K = (KK); r.N = (NN); r.kt = tl_ % nkt_; r.ntile = tl_ / nkt_; r.valid = true; } base += cnt_; } while (0)
  CVT_JOB(PIN(I_WIN) + (size_t)layer * DM * 3616, (bf16_t*)(PWS() + WS_WIN), DM, 3616);
  CVT_JOB(PIN(I_RWVDOWN), (bf16_t*)(PWS() + WS_WIN) + (size_t)C_VD * DM, DM, (layer == 0) ? 0 : 32);
  CVT_JOB(PIN(I_WOUT) + (size_t)layer * DM * DM, (bf16_t*)(PWS() + WS_WOUT), DM, DM);
  CVT_JOB(PIN(I_WQB) + (size_t)layer * 512 * 1536, (bf16_t*)(PWS() + WS_WQ), 512, 1536);
  CVT_JOB(PIN(I_WKVB) + (size_t)layer * 256 * 2048, (bf16_t*)(PWS() + WS_WKV), 256, 2048);
  CVT_JOB(PIN(I_WGATE) + (size_t)layer * DM * DFF, (bf16_t*)(PWS() + WS_WGU), DM, DFF);
  CVT_JOB(PIN(I_WUP) + (size_t)layer * DM * DFF, (bf16_t*)(PWS() + WS_WGU) + (size_t)DFF * DM, DM, DFF);
  CVT_JOB(PIN(I_WDOWN) + (size_t)layer * DFF * DM, (bf16_t*)(PWS() + WS_WDN), DFF, DM);
#undef CVT_JOB
  return r;
}
__device__ __forceinline__ void cvt_load(const CvtItem& c, f32x4 (&v)[2]) {
  const int tid = mk_tid(), kr = tid >> 4, nc = (tid & 15) * 4, k0 = c.kt * 64, n0 = c.ntile * 64;
#pragma unroll
  for (int i = 0; i < 2; ++i) { v[i] = (f32x4){0.f, 0.f, 0.f, 0.f}; if (c.valid && n0 + nc < c.N) v[i] = *(const f32x4*)(c.src + (size_t)(k0 + kr + 32 * i) * c.N + n0 + nc); }
}
__device__ __forceinline__ void phase_convert(const Params& P, int layer, float* lds) {
  const int tid = mk_tid(), kr = tid >> 4, nc = (tid & 15) * 4, n = tid >> 3, kc = (tid & 7) * 8, G = mk_nblk();
  int it = mk_bid();
  CvtItem cur = cvt_decode(P, layer, it); f32x4 v[2]; cvt_load(cur, v);
  while (cur.valid) {
    const CvtItem nxt = cvt_decode(P, layer, it + G); f32x4 nv[2]; cvt_load(nxt, nv);
#pragma unroll
    for (int i = 0; i < 2; ++i) { const int k = kr + 32 * i;
      lds[(nc + 0) * 65 + k] = v[i][0]; lds[(nc + 1) * 65 + k] = v[i][1]; lds[(nc + 2) * 65 + k] = v[i][2]; lds[(nc + 3) * 65 + k] = v[i][3]; }
    __syncthreads();
    if (cur.ntile * 64 + n < cur.N) {
      const float* p = lds + n * 65 + kc;
      u32x4 w; w.x = cvtpk(p[0], p[1]); w.y = cvtpk(p[2], p[3]); w.z = cvtpk(p[4], p[5]); w.w = cvtpk(p[6], p[7]);
      *(u32x4*)(cur.dst + (size_t)(cur.ntile * 64 + n) * cur.K + cur.kt * 64 + kc) = w;
    }
    __syncthreads();
    cur = nxt; v[0] = nv[0]; v[1] = nv[1]; it += G;
  }
}

__device__ __forceinline__ void phase_norm(const Params& P, int layer, int which, bool skip_ctx) {
  const int lane = mk_tid() & 63, wave = mk_tid() >> 6;
  const float* g = P.in[which ? I_NORM2 : I_NORM1] + (size_t)layer * DM;
  const float* mod = (const float*)(PWS() + WS_MOD) + (size_t)layer * 2 * 12288;
  bf16_t* H = (bf16_t*)(PWS() + WS_H);
  const int soff = which ? 6144 : 0;
  const float* src_c = (which == 0 && layer == 0) ? PIN(I_CTX) : (const float*)(PWS() + WS_XC);
  const float* src_l = (which == 0 && layer == 0) ? PIN(I_X) : (const float*)POUT();
  const int stride = mk_nblk() * 8;
  for (int row = mk_bid() * 8 + wave; row < T; row += 2 * stride) {
    int rows[2] = {row, row + stride}; f32x4 v[2][8]; bool ok[2];
#pragma unroll
    for (int u = 0; u < 2; ++u) { ok[u] = rows[u] < T && !(skip_ctx && rows[u] < NCTX);
      if (ok[u]) { const float* xr = rows[u] < NCTX ? src_c + (size_t)rows[u] * DM : src_l + (size_t)(rows[u] - NCTX) * DM;
#pragma unroll
        for (int i = 0; i < 8; ++i) v[u][i] = *(const f32x4*)(xr + i * 256 + lane * 4);
        if (which == 0 && layer == 0 && rows[u] < NCTX) { float* xc = (float*)(PWS() + WS_XC) + (size_t)rows[u] * DM;
#pragma unroll
          for (int i = 0; i < 8; ++i) *(f32x4*)(xc + i * 256 + lane * 4) = v[u][i]; } } }
#pragma unroll
    for (int u = 0; u < 2; ++u) if (ok[u]) {
      const float* m = mod + (rows[u] < NCTX ? 12288 : 0) + soff; float ss = 0.f;
#pragma unroll
      for (int i = 0; i < 8; ++i) ss += v[u][i][0] * v[u][i][0] + v[u][i][1] * v[u][i][1] + v[u][i][2] * v[u][i][2] + v[u][i][3] * v[u][i][3];
      ss = wave_sum(ss);
      const float rstd = rsqrtf(ss * (1.0f / DM) + 1e-6f);
#pragma unroll
      for (int i = 0; i < 8; ++i) {
        const int c = i * 256 + lane * 4;
        const f32x4 gv = *(const f32x4*)(g + c), sh = *(const f32x4*)(m + c), sc = *(const f32x4*)(m + 2048 + c);
        float o[4];
#pragma unroll
        for (int q = 0; q < 4; ++q) o[q] = (v[u][i][q] * rstd * gv[q]) * (1.0f + sc[q]) + sh[q];
        u32x2 w; w.x = cvtpk(o[0], o[1]); w.y = cvtpk(o[2], o[3]);
        *(u32x2*)(H + (size_t)rows[u] * DM + c) = w;
      }
    }
  }
}

__device__ __forceinline__ void phase_final_norm(const Params& P) {
  const int lane = mk_tid() & 63, wave = mk_tid() >> 6;
  const float* g = PIN(I_FNORM); float* out = POUT();
  const int stride = mk_nblk() * 8;
  for (int row = mk_bid() * 8 + wave; row < T - NCTX; row += 2 * stride) {
    int rows[2] = {row, row + stride}; f32x4 v[2][8]; bool ok[2];
#pragma unroll
    for (int u = 0; u < 2; ++u) { ok[u] = rows[u] < T - NCTX;
      if (ok[u]) {
#pragma unroll
        for (int i = 0; i < 8; ++i) v[u][i] = *(const f32x4*)(out + (size_t)rows[u] * DM + i * 256 + lane * 4); } }
#pragma unroll
    for (int u = 0; u < 2; ++u) if (ok[u]) {
      float ss = 0.f;
#pragma unroll
      for (int i = 0; i < 8; ++i) ss += v[u][i][0] * v[u][i][0] + v[u][i][1] * v[u][i][1] + v[u][i][2] * v[u][i][2] + v[u][i][3] * v[u][i][3];
      ss = wave_sum(ss);
      const float rstd = rsqrtf(ss * (1.0f / DM) + 1e-6f);
#pragma unroll
      for (int i = 0; i < 8; ++i) { const int c = i * 256 + lane * 4; const f32x4 gv = *(const f32x4*)(g + c); *(f32x4*)(out + (size_t)rows[u] * DM + c) = v[u][i] * rstd * gv; }
    }
  }
}

struct EpiStore {
  static constexpr bool PERM = true, AFTER_DRAIN = false;
  bf16_t* O; int ldc;
  __device__ __forceinline__ void operator()(const f32x4 (&acc)[2][2][4][2], const pg8::Unit& u, int wr, int wc, int fr, int fq) const {
    const int row0 = u.pm * 256 + wr * 64 + fr, col0 = u.pn * 256 + wc * 32 + 8 * fq;
#pragma unroll
    for (int ai = 0; ai < 2; ++ai)
#pragma unroll
      for (int m = 0; m < 4; ++m) { bf16_t* rowp = O + (size_t)(row0 + ai * 128 + m * 16) * ldc + col0;
#pragma unroll
        for (int bj = 0; bj < 2; ++bj) { const f32x4 v0 = acc[ai][bj][m][0], v1 = acc[ai][bj][m][1];
          u32x4 w; w.x = cvtpk(v0[0], v0[1]); w.y = cvtpk(v0[2], v0[3]); w.z = cvtpk(v1[0], v1[1]); w.w = cvtpk(v1[2], v1[3]);
          *(u32x4*)(rowp + bj * 128) = w; } }
  }
};
struct EpiResid {
  static constexpr bool PERM = false, AFTER_DRAIN = false;
  const float* src_c; const float* src_l; float* dst_c; float* dst_l; const float* gate_c; const float* gate_l; int row_off;
  __device__ __forceinline__ void operator()(const f32x4 (&acc)[2][2][4][2], const pg8::Unit& u, int wr, int wc, int fr, int fq) const {
    const int t0 = row_off + u.pm * 256;
    const bool isc = t0 < NCTX;
    const float* src = isc ? src_c : src_l - (size_t)NCTX * DM; float* dst = isc ? dst_c : dst_l - (size_t)NCTX * DM; const float* gate = isc ? gate_c : gate_l;
    const int row0 = t0 + wr * 64 + fr, col0 = u.pn * 256 + wc * 32 + 4 * fq;
    f32x4 gv[2][2];
#pragma unroll
    for (int bj = 0; bj < 2; ++bj)
#pragma unroll
      for (int n = 0; n < 2; ++n) gv[bj][n] = *(const f32x4*)(gate + col0 + bj * 128 + n * 16);
#pragma unroll
    for (int ai = 0; ai < 2; ++ai)
#pragma unroll
      for (int m = 0; m < 4; ++m) { const size_t off = (size_t)(row0 + ai * 128 + m * 16) * DM + col0;
#pragma unroll
        for (int bj = 0; bj < 2; ++bj)
#pragma unroll
          for (int n = 0; n < 2; ++n) { const f32x4 xs = *(const f32x4*)(src + off + bj * 128 + n * 16);
            *(f32x4*)(dst + off + bj * 128 + n * 16) = xs + gv[bj][n] * acc[ai][bj][m][n]; } }
  }
};

struct EpiResidAtomic {
  static constexpr bool PERM = false, AFTER_DRAIN = false;
  float* dst; const float* gate;
  __device__ __forceinline__ void operator()(const f32x4 (&acc)[2][2][4][2], const pg8::Unit& u, int wr, int wc, int fr, int fq) const {
    const int row0 = wr * 64 + fr, col0 = u.pn * 256 + wc * 32 + 4 * fq;
    f32x4 gv[2][2];
#pragma unroll
    for (int bj = 0; bj < 2; ++bj)
#pragma unroll
      for (int n = 0; n < 2; ++n) gv[bj][n] = *(const f32x4*)(gate + col0 + bj * 128 + n * 16);
#pragma unroll
    for (int ai = 0; ai < 2; ++ai)
#pragma unroll
      for (int m = 0; m < 4; ++m) { float* rp = dst + (size_t)(row0 + ai * 128 + m * 16) * DM + col0;
#pragma unroll
        for (int bj = 0; bj < 2; ++bj)
#pragma unroll
          for (int n = 0; n < 2; ++n) { const f32x4 v = gv[bj][n] * acc[ai][bj][m][n];
#pragma unroll
            for (int q = 0; q < 4; ++q) __hip_atomic_fetch_add(rp + bj * 128 + n * 16 + q, v[q], __ATOMIC_RELAXED, __HIP_MEMORY_SCOPE_AGENT); } }
  }
};
template <class Epi>
__device__ __forceinline__ void run_gemm(unsigned char* lds, const bf16_t* A, const bf16_t* Bt, int M, int N, int K, const Epi& E, int wg, int nwg, int ld = 0, int ksplit = 0) {
  pg8::Gemm g{A, Bt, M, N, K, ld ? ld : K, ksplit}; pg8::StaticOrder S; S.init(M, N, nwg, wg);
  pg8::gemm_phase<Epi, pg8::StaticOrder, false>((PG8_LAS unsigned char*)lds, g, S, E, nullptr);
}

__device__ __forceinline__ float colv(const bf16_t* cols, int t, int c) { return bf2f(cols[(size_t)t * NIN + c]); }
__device__ __forceinline__ float rwconv3(const bf16_t* cols, const float* cw, const float* cb, int t, int c, int lo, int hi) {
  float u = cb[c] + cw[1760 + c] * colv(cols, t, c);
  if (t - 1 >= lo) u += cw[c] * colv(cols, t - 1, c);
  if (t + 1 < hi) u += cw[2 * 1760 + c] * colv(cols, t + 1, c);
  return u;
}

__device__ __forceinline__ float rwconv3w(const bf16_t* cols, float w0, float w1, float w2, float b, int t, int c, int lo, int hi) {
  float u = b + w1 * colv(cols, t, c);
  if (t - 1 >= lo) u += w0 * colv(cols, t - 1, c);
  if (t + 1 < hi) u += w2 * colv(cols, t + 1, c);
  return u;
}
template <int PART>
__device__ __forceinline__ void phase_prep(const Params& P, int layer, float* lds, int wg, int nwg) {
  const int tid = mk_tid(), lane = tid & 63, wave = tid >> 6;
  float* lin = lds;
  float* xs = lds + 8 * 256;
  const bf16_t* cols = (const bf16_t*)(PWS() + WS_COLS);
  const float* cw = PIN(I_RWCONV) + (size_t)layer * 3 * 1760; const float* cb = PIN(I_RWCONVB) + (size_t)layer * 1760;
  const float* lcw = PIN(I_LRUCONV) + (size_t)layer * 4 * 512; const float* lcb = PIN(I_LRUCONVB) + (size_t)layer * 512;
  const int c = tid, hd = c >> 6, n = c & 63;
  bf16_t* VF = (bf16_t*)(PWS() + WS_VF); bf16_t* RG = (bf16_t*)(PWS() + WS_RG); bf16_t* CV = (bf16_t*)(PWS() + WS_CV);
  bf16_t* LAB = (bf16_t*)(PWS() + WS_LAB); bf16_t* GG = (bf16_t*)(PWS() + WS_GG);
  bf16_t* QN = (bf16_t*)(PWS() + WS_QN); bf16_t* KVN = (bf16_t*)(PWS() + WS_KVN); bf16_t* KR = (bf16_t*)(PWS() + WS_KR);
  unsigned char* REC = PWS() + WS_REC;
  const float w0_0 = PIN(I_RWW0)[(layer * 2 + 0) * 512 + c], w0_1 = PIN(I_RWW0)[(layer * 2 + 1) * 512 + c];
  const float a0_0 = PIN(I_RWA0)[(layer * 2 + 0) * 512 + c], a0_1 = PIN(I_RWA0)[(layer * 2 + 1) * 512 + c];
  const float kkc = PIN(I_RWKK)[layer * 512 + c], kac = PIN(I_RWKA)[layer * 512 + c], rkc = PIN(I_RWRK)[layer * 512 + c];
  const float v0c = (layer > 0) ? PIN(I_RWV0)[c] : 0.f;
  const float* wup = PIN(I_RWWUP) + (size_t)layer * 2 * 32 * 512 + c; const float* aup = PIN(I_RWAUP) + (size_t)layer * 2 * 32 * 512 + c;
  const float* gup = PIN(I_RWGUP) + (size_t)layer * 96 * 512 + c; const float* vup = PIN(I_RWVUP) + c;
  const float* lwa = PIN(I_LRUWA) + (size_t)layer * 2 * 8 * 4096 + (size_t)hd * 4096 + n; const float* lwx = PIN(I_LRUWX) + (size_t)layer * 2 * 8 * 4096 + (size_t)hd * 4096 + n;
  const float lba0 = PIN(I_LRUBA)[(layer * 2 + 0) * 512 + c], lba1 = PIN(I_LRUBA)[(layer * 2 + 1) * 512 + c];
  const float lbx0 = PIN(I_LRUBX)[(layer * 2 + 0) * 512 + c], lbx1 = PIN(I_LRUBX)[(layer * 2 + 1) * 512 + c];
  const float lam0 = PIN(I_LRULAM)[(layer * 2 + 0) * 512 + c], lam1 = PIN(I_LRULAM)[(layer * 2 + 1) * 512 + c];
  const float sp0 = log1pf(__expf(-lam0)), sp1 = log1pf(__expf(-lam1));
  float cwr[3], cwk[3], cwv[3], cwe[3], cbr = 0.f, cbk = 0.f, cbv = 0.f, cbe = 0.f;
  const int ecol = 1536 + ((tid & 255) < 224 ? (tid & 255) : 0);
#pragma unroll
  for (int q = 0; q < 3; ++q) { cwr[q] = (PART == 0) ? cw[q * 1760 + c] : 0.f; cwk[q] = (PART == 0) ? cw[q * 1760 + 512 + c] : 0.f; cwv[q] = (PART == 0) ? cw[q * 1760 + 1024 + c] : 0.f; cwe[q] = (PART == 0) ? cw[q * 1760 + ecol] : 0.f; }
  if (PART == 0) { cbr = cb[c]; cbk = cb[512 + c]; cbv = cb[1024 + c]; cbe = cb[ecol]; }

  for (int tile = wg; tile < T / 8; tile += nwg) {
    const int t0 = tile * 8;
    const int lo = t0 < NCTX ? 0 : NCTX, hi = t0 < NCTX ? NCTX : T;
    if (PART == 0) {
#pragma unroll
    for (int i = 0; i < 4; ++i) {
      const int idx = tid + 512 * i, tt = idx >> 8, e = idx & 255, t = t0 + tt; float v;
      if (e < 224) { v = rwconv3w(cols, cwe[0], cwe[1], cwe[2], cbe, t, 1536 + e, lo, hi); if (e < 64) v = tanhf_(v); else if (e >= 128) v = sigmoidf_(v); }
      else v = (layer > 0) ? colv(cols, t, C_VD + e - 224) : 0.f;
      lin[tt * 256 + e] = v;
    }
    }
    if (PART == 1) {
#pragma unroll
    for (int tt = 0; tt < 8; ++tt) {
      const int t = t0 + tt; float u = lcb[c];
#pragma unroll
      for (int j = 0; j < 4; ++j) { const int ts = t + j - 2; if (ts >= lo && ts < hi) u += lcw[j * 512 + c] * colv(cols, ts, C_LRU + c); }
      xs[tt * 512 + c] = u;
    }
    {
      const int t = t0 + wave; const bf16_t* cr = cols + (size_t)t * NIN;
      float q[8]; float ss = 0.f;
      { const bf16x8 raw = *(const bf16x8*)(cr + C_MLA + lane * 8);
#pragma unroll
        for (int i = 0; i < 8; ++i) { q[i] = bf2f((bf16_t)raw[i]); ss += q[i] * q[i]; } }
      ss = wave_sum(ss); float rstd = rsqrtf(ss * (1.0f / 512.0f) + 1e-6f);
      { const float* gq = PIN(I_QNORM) + layer * 512 + lane * 8; u32x4 w;
        w.x = cvtpk(q[0] * rstd * gq[0], q[1] * rstd * gq[1]); w.y = cvtpk(q[2] * rstd * gq[2], q[3] * rstd * gq[3]);
        w.z = cvtpk(q[4] * rstd * gq[4], q[5] * rstd * gq[5]); w.w = cvtpk(q[6] * rstd * gq[6], q[7] * rstd * gq[7]);
        *(u32x4*)(QN + (size_t)t * 512 + lane * 8) = w; }
      float k4[4]; ss = 0.f;
      { const s16x4 raw = *(const s16x4*)(cr + C_MLA + 512 + lane * 4);
#pragma unroll
        for (int i = 0; i < 4; ++i) { k4[i] = bf2f((bf16_t)raw[i]); ss += k4[i] * k4[i]; } }
      ss = wave_sum(ss); rstd = rsqrtf(ss * (1.0f / 256.0f) + 1e-6f);
      { const float* gk = PIN(I_KVNORM) + layer * 256 + lane * 4; u32x2 w;
        w.x = cvtpk(k4[0] * rstd * gk[0], k4[1] * rstd * gk[1]); w.y = cvtpk(k4[2] * rstd * gk[2], k4[3] * rstd * gk[3]);
        *(u32x2*)(KVN + (size_t)t * 256 + lane * 4) = w; }
      const float own = bf2f(cr[C_MLA + 768 + lane]); const float oth = __shfl_xor(own, 16);
      float res = own;
      if (t >= NCTX) {
        const int tl = t - NCTX, axis = lane >> 5, half = (lane >> 4) & 1, f = lane & 15;
        const float pos = (float)(axis == 0 ? (tl >> 6) : (tl & 63));
        const float inv = exp2f(-(float)f * (13.287712379549449f / 16.0f));
        const float sn = __sinf(pos * inv), cs = __cosf(pos * inv);
        res = half == 0 ? own * cs - oth * sn : oth * sn + own * cs;
      }
      KR[(size_t)t * 64 + lane] = f2bf(res);
    }
    }
    __syncthreads();
    if (PART == 0) {
      float zw0[8], zw1[8], za0[8], za1[8], gg[8], mx[8];
#pragma unroll
      for (int tt = 0; tt < 8; ++tt) { zw0[tt] = 0.f; zw1[tt] = 0.f; za0[tt] = 0.f; za1[tt] = 0.f; gg[tt] = 0.f; mx[tt] = 0.f; }
      {
        float wa[4], wb[4], aa[4], ab[4], vv[4];
#pragma unroll
        for (int i = 0; i < 4; ++i) { wa[i] = wup[(size_t)i * 512]; wb[i] = wup[(size_t)(32 + i) * 512]; aa[i] = aup[(size_t)i * 512]; ab[i] = aup[(size_t)(32 + i) * 512]; vv[i] = (layer > 0) ? vup[(size_t)i * 512] : 0.f; }
#pragma unroll 1
        for (int e = 0; e < 32; e += 4) {
          float nwa[4], nwb[4], naa[4], nab[4], nvv[4];
          const int en = (e + 4 < 32) ? e + 4 : e;
#pragma unroll
          for (int i = 0; i < 4; ++i) { nwa[i] = wup[(size_t)(en + i) * 512]; nwb[i] = wup[(size_t)(32 + en + i) * 512]; naa[i] = aup[(size_t)(en + i) * 512]; nab[i] = aup[(size_t)(32 + en + i) * 512];
            nvv[i] = (layer > 0) ? vup[(size_t)(en + i) * 512] : 0.f; }
#pragma unroll
          for (int tt = 0; tt < 8; ++tt) {
            const f32x4 x0 = *(const f32x4*)(lin + tt * 256 + e), x1 = *(const f32x4*)(lin + tt * 256 + 32 + e), y0 = *(const f32x4*)(lin + tt * 256 + 64 + e),
                        y1 = *(const f32x4*)(lin + tt * 256 + 96 + e), hv = *(const f32x4*)(lin + tt * 256 + 224 + e);
#pragma unroll
            for (int i = 0; i < 4; ++i) { zw0[tt] += x0[i] * wa[i]; zw1[tt] += x1[i] * wb[i]; za0[tt] += y0[i] * aa[i]; za1[tt] += y1[i] * ab[i]; mx[tt] += hv[i] * vv[i]; }
          }
#pragma unroll
          for (int i = 0; i < 4; ++i) { wa[i] = nwa[i]; wb[i] = nwb[i]; aa[i] = naa[i]; ab[i] = nab[i]; vv[i] = nvv[i]; }
        }
        float gw[8];
#pragma unroll
        for (int i = 0; i < 8; ++i) gw[i] = gup[(size_t)i * 512];
#pragma unroll 1
        for (int e = 0; e < 96; e += 8) {
          float ngw[8];
          const int en = (e + 8 < 96) ? e + 8 : e;
#pragma unroll
          for (int i = 0; i < 8; ++i) ngw[i] = gup[(size_t)(en + i) * 512];
#pragma unroll
          for (int tt = 0; tt < 8; ++tt) { const f32x4 s0 = *(const f32x4*)(lin + tt * 256 + 128 + e), s1 = *(const f32x4*)(lin + tt * 256 + 132 + e);
#pragma unroll
            for (int i = 0; i < 4; ++i) gg[tt] += s0[i] * gw[i] + s1[i] * gw[4 + i]; }
#pragma unroll
          for (int i = 0; i < 8; ++i) gw[i] = ngw[i];
        }
      }
      float r8[8], k8[8], v8[8], vf8[8];
#pragma unroll
      for (int tt = 0; tt < 8; ++tt) { const int t = t0 + tt;
        r8[tt] = rwconv3w(cols, cwr[0], cwr[1], cwr[2], cbr, t, c, lo, hi); k8[tt] = rwconv3w(cols, cwk[0], cwk[1], cwk[2], cbk, t, 512 + c, lo, hi); v8[tt] = rwconv3w(cols, cwv[0], cwv[1], cwv[2], cbv, t, 1024 + c, lo, hi);
        vf8[tt] = (layer > 0) ? bf2f(VF[(size_t)t * 512 + c]) : 0.f; }
#pragma unroll
      for (int tt = 0; tt < 8; ++tt) {
        const int t = t0 + tt;
        const float r = r8[tt], k = k8[tt]; float v = v8[tt];
        const float wd0 = __expf(-0.606531f * sigmoidf_(w0_0 + zw0[tt])), wd1 = __expf(-0.606531f * sigmoidf_(w0_1 + zw1[tt]));
        const float ic0 = sigmoidf_(a0_0 + za0[tt]), ic1 = sigmoidf_(a0_1 + za1[tt]);
        if (layer > 0) { const float mixv = sigmoidf_(v0c + mx[tt]); const float vf = vf8[tt]; v = v + (vf - v) * mixv; }
        else VF[(size_t)t * 512 + c] = f2bf(v);
        float kk = k * kkc; const float ssq = wave_sum(kk * kk); kk *= rsqrtf(fmaxf(ssq, 1e-24f));
        const float kd0 = k * (1.0f + (ic0 - 1.0f) * kac), kd1 = k * (1.0f + (ic1 - 1.0f) * kac);
        const float b0 = kk * ic0, b1 = kk * ic1;
        const float coef = wave_sum(r * (kd0 + kd1) * rkc);
        RG[(size_t)t * 512 + c] = f2bf(gg[tt]); CV[(size_t)t * 512 + c] = f2bf(coef * v);
        const bf16_t ab_ = f2bf(-kk), rb_ = f2bf(r), vb_ = f2bf(v);
        { unsigned char* rp = REC + ((size_t)(0 * 8 + hd) * T + t) * RECB;
          ((float*)rp)[n] = wd0; bf16_t* q = (bf16_t*)(rp + 256); q[n] = f2bf(kd0); q[64 + n] = ab_; q[128 + n] = f2bf(b0); q[192 + n] = rb_; q[256 + n] = vb_; }
        { unsigned char* rp = REC + ((size_t)(1 * 8 + hd) * T + scan_pos_rev(t)) * RECB;
          ((float*)rp)[n] = wd1; bf16_t* q = (bf16_t*)(rp + 256); q[n] = f2bf(kd1); q[64 + n] = ab_; q[128 + n] = f2bf(b1); q[192 + n] = rb_; q[256 + n] = vb_; }
        asm volatile("" ::: "memory");
      }
    }
    if (PART == 1) {
      float pa0[8], pa1[8], px0[8], px1[8];
#pragma unroll
      for (int tt = 0; tt < 8; ++tt) { pa0[tt] = 0.f; pa1[tt] = 0.f; px0[tt] = 0.f; px1[tt] = 0.f; }
      {
        float a0w[4], a1w[4], x0w[4], x1w[4];
#pragma unroll
        for (int i = 0; i < 4; ++i) { a0w[i] = lwa[(size_t)i * 64]; a1w[i] = lwa[(size_t)8 * 4096 + (size_t)i * 64]; x0w[i] = lwx[(size_t)i * 64]; x1w[i] = lwx[(size_t)8 * 4096 + (size_t)i * 64]; }
#pragma unroll 1
        for (int i0 = 0; i0 < 64; i0 += 4) {
          float na0[4], na1[4], nx0[4], nx1[4];
          const int in_ = (i0 + 4 < 64) ? i0 + 4 : i0;
#pragma unroll
          for (int i = 0; i < 4; ++i) { na0[i] = lwa[(size_t)(in_ + i) * 64]; na1[i] = lwa[(size_t)8 * 4096 + (size_t)(in_ + i) * 64]; nx0[i] = lwx[(size_t)(in_ + i) * 64]; nx1[i] = lwx[(size_t)8 * 4096 + (size_t)(in_ + i) * 64]; }
#pragma unroll
          for (int tt = 0; tt < 8; ++tt) { const f32x4 x = *(const f32x4*)(xs + tt * 512 + hd * 64 + i0);
#pragma unroll
            for (int i = 0; i < 4; ++i) { pa0[tt] += x[i] * a0w[i]; pa1[tt] += x[i] * a1w[i]; px0[tt] += x[i] * x0w[i]; px1[tt] += x[i] * x1w[i]; } }
#pragma unroll
          for (int i = 0; i < 4; ++i) { a0w[i] = na0[i]; a1w[i] = na1[i]; x0w[i] = nx0[i]; x1w[i] = nx1[i]; }
        }
      }
      float gt8[8];
#pragma unroll
      for (int tt = 0; tt < 8; ++tt) gt8[tt] = colv(cols, t0 + tt, C_LRU + 512 + c);
#pragma unroll
      for (int tt = 0; tt < 8; ++tt) {
        const int t = t0 + tt; const float xb = xs[tt * 512 + c];
        const float la0 = -8.0f * sigmoidf_(pa0[tt] + lba0) * sp0, la1 = -8.0f * sigmoidf_(pa1[tt] + lba1) * sp1;
        const float bb0 = sqrtf(fmaxf(1.0f - __expf(2.0f * la0), 0.f)) * sigmoidf_(px0[tt] + lbx0) * xb;
        const float bb1 = sqrtf(fmaxf(1.0f - __expf(2.0f * la1), 0.f)) * sigmoidf_(px1[tt] + lbx1) * xb;
        bf16_t* lp = LAB + (size_t)t * 2048;
        lp[c] = f2bf(la0); lp[512 + c] = f2bf(bb0); lp[1024 + c] = f2bf(la1); lp[1536 + c] = f2bf(bb1);
        GG[(size_t)t * 512 + c] = f2bf(gelu_tanh(gt8[tt]));
        asm volatile("" ::: "memory");
      }
    }
    __syncthreads();
  }
}

__device__ __forceinline__ void phase_lru_agg(const Params& P, int wg, int nwg) {
  const int c = mk_tid(); const bf16_t* LAB = (const bf16_t*)(PWS() + WS_LAB); float* AGG = (float*)(PWS() + WS_AGG);
  for (int ck = wg; ck < T / 64; ck += nwg) {
    float A0 = 1.f, B0 = 0.f, A1 = 1.f, B1 = 0.f;
#pragma unroll 1
    for (int t8 = 0; t8 < 64; t8 += 8) {
      bf16_t x[8][4];
#pragma unroll
      for (int u = 0; u < 8; ++u) { const bf16_t* lp = LAB + (size_t)(ck * 64 + t8 + u) * 2048; x[u][0] = lp[c]; x[u][1] = lp[512 + c]; x[u][2] = lp[1024 + c]; x[u][3] = lp[1536 + c]; }
#pragma unroll
      for (int u = 0; u < 8; ++u) {
        const float a0 = __expf(bf2f(x[u][0])), b0 = bf2f(x[u][1]), a1 = __expf(bf2f(x[u][2])), b1 = bf2f(x[u][3]);
        A0 = a0 * A0; B0 = a0 * B0 + b0;
        B1 = B1 + A1 * b1; A1 = A1 * a1;
      }
    }
    float* ap = AGG + (size_t)ck * 2048; ap[c] = A0; ap[512 + c] = B0; ap[1024 + c] = A1; ap[1536 + c] = B1;
  }
}
__device__ __forceinline__ float lru_compose(const float* AGG, int c, int off, int q0, int dq, int n, float h) {
  int i = 0;
#pragma unroll 1
  for (; i + 8 <= n; i += 8) {
    float a[8], b[8];
#pragma unroll
    for (int u = 0; u < 8; ++u) { const float* ap = AGG + (size_t)(q0 + (i + u) * dq) * 2048 + off; a[u] = ap[c]; b[u] = ap[512 + c]; }
#pragma unroll
    for (int u = 0; u < 8; ++u) h = a[u] * h + b[u];
  }
#pragma unroll 1
  for (; i < n; ++i) { const float* ap = AGG + (size_t)(q0 + i * dq) * 2048 + off; h = ap[c] * h + ap[512 + c]; }
  return h;
}
__device__ __forceinline__ void phase_lru_out(const Params& P, int layer, float* lds, int wg, int nwg) {
  const int c = mk_tid(); const bf16_t* LAB = (const bf16_t*)(PWS() + WS_LAB); const float* AGG = (const float*)(PWS() + WS_AGG);
  const bf16_t* GG = (const bf16_t*)(PWS() + WS_GG); bf16_t* MIX = (bf16_t*)(PWS() + WS_H);
  const int ck_lo = (layer == 1) ? 4 : 0;
  for (int ck = ck_lo + wg; ck < T / 64; ck += nwg) {
    float h0 = lru_compose(AGG, c, 0, 0, 1, ck, 0.f);
    float h1;
    if (ck < 4) h1 = lru_compose(AGG, c, 1024, 3, -1, 3 - ck, 0.f);
    else { h1 = lru_compose(AGG, c, 1024, 3, -1, 4, 0.f); h1 = lru_compose(AGG, c, 1024, T / 64 - 1, -1, T / 64 - 1 - ck, h1); }
#pragma unroll 1
    for (int t8 = 0; t8 < 64; t8 += 8) {
      bf16_t x[8][2];
#pragma unroll
      for (int u = 0; u < 8; ++u) { const bf16_t* lp = LAB + (size_t)(ck * 64 + t8 + u) * 2048; x[u][0] = lp[c]; x[u][1] = lp[512 + c]; }
#pragma unroll
      for (int u = 0; u < 8; ++u) { h0 = __expf(bf2f(x[u][0])) * h0 + bf2f(x[u][1]); lds[(t8 + u) * 512 + c] = h0; }
    }
#pragma unroll 1
    for (int t8 = 56; t8 >= 0; t8 -= 8) {
      bf16_t x[8][3];
#pragma unroll
      for (int u = 0; u < 8; ++u) { const int t = ck * 64 + t8 + u; const bf16_t* lp = LAB + (size_t)t * 2048; x[u][0] = lp[1024 + c]; x[u][1] = lp[1536 + c]; x[u][2] = GG[(size_t)t * 512 + c]; }
#pragma unroll
      for (int u = 7; u >= 0; --u) { const int t = ck * 64 + t8 + u; h1 = __expf(bf2f(x[u][0])) * h1 + bf2f(x[u][1]);
        MIX[(size_t)t * DM + 512 + c] = f2bf((lds[(t8 + u) * 512 + c] + h1) * bf2f(x[u][2])); }
    }
  }
}

template <int NCW>
__device__ __forceinline__ void rwkv_scan(const Params& P, int s, float* lds) {
  const int d = (NCW == 4) ? (s >> 5) : (s >> 4), h = (NCW == 4) ? ((s >> 2) & 7) : ((s >> 1) & 7), part = (NCW == 4) ? (s & 3) : (s & 1);
  const int tid = mk_tid(), lane = tid & 63, wave = tid >> 6, rgp = lane >> 4, j = lane & 15, row = part * (NCW * 4) + (wave & (NCW - 1)) * 4 + rgp;
  const unsigned char* rec = PWS() + WS_REC + (size_t)(d * 8 + h) * T * RECB;
  float* Y = (float*)(PWS() + WS_Y) + (size_t)d * T * 512 + h * 64 + row;
  constexpr int NST = (NCW == 4) ? 7 : 4, STS = (NCW == 4) ? 256 : 512;
  const bool stager = (NCW == 4) ? (wave >= 4) : true; const int stid = (NCW == 4) ? (tid - 256) : tid;
  int goff[NST], loff[NST]; bool isw[NST], val[NST];
#pragma unroll
  for (int i = 0; i < NST; ++i) { const int q = stid + STS * i; val[i] = stager && q >= 0 && q < 1792; const int rc = q / 56, pr = q % 56; goff[i] = rc * RECB + pr * 16; isw[i] = pr < 16;
    loff[i] = rc * 384 + (isw[i] ? pr * 4 : 64 + ((pr - 16) >> 3) * 64 + ((pr - 16) & 7) * 8); }
  u32x4 stA[NST], stB[NST];
#define RS_LOAD(st, ch) do { _Pragma("unroll") for (int i = 0; i < NST; ++i) if (val[i]) st[i] = *(const u32x4*)(rec + (size_t)(ch) * 32 * RECB + goff[i]); } while (0)
#define RS_WRITE(st, buf) do { _Pragma("unroll") for (int i = 0; i < NST; ++i) if (val[i]) { float* dp = (buf) + loff[i]; \
    if (isw[i]) { *(u32x4*)dp = st[i]; } else { u32x4 lo_, hi_; lo_.x = st[i].x << 16; lo_.y = st[i].x & 0xffff0000u; lo_.z = st[i].y << 16; lo_.w = st[i].y & 0xffff0000u; \
      hi_.x = st[i].z << 16; hi_.y = st[i].z & 0xffff0000u; hi_.z = st[i].w << 16; hi_.w = st[i].w & 0xffff0000u; *(u32x4*)dp = lo_; *(u32x4*)(dp + 4) = hi_; } } } while (0)
  f32x4 S = {0.f, 0.f, 0.f, 0.f}; float ykeep = 0.f, yprev = 0.f;
  constexpr int NCH = T / 32;
#define RS_COMPUTE(ch) do { const float* buf = lds + ((ch) & 1) * 12288; \
    if (wave < NCW) { \
      const float* sp = buf + j * 4; \
      f32x4 w4 = *(const f32x4*)(sp), kd4 = *(const f32x4*)(sp + 64), a4 = *(const f32x4*)(sp + 128), b4 = *(const f32x4*)(sp + 192), r4 = *(const f32x4*)(sp + 256); \
      float v = buf[320 + row]; \
      _Pragma("unroll 8") \
      for (int stp = 0; stp < 32; ++stp) { \
        float sa = dot4(S, a4); \
          \
        __builtin_amdgcn_sched_barrier(0); \
        const float* np = sp + (stp + 1) * 384;            \
        const f32x4 nw4 = *(const f32x4*)(np), nkd4 = *(const f32x4*)(np + 64), na4 = *(const f32x4*)(np + 128), nb4 = *(const f32x4*)(np + 192), nr4 = *(const f32x4*)(np + 256); \
        const float nv = buf[(stp + 1) * 384 + 320 + row]; \
        __builtin_amdgcn_sched_barrier(0); \
          \
          \
        f32x2 q01, t23, vv; vv[0] = v; vv[1] = v; \
        { const f32x2 kd01 = kd4.lo, kd23 = kd4.hi, S01 = S.lo, w01 = w4.lo; \
        asm volatile("v_add_f32_dpp %0, %0, %0 quad_perm:[1,0,3,2] row_mask:0xf bank_mask:0xf\n\t" \
                     "v_add_f32_dpp %1, %1, %1 quad_perm:[1,0,3,2] row_mask:0xf bank_mask:0xf\n\t" \
                     "v_pk_mul_f32 %2, %4, %6 op_sel_hi:[1,0]\n\t" \
                     "v_add_f32_dpp %0, %0, %0 quad_perm:[2,3,0,1] row_mask:0xf bank_mask:0xf\n\t" \
                     "v_add_f32_dpp %1, %1, %1 quad_perm:[2,3,0,1] row_mask:0xf bank_mask:0xf\n\t" \
                     "v_pk_mul_f32 %3, %5, %6 op_sel_hi:[1,0]\n\t" \
                     "v_add_f32_dpp %0, %0, %0 row_half_mirror row_mask:0xf bank_mask:0xf\n\t" \
                     "v_add_f32_dpp %1, %1, %1 row_half_mirror row_mask:0xf bank_mask:0xf\n\t" \
                     "v_pk_fma_f32 %2, %7, %8, %2\n\t" \
                     "v_add_f32_dpp %0, %0, %0 row_mirror row_mask:0xf bank_mask:0xf\n\t" \
                     "v_add_f32_dpp %1, %1, %1 row_mirror row_mask:0xf bank_mask:0xf" \
                     : "+v"(sa), "+v"(yprev), "=&v"(q01), "=&v"(t23) \
                     : "v"(kd01), "v"(kd23), "v"(vv), "v"(S01), "v"(w01)); } \
        const f32x2 q23 = S.hi * w4.hi + t23; \
        ykeep = (((stp + 15) & 15) == j) ? yprev : ykeep;         \
        if ((stp & 15) == 0 && ((ch) > 0 || stp > 0)) { const int p = (ch) * 32 + stp - 16 + j; const int tok = d ? scan_pos_rev(p) : p; Y[(size_t)tok * 512] = ykeep; } \
        S.lo = sa * b4.lo + q01; S.hi = sa * b4.hi + q23; \
        yprev = dot4(S, r4); \
        w4 = nw4; kd4 = nkd4; a4 = na4; b4 = nb4; r4 = nr4; v = nv; \
      } \
    } } while (0)
  RS_LOAD(stA, 0); RS_WRITE(stA, lds); RS_LOAD(stA, 1); __syncthreads();
  static_assert(NCH % 2 == 0, "the chunk loop is unrolled by two");
  for (int ch = 0; ch < NCH; ch += 2) {
    if (ch + 2 < NCH) RS_LOAD(stB, ch + 2);
    RS_COMPUTE(ch);
    RS_WRITE(stA, lds + 12288);
    __syncthreads();
    if (ch + 3 < NCH) RS_LOAD(stA, ch + 3);
    RS_COMPUTE(ch + 1);
    if (ch + 2 < NCH) RS_WRITE(stB, lds);
    __syncthreads();
  }
  if (wave < NCW) {
    yprev = row16_sum(yprev);
    ykeep = (j == 15) ? yprev : ykeep;
    const int p = T - 16 + j; const int tok = d ? scan_pos_rev(p) : p; Y[(size_t)tok * 512] = ykeep;
  }
#undef RS_COMPUTE
#undef RS_LOAD
#undef RS_WRITE
}

__device__ __forceinline__ void phase_rwkv_out(const Params& P, int layer, int wg, int nwg) {
  const int c = mk_tid();
  const float* Y0 = (const float*)(PWS() + WS_Y); const float* Y1 = Y0 + (size_t)T * 512;
  const bf16_t* RG = (const bf16_t*)(PWS() + WS_RG); const bf16_t* CV = (const bf16_t*)(PWS() + WS_CV); bf16_t* MIX = (bf16_t*)(PWS() + WS_H);
  const float lg = PIN(I_RWLNG)[layer * 512 + c], lb = PIN(I_RWLNB)[layer * 512 + c];
  const int G = nwg;
  for (int t0 = (layer == 1 ? NCTX : 0) + wg; t0 < T; t0 += 4 * G) {
    float y[4], cv[4], rg[4];
#pragma unroll
    for (int u = 0; u < 4; ++u) { const int t = t0 + u * G; if (t < T) { y[u] = Y0[(size_t)t * 512 + c] + Y1[(size_t)t * 512 + c]; cv[u] = bf2f(CV[(size_t)t * 512 + c]); rg[u] = bf2f(RG[(size_t)t * 512 + c]); } else { y[u] = 0.f; cv[u] = 0.f; rg[u] = 0.f; } }
#pragma unroll
    for (int u = 0; u < 4; ++u) { const int t = t0 + u * G;
      const float mu = wave_sum(y[u]) * (1.0f / 64.0f); const float dlt = y[u] - mu; const float var = wave_sum(dlt * dlt) * (1.0f / 64.0f);
      const float yn = dlt * rsqrtf(var + 64e-5f) * lg + lb;
      if (t < T) MIX[(size_t)t * DM + c] = f2bf((yn + cv[u]) * rg[u]); }
  }
}

__device__ __forceinline__ void phase_ffn_act(const Params& P, int layer) {
  const bf16_t* GU = (const bf16_t*)(PWS() + WS_GU); bf16_t* ACT = (bf16_t*)(PWS() + WS_ACT);
  const float* fw = PIN(I_FCONV) + (size_t)layer * 3 * DFF; const float* fb = PIN(I_FCONVB) + (size_t)layer * DFF;
  const int run_lo = (layer == 1) ? NCTX / 32 : 0, nruns = T / 32 - run_lo;
  for (int idx = mk_bid() * NTH + mk_tid(); idx < nruns * 704; idx += mk_nblk() * NTH) {
    const int cgp = idx % 704, run = run_lo + idx / 704, c0 = cgp * 8, t0 = run * 32;
    const int lo = t0 < NCTX ? 0 : NCTX, hi = t0 < NCTX ? NCTX : T;
    float w0[8], w1[8], w2[8], bb[8];
#pragma unroll
    for (int i = 0; i < 8; ++i) { w0[i] = fw[c0 + i]; w1[i] = fw[DFF + c0 + i]; w2[i] = fw[2 * DFF + c0 + i]; bb[i] = fb[c0 + i]; }
    const bf16x8 zero = {0, 0, 0, 0, 0, 0, 0, 0};
    bf16x8 prev = (t0 - 1 >= lo) ? *(const bf16x8*)(GU + (size_t)(t0 - 1) * NGU + c0) : zero;
    bf16x8 cur = *(const bf16x8*)(GU + (size_t)t0 * NGU + c0);
    for (int tt = 0; tt < 32; ++tt) {
      const int t = t0 + tt;
      const bf16x8 nxt = (t + 1 < hi) ? *(const bf16x8*)(GU + (size_t)(t + 1) * NGU + c0) : zero;
      const bf16x8 up = *(const bf16x8*)(GU + (size_t)t * NGU + DFF + c0);
      float o[8];
#pragma unroll
      for (int i = 0; i < 8; ++i) { const float g = bb[i] + w0[i] * bf2f((bf16_t)prev[i]) + w1[i] * bf2f((bf16_t)cur[i]) + w2[i] * bf2f((bf16_t)nxt[i]); o[i] = siluf_(g) * bf2f((bf16_t)up[i]); }
      u32x4 w; w.x = cvtpk(o[0], o[1]); w.y = cvtpk(o[2], o[3]); w.z = cvtpk(o[4], o[5]); w.w = cvtpk(o[6], o[7]);
      *(u32x4*)(ACT + (size_t)t * DFF + c0) = w;
      prev = cur; cur = nxt;
    }
  }
}

namespace at2 {
constexpr int DQK = 192, DV = 128, QBLK = 32, KVBLK = 64;
constexpr float SCALE = 0.07216878364870322f;
constexpr float THR = 8.f;
#ifndef ATT_NQREG
#define ATT_NQREG 12
#endif
constexpr int NQREG = ATT_NQREG;
constexpr int SHM_V = KVBLK * DV * 2, SHM_K = KVBLK * DQK * 2, SHM_ATTN = 3 * SHM_V + 3 * SHM_K + 8 * 64 * 4,     SHM_TOTAL = SHM_ATTN + (12 - NQREG) * 8192;
#define KSWZ(row, colB) ((row) * 384 + ((colB) ^ (((row) & 7) << 4)))
#define SBAR() __builtin_amdgcn_sched_barrier(0)
__device__ __forceinline__ int crow(int r, int hi) { return (r & 3) + 8 * (r >> 2) + 4 * hi; }

__device__ __forceinline__ void partialSM(f32x16& p0, f32x16& p1, float& m_reg, float& mn, float& alpha) {
  constexpr float C = SCALE * 1.4426950408889634f;
  float pmax = p0[0];
#pragma unroll
  for (int r = 1; r < 16; ++r) pmax = fmaxf(pmax, p0[r]);
#pragma unroll
  for (int r = 0; r < 16; ++r) pmax = fmaxf(pmax, p1[r]);
  { auto rr = __builtin_amdgcn_permlane32_swap(__float_as_uint(pmax), __float_as_uint(pmax), false, false);
    pmax = fmaxf(__uint_as_float(rr[0]), __uint_as_float(rr[1])); }
  if (__builtin_expect(__all(pmax - m_reg <= THR / SCALE), 1)) { mn = m_reg; alpha = 1.f; }
  else { mn = fmaxf(m_reg, pmax); alpha = __builtin_amdgcn_exp2f((m_reg - mn) * C); m_reg = mn; }
  const float mnC = -mn * C;
#pragma unroll
  for (int r = 0; r < 16; ++r) p0[r] = fmaf(p0[r], C, mnC);
#pragma unroll
  for (int r = 0; r < 16; ++r) p1[r] = fmaf(p1[r], C, mnC);
#pragma unroll
  for (int r = 0; r < 16; ++r) p0[r] = __builtin_amdgcn_exp2f(p0[r]);
}
__device__ __forceinline__ void finishSM(f32x16& p0, f32x16& p1, float alpha, float& l_reg, bf16x8& pa0, bf16x8& pa1, bf16x8& pa2, bf16x8& pa3) {
#pragma unroll
  for (int r = 0; r < 16; ++r) p1[r] = __builtin_amdgcn_exp2f(p1[r]);
  float ps = 0;
#pragma unroll
  for (int r = 0; r < 16; ++r) ps += p0[r];
#pragma unroll
  for (int r = 0; r < 16; ++r) ps += p1[r];
  { auto rr = __builtin_amdgcn_permlane32_swap(__float_as_uint(ps), __float_as_uint(ps), false, false);
    ps = __uint_as_float(rr[0]) + __uint_as_float(rr[1]); }
  l_reg = l_reg * alpha + ps;
#define PK4(P, BASE, OUT) do { unsigned a0 = cvtpk(P[BASE + 0], P[BASE + 1]), a1 = cvtpk(P[BASE + 2], P[BASE + 3]);   \
    unsigned b0 = cvtpk(P[BASE + 4], P[BASE + 5]), b1 = cvtpk(P[BASE + 6], P[BASE + 7]);                              \
    auto r0 = __builtin_amdgcn_permlane32_swap(a0, b0, false, false); auto r1 = __builtin_amdgcn_permlane32_swap(a1, b1, false, false); \
    u32x4 w = {r0[0], r1[0], r0[1], r1[1]}; OUT = *reinterpret_cast<bf16x8*>(&w); } while (0)
  PK4(p0, 0, pa0); PK4(p0, 8, pa1); PK4(p1, 0, pa2); PK4(p1, 8, pa3);
#undef PK4
}
__device__ __forceinline__ void qkt(f32x16& p0, f32x16& p1, const char* Ks, const bf16x8* qr, const char* qsp, int r32, int hi) {
  p0 = f32x16{}; p1 = f32x16{};
#pragma unroll
  for (int d0 = 0; d0 < 12; ++d0) { const int cb = (d0 * 16 + hi * 8) * 2;
    const bf16x8 b0 = *reinterpret_cast<const bf16x8*>(Ks + KSWZ(r32, cb));
    const bf16x8 b1 = *reinterpret_cast<const bf16x8*>(Ks + KSWZ(32 + r32, cb));
    const bf16x8 qv = (d0 < NQREG) ? qr[d0 < NQREG ? d0 : 0] : *reinterpret_cast<const bf16x8*>(qsp + (d0 - NQREG) * 8192);
    p0 = __builtin_amdgcn_mfma_f32_32x32x16_bf16(b0, qv, p0, 0, 0, 0);
    p1 = __builtin_amdgcn_mfma_f32_32x32x16_bf16(b1, qv, p1, 0, 0, 0); }
}
__device__ __forceinline__ int v_st(int k, int c) { const int kk = (k & ~0xC) | ((k & 4) << 1) | ((k & 8) >> 1); return ((kk >> 3) * 4 + (c >> 5)) * 512 + ((kk & 7) * 32 + (c & 31)) * 2; }
__device__ __forceinline__ int v_rd_base(int lane) { return ((lane & 3) << 3) | (((lane >> 2) & 3) << 6) | (((lane >> 4) & 1) << 5) | (((lane >> 5) & 1) << 8); }
constexpr int v_rd_off(int d0, int ks, int half) { return d0 * 512 + ks * 4096 + half * 2048; }
template <int OFF> __device__ __forceinline__ s16x4 tr_read(int vb) {
  s16x4 r; asm volatile("ds_read_b64_tr_b16 %0, %1 offset:%2" : "=&v"(r) : "v"(vb), "i"(OFF) : "memory"); return r;
}
template <int D0> __device__ __forceinline__ void pv_one(f32x16& od, int vb, bf16x8 pa0, bf16x8 pa1, bf16x8 pa2, bf16x8 pa3) {
  const s16x4 l0 = tr_read<v_rd_off(D0, 0, 0)>(vb), h0 = tr_read<v_rd_off(D0, 0, 1)>(vb), l1 = tr_read<v_rd_off(D0, 1, 0)>(vb), h1 = tr_read<v_rd_off(D0, 1, 1)>(vb);
  const s16x4 l2 = tr_read<v_rd_off(D0, 2, 0)>(vb), h2 = tr_read<v_rd_off(D0, 2, 1)>(vb), l3 = tr_read<v_rd_off(D0, 3, 0)>(vb), h3 = tr_read<v_rd_off(D0, 3, 1)>(vb);
  asm volatile("s_waitcnt lgkmcnt(0)" ::: "memory"); SBAR();
#define PK(L, H) (bf16x8){L[0], L[1], L[2], L[3], H[0], H[1], H[2], H[3]}
  od = __builtin_amdgcn_mfma_f32_32x32x16_bf16(pa0, PK(l0, h0), od, 0, 0, 0);
  od = __builtin_amdgcn_mfma_f32_32x32x16_bf16(pa1, PK(l1, h1), od, 0, 0, 0);
  od = __builtin_amdgcn_mfma_f32_32x32x16_bf16(pa2, PK(l2, h2), od, 0, 0, 0);
  od = __builtin_amdgcn_mfma_f32_32x32x16_bf16(pa3, PK(l3, h3), od, 0, 0, 0);
#undef PK
}
__device__ __forceinline__ void pv_d0(f32x16* o, int vb, bf16x8 pa0, bf16x8 pa1, bf16x8 pa2, bf16x8 pa3) {
  pv_one<0>(o[0], vb, pa0, pa1, pa2, pa3); pv_one<1>(o[1], vb, pa0, pa1, pa2, pa3); pv_one<2>(o[2], vb, pa0, pa1, pa2, pa3); pv_one<3>(o[3], vb, pa0, pa1, pa2, pa3);
}
__device__ __forceinline__ void rope_pair(bf16x8& A, bf16x8& B, float pos, int hi) {
  float oa[8], ob[8];
#pragma unroll
  for (int e = 0; e < 8; ++e) {
    const float inv = exp2f(-(float)(hi * 8 + e) * (13.287712379549449f / 16.0f));
    const float sn = __sinf(pos * inv), cs = __cosf(pos * inv);
    const float a = bf2f((bf16_t)A[e]), b = bf2f((bf16_t)B[e]);
    oa[e] = a * cs - b * sn; ob[e] = a * sn + b * cs;
  }
  u32x4 wa = {cvtpk(oa[0], oa[1]), cvtpk(oa[2], oa[3]), cvtpk(oa[4], oa[5]), cvtpk(oa[6], oa[7])};
  u32x4 wb = {cvtpk(ob[0], ob[1]), cvtpk(ob[2], ob[3]), cvtpk(ob[4], ob[5]), cvtpk(ob[6], ob[7])};
  A = *reinterpret_cast<bf16x8*>(&wa); B = *reinterpret_cast<bf16x8*>(&wb);
}

__device__ __forceinline__ void attn_unit(const bf16_t* __restrict__ Q, const bf16_t* __restrict__ KV, const bf16_t* __restrict__ KR, bf16_t* __restrict__ MIX,
                                          int q0, int h, int kv0, int seq, bool rope_q, char* lds, bf16_t* __restrict__ part_o, float* __restrict__ part_ml) {
  const int tid = mk_tid(), wid = tid >> 6, lane = tid & 63, r32 = lane & 31, hi = lane >> 5;
  char* V_lds = lds; char* K_lds = lds + 3 * SHM_V;
  float* ws = (float*)(lds + 3 * SHM_V + 3 * SHM_K) + wid * 64; float* li_l = ws; float* al_l = ws + 32;
  float m_reg = -1e30f, l_reg = 0; f32x16 o[4] = {}; bf16x8 qr[12];
  const int qrow = q0 + wid * QBLK + r32;
  const bf16_t* Qw = Q + (size_t)qrow * 1536 + h * DQK + hi * 8;
#pragma unroll
  for (int d0 = 0; d0 < 12; ++d0) qr[d0] = *reinterpret_cast<const bf16x8*>(Qw + d0 * 16);
  if (rope_q) { const int tl = qrow - NCTX; rope_pair(qr[8], qr[9], (float)(tl >> 6), hi); rope_pair(qr[10], qr[11], (float)(tl & 63), hi); }
  char* qsp = lds + SHM_ATTN + tid * 16;
#pragma unroll
  for (int d0 = NQREG; d0 < 12; ++d0) *reinterpret_cast<bf16x8*>(qsp + (d0 - NQREG) * 8192) = qr[d0];
  const bf16_t* Kh = KV + (size_t)kv0 * 2048 + h * 256; const bf16_t* Vh = Kh + 128; KR += (size_t)kv0 * 64;
  const int sr = tid >> 4, sc = (tid & 15) * 8, vst0 = v_st(sr, sc), vst1 = v_st(32 + sr, sc);
  const int rr = tid >> 3, rc = (tid & 7) * 8;
  const int vb0 = (int)(uintptr_t)V_lds + v_rd_base(lane);
  bf16x8 vs0, vs1, ks0, ks1, ks2;
#define SLOAD(k0) do { vs0 = *(const bf16x8*)(Vh + (size_t)((k0) + sr) * 2048 + sc); vs1 = *(const bf16x8*)(Vh + (size_t)((k0) + 32 + sr) * 2048 + sc); \
    ks0 = *(const bf16x8*)(Kh + (size_t)((k0) + sr) * 2048 + sc); ks1 = *(const bf16x8*)(Kh + (size_t)((k0) + 32 + sr) * 2048 + sc); \
    ks2 = *(const bf16x8*)(KR + (size_t)((k0) + rr) * 64 + rc); } while (0)
#define SWRITE(b) do { *(bf16x8*)(V_lds + (b) * SHM_V + vst0) = vs0; *(bf16x8*)(V_lds + (b) * SHM_V + vst1) = vs1; const int kc = sc * 2; \
    *(bf16x8*)(K_lds + (b) * SHM_K + KSWZ(sr, kc)) = ks0; *(bf16x8*)(K_lds + (b) * SHM_K + KSWZ(32 + sr, kc)) = ks1; \
    *(bf16x8*)(K_lds + (b) * SHM_K + KSWZ(rr, 256 + rc * 2)) = ks2; } while (0)
#define SWAIT() asm volatile("s_waitcnt vmcnt(0)" ::: "memory")
#define RESC(a) do { if (__any((a) < 1.f)) { if (hi == 0) al_l[r32] = (a); asm volatile("s_waitcnt lgkmcnt(0)" ::: "memory"); \
    _Pragma("unroll") for (int d = 0; d < 4; ++d) _Pragma("unroll") for (int r = 0; r < 16; ++r) o[d][r] *= al_l[crow(r, hi)]; } } while (0)
  f32x16 pA0, pA1, pB0, pB1; float mnA, mnB, alA, alB; bf16x8 pa0, pa1, pa2, pa3; const int NT = seq / KVBLK;
  SLOAD(0); SWAIT(); SWRITE(0); __syncthreads();
  qkt(pA0, pA1, K_lds, qr, qsp, r32, hi); partialSM(pA0, pA1, m_reg, mnA, alA);
  SLOAD(KVBLK);
  SWAIT(); SWRITE(1); __syncthreads();
  int bp = 0, bc = 1, bn = 2;
  for (int j = 1; j + 1 < NT; j += 2) {
    SBAR(); qkt(pB0, pB1, K_lds + bc * SHM_K, qr, qsp, r32, hi);
    finishSM(pA0, pA1, alA, l_reg, pa0, pa1, pa2, pa3); SBAR();
    SLOAD((j + 1) * KVBLK); SBAR();
    pv_d0(o, vb0 + bp * SHM_V, pa0, pa1, pa2, pa3); partialSM(pB0, pB1, m_reg, mnB, alB);
    SWAIT(); SWRITE(bn);
    RESC(alB); __syncthreads();
    bp = bc; bc = bn; bn = (bn == 2) ? 0 : bn + 1;
    SBAR(); qkt(pA0, pA1, K_lds + bc * SHM_K, qr, qsp, r32, hi);
    finishSM(pB0, pB1, alB, l_reg, pa0, pa1, pa2, pa3); SBAR();
    SLOAD((j + 2) * KVBLK); SBAR();
    pv_d0(o, vb0 + bp * SHM_V, pa0, pa1, pa2, pa3); partialSM(pA0, pA1, m_reg, mnA, alA);
    SWAIT(); SWRITE(bn);
    RESC(alA); __syncthreads();
    bp = bc; bc = bn; bn = (bn == 2) ? 0 : bn + 1;
  }
  SBAR(); qkt(pB0, pB1, K_lds + bc * SHM_K, qr, qsp, r32, hi);
  finishSM(pA0, pA1, alA, l_reg, pa0, pa1, pa2, pa3); SBAR();
  pv_d0(o, vb0 + bp * SHM_V, pa0, pa1, pa2, pa3); partialSM(pB0, pB1, m_reg, mnB, alB);
  __syncthreads(); RESC(alB);
  finishSM(pB0, pB1, alB, l_reg, pa0, pa1, pa2, pa3); SBAR();
  pv_d0(o, vb0 + bc * SHM_V, pa0, pa1, pa2, pa3);
  if (hi == 0) li_l[r32] = l_reg; asm volatile("s_waitcnt lgkmcnt(0)" ::: "memory");
  float rli[16];
#pragma unroll
  for (int r = 0; r < 16; ++r) rli[r] = __builtin_amdgcn_rcpf(li_l[crow(r, hi)]);
  if (part_o == nullptr) {
    bf16_t* Ow = MIX + (size_t)(q0 + wid * QBLK) * DM + 1024 + h * DV;
#pragma unroll
    for (int r = 0; r < 16; ++r) { const int orow = crow(r, hi);
#pragma unroll
      for (int d0 = 0; d0 < 4; ++d0) Ow[(size_t)orow * DM + d0 * 32 + r32] = f2bf(o[d0][r] * rli[r]); }
  } else {
    bf16_t* Ow = part_o + (size_t)(wid * QBLK) * DV;
#pragma unroll
    for (int r = 0; r < 16; ++r) { const int orow = crow(r, hi);
#pragma unroll
      for (int d0 = 0; d0 < 4; ++d0) Ow[(size_t)orow * DV + d0 * 32 + r32] = f2bf(o[d0][r] * rli[r]); }
    if (hi == 0) { part_ml[(wid * QBLK + r32) * 2] = m_reg; part_ml[(wid * QBLK + r32) * 2 + 1] = l_reg; }
  }
  __syncthreads();
#undef SLOAD
#undef SWRITE
#undef SWAIT
#undef RESC
}
}

__device__ __forceinline__ int attn_np(int nwg) { return nwg == 192 ? 3 : (nwg == 224 ? 7 : 0); }
__device__ __forceinline__ int attn_part_tiles(int np, int p) { return 2 * (130 / np) + (p < (130 % np) ? 2 : 0); }
__device__ __forceinline__ void phase_attention(const Params& P, int layer, char* lds, int wg, int nwg) {
  const bf16_t* Q = (const bf16_t*)(PWS() + WS_Q); const bf16_t* KV = (const bf16_t*)(PWS() + WS_KV); const bf16_t* KR = (const bf16_t*)(PWS() + WS_KR);
  bf16_t* MIX = (bf16_t*)(PWS() + WS_H); bf16_t* PO = (bf16_t*)(PWS() + WS_PARTO); float* PML = (float*)(PWS() + WS_PARTML);
  const int np = attn_np(nwg);
  const int nwhole = np ? (512 / nwg) * nwg : 512, nparts = (512 - nwhole) * np, nctx = (layer == 0) ? 8 : 0;
  for (int it = wg; it < nwhole + nparts + nctx; it += nwg) {
    int q0, h, kv0 = 0, seq = T; bool lat = true; bf16_t* po = nullptr; float* pml = nullptr;
    if (it < nwhole) { q0 = NCTX + (it & 63) * 256; h = it >> 6; }
    else if (it < nwhole + nparts) { const int q = it - nwhole, u = nwhole + q / np, p = q % np; q0 = NCTX + (u & 63) * 256; h = u >> 6;
      int t0 = 0; for (int pp = 0; pp < p; ++pp) t0 += attn_part_tiles(np, pp);
      kv0 = t0 * 64; seq = attn_part_tiles(np, p) * 64; po = PO + (size_t)q * 256 * 128; pml = PML + (size_t)q * 512; }
    else { q0 = 0; h = it - nwhole - nparts; seq = NCTX; lat = false; }
    at2::attn_unit(Q, KV, KR, MIX, q0, h, kv0, seq, lat, lds, po, pml);
  }
}
__device__ __forceinline__ void phase_attn_merge(const Params& P, int wg, int nwg, int np, int nwhole) {
  if (np == 0) return;
  const bf16_t* PO = (const bf16_t*)(PWS() + WS_PARTO); const float* PML = (const float*)(PWS() + WS_PARTML); bf16_t* MIX = (bf16_t*)(PWS() + WS_H);
  constexpr float C = at2::SCALE * 1.4426950408889634f;
  const int tid = mk_tid(), row = tid >> 1, c0 = (tid & 1) * 64;
  for (int us = wg; us < 512 - nwhole; us += nwg) {
    const int u = nwhole + us, q0 = NCTX + (u & 63) * 256, h = u >> 6;
    float M = -3.0e38f;
    for (int p = 0; p < np; ++p) M = fmaxf(M, PML[(size_t)(us * np + p) * 512 + row * 2]);
    float acc[64];
#pragma unroll
    for (int i = 0; i < 64; ++i) acc[i] = 0.f;
    float ws = 0.f;
#pragma unroll 1
    for (int p = 0; p < np; ++p) {
      const float* ml = PML + (size_t)(us * np + p) * 512 + row * 2;
      const float w = ml[1] * exp2f((ml[0] - M) * C); ws += w;
      const bf16_t* src = PO + ((size_t)(us * np + p) * 256 + row) * 128 + c0;
#pragma unroll
      for (int cc = 0; cc < 64; cc += 8) { const bf16x8 x = *(const bf16x8*)(src + cc);
#pragma unroll
        for (int i = 0; i < 8; ++i) acc[cc + i] += w * bf2f((bf16_t)x[i]); }
    }
    const float inv = 1.0f / ws;
#pragma unroll
    for (int cc = 0; cc < 64; cc += 8) {
      u32x4 o; o.x = cvtpk(acc[cc] * inv, acc[cc + 1] * inv); o.y = cvtpk(acc[cc + 2] * inv, acc[cc + 3] * inv); o.z = cvtpk(acc[cc + 4] * inv, acc[cc + 5] * inv); o.w = cvtpk(acc[cc + 6] * inv, acc[cc + 7] * inv);
      *(u32x4*)(MIX + (size_t)(q0 + row) * DM + 1024 + h * 128 + c0 + cc) = o;
    }
  }
}

#ifndef REP_ATT
#define REP_ATT 1
#endif
#ifndef REP_SCAN
#define REP_SCAN 1
#endif
#ifndef REP_PREP
#define REP_PREP 1
#endif
#ifndef REP_GU
#define REP_GU 1
#endif
#ifndef REP_MISC
#define REP_MISC 1
#endif
#ifndef N_SCAN_WG
#define N_SCAN_WG 64
#endif
__device__ __forceinline__ void grid_barrier(unsigned* ctr, unsigned target) {
  asm volatile("s_waitcnt vmcnt(0) lgkmcnt(0)" ::: "memory");
  __syncthreads();
  if (mk_tid() == 0) {
    __builtin_amdgcn_fence(__ATOMIC_RELEASE, "agent");
    __hip_atomic_fetch_add(ctr, 1u, __ATOMIC_RELAXED, __HIP_MEMORY_SCOPE_AGENT);
    while (__hip_atomic_load(ctr, __ATOMIC_RELAXED, __HIP_MEMORY_SCOPE_AGENT) < target) __builtin_amdgcn_s_sleep(2);
    __builtin_amdgcn_fence(__ATOMIC_ACQUIRE, "agent");
  }
  __syncthreads();
}
__device__ __forceinline__ void grid_arrive(unsigned* ctr) {
  asm volatile("s_waitcnt vmcnt(0) lgkmcnt(0)" ::: "memory");
  __syncthreads();
  if (mk_tid() == 0) { __builtin_amdgcn_fence(__ATOMIC_RELEASE, "agent"); __hip_atomic_fetch_add(ctr, 1u, __ATOMIC_RELAXED, __HIP_MEMORY_SCOPE_AGENT); }
}
enum { K_MOD = 0, K_NORM1, K_GEMM_IN, K_PREP, K_MIX, K_RWOUT, K_GEMM_OUT, K_NORM2, K_GEMM_GU, K_ACT, K_GEMM_DN, K_FINAL };
constexpr int STEPS_PER_LAYER = 10, N_STEPS = 1 + 2 * STEPS_PER_LAYER + 1;
__global__ void __launch_bounds__(NTH) fwd_megakernel(Params P_arg) {
  extern __shared__ __attribute__((aligned(16))) unsigned char lds[];
  cg::grid_group grid = cg::this_grid();
  const int lo = P_arg.ph_lo, hi = P_arg.ph_hi;
  unsigned nbar = 0, nsub = 0, nscn = 0;
#pragma unroll 1
  for (int st = lo; st < hi; ++st) {
    const Params& P = P_arg;
    int kind, layer = 0;
    if (st == 0) kind = K_MOD; else if (st == N_STEPS - 1) kind = K_FINAL; else { layer = (st - 1) / STEPS_PER_LAYER; kind = K_NORM1 + (st - 1) % STEPS_PER_LAYER; }
    const bool last = (layer == 1);
    float* ldsf = (float*)lds;
    bool sync_after = true;
    switch (kind) {
      case K_MOD: for (int rep = 0; rep < REP_MISC; ++rep) phase_mod(P, ldsf); break;
      case K_NORM1: for (int rep = 0; rep < REP_MISC; ++rep) phase_convert(P, layer, ldsf); break;
      case K_PREP: for (int rep = 0; rep < REP_PREP; ++rep) phase_prep<0>(P, layer, ldsf, mk_bid(), mk_nblk()); break;
      case K_MIX: {
        const int G = mk_nblk();
        const int vcu = (G % 8 == 0) ? (mk_bid() % 8) * (G / 8) + mk_bid() / 8 : mk_bid();
        const int nscan = (G >= 2 * N_SCAN_WG) ? N_SCAN_WG : 0;
        unsigned* sbar = (unsigned*)(PWS() + WS_BAR) + 32;
        const int sg = vcu - nscan, SG = G - nscan;
        const unsigned per_layer = (unsigned)(G + 2 * SG), base = per_layer * (unsigned)layer;
        phase_prep<1>(P, layer, ldsf, vcu, G);
        if (vcu < nscan) {
          grid_arrive(sbar);
          for (int sc = vcu; sc < ((N_SCAN_WG == 32) ? 32 : 64); sc += nscan) rwkv_scan<(N_SCAN_WG == 32) ? 8 : 4>(P, sc, ldsf);
        } else {
          grid_barrier(sbar, base + (unsigned)G);
          if (nscan == 0) { for (int sc = vcu; sc < ((N_SCAN_WG == 32) ? 32 : 64); sc += G) rwkv_scan<(N_SCAN_WG == 32) ? 8 : 4>(P, sc, ldsf); __syncthreads(); }
#pragma unroll 1
          for (int q = 0; q < 2; ++q) {
            const size_t ro = (q == 0 && last) ? NCTX : 0;
            const bf16_t* A = (const bf16_t*)(PWS() + (q ? WS_KVN : WS_QN)) + ro * 512; const bf16_t* Bt = (const bf16_t*)(PWS() + (q ? WS_WKV : WS_WQ));
            EpiStore E{(bf16_t*)(PWS() + (q ? WS_KV : WS_Q)) + ro * 1536, q ? 2048 : 1536};
            run_gemm(lds, A, Bt, T - (int)ro, q ? 2048 : 1536, q ? 256 : 512, E, sg, SG);
          }
          phase_lru_agg(P, sg, SG);
          grid_barrier(sbar, base + (unsigned)(G + SG));
          phase_attention(P, layer, (char*)lds, sg, SG);
          grid_barrier(sbar, base + per_layer);
          { const int np = attn_np(SG), nwhole = np ? (512 / SG) * SG : 512, nmerge = np ? 512 - nwhole : 0, nlru = T / 64 - (last ? 4 : 0);
#pragma unroll 1
            for (int it = sg; it < nmerge + nlru; it += SG) {
              if (it < nmerge) phase_attn_merge(P, it, 1 << 24, np, nwhole);
              else phase_lru_out(P, layer, ldsf, it - nmerge, 1 << 24);
            } }
        }
      } break;
      case K_RWOUT: phase_rwkv_out(P, layer, mk_bid(), mk_nblk()); break;
      case K_ACT: for (int rep = 0; rep < REP_MISC; ++rep) phase_ffn_act(P, layer); break;
      case K_FINAL: phase_final_norm(P); break;
      default: break;
    }
    if (kind == K_NORM1 || kind == K_NORM2) for (int rep = 0; rep < REP_MISC; ++rep) phase_norm(P, layer, kind == K_NORM2 ? 1 : 0, kind == K_NORM2 && last);
    if (kind == K_GEMM_IN || kind == K_GEMM_GU) {
      const bf16_t* A; const bf16_t* Bt; bf16_t* O; int M = T, N, K;
      if (kind == K_GEMM_IN) { A = (const bf16_t*)(PWS() + WS_H); Bt = (const bf16_t*)(PWS() + WS_WIN); O = (bf16_t*)(PWS() + WS_COLS); N = NIN; K = DM; }
      else { const size_t ro = last ? NCTX : 0; A = (const bf16_t*)(PWS() + WS_H) + ro * DM; Bt = (const bf16_t*)(PWS() + WS_WGU); O = (bf16_t*)(PWS() + WS_GU) + ro * NGU; M = last ? T - NCTX : T; N = NGU; K = DM; }
      EpiStore E{O, N};
      run_gemm(lds, A, Bt, M, N, K, E, mk_bid(), mk_nblk());
    }
    if (kind == K_GEMM_OUT || kind == K_GEMM_DN) {
      const float* mod_l = (const float*)(PWS() + WS_MOD) + (size_t)(layer * 2 + 0) * 12288; const float* mod_c = mod_l + 12288;
      const int goff = (kind == K_GEMM_OUT) ? 4096 : 10240;
      EpiResid E{(const float*)(PWS() + WS_XC), POUT(), (float*)(PWS() + WS_XC), POUT(), mod_c + goff, mod_l + goff, NCTX};
      if (kind == K_GEMM_OUT && layer == 0) { E.src_c = PIN(I_CTX); E.src_l = PIN(I_X); }
      const int Kf = (kind == K_GEMM_OUT) ? DM : DFF;
      const bf16_t* A0 = (kind == K_GEMM_OUT) ? (const bf16_t*)(PWS() + WS_H) : (const bf16_t*)(PWS() + WS_ACT);
      const bf16_t* Bt = (kind == K_GEMM_OUT) ? (const bf16_t*)(PWS() + WS_WOUT) : (const bf16_t*)(PWS() + WS_WDN);
      run_gemm(lds, A0 + (size_t)NCTX * Kf, Bt, T - NCTX, DM, Kf, E, mk_bid(), mk_nblk());
      if (!last) {
        EpiResidAtomic EA{(float*)(PWS() + WS_XC), mod_c + goff};
        run_gemm(lds, A0, Bt, (Kf / 512) * 256, DM, 512, EA, mk_bid(), mk_nblk(), Kf, 512);
      }
    }
    if (sync_after && st + 1 < hi) {
      if (st == lo) grid.sync();
      else { ++nbar; grid_barrier((unsigned*)(PWS() + WS_BAR), nbar * mk_nblk()); }
    }
  }
}

#ifndef MK_PER_PHASE
#define MK_PER_PHASE 0
#endif
extern "C" void kernel_launch(void* const* d_in, const int* in_sizes, int n_in, void* d_out, int out_size, void* d_ws, size_t ws_size, hipStream_t stream) {
  static int grid = 0;
  if (grid == 0) {
    if (n_in != 42 || out_size != (T - NCTX) * DM || ws_size < WS_END) { fprintf(stderr, "kernel_launch: unexpected shapes (n_in %d out %d ws %zu need %zu)\n", n_in, out_size, ws_size, (size_t)WS_END); grid = -1; return; }
    int dev = 0, cus = 0, per_cu = 0;
    (void)hipGetDevice(&dev); (void)hipDeviceGetAttribute(&cus, hipDeviceAttributeMultiprocessorCount, dev);
    if (hipFuncSetAttribute((const void*)fwd_megakernel, hipFuncAttributeMaxDynamicSharedMemorySize, LDS_BYTES) != hipSuccess) { fprintf(stderr, "kernel_launch: hipFuncSetAttribute failed\n"); grid = -1; return; }
    if (hipOccupancyMaxActiveBlocksPerMultiprocessor(&per_cu, (const void*)fwd_megakernel, NTH, LDS_BYTES) != hipSuccess || per_cu < 1) per_cu = 1;
    (void)hipGetLastError();
    grid = (cus > 0 ? cus : 256) * per_cu;
  }
  if (grid < 0) return;
  if (hipMemsetAsync((char*)d_ws + WS_BAR, 0, 256, stream) != hipSuccess) { fprintf(stderr, "kernel_launch: memset failed\n"); return; }
  Params p{};
  for (int i = 0; i < 42; ++i) p.in[i] = (const float*)d_in[i];
  p.out = (float*)d_out; p.ws = (unsigned char*)d_ws;
#if MK_PER_PHASE
  for (int st = 0; st < N_STEPS; ++st) { p.ph_lo = st; p.ph_hi = st + 1; hipLaunchKernelGGL(fwd_megakernel, dim3(grid), dim3(NTH), LDS_BYTES, stream, p); }
#else
  p.ph_lo = 0; p.ph_hi = N_STEPS;
  void* args[] = {&p};
  hipError_t e = hipLaunchCooperativeKernel((const void*)fwd_megakernel, dim3(grid), dim3(NTH), args, LDS_BYTES, stream);
  if (e != hipSuccess) fprintf(stderr, "cooperative launch failed: %s (grid %d)\n", hipGetErrorString(e), grid);
#endif
}
```

```cpp
#include <hip/hip_runtime.h>
#include <hip/hip_cooperative_groups.h>
#include <cstdio>
#include <cstdint>
__device__ __forceinline__ int mk_tid() { int t = (int)threadIdx.x; asm volatile("" : "+v"(t)); return t; }
__device__ __forceinline__ int mk_bid() { int b = (int)blockIdx.x; asm volatile("" : "+s"(b)); return b; }
__device__ __forceinline__ int mk_nblk() { int g = (int)gridDim.x; asm volatile("" : "+s"(g)); return g; }
template <int OFF> __device__ __forceinline__ unsigned long long kp_load() {
  unsigned long long r; auto kp = __builtin_amdgcn_kernarg_segment_ptr();
  asm volatile("s_load_dwordx2 %0, %1, %2\n\ts_waitcnt lgkmcnt(0)" : "=s"(r) : "s"(kp), "i"(OFF));
  return r;
}
#define PIN(i) ((const float*)kp_load<8 * (i)>())
#define POUT() ((float*)kp_load<8 * 42>())
#define PWS() ((unsigned char*)kp_load<8 * 43>())
namespace pg8 {
#define PG8_LAS __attribute__((address_space(3)))
typedef unsigned short bf16_t;
typedef short bf16x8 __attribute__((ext_vector_type(8)));
typedef float f32x4 __attribute__((ext_vector_type(4)));
typedef unsigned u32x4 __attribute__((ext_vector_type(4)));
constexpr int BM = 256, BK = 64, HALF = 128, HTB = HALF * BK * 2  , STAGE_BYTES = 8 * HTB, NXCD = 8, WGM = 8;

__host__ __device__ __forceinline__ int lds_byte(int r, int c) { const int st = (r >> 4) * 2 + (c >> 5), rr = r & 15, cc = c & 31, ob = rr * 64 + cc * 2; return st * 1024 + (ob ^ (((ob >> 9) & 1) << 5)); }
__host__ __device__ __forceinline__ void stage_rc(int b, int& R, int& C) { const int st = b / 1024, sb = b % 1024, swz = sb ^ (((sb >> 9) & 1) << 5); R = (st >> 1) * 16 + swz / 64; C = (st & 1) * 32 + (swz % 64) / 2; }
__host__ __device__ __forceinline__ int perm32(int rho) { const int n = rho >> 4, i = rho & 15; return 8 * (i >> 2) + 4 * n + (i & 3); }

struct Unit { int pm, pn; };
struct Gemm { const bf16_t* A; const bf16_t* Bt; int M, N, K; int ld; int ksplit; };

struct StaticOrder {
    int nM, nN, nwg, G, c;
    __host__ __device__ void init(int M, int N, int G_, int c_) { nM = M / BM; nN = N / BM; nwg = nM * nN; G = G_; c = c_; }
    __host__ __device__ bool next(int i, Unit& u) const {
        const long L = (long)i * G + c; if (L >= nwg) return false;
        int wgid = (int)L; { const int q = nwg / NXCD, r = nwg % NXCD, xcd = wgid % NXCD, off = wgid / NXCD; wgid = (xcd < r ? xcd * (q + 1) : r * (q + 1) + (xcd - r) * q) + off; }
        const int nig = WGM * nN, gid = wgid / nig, fm = gid * WGM, gsz = (nM - fm) < WGM ? (nM - fm) : WGM;
        u.pm = fm + ((wgid % nig) % gsz); u.pn = (wgid % nig) / gsz; return true;
    }
    __device__ __forceinline__ void a_ready(const Unit&) const {}
    __device__ __forceinline__ void done(const Unit&) const {}
};
__device__ __forceinline__ unsigned cvt_pk_bf16(float lo, float hi) { unsigned r; asm volatile("v_cvt_pk_bf16_f32 %0, %1, %2" : "=v"(r) : "v"(lo), "v"(hi)); return r; }
typedef float f32x2 __attribute__((ext_vector_type(2)));
template <class Epi, class Sched, bool STAMP = false>
__device__ __forceinline__ void gemm_phase(PG8_LAS unsigned char* lds, const Gemm g, const Sched& S, const Epi& E, unsigned long long* stamps) {
    const int tid = mk_tid(), wid = __builtin_amdgcn_readfirstlane(tid >> 6), lane = tid & 63, wr = wid >> 2, wc = wid & 3, fr = lane & 15, fq = lane >> 4;
    const int K = g.K, nt = K / BK, LD = g.ld; const size_t ksb = (size_t)g.ksplit * 2;
    int ts_lo = 0, ts_hi = 0, nts = 0; const unsigned long long rt_entry = STAMP ? (unsigned long long)wall_clock64() : 0ull;
#define PG8_STAMP() do { if (STAMP && wid == 0 && nts < 64) { const unsigned long long _c = (unsigned long long)clock64(); \
        ts_lo = (lane == nts) ? (int)(unsigned)_c : ts_lo; ts_hi = (lane == nts) ? (int)(unsigned)(_c >> 32) : ts_hi; ++nts; } } while (0)
    PG8_STAMP();
    unsigned voffA[2], voffB[2];
#pragma unroll
    for (int i = 0; i < 2; ++i) { int R, C; stage_rc(tid * 16 + i * 8192, R, C); const int Rb = Epi::PERM ? ((R & ~31) + perm32(R & 31)) : R;
        voffA[i] = (unsigned)(R * LD + C) * 2u; voffB[i] = (unsigned)(Rb * LD + C) * 2u; }
    const size_t kstep = (size_t)(BK * 2);
    const size_t hstep = (size_t)HALF * LD * 2;
    const size_t tstep = 2 * hstep;
    const unsigned ldsw = (unsigned)wid * 1024u;
    const int aoff = lds_byte(wr * 64 + fr, fq * 8), boff = lds_byte(wc * 32 + fr, fq * 8);
#define PG8_SA(b, h) (((b) * 2 + (h)) * HTB)
#define PG8_SB(b, h) ((4 + (b) * 2 + (h)) * HTB)
#define PG8_STAGE(bufoff, gbase, voff) do { _Pragma("unroll") for (int _i = 0; _i < 2; ++_i) \
        __builtin_amdgcn_global_load_lds((const unsigned*)((const char*)(gbase) + (voff)[_i]), (PG8_LAS unsigned*)(lds + (bufoff) + ldsw + _i * 8192), 16, 0, 0); } while (0)
#define PG8_LDA(dst, b, h) do { _Pragma("unroll") for (int m = 0; m < 4; ++m) _Pragma("unroll") for (int k = 0; k < 2; ++k) dst[m][k] = *(const PG8_LAS bf16x8*)(lds + PG8_SA(b, h) + aoff + m * 2048 + k * 1024); } while (0)
#define PG8_LDB(dst, b, h) do { _Pragma("unroll") for (int n = 0; n < 2; ++n) _Pragma("unroll") for (int k = 0; k < 2; ++k) dst[n][k] = *(const PG8_LAS bf16x8*)(lds + PG8_SB(b, h) + boff + n * 2048 + k * 1024); } while (0)
#define PG8_MMA(ai, bj, At, Bt) do { __builtin_amdgcn_s_setprio(1); _Pragma("unroll") for (int m = 0; m < 4; ++m) _Pragma("unroll") for (int n = 0; n < 2; ++n) _Pragma("unroll") for (int k = 0; k < 2; ++k) \
        acc[ai][bj][m][n] = __builtin_amdgcn_mfma_f32_16x16x32_bf16(Bt[n][k], At[m][k], acc[ai][bj][m][n], 0, 0, 0); __builtin_amdgcn_s_setprio(0); } while (0)
#define PG8_WAIT_V(n) asm volatile("s_waitcnt vmcnt(" #n ")" ::: "memory")
#define PG8_WAIT_L(n) asm volatile("s_waitcnt lgkmcnt(" #n ")" ::: "memory")
#define PG8_BAR __builtin_amdgcn_s_barrier()
#define PG8_SCHED __builtin_amdgcn_sched_barrier(0)
    Unit cur, nxt; int ui = 0;
    if (!S.next(0, cur)) return;
    f32x4 acc[2][2][4][2];
#pragma unroll
    for (int a = 0; a < 2; ++a)
#pragma unroll
        for (int b = 0; b < 2; ++b)
#pragma unroll
            for (int m = 0; m < 4; ++m)
#pragma unroll
                for (int n = 0; n < 2; ++n) acc[a][b][m][n] = (f32x4){0.f, 0.f, 0.f, 0.f};
    bf16x8 At[4][2], B0[2][2], B1[2][2];
    const char* cA = (const char*)g.A + (ksb ? (size_t)cur.pm * ksb : (size_t)cur.pm * tstep); const char* cB = (const char*)g.Bt + (size_t)cur.pn * tstep + (size_t)cur.pm * ksb;
    S.a_ready(cur);
    PG8_STAGE(PG8_SB(0, 0), cB, voffB); PG8_STAGE(PG8_SA(0, 0), cA, voffA); PG8_STAGE(PG8_SB(0, 1), cB + hstep, voffB); PG8_STAGE(PG8_SA(0, 1), cA + hstep, voffA);
    if (wr == 1) PG8_BAR;
    PG8_WAIT_V(4); PG8_BAR;
    PG8_STAGE(PG8_SB(1, 0), cB + kstep, voffB); PG8_STAGE(PG8_SA(1, 0), cA + kstep, voffA); PG8_STAGE(PG8_SB(1, 1), cB + hstep + kstep, voffB);
    PG8_WAIT_V(6); PG8_BAR;
    PG8_STAMP();
    for (;;) {
        const bool has_next = S.next(ui + 1, nxt);
        const char* nA = has_next ? (const char*)g.A + (ksb ? (size_t)nxt.pm * ksb : (size_t)nxt.pm * tstep) : cA; const char* nB = has_next ? (const char*)g.Bt + (size_t)nxt.pn * tstep + (size_t)nxt.pm * ksb : cB;
        for (int t = 0; t < nt; t += 2) {
            const bool last = (t == nt - 2);
            const char* a1 = cA + (size_t)(t + 1) * kstep;
            const char* a2 = last ? nA : cA + (size_t)(t + 2) * kstep; const char* b2 = last ? nB : cB + (size_t)(t + 2) * kstep;
            const char* a3 = a2 + kstep; const char* b3 = b2 + kstep;
            if (last && has_next) S.a_ready(nxt);
            PG8_LDB(B0, 0, 0); PG8_SCHED; PG8_LDA(At, 0, 0); PG8_STAGE(PG8_SA(1, 1), a1 + hstep, voffA);
            PG8_WAIT_L(8); PG8_BAR; PG8_WAIT_L(0); PG8_MMA(0, 0, At, B0); PG8_BAR; PG8_SCHED;
            PG8_LDB(B1, 0, 1); PG8_STAGE(PG8_SB(0, 0), b2, voffB);
            PG8_BAR; PG8_WAIT_L(0); PG8_MMA(0, 1, At, B1); PG8_BAR;
            PG8_LDA(At, 0, 1); PG8_STAGE(PG8_SA(0, 0), a2, voffA);
            PG8_BAR; PG8_WAIT_L(0); PG8_MMA(1, 0, At, B0); PG8_BAR; PG8_SCHED;
            PG8_STAGE(PG8_SB(0, 1), b2 + hstep, voffB);
            PG8_WAIT_V(6); PG8_BAR; PG8_MMA(1, 1, At, B1); PG8_BAR;
            PG8_LDB(B0, 1, 0); PG8_SCHED; PG8_LDA(At, 1, 0); PG8_STAGE(PG8_SA(0, 1), a2 + hstep, voffA);
            PG8_WAIT_L(8); PG8_BAR; PG8_WAIT_L(0); PG8_MMA(0, 0, At, B0); PG8_BAR; PG8_SCHED;
            PG8_LDB(B1, 1, 1); PG8_STAGE(PG8_SB(1, 0), b3, voffB);
            PG8_BAR; PG8_WAIT_L(0); PG8_MMA(0, 1, At, B1); PG8_BAR;
            PG8_LDA(At, 1, 1); PG8_STAGE(PG8_SA(1, 0), a3, voffA);
            PG8_BAR; PG8_WAIT_L(0); PG8_MMA(1, 0, At, B0); PG8_BAR; PG8_SCHED;
            PG8_STAGE(PG8_SB(1, 1), b3 + hstep, voffB);
            PG8_WAIT_V(6); PG8_BAR; PG8_MMA(1, 1, At, B1); PG8_BAR;
        }
        PG8_STAMP();
        if constexpr (!Epi::AFTER_DRAIN) { E(acc, cur, wr, wc, fr, fq); S.done(cur); }
        PG8_STAMP();
        if (!has_next) break;
#pragma unroll
        for (int a = 0; a < 2; ++a)
#pragma unroll
            for (int b = 0; b < 2; ++b)
#pragma unroll
                for (int m = 0; m < 4; ++m)
#pragma unroll
                    for (int n = 0; n < 2; ++n) acc[a][b][m][n] = (f32x4){0.f, 0.f, 0.f, 0.f};
        cur = nxt; cA = nA; cB = nB; ++ui;
    }
    PG8_WAIT_V(0);
    if (wr == 0) PG8_BAR;
    PG8_BAR;
    if constexpr (Epi::AFTER_DRAIN) { E.fused(acc, cur, wr, wc, fr, fq, lds, wid, lane); S.done(cur); }
    PG8_STAMP();
    if (STAMP && wid == 0) { stamps[lane] = lane < nts ? (((unsigned long long)(unsigned)ts_hi << 32) | (unsigned)ts_lo) : 0ull;
        if (lane == 62) stamps[62] = rt_entry; if (lane == 63) stamps[63] = (unsigned long long)wall_clock64(); }
#undef PG8_STAMP
#undef PG8_SA
#undef PG8_SB
#undef PG8_STAGE
#undef PG8_LDA
#undef PG8_LDB
#undef PG8_MMA
#undef PG8_WAIT_V
#undef PG8_WAIT_L
#undef PG8_BAR
#undef PG8_SCHED
}
}

namespace cg = cooperative_groups;
typedef unsigned short bf16_t;
typedef short bf16x8 __attribute__((ext_vector_type(8)));
typedef short s16x4 __attribute__((ext_vector_type(4)));
typedef float f32x4 __attribute__((ext_vector_type(4)));
typedef float f32x8 __attribute__((ext_vector_type(8)));
typedef float f32x16 __attribute__((ext_vector_type(16)));
typedef unsigned u32x4 __attribute__((ext_vector_type(4)));
typedef unsigned u32x2 __attribute__((ext_vector_type(2)));

constexpr int T = 16640, NCTX = 256, DM = 2048, NTH = 512;
constexpr int NIN = 3840;
constexpr int DFF = 5632, NGU = 2 * DFF;
constexpr int C_LRU = 1760, C_MLA = 2784, C_VD = 3616;
constexpr int RECB = 896;
constexpr int LDS_BYTES = 150528;

constexpr size_t al256(size_t x) { return (x + 255) / 256 * 256; }
constexpr size_t WS_BAR = 0;
constexpr size_t WS_MOD = 256;
constexpr size_t WS_XC = al256(WS_MOD + 2 * 2 * 12288 * 4);
constexpr size_t WS_H = al256(WS_XC + (size_t)NCTX * DM * 4);
constexpr size_t WS_VF = al256(WS_H + (size_t)T * DM * 2);
constexpr size_t WS_WIN = al256(WS_VF + (size_t)T * 512 * 2);
constexpr size_t WS_WOUT = al256(WS_WIN + (size_t)NIN * DM * 2);
constexpr size_t WS_WQ = al256(WS_WOUT + (size_t)DM * DM * 2);
constexpr size_t WS_WKV = al256(WS_WQ + (size_t)1536 * 512 * 2);
constexpr size_t WS_WGU = al256(WS_WKV + (size_t)2048 * 256 * 2);
constexpr size_t WS_WDN = al256(WS_WGU + (size_t)NGU * DM * 2);
constexpr size_t WS_R = al256(WS_WDN + (size_t)DM * DFF * 2);
constexpr size_t WS_COLS = WS_R;
constexpr size_t WS_Q = WS_COLS;
constexpr size_t WS_KV = al256(WS_Q + (size_t)T * 1536 * 2);
constexpr size_t WS_REC = al256(WS_COLS + (size_t)T * NIN * 2);
constexpr size_t WS_Y = al256(WS_REC + (size_t)16 * T * RECB);
constexpr size_t WS_LAB = al256(WS_Y + (size_t)2 * T * 512 * 4);
constexpr size_t WS_GG = al256(WS_LAB + (size_t)T * 2048 * 2);
constexpr size_t WS_QN = al256(WS_GG + (size_t)T * 512 * 2);
constexpr size_t WS_KVN = al256(WS_QN + (size_t)T * 512 * 2);
constexpr size_t WS_KR = al256(WS_KVN + (size_t)T * 256 * 2);
constexpr size_t WS_RG = al256(WS_KR + (size_t)T * 64 * 2);
constexpr size_t WS_CV = al256(WS_RG + (size_t)T * 512 * 2);
constexpr size_t WS_AGG = al256(WS_CV + (size_t)T * 512 * 2);
constexpr size_t WS_MIX_END = al256(WS_AGG + (size_t)260 * 2048 * 4);
constexpr size_t WS_GU = WS_R;
constexpr size_t WS_ACT = al256(WS_GU + (size_t)T * NGU * 2);
constexpr size_t WS_FFN_END = al256(WS_ACT + (size_t)T * DFF * 2);
constexpr size_t WS_REND = WS_MIX_END > WS_FFN_END ? WS_MIX_END : WS_FFN_END;
constexpr size_t WS_PARTO = WS_REND;
constexpr size_t WS_PARTML = al256(WS_PARTO + (size_t)448 * 256 * 128 * 2);
constexpr size_t WS_END = al256(WS_PARTML + (size_t)448 * 512 * 4);
static_assert(WS_KV + (size_t)T * 2048 * 2 <= WS_REC, "Q|KV must fit in the cols buffer");

struct Params { const float* in[42]; float* out; unsigned char* ws; int ph_lo, ph_hi; };

enum { I_X = 0, I_C, I_CTX, I_CCTX, I_ADAW, I_ADAB, I_NORM1, I_NORM2, I_WIN, I_WOUT, I_RWCONV, I_RWCONVB, I_RWW0, I_RWWUP, I_RWA0, I_RWAUP, I_RWGUP,
       I_RWKK, I_RWKA, I_RWRK, I_RWLNG, I_RWLNB, I_RWV0, I_RWVDOWN, I_RWVUP, I_LRUCONV, I_LRUCONVB, I_LRUWA, I_LRUBA, I_LRUWX, I_LRUBX, I_LRULAM,
       I_QNORM, I_WQB, I_KVNORM, I_WKVB, I_WGATE, I_WUP, I_FCONV, I_FCONVB, I_WDOWN, I_FNORM };

__device__ __forceinline__ float bf2f(bf16_t b) { return __uint_as_float(((unsigned)b) << 16); }
__device__ __forceinline__ unsigned cvtpk(float lo, float hi) { unsigned r; asm volatile("v_cvt_pk_bf16_f32 %0, %1, %2" : "=v"(r) : "v"(lo), "v"(hi)); return r; }
__device__ __forceinline__ bf16_t f2bf(float f) { return (bf16_t)(cvtpk(f, 0.f) & 0xffffu); }
__device__ __forceinline__ float sigmoidf_(float x) { return __builtin_amdgcn_rcpf(1.0f + __expf(-x)); }
__device__ __forceinline__ float tanhf_(float x) { return 1.0f - 2.0f * __builtin_amdgcn_rcpf(1.0f + __expf(2.0f * x)); }
__device__ __forceinline__ float siluf_(float x) { return x * sigmoidf_(x); }
__device__ __forceinline__ float gelu_tanh(float x) { const float u = 0.7978845608028654f * (x + 0.044715f * x * x * x); return 0.5f * x * (1.0f + tanhf_(u)); }
__device__ __forceinline__ float wave_sum(float v) {
#pragma unroll
  for (int o = 32; o >= 1; o >>= 1) v += __shfl_xor(v, o);
  return v;
}
template <int CTRL> __device__ __forceinline__ float dpp_add(float x) {
  const int xi = __float_as_int(x);
  const int yi = __builtin_amdgcn_update_dpp(xi, xi, CTRL, 0xF, 0xF, false);
  return x + __int_as_float(yi);
}
__device__ __forceinline__ float fma_(float a, float b, float c) { float r; asm("v_fma_f32 %0, %1, %2, %3" : "=v"(r) : "v"(a), "v"(b), "v"(c)); return r; }
__device__ __forceinline__ float mul_(float a, float b) { float r; asm("v_mul_f32 %0, %1, %2" : "=v"(r) : "v"(a), "v"(b)); return r; }
__device__ __forceinline__ float add_(float a, float b) { float r; asm("v_add_f32 %0, %1, %2" : "=v"(r) : "v"(a), "v"(b)); return r; }
typedef float f32x2 __attribute__((ext_vector_type(2)));
__device__ __forceinline__ float dot4(f32x4 a, f32x4 b) { const f32x2 t = a.lo * b.lo + a.hi * b.hi; return t.x + t.y; }
__device__ __forceinline__ float row16_sum(float x) {
  x = dpp_add<0xB1>(x);
  x = dpp_add<0x4E>(x);
  x = dpp_add<0x141>(x);
  x = dpp_add<0x140>(x);
  return x;
}
__device__ __forceinline__ const float* resid_src(const Params& P, int layer, int t) {
  if (layer == 0) return t < NCTX ? PIN(I_CTX) + (size_t)t * DM : PIN(I_X) + (size_t)(t - NCTX) * DM;
  return t < NCTX ? (const float*)(PWS() + WS_XC) + (size_t)t * DM : POUT() + (size_t)(t - NCTX) * DM;
}
__device__ __forceinline__ float* resid_dst(const Params& P, int t) {
  return t < NCTX ? (float*)(PWS() + WS_XC) + (size_t)t * DM : POUT() + (size_t)(t - NCTX) * DM;
}
__device__ __forceinline__ int scan_pos_rev(int t) { return t < NCTX ? (NCTX - 1 - t) : (T + NCTX - 1 - t); }

__device__ __forceinline__ void phase_mod(const Params& P, float* lds) {
  const int tid = mk_tid(), cgp = tid & 15, rg = tid >> 4;
  float* mod = (float*)(PWS() + WS_MOD);
  const float* cvec = PIN(I_C); const float* ccvec = PIN(I_CCTX); const float* adaw = PIN(I_ADAW); const float* adab = PIN(I_ADAB);
  for (int item = mk_bid(); item < 2 * 192; item += mk_nblk()) {
    const int layer = item / 192, col0 = (item % 192) * 64;
    const float* W = adaw + (size_t)layer * DM * 12288 + col0 + cgp * 4;
    f32x4 al = {0.f, 0.f, 0.f, 0.f}, ac = {0.f, 0.f, 0.f, 0.f};
#pragma unroll 1
    for (int r0 = 0; r0 < 64; r0 += 8) {
      f32x4 wv[8]; float sl[8], sc[8];
#pragma unroll
      for (int r = 0; r < 8; ++r) { const int row = rg * 64 + r0 + r; wv[r] = *(const f32x4*)(W + (size_t)row * 12288); sl[r] = cvec[row]; sc[r] = ccvec[row]; }
#pragma unroll
      for (int r = 0; r < 8; ++r) { al += siluf_(sl[r]) * wv[r]; ac += siluf_(sc[r]) * wv[r]; }
    }
#pragma unroll
    for (int i = 0; i < 4; ++i) { lds[(rg * 2 + 0) * 64 + cgp * 4 + i] = al[i]; lds[(rg * 2 + 1) * 64 + cgp * 4 + i] = ac[i]; }
    __syncthreads();
    if (tid < 128) {
      const int which = tid >> 6, col = tid & 63; float sacc = 0.f;
      for (int g = 0; g < 32; ++g) sacc += lds[(g * 2 + which) * 64 + col];
      mod[(size_t)(layer * 2 + which) * 12288 + col0 + col] = sacc + adab[(size_t)layer * 12288 + col0 + col];
    }
    __syncthreads();
  }
}

struct CvtItem { const float* src; bf16_t* dst; int K, N, kt, ntile; bool valid; };
__device__ __forceinline__ CvtItem cvt_decode(const Params& P, int layer, int it) {
  CvtItem r; r.src = nullptr; r.dst = nullptr; r.K = 64; r.N = 0; r.kt = 0; r.ntile = 0; r.valid = false;
  int base = 0;
#define CVT_JOB(SRC, DST, KK, NN) do { const int nkt_ = (KK) / 64, cnt_ = nkt_ * (((NN) + 63) / 64); \
    if (!r.valid && it < base + cnt_) { const int tl_ = it - base; r.src = (SRC); r.dst = (DST); r.K = (KK); r.N = (NN); r.kt = tl_ % nkt_; r.ntile = tl_ / nkt_; r.valid = true; } base += cnt_; } while (0)
  CVT_JOB(PIN(I_WIN) + (size_t)layer * DM * 3616, (bf16_t*)(PWS() + WS_WIN), DM, 3616);
  CVT_JOB(PIN(I_RWVDOWN), (bf16_t*)(PWS() + WS_WIN) + (size_t)C_VD * DM, DM, (layer == 0) ? 0 : 32);
  CVT_JOB(PIN(I_WOUT) + (size_t)layer * DM * DM, (bf16_t*)(PWS() + WS_WOUT), DM, DM);
  CVT_JOB(PIN(I_WQB) + (size_t)layer * 512 * 1536, (bf16_t*)(PWS() + WS_WQ), 512, 1536);
  CVT_JOB(PIN(I_WKVB) + (size_t)layer * 256 * 2048, (bf16_t*)(PWS() + WS_WKV), 256, 2048);
  CVT_JOB(PIN(I_WGATE) + (size_t)layer * DM * DFF, (bf16_t*)(PWS() + WS_WGU), DM, DFF);
  CVT_JOB(PIN(I_WUP) + (size_t)layer * DM * DFF, (bf16_t*)(PWS() + WS_WGU) + (size_t)DFF * DM, DM, DFF);
  CVT_JOB(PIN(I_WDOWN) + (size_t)layer * DFF * DM, (bf16_t*)(PWS() + WS_WDN), DFF, DM);
#undef CVT_JOB
  return r;
}
__device__ __forceinline__ void cvt_load(const CvtItem& c, f32x4 (&v)[2]) {
  const int tid = mk_tid(), kr = tid >> 4, nc = (tid & 15) * 4, k0 = c.kt * 64, n0 = c.ntile * 64;
#pragma unroll
  for (int i = 0; i < 2; ++i) { v[i] = (f32x4){0.f, 0.f, 0.f, 0.f}; if (c.valid && n0 + nc < c.N) v[i] = *(const f32x4*)(c.src + (size_t)(k0 + kr + 32 * i) * c.N + n0 + nc); }
}
__device__ __forceinline__ void phase_convert(const Params& P, int layer, float* lds) {
  const int tid = mk_tid(), kr = tid >> 4, nc = (tid & 15) * 4, n = tid >> 3, kc = (tid & 7) * 8, G = mk_nblk();
  int it = mk_bid();
  CvtItem cur = cvt_decode(P, layer, it); f32x4 v[2]; cvt_load(cur, v);
  while (cur.valid) {
    const CvtItem nxt = cvt_decode(P, layer, it + G); f32x4 nv[2]; cvt_load(nxt, nv);
#pragma unroll
    for (int i = 0; i < 2; ++i) { const int k = kr + 32 * i;
      lds[(nc + 0) * 65 + k] = v[i][0]; lds[(nc + 1) * 65 + k] = v[i][1]; lds[(nc + 2) * 65 + k] = v[i][2]; lds[(nc + 3) * 65 + k] = v[i][3]; }
    __syncthreads();
    if (cur.ntile * 64 + n < cur.N) {
      const float* p = lds + n * 65 + kc;
      u32x4 w; w.x = cvtpk(p[0], p[1]); w.y = cvtpk(p[2], p[3]); w.z = cvtpk(p[4], p[5]); w.w = cvtpk(p[6], p[7]);
      *(u32x4*)(cur.dst + (size_t)(cur.ntile * 64 + n) * cur.K + cur.kt * 64 + kc) = w;
    }
    __syncthreads();
    cur = nxt; v[0] = nv[0]; v[1] = nv[1]; it += G;
  }
}

__device__ __forceinline__ void phase_norm(const Params& P, int layer, int which, bool skip_ctx) {
  const int lane = mk_tid() & 63, wave = mk_tid() >> 6;
  const float* g = P.in[which ? I_NORM2 : I_NORM1] + (size_t)layer * DM;
  const float* mod = (const float*)(PWS() + WS_MOD) + (size_t)layer * 2 * 12288;
  bf16_t* H = (bf16_t*)(PWS() + WS_H);
  const int soff = which ? 6144 : 0;
  const float* src_c = (which == 0 && layer == 0) ? PIN(I_CTX) : (const float*)(PWS() + WS_XC);
  const float* src_l = (which == 0 && layer == 0) ? PIN(I_X) : (const float*)POUT();
  const int stride = mk_nblk() * 8;
  for (int row = mk_bid() * 8 + wave; row < T; row += 2 * stride) {
    int rows[2] = {row, row + stride}; f32x4 v[2][8]; bool ok[2];
#pragma unroll
    for (int u = 0; u < 2; ++u) { ok[u] = rows[u] < T && !(skip_ctx && rows[u] < NCTX);
      if (ok[u]) { const float* xr = rows[u] < NCTX ? src_c + (size_t)rows[u] * DM : src_l + (size_t)(rows[u] - NCTX) * DM;
#pragma unroll
        for (int i = 0; i < 8; ++i) v[u][i] = *(const f32x4*)(xr + i * 256 + lane * 4);
        if (which == 0 && layer == 0 && rows[u] < NCTX) { float* xc = (float*)(PWS() + WS_XC) + (size_t)rows[u] * DM;
#pragma unroll
          for (int i = 0; i < 8; ++i) *(f32x4*)(xc + i * 256 + lane * 4) = v[u][i]; } } }
#pragma unroll
    for (int u = 0; u < 2; ++u) if (ok[u]) {
      const float* m = mod + (rows[u] < NCTX ? 12288 : 0) + soff; float ss = 0.f;
#pragma unroll
      for (int i = 0; i < 8; ++i) ss += v[u][i][0] * v[u][i][0] + v[u][i][1] * v[u][i][1] + v[u][i][2] * v[u][i][2] + v[u][i][3] * v[u][i][3];
      ss = wave_sum(ss);
      const float rstd = rsqrtf(ss * (1.0f / DM) + 1e-6f);
#pragma unroll
      for (int i = 0; i < 8; ++i) {
        const int c = i * 256 + lane * 4;
        const f32x4 gv = *(const f32x4*)(g + c), sh = *(const f32x4*)(m + c), sc = *(const f32x4*)(m + 2048 + c);
        float o[4];
#pragma unroll
        for (int q = 0; q < 4; ++q) o[q] = (v[u][i][q] * rstd * gv[q]) * (1.0f + sc[q]) + sh[q];
        u32x2 w; w.x = cvtpk(o[0], o[1]); w.y = cvtpk(o[2], o[3]);
        *(u32x2*)(H + (size_t)rows[u] * DM + c) = w;
      }
    }
  }
}

__device__ __forceinline__ void phase_final_norm(const Params& P) {
  const int lane = mk_tid() & 63, wave = mk_tid() >> 6;
  const float* g = PIN(I_FNORM); float* out = POUT();
  const int stride = mk_nblk() * 8;
  for (int row = mk_bid() * 8 + wave; row < T - NCTX; row += 2 * stride) {
    int rows[2] = {row, row + stride}; f32x4 v[2][8]; bool ok[2];
#pragma unroll
    for (int u = 0; u < 2; ++u) { ok[u] = rows[u] < T - NCTX;
      if (ok[u]) {
#pragma unroll
        for (int i = 0; i < 8; ++i) v[u][i] = *(const f32x4*)(out + (size_t)rows[u] * DM + i * 256 + lane * 4); } }
#pragma unroll
    for (int u = 0; u < 2; ++u) if (ok[u]) {
      float ss = 0.f;
#pragma unroll
      for (int i = 0; i < 8; ++i) ss += v[u][i][0] * v[u][i][0] + v[u][i][1] * v[u][i][1] + v[u][i][2] * v[u][i][2] + v[u][i][3] * v[u][i][3];
      ss = wave_sum(ss);
      const float rstd = rsqrtf(ss * (1.0f / DM) + 1e-6f);
#pragma unroll
      for (int i = 0; i < 8; ++i) { const int c = i * 256 + lane * 4; const f32x4 gv = *(const f32x4*)(g + c); *(f32x4*)(out + (size_t)rows[u] * DM + c) = v[u][i] * rstd * gv; }
    }
  }
}

struct EpiStore {
  static constexpr bool PERM = true, AFTER_DRAIN = false;
  bf16_t* O; int ldc;
  __device__ __forceinline__ void operator()(const f32x4 (&acc)[2][2][4][2], const pg8::Unit& u, int wr, int wc, int fr, int fq) const {
    const int row0 = u.pm * 256 + wr * 64 + fr, col0 = u.pn * 256 + wc * 32 + 8 * fq;
#pragma unroll
    for (int ai = 0; ai < 2; ++ai)
#pragma unroll
      for (int m = 0; m < 4; ++m) { bf16_t* rowp = O + (size_t)(row0 + ai * 128 + m * 16) * ldc + col0;
#pragma unroll
        for (int bj = 0; bj < 2; ++bj) { const f32x4 v0 = acc[ai][bj][m][0], v1 = acc[ai][bj][m][1];
          u32x4 w; w.x = cvtpk(v0[0], v0[1]); w.y = cvtpk(v0[2], v0[3]); w.z = cvtpk(v1[0], v1[1]); w.w = cvtpk(v1[2], v1[3]);
          *(u32x4*)(rowp + bj * 128) = w; } }
  }
};
struct EpiResid {
  static constexpr bool PERM = false, AFTER_DRAIN = false;
  const float* src_c; const float* src_l; float* dst_c; float* dst_l; const float* gate_c; const float* gate_l; int row_off;
  __device__ __forceinline__ void operator()(const f32x4 (&acc)[2][2][4][2], const pg8::Unit& u, int wr, int wc, int fr, int fq) const {
    const int t0 = row_off + u.pm * 256;
    const bool isc = t0 < NCTX;
    const float* src = isc ? src_c : src_l - (size_t)NCTX * DM; float* dst = isc ? dst_c : dst_l - (size_t)NCTX * DM; const float* gate = isc ? gate_c : gate_l;
    const int row0 = t0 + wr * 64 + fr, col0 = u.pn * 256 + wc * 32 + 4 * fq;
    f32x4 gv[2][2];
#pragma unroll
    for (int bj = 0; bj < 2; ++bj)
#pragma unroll
      for (int n = 0; n < 2; ++n) gv[bj][n] = *(const f32x4*)(gate + col0 + bj * 128 + n * 16);
#pragma unroll
    for (int ai = 0; ai < 2; ++ai)
#pragma unroll
      for (int m = 0; m < 4; ++m) { const size_t off = (size_t)(row0 + ai * 128 + m * 16) * DM + col0;
#pragma unroll
        for (int bj = 0; bj < 2; ++bj)
#pragma unroll
          for (int n = 0; n < 2; ++n) { const f32x4 xs = *(const f32x4*)(src + off + bj * 128 + n * 16);
            *(f32x4*)(dst + off + bj * 128 + n * 16) = xs + gv[bj][n] * acc[ai][bj][m][n]; } }
  }
};

struct EpiResidAtomic {
  static constexpr bool PERM = false, AFTER_DRAIN = false;
  float* dst; const float* gate;
  __device__ __forceinline__ void operator()(const f32x4 (&acc)[2][2][4][2], const pg8::Unit& u, int wr, int wc, int fr, int fq) const {
    const int row0 = wr * 64 + fr, col0 = u.pn * 256 + wc * 32 + 4 * fq;
    f32x4 gv[2][2];
#pragma unroll
    for (int bj = 0; bj < 2; ++bj)
#pragma unroll
      for (int n = 0; n < 2; ++n) gv[bj][n] = *(const f32x4*)(gate + col0 + bj * 128 + n * 16);
#pragma unroll
    for (int ai = 0; ai < 2; ++ai)
#pragma unroll
      for (int m = 0; m < 4; ++m) { float* rp = dst + (size_t)(row0 + ai * 128 + m * 16) * DM + col0;
#pragma unroll
        for (int bj = 0; bj < 2; ++bj)
#pragma unroll
          for (int n = 0; n < 2; ++n) { const f32x4 v = gv[bj][n] * acc[ai][bj][m][n];
#pragma unroll
            for (int q = 0; q < 4; ++q) __hip_atomic_fetch_add(rp + bj * 128 + n * 16 + q, v[q], __ATOMIC_RELAXED, __HIP_MEMORY_SCOPE_AGENT); } }
  }
};
template <class Epi>
__device__ __forceinline__ void run_gemm(unsigned char* lds, const bf16_t* A, const bf16_t* Bt, int M, int N, int K, const Epi& E, int wg, int nwg, int ld = 0, int ksplit = 0) {
  pg8::Gemm g{A, Bt, M, N, K, ld ? ld : K, ksplit}; pg8::StaticOrder S; S.init(M, N, nwg, wg);
  pg8::gemm_phase<Epi, pg8::StaticOrder, false>((PG8_LAS unsigned char*)lds, g, S, E, nullptr);
}

__device__ __forceinline__ float colv(const bf16_t* cols, int t, int c) { return bf2f(cols[(size_t)t * NIN + c]); }
__device__ __forceinline__ float rwconv3(const bf16_t* cols, const float* cw, const float* cb, int t, int c, int lo, int hi) {
  float u = cb[c] + cw[1760 + c] * colv(cols, t, c);
  if (t - 1 >= lo) u += cw[c] * colv(cols, t - 1, c);
  if (t + 1 < hi) u += cw[2 * 1760 + c] * colv(cols, t + 1, c);
  return u;
}

__device__ __forceinline__ float rwconv3w(const bf16_t* cols, float w0, float w1, float w2, float b, int t, int c, int lo, int hi) {
  float u = b + w1 * colv(cols, t, c);
  if (t - 1 >= lo) u += w0 * colv(cols, t - 1, c);
  if (t + 1 < hi) u += w2 * colv(cols, t + 1, c);
  return u;
}
template <int PART>
__device__ __forceinline__ void phase_prep(const Params& P, int layer, float* lds, int wg, int nwg) {
  constexpr int NTK = (PART == 0) ? 13 : 8;
  const int tid = mk_tid(), lane = tid & 63, wave = tid >> 6;
  float* lin = lds;
  float* xs = lds + 16 * 256;
  const bf16_t* cols = (const bf16_t*)(PWS() + WS_COLS);
  const float* cw = PIN(I_RWCONV) + (size_t)layer * 3 * 1760; const float* cb = PIN(I_RWCONVB) + (size_t)layer * 1760;
  const float* lcw = PIN(I_LRUCONV) + (size_t)layer * 4 * 512; const float* lcb = PIN(I_LRUCONVB) + (size_t)layer * 512;
  const int c = tid, hd = c >> 6, n = c & 63;
  bf16_t* VF = (bf16_t*)(PWS() + WS_VF); bf16_t* RG = (bf16_t*)(PWS() + WS_RG); bf16_t* CV = (bf16_t*)(PWS() + WS_CV);
  bf16_t* LAB = (bf16_t*)(PWS() + WS_LAB); bf16_t* GG = (bf16_t*)(PWS() + WS_GG);
  bf16_t* QN = (bf16_t*)(PWS() + WS_QN); bf16_t* KVN = (bf16_t*)(PWS() + WS_KVN); bf16_t* KR = (bf16_t*)(PWS() + WS_KR);
  unsigned char* REC = PWS() + WS_REC;
  const float w0_0 = PIN(I_RWW0)[(layer * 2 + 0) * 512 + c], w0_1 = PIN(I_RWW0)[(layer * 2 + 1) * 512 + c];
  const float a0_0 = PIN(I_RWA0)[(layer * 2 + 0) * 512 + c], a0_1 = PIN(I_RWA0)[(layer * 2 + 1) * 512 + c];
  const float kkc = PIN(I_RWKK)[layer * 512 + c], kac = PIN(I_RWKA)[layer * 512 + c], rkc = PIN(I_RWRK)[layer * 512 + c];
  const float v0c = (layer > 0) ? PIN(I_RWV0)[c] : 0.f;
  const float* wup = PIN(I_RWWUP) + (size_t)layer * 2 * 32 * 512 + c; const float* aup = PIN(I_RWAUP) + (size_t)layer * 2 * 32 * 512 + c;
  const float* gup = PIN(I_RWGUP) + (size_t)layer * 96 * 512 + c; const float* vup = PIN(I_RWVUP) + c;
  const float* lwa = PIN(I_LRUWA) + (size_t)layer * 2 * 8 * 4096 + (size_t)hd * 4096 + n; const float* lwx = PIN(I_LRUWX) + (size_t)layer * 2 * 8 * 4096 + (size_t)hd * 4096 + n;
  const float lba0 = PIN(I_LRUBA)[(layer * 2 + 0) * 512 + c], lba1 = PIN(I_LRUBA)[(layer * 2 + 1) * 512 + c];
  const float lbx0 = PIN(I_LRUBX)[(layer * 2 + 0) * 512 + c], lbx1 = PIN(I_LRUBX)[(layer * 2 + 1) * 512 + c];
  const float lam0 = PIN(I_LRULAM)[(layer * 2 + 0) * 512 + c], lam1 = PIN(I_LRULAM)[(layer * 2 + 1) * 512 + c];
  const float sp0 = log1pf(__expf(-lam0)), sp1 = log1pf(__expf(-lam1));
  float cwr[3], cwk[3], cwv[3], cwe[3], cbr = 0.f, cbk = 0.f, cbv = 0.f, cbe = 0.f;
  const int ecol = 1536 + ((tid & 255) < 224 ? (tid & 255) : 0);
#pragma unroll
  for (int q = 0; q < 3; ++q) { cwr[q] = (PART == 0) ? cw[q * 1760 + c] : 0.f; cwk[q] = (PART == 0) ? cw[q * 1760 + 512 + c] : 0.f; cwv[q] = (PART == 0) ? cw[q * 1760 + 1024 + c] : 0.f; cwe[q] = (PART == 0) ? cw[q * 1760 + ecol] : 0.f; }
  if (PART == 0) { cbr = cb[c]; cbk = cb[512 + c]; cbv = cb[1024 + c]; cbe = cb[ecol]; }

  for (int tile = wg; tile < T / NTK; tile += nwg) {
    const int t0 = tile * NTK;
    const int lo = t0 < NCTX ? 0 : NCTX, hi = t0 < NCTX ? NCTX : T;
    if (PART == 0) {
#pragma unroll
    for (int i = 0; i < (NTK * 256 + 511) / 512; ++i) {
      const int idx = tid + 512 * i, tt = idx >> 8, e = idx & 255, t = t0 + tt; float v;
      if (idx >= NTK * 256) continue;
      const int lo_t = t < NCTX ? 0 : NCTX, hi_t = t < NCTX ? NCTX : T;
      if (e < 224) { v = rwconv3w(cols, cwe[0], cwe[1], cwe[2], cbe, t, 1536 + e, lo_t, hi_t); if (e < 64) v = tanhf_(v); else if (e >= 128) v = sigmoidf_(v); }
      else v = (layer > 0) ? colv(cols, t, C_VD + e - 224) : 0.f;
      lin[tt * 256 + e] = v;
    }
    }
    if (PART == 1) {
#pragma unroll
    for (int tt = 0; tt < 8; ++tt) {
      const int t = t0 + tt; float u = lcb[c];
#pragma unroll
      for (int j = 0; j < 4; ++j) { const int ts = t + j - 2; if (ts >= lo && ts < hi) u += lcw[j * 512 + c] * colv(cols, ts, C_LRU + c); }
      xs[tt * 512 + c] = u;
    }
    {
      const int t = t0 + wave; const bf16_t* cr = cols + (size_t)t * NIN;
      float q[8]; float ss = 0.f;
      { const bf16x8 raw = *(const bf16x8*)(cr + C_MLA + lane * 8);
#pragma unroll
        for (int i = 0; i < 8; ++i) { q[i] = bf2f((bf16_t)raw[i]); ss += q[i] * q[i]; } }
      ss = wave_sum(ss); float rstd = rsqrtf(ss * (1.0f / 512.0f) + 1e-6f);
      { const float* gq = PIN(I_QNORM) + layer * 512 + lane * 8; u32x4 w;
        w.x = cvtpk(q[0] * rstd * gq[0], q[1] * rstd * gq[1]); w.y = cvtpk(q[2] * rstd * gq[2], q[3] * rstd * gq[3]);
        w.z = cvtpk(q[4] * rstd * gq[4], q[5] * rstd * gq[5]); w.w = cvtpk(q[6] * rstd * gq[6], q[7] * rstd * gq[7]);
        *(u32x4*)(QN + (size_t)t * 512 + lane * 8) = w; }
      float k4[4]; ss = 0.f;
      { const s16x4 raw = *(const s16x4*)(cr + C_MLA + 512 + lane * 4);
#pragma unroll
        for (int i = 0; i < 4; ++i) { k4[i] = bf2f((bf16_t)raw[i]); ss += k4[i] * k4[i]; } }
      ss = wave_sum(ss); rstd = rsqrtf(ss * (1.0f / 256.0f) + 1e-6f);
      { const float* gk = PIN(I_KVNORM) + layer * 256 + lane * 4; u32x2 w;
        w.x = cvtpk(k4[0] * rstd * gk[0], k4[1] * rstd * gk[1]); w.y = cvtpk(k4[2] * rstd * gk[2], k4[3] * rstd * gk[3]);
        *(u32x2*)(KVN + (size_t)t * 256 + lane * 4) = w; }
      const float own = bf2f(cr[C_MLA + 768 + lane]); const float oth = __shfl_xor(own, 16);
      float res = own;
      if (t >= NCTX) {
        const int tl = t - NCTX, axis = lane >> 5, half = (lane >> 4) & 1, f = lane & 15;
        const float pos = (float)(axis == 0 ? (tl >> 6) : (tl & 63));
        const float inv = exp2f(-(float)f * (13.287712379549449f / 16.0f));
        const float sn = __sinf(pos * inv), cs = __cosf(pos * inv);
        res = half == 0 ? own * cs - oth * sn : oth * sn + own * cs;
      }
      KR[(size_t)t * 64 + lane] = f2bf(res);
    }
    }
    __syncthreads();
    if (PART == 0) {
      float zw0[NTK], zw1[NTK], za0[NTK], za1[NTK], gg[NTK], mx[NTK];
#pragma unroll
      for (int tt = 0; tt < NTK; ++tt) { zw0[tt] = 0.f; zw1[tt] = 0.f; za0[tt] = 0.f; za1[tt] = 0.f; gg[tt] = 0.f; mx[tt] = 0.f; }
#pragma unroll 1
      for (int e = 0; e < 32; e += 4) {
        float wa[4], wb[4], aa[4], ab[4], vv[4];
#pragma unroll
        for (int i = 0; i < 4; ++i) { wa[i] = wup[(size_t)(e + i) * 512]; wb[i] = wup[(size_t)(32 + e + i) * 512]; aa[i] = aup[(size_t)(e + i) * 512]; ab[i] = aup[(size_t)(32 + e + i) * 512];
          vv[i] = (layer > 0) ? vup[(size_t)(e + i) * 512] : 0.f; }
#pragma unroll
        for (int tt = 0; tt < NTK; ++tt) {
          const f32x4 x0 = *(const f32x4*)(lin + tt * 256 + e), x1 = *(const f32x4*)(lin + tt * 256 + 32 + e), y0 = *(const f32x4*)(lin + tt * 256 + 64 + e),
                      y1 = *(const f32x4*)(lin + tt * 256 + 96 + e), hv = *(const f32x4*)(lin + tt * 256 + 224 + e);
#pragma unroll
          for (int i = 0; i < 4; ++i) { zw0[tt] += x0[i] * wa[i]; zw1[tt] += x1[i] * wb[i]; za0[tt] += y0[i] * aa[i]; za1[tt] += y1[i] * ab[i]; mx[tt] += hv[i] * vv[i]; }
        }
      }
#pragma unroll 1
      for (int e = 0; e < 96; e += 4) {
        float gw[4];
#pragma unroll
        for (int i = 0; i < 4; ++i) gw[i] = gup[(size_t)(e + i) * 512];
#pragma unroll
        for (int tt = 0; tt < NTK; ++tt) { const f32x4 s4 = *(const f32x4*)(lin + tt * 256 + 128 + e);
#pragma unroll
          for (int i = 0; i < 4; ++i) gg[tt] += s4[i] * gw[i]; }
      }
#pragma unroll
      for (int tt = 0; tt < NTK; ++tt) {
        const int t = t0 + tt; const int lo_t = t < NCTX ? 0 : NCTX, hi_t = t < NCTX ? NCTX : T;
        const float r = rwconv3w(cols, cwr[0], cwr[1], cwr[2], cbr, t, c, lo_t, hi_t), k = rwconv3w(cols, cwk[0], cwk[1], cwk[2], cbk, t, 512 + c, lo_t, hi_t);
        float v = rwconv3w(cols, cwv[0], cwv[1], cwv[2], cbv, t, 1024 + c, lo_t, hi_t);
        const float wd0 = __expf(-0.606531f * sigmoidf_(w0_0 + zw0[tt])), wd1 = __expf(-0.606531f * sigmoidf_(w0_1 + zw1[tt]));
        const float ic0 = sigmoidf_(a0_0 + za0[tt]), ic1 = sigmoidf_(a0_1 + za1[tt]);
        if (layer > 0) { const float mixv = sigmoidf_(v0c + mx[tt]); const float vf = bf2f(VF[(size_t)t * 512 + c]); v = v + (vf - v) * mixv; }
        else VF[(size_t)t * 512 + c] = f2bf(v);
        float kk = k * kkc; const float ssq = wave_sum(kk * kk); kk *= rsqrtf(fmaxf(ssq, 1e-24f));
        const float kd0 = k * (1.0f + (ic0 - 1.0f) * kac), kd1 = k * (1.0f + (ic1 - 1.0f) * kac);
        const float b0 = kk * ic0, b1 = kk * ic1;
        const float coef = wave_sum(r * (kd0 + kd1) * rkc);
        RG[(size_t)t * 512 + c] = f2bf(gg[tt]); CV[(size_t)t * 512 + c] = f2bf(coef * v);
        const bf16_t ab_ = f2bf(-kk), rb_ = f2bf(r), vb_ = f2bf(v);
        { unsigned char* rp = REC + ((size_t)(0 * 8 + hd) * T + t) * RECB;
          ((float*)rp)[n] = wd0; bf16_t* q = (bf16_t*)(rp + 256); q[n] = f2bf(kd0); q[64 + n] = ab_; q[128 + n] = f2bf(b0); q[192 + n] = rb_; q[256 + n] = vb_; }
        { unsigned char* rp = REC + ((size_t)(1 * 8 + hd) * T + scan_pos_rev(t)) * RECB;
          ((float*)rp)[n] = wd1; bf16_t* q = (bf16_t*)(rp + 256); q[n] = f2bf(kd1); q[64 + n] = ab_; q[128 + n] = f2bf(b1); q[192 + n] = rb_; q[256 + n] = vb_; }
        asm volatile("" ::: "memory");
      }
    }
    if (PART == 1) {
      float pa0[8], pa1[8], px0[8], px1[8];
#pragma unroll
      for (int tt = 0; tt < 8; ++tt) { pa0[tt] = 0.f; pa1[tt] = 0.f; px0[tt] = 0.f; px1[tt] = 0.f; }
      {
        float a0w[4], a1w[4], x0w[4], x1w[4];
#pragma unroll
        for (int i = 0; i < 4; ++i) { a0w[i] = lwa[(size_t)i * 64]; a1w[i] = lwa[(size_t)8 * 4096 + (size_t)i * 64]; x0w[i] = lwx[(size_t)i * 64]; x1w[i] = lwx[(size_t)8 * 4096 + (size_t)i * 64]; }
#pragma unroll 1
        for (int i0 = 0; i0 < 64; i0 += 4) {
          float na0[4], na1[4], nx0[4], nx1[4];
          const int in_ = (i0 + 4 < 64) ? i0 + 4 : i0;
#pragma unroll
          for (int i = 0; i < 4; ++i) { na0[i] = lwa[(size_t)(in_ + i) * 64]; na1[i] = lwa[(size_t)8 * 4096 + (size_t)(in_ + i) * 64]; nx0[i] = lwx[(size_t)(in_ + i) * 64]; nx1[i] = lwx[(size_t)8 * 4096 + (size_t)(in_ + i) * 64]; }
#pragma unroll
          for (int tt = 0; tt < 8; ++tt) { const f32x4 x = *(const f32x4*)(xs + tt * 512 + hd * 64 + i0);
#pragma unroll
            for (int i = 0; i < 4; ++i) { pa0[tt] += x[i] * a0w[i]; pa1[tt] += x[i] * a1w[i]; px0[tt] += x[i] * x0w[i]; px1[tt] += x[i] * x1w[i]; } }
#pragma unroll
          for (int i = 0; i < 4; ++i) { a0w[i] = na0[i]; a1w[i] = na1[i]; x0w[i] = nx0[i]; x1w[i] = nx1[i]; }
        }
      }
      float gt8[8];
#pragma unroll
      for (int tt = 0; tt < 8; ++tt) gt8[tt] = colv(cols, t0 + tt, C_LRU + 512 + c);
#pragma unroll
      for (int tt = 0; tt < 8; ++tt) {
        const int t = t0 + tt; const float xb = xs[tt * 512 + c];
        const float la0 = -8.0f * sigmoidf_(pa0[tt] + lba0) * sp0, la1 = -8.0f * sigmoidf_(pa1[tt] + lba1) * sp1;
        const float bb0 = sqrtf(fmaxf(1.0f - __expf(2.0f * la0), 0.f)) * sigmoidf_(px0[tt] + lbx0) * xb;
        const float bb1 = sqrtf(fmaxf(1.0f - __expf(2.0f * la1), 0.f)) * sigmoidf_(px1[tt] + lbx1) * xb;
        bf16_t* lp = LAB + (size_t)t * 2048;
        lp[c] = f2bf(la0); lp[512 + c] = f2bf(bb0); lp[1024 + c] = f2bf(la1); lp[1536 + c] = f2bf(bb1);
        GG[(size_t)t * 512 + c] = f2bf(gelu_tanh(gt8[tt]));
        asm volatile("" ::: "memory");
      }
    }
    __syncthreads();
  }
}

__device__ __forceinline__ void phase_lru_agg(const Params& P, int wg, int nwg) {
  const int c = mk_tid(); const bf16_t* LAB = (const bf16_t*)(PWS() + WS_LAB); float* AGG = (float*)(PWS() + WS_AGG);
  for (int ck = wg; ck < T / 64; ck += nwg) {
    float A0 = 1.f, B0 = 0.f, A1 = 1.f, B1 = 0.f;
#pragma unroll 1
    for (int t8 = 0; t8 < 64; t8 += 8) {
      bf16_t x[8][4];
#pragma unroll
      for (int u = 0; u < 8; ++u) { const bf16_t* lp = LAB + (size_t)(ck * 64 + t8 + u) * 2048; x[u][0] = lp[c]; x[u][1] = lp[512 + c]; x[u][2] = lp[1024 + c]; x[u][3] = lp[1536 + c]; }
#pragma unroll
      for (int u = 0; u < 8; ++u) {
        const float a0 = __expf(bf2f(x[u][0])), b0 = bf2f(x[u][1]), a1 = __expf(bf2f(x[u][2])), b1 = bf2f(x[u][3]);
        A0 = a0 * A0; B0 = a0 * B0 + b0;
        B1 = B1 + A1 * b1; A1 = A1 * a1;
      }
    }
    float* ap = AGG + (size_t)ck * 2048; ap[c] = A0; ap[512 + c] = B0; ap[1024 + c] = A1; ap[1536 + c] = B1;
  }
}
__device__ __forceinline__ float lru_compose(const float* AGG, int c, int off, int q0, int dq, int n, float h) {
  int i = 0;
#pragma unroll 1
  for (; i + 8 <= n; i += 8) {
    float a[8], b[8];
#pragma unroll
    for (int u = 0; u < 8; ++u) { const float* ap = AGG + (size_t)(q0 + (i + u) * dq) * 2048 + off; a[u] = ap[c]; b[u] = ap[512 + c]; }
#pragma unroll
    for (int u = 0; u < 8; ++u) h = a[u] * h + b[u];
  }
#pragma unroll 1
  for (; i < n; ++i) { const float* ap = AGG + (size_t)(q0 + i * dq) * 2048 + off; h = ap[c] * h + ap[512 + c]; }
  return h;
}
__device__ __forceinline__ void phase_lru_out(const Params& P, int layer, float* lds, int wg, int nwg) {
  const int c = mk_tid(); const bf16_t* LAB = (const bf16_t*)(PWS() + WS_LAB); const float* AGG = (const float*)(PWS() + WS_AGG);
  const bf16_t* GG = (const bf16_t*)(PWS() + WS_GG); bf16_t* MIX = (bf16_t*)(PWS() + WS_H);
  const int ck_lo = (layer == 1) ? 4 : 0;
  for (int ck = ck_lo + wg; ck < T / 64; ck += nwg) {
    float h0 = lru_compose(AGG, c, 0, 0, 1, ck, 0.f);
    float h1;
    if (ck < 4) h1 = lru_compose(AGG, c, 1024, 3, -1, 3 - ck, 0.f);
    else { h1 = lru_compose(AGG, c, 1024, 3, -1, 4, 0.f); h1 = lru_compose(AGG, c, 1024, T / 64 - 1, -1, T / 64 - 1 - ck, h1); }
#pragma unroll 1
    for (int t8 = 0; t8 < 64; t8 += 8) {
      bf16_t x[8][2];
#pragma unroll
      for (int u = 0; u < 8; ++u) { const bf16_t* lp = LAB + (size_t)(ck * 64 + t8 + u) * 2048; x[u][0] = lp[c]; x[u][1] = lp[512 + c]; }
#pragma unroll
      for (int u = 0; u < 8; ++u) { h0 = __expf(bf2f(x[u][0])) * h0 + bf2f(x[u][1]); lds[(t8 + u) * 512 + c] = h0; }
    }
#pragma unroll 1
    for (int t8 = 56; t8 >= 0; t8 -= 8) {
      bf16_t x[8][3];
#pragma unroll
      for (int u = 0; u < 8; ++u) { const int t = ck * 64 + t8 + u; const bf16_t* lp = LAB + (size_t)t * 2048; x[u][0] = lp[1024 + c]; x[u][1] = lp[1536 + c]; x[u][2] = GG[(size_t)t * 512 + c]; }
#pragma unroll
      for (int u = 7; u >= 0; --u) { const int t = ck * 64 + t8 + u; h1 = __expf(bf2f(x[u][0])) * h1 + bf2f(x[u][1]);
        MIX[(size_t)t * DM + 512 + c] = f2bf((lds[(t8 + u) * 512 + c] + h1) * bf2f(x[u][2])); }
    }
  }
}

template <int NCW>
__device__ __forceinline__ void rwkv_scan(const Params& P, int s, float* lds) {
  const int d = (NCW == 4) ? (s >> 5) : (s >> 4), h = (NCW == 4) ? ((s >> 2) & 7) : ((s >> 1) & 7), part = (NCW == 4) ? (s & 3) : (s & 1);
  const int tid = mk_tid(), lane = tid & 63, wave = tid >> 6, rgp = lane >> 4, j = lane & 15, row = part * (NCW * 4) + (wave & (NCW - 1)) * 4 + rgp;
  const unsigned char* rec = PWS() + WS_REC + (size_t)(d * 8 + h) * T * RECB;
  float* Y = (float*)(PWS() + WS_Y) + (size_t)d * T * 512 + h * 64 + row;
  constexpr int NST = (NCW == 4) ? 7 : 4, STS = (NCW == 4) ? 256 : 512;
  const bool stager = (NCW == 4) ? (wave >= 4) : true; const int stid = (NCW == 4) ? (tid - 256) : tid;
  int goff[NST], loff[NST]; bool isw[NST], val[NST];
#pragma unroll
  for (int i = 0; i < NST; ++i) { const int q = stid + STS * i; val[i] = stager && q >= 0 && q < 1792; const int rc = q / 56, pr = q % 56; goff[i] = rc * RECB + pr * 16; isw[i] = pr < 16;
    loff[i] = rc * 384 + (isw[i] ? pr * 4 : 64 + ((pr - 16) >> 3) * 64 + ((pr - 16) & 7) * 8); }
  u32x4 stA[NST], stB[NST];
#define RS_LOAD(st, ch) do { _Pragma("unroll") for (int i = 0; i < NST; ++i) if (val[i]) st[i] = *(const u32x4*)(rec + (size_t)(ch) * 32 * RECB + goff[i]); } while (0)
#define RS_WRITE(st, buf) do { _Pragma("unroll") for (int i = 0; i < NST; ++i) if (val[i]) { float* dp = (buf) + loff[i]; \
    if (isw[i]) { *(u32x4*)dp = st[i]; } else { u32x4 lo_, hi_; lo_.x = st[i].x << 16; lo_.y = st[i].x & 0xffff0000u; lo_.z = st[i].y << 16; lo_.w = st[i].y & 0xffff0000u; \
      hi_.x = st[i].z << 16; hi_.y = st[i].z & 0xffff0000u; hi_.z = st[i].w << 16; hi_.w = st[i].w & 0xffff0000u; *(u32x4*)dp = lo_; *(u32x4*)(dp + 4) = hi_; } } } while (0)
  f32x4 S = {0.f, 0.f, 0.f, 0.f}; float ykeep = 0.f, yprev = 0.f;
  constexpr int NCH = T / 32;
#define RS_COMPUTE(ch) do { const float* buf = lds + ((ch) & 1) * 12288; \
    if (wave < NCW) { \
      const float* sp = buf + j * 4; \
      f32x4 w4 = *(const f32x4*)(sp), kd4 = *(const f32x4*)(sp + 64), a4 = *(const f32x4*)(sp + 128), b4 = *(const f32x4*)(sp + 192), r4 = *(const f32x4*)(sp + 256); \
      float v = buf[320 + row]; \
      _Pragma("unroll 8") \
      for (int stp = 0; stp < 32; ++stp) { \
        float sa = dot4(S, a4); \
          \
        __builtin_amdgcn_sched_barrier(0); \
        const float* np = sp + (stp + 1) * 384;            \
        const f32x4 nw4 = *(const f32x4*)(np), nkd4 = *(const f32x4*)(np + 64), na4 = *(const f32x4*)(np + 128), nb4 = *(const f32x4*)(np + 192), nr4 = *(const f32x4*)(np + 256); \
        const float nv = buf[(stp + 1) * 384 + 320 + row]; \
        __builtin_amdgcn_sched_barrier(0); \
          \
          \
        f32x2 q01, t23, vv; vv[0] = v; vv[1] = v; \
        { const f32x2 kd01 = kd4.lo, kd23 = kd4.hi, S01 = S.lo, w01 = w4.lo; \
        asm volatile("v_add_f32_dpp %0, %0, %0 quad_perm:[1,0,3,2] row_mask:0xf bank_mask:0xf\n\t" \
                     "v_add_f32_dpp %1, %1, %1 quad_perm:[1,0,3,2] row_mask:0xf bank_mask:0xf\n\t" \
                     "v_pk_mul_f32 %2, %4, %6 op_sel_hi:[1,0]\n\t" \
                     "v_add_f32_dpp %0, %0, %0 quad_perm:[2,3,0,1] row_mask:0xf bank_mask:0xf\n\t" \
                     "v_add_f32_dpp %1, %1, %1 quad_perm:[2,3,0,1] row_mask:0xf bank_mask:0xf\n\t" \
                     "v_pk_mul_f32 %3, %5, %6 op_sel_hi:[1,0]\n\t" \
                     "v_add_f32_dpp %0, %0, %0 row_half_mirror row_mask:0xf bank_mask:0xf\n\t" \
                     "v_add_f32_dpp %1, %1, %1 row_half_mirror row_mask:0xf bank_mask:0xf\n\t" \
                     "v_pk_fma_f32 %2, %7, %8, %2\n\t" \
                     "v_add_f32_dpp %0, %0, %0 row_mirror row_mask:0xf bank_mask:0xf\n\t" \
                     "v_add_f32_dpp %1, %1, %1 row_mirror row_mask:0xf bank_mask:0xf" \
                     : "+v"(sa), "+v"(yprev), "=&v"(q01), "=&v"(t23) \
                     : "v"(kd01), "v"(kd23), "v"(vv), "v"(S01), "v"(w01)); } \
        const f32x2 q23 = S.hi * w4.hi + t23; \
        ykeep = (((stp + 15) & 15) == j) ? yprev : ykeep;         \
        if ((stp & 15) == 0 && ((ch) > 0 || stp > 0)) { const int p = (ch) * 32 + stp - 16 + j; const int tok = d ? scan_pos_rev(p) : p; Y[(size_t)tok * 512] = ykeep; } \
        S.lo = sa * b4.lo + q01; S.hi = sa * b4.hi + q23; \
        yprev = dot4(S, r4); \
        w4 = nw4; kd4 = nkd4; a4 = na4; b4 = nb4; r4 = nr4; v = nv; \
      } \
    } } while (0)
  RS_LOAD(stA, 0); RS_WRITE(stA, lds); RS_LOAD(stA, 1); __syncthreads();
  static_assert(NCH % 2 == 0, "the chunk loop is unrolled by two");
  for (int ch = 0; ch < NCH; ch += 2) {
    if (ch + 2 < NCH) RS_LOAD(stB, ch + 2);
    RS_COMPUTE(ch);
    RS_WRITE(stA, lds + 12288);
    __syncthreads();
    if (ch + 3 < NCH) RS_LOAD(stA, ch + 3);
    RS_COMPUTE(ch + 1);
    if (ch + 2 < NCH) RS_WRITE(stB, lds);
    __syncthreads();
  }
  if (wave < NCW) {
    yprev = row16_sum(yprev);
    ykeep = (j == 15) ? yprev : ykeep;
    const int p = T - 16 + j; const int tok = d ? scan_pos_rev(p) : p; Y[(size_t)tok * 512] = ykeep;
  }
#undef RS_COMPUTE
#undef RS_LOAD
#undef RS_WRITE
}

__device__ __forceinline__ void phase_rwkv_out(const Params& P, int layer, int wg, int nwg) {
  const int c = mk_tid();
  const float* Y0 = (const float*)(PWS() + WS_Y); const float* Y1 = Y0 + (size_t)T * 512;
  const bf16_t* RG = (const bf16_t*)(PWS() + WS_RG); const bf16_t* CV = (const bf16_t*)(PWS() + WS_CV); bf16_t* MIX = (bf16_t*)(PWS() + WS_H);
  const float lg = PIN(I_RWLNG)[layer * 512 + c], lb = PIN(I_RWLNB)[layer * 512 + c];
  const int G = nwg;
  for (int t0 = (layer == 1 ? NCTX : 0) + wg; t0 < T; t0 += 4 * G) {
    float y[4], cv[4], rg[4];
#pragma unroll
    for (int u = 0; u < 4; ++u) { const int t = t0 + u * G; if (t < T) { y[u] = Y0[(size_t)t * 512 + c] + Y1[(size_t)t * 512 + c]; cv[u] = bf2f(CV[(size_t)t * 512 + c]); rg[u] = bf2f(RG[(size_t)t * 512 + c]); } else { y[u] = 0.f; cv[u] = 0.f; rg[u] = 0.f; } }
#pragma unroll
    for (int u = 0; u < 4; ++u) { const int t = t0 + u * G;
      const float mu = wave_sum(y[u]) * (1.0f / 64.0f); const float dlt = y[u] - mu; const float var = wave_sum(dlt * dlt) * (1.0f / 64.0f);
      const float yn = dlt * rsqrtf(var + 64e-5f) * lg + lb;
      if (t < T) MIX[(size_t)t * DM + c] = f2bf((yn + cv[u]) * rg[u]); }
  }
}

__device__ __forceinline__ void phase_ffn_act(const Params& P, int layer) {
  const bf16_t* GU = (const bf16_t*)(PWS() + WS_GU); bf16_t* ACT = (bf16_t*)(PWS() + WS_ACT);
  const float* fw = PIN(I_FCONV) + (size_t)layer * 3 * DFF; const float* fb = PIN(I_FCONVB) + (size_t)layer * DFF;
  const int run_lo = (layer == 1) ? NCTX / 32 : 0, nruns = T / 32 - run_lo;
  for (int idx = mk_bid() * NTH + mk_tid(); idx < nruns * 704; idx += mk_nblk() * NTH) {
    const int cgp = idx % 704, run = run_lo + idx / 704, c0 = cgp * 8, t0 = run * 32;
    const int lo = t0 < NCTX ? 0 : NCTX, hi = t0 < NCTX ? NCTX : T;
    float w0[8], w1[8], w2[8], bb[8];
#pragma unroll
    for (int i = 0; i < 8; ++i) { w0[i] = fw[c0 + i]; w1[i] = fw[DFF + c0 + i]; w2[i] = fw[2 * DFF + c0 + i]; bb[i] = fb[c0 + i]; }
    const bf16x8 zero = {0, 0, 0, 0, 0, 0, 0, 0};
    bf16x8 prev = (t0 - 1 >= lo) ? *(const bf16x8*)(GU + (size_t)(t0 - 1) * NGU + c0) : zero;
    bf16x8 cur = *(const bf16x8*)(GU + (size_t)t0 * NGU + c0);
    for (int tt = 0; tt < 32; ++tt) {
      const int t = t0 + tt;
      const bf16x8 nxt = (t + 1 < hi) ? *(const bf16x8*)(GU + (size_t)(t + 1) * NGU + c0) : zero;
      const bf16x8 up = *(const bf16x8*)(GU + (size_t)t * NGU + DFF + c0);
      float o[8];
#pragma unroll
      for (int i = 0; i < 8; ++i) { const float g = bb[i] + w0[i] * bf2f((bf16_t)prev[i]) + w1[i] * bf2f((bf16_t)cur[i]) + w2[i] * bf2f((bf16_t)nxt[i]); o[i] = siluf_(g) * bf2f((bf16_t)up[i]); }
      u32x4 w; w.x = cvtpk(o[0], o[1]); w.y = cvtpk(o[2], o[3]); w.z = cvtpk(o[4], o[5]); w.w = cvtpk(o[6], o[7]);
      *(u32x4*)(ACT + (size_t)t * DFF + c0) = w;
      prev = cur; cur = nxt;
    }
  }
}

namespace at2 {
constexpr int DQK = 192, DV = 128, QBLK = 32, KVBLK = 64;
constexpr float SCALE = 0.07216878364870322f;
constexpr float THR = 8.f;
#ifndef ATT_NQREG
#define ATT_NQREG 12
#endif
constexpr int NQREG = ATT_NQREG;
constexpr int SHM_V = KVBLK * DV * 2, SHM_K = KVBLK * DQK * 2, SHM_ATTN = 3 * SHM_V + 3 * SHM_K + 8 * 64 * 4,     SHM_TOTAL = SHM_ATTN + (12 - NQREG) * 8192;
#define KSWZ(row, colB) ((row) * 384 + ((colB) ^ (((row) & 7) << 4)))
#define SBAR() __builtin_amdgcn_sched_barrier(0)
__device__ __forceinline__ int crow(int r, int hi) { return (r & 3) + 8 * (r >> 2) + 4 * hi; }

__device__ __forceinline__ void partialSM(f32x16& p0, f32x16& p1, float& m_reg, float& mn, float& alpha) {
  constexpr float C = SCALE * 1.4426950408889634f;
  float pmax = p0[0];
#pragma unroll
  for (int r = 1; r < 16; ++r) pmax = fmaxf(pmax, p0[r]);
#pragma unroll
  for (int r = 0; r < 16; ++r) pmax = fmaxf(pmax, p1[r]);
  { auto rr = __builtin_amdgcn_permlane32_swap(__float_as_uint(pmax), __float_as_uint(pmax), false, false);
    pmax = fmaxf(__uint_as_float(rr[0]), __uint_as_float(rr[1])); }
  if (__builtin_expect(__all(pmax - m_reg <= THR / SCALE), 1)) { mn = m_reg; alpha = 1.f; }
  else { mn = fmaxf(m_reg, pmax); alpha = __builtin_amdgcn_exp2f((m_reg - mn) * C); m_reg = mn; }
  const float mnC = -mn * C;
#pragma unroll
  for (int r = 0; r < 16; ++r) p0[r] = fmaf(p0[r], C, mnC);
#pragma unroll
  for (int r = 0; r < 16; ++r) p1[r] = fmaf(p1[r], C, mnC);
#pragma unroll
  for (int r = 0; r < 16; ++r) p0[r] = __builtin_amdgcn_exp2f(p0[r]);
}
__device__ __forceinline__ void finishSM(f32x16& p0, f32x16& p1, float alpha, float& l_reg, bf16x8& pa0, bf16x8& pa1, bf16x8& pa2, bf16x8& pa3) {
#pragma unroll
  for (int r = 0; r < 16; ++r) p1[r] = __builtin_amdgcn_exp2f(p1[r]);
  float ps = 0;
#pragma unroll
  for (int r = 0; r < 16; ++r) ps += p0[r];
#pragma unroll
  for (int r = 0; r < 16; ++r) ps += p1[r];
  { auto rr = __builtin_amdgcn_permlane32_swap(__float_as_uint(ps), __float_as_uint(ps), false, false);
    ps = __uint_as_float(rr[0]) + __uint_as_float(rr[1]); }
  l_reg = l_reg * alpha + ps;
#define PK4(P, BASE, OUT) do { unsigned a0 = cvtpk(P[BASE + 0], P[BASE + 1]), a1 = cvtpk(P[BASE + 2], P[BASE + 3]);   \
    unsigned b0 = cvtpk(P[BASE + 4], P[BASE + 5]), b1 = cvtpk(P[BASE + 6], P[BASE + 7]);                              \
    auto r0 = __builtin_amdgcn_permlane32_swap(a0, b0, false, false); auto r1 = __builtin_amdgcn_permlane32_swap(a1, b1, false, false); \
    u32x4 w = {r0[0], r1[0], r0[1], r1[1]}; OUT = *reinterpret_cast<bf16x8*>(&w); } while (0)
  PK4(p0, 0, pa0); PK4(p0, 8, pa1); PK4(p1, 0, pa2); PK4(p1, 8, pa3);
#undef PK4
}
__device__ __forceinline__ void qkt(f32x16& p0, f32x16& p1, const char* Ks, const bf16x8* qr, const char* qsp, int r32, int hi) {
  p0 = f32x16{}; p1 = f32x16{};
#pragma unroll
  for (int d0 = 0; d0 < 12; ++d0) { const int cb = (d0 * 16 + hi * 8) * 2;
    const bf16x8 b0 = *reinterpret_cast<const bf16x8*>(Ks + KSWZ(r32, cb));
    const bf16x8 b1 = *reinterpret_cast<const bf16x8*>(Ks + KSWZ(32 + r32, cb));
    const bf16x8 qv = (d0 < NQREG) ? qr[d0 < NQREG ? d0 : 0] : *reinterpret_cast<const bf16x8*>(qsp + (d0 - NQREG) * 8192);
    p0 = __builtin_amdgcn_mfma_f32_32x32x16_bf16(b0, qv, p0, 0, 0, 0);
    p1 = __builtin_amdgcn_mfma_f32_32x32x16_bf16(b1, qv, p1, 0, 0, 0); }
}
__device__ __forceinline__ int v_st(int k, int c) { const int kk = (k & ~0xC) | ((k & 4) << 1) | ((k & 8) >> 1); return ((kk >> 3) * 4 + (c >> 5)) * 512 + ((kk & 7) * 32 + (c & 31)) * 2; }
__device__ __forceinline__ int v_rd_base(int lane) { return ((lane & 3) << 3) | (((lane >> 2) & 3) << 6) | (((lane >> 4) & 1) << 5) | (((lane >> 5) & 1) << 8); }
constexpr int v_rd_off(int d0, int ks, int half) { return d0 * 512 + ks * 4096 + half * 2048; }
template <int OFF> __device__ __forceinline__ s16x4 tr_read(int vb) {
  s16x4 r; asm volatile("ds_read_b64_tr_b16 %0, %1 offset:%2" : "=&v"(r) : "v"(vb), "i"(OFF) : "memory"); return r;
}
template <int D0> __device__ __forceinline__ void pv_one(f32x16& od, int vb, bf16x8 pa0, bf16x8 pa1, bf16x8 pa2, bf16x8 pa3) {
  const s16x4 l0 = tr_read<v_rd_off(D0, 0, 0)>(vb), h0 = tr_read<v_rd_off(D0, 0, 1)>(vb), l1 = tr_read<v_rd_off(D0, 1, 0)>(vb), h1 = tr_read<v_rd_off(D0, 1, 1)>(vb);
  const s16x4 l2 = tr_read<v_rd_off(D0, 2, 0)>(vb), h2 = tr_read<v_rd_off(D0, 2, 1)>(vb), l3 = tr_read<v_rd_off(D0, 3, 0)>(vb), h3 = tr_read<v_rd_off(D0, 3, 1)>(vb);
  asm volatile("s_waitcnt lgkmcnt(0)" ::: "memory"); SBAR();
#define PK(L, H) (bf16x8){L[0], L[1], L[2], L[3], H[0], H[1], H[2], H[3]}
  od = __builtin_amdgcn_mfma_f32_32x32x16_bf16(pa0, PK(l0, h0), od, 0, 0, 0);
  od = __builtin_amdgcn_mfma_f32_32x32x16_bf16(pa1, PK(l1, h1), od, 0, 0, 0);
  od = __builtin_amdgcn_mfma_f32_32x32x16_bf16(pa2, PK(l2, h2), od, 0, 0, 0);
  od = __builtin_amdgcn_mfma_f32_32x32x16_bf16(pa3, PK(l3, h3), od, 0, 0, 0);
#undef PK
}
__device__ __forceinline__ void pv_d0(f32x16* o, int vb, bf16x8 pa0, bf16x8 pa1, bf16x8 pa2, bf16x8 pa3) {
  pv_one<0>(o[0], vb, pa0, pa1, pa2, pa3); pv_one<1>(o[1], vb, pa0, pa1, pa2, pa3); pv_one<2>(o[2], vb, pa0, pa1, pa2, pa3); pv_one<3>(o[3], vb, pa0, pa1, pa2, pa3);
}
__device__ __forceinline__ void rope_pair(bf16x8& A, bf16x8& B, float pos, int hi) {
  float oa[8], ob[8];
#pragma unroll
  for (int e = 0; e < 8; ++e) {
    const float inv = exp2f(-(float)(hi * 8 + e) * (13.287712379549449f / 16.0f));
    const float sn = __sinf(pos * inv), cs = __cosf(pos * inv);
    const float a = bf2f((bf16_t)A[e]), b = bf2f((bf16_t)B[e]);
    oa[e] = a * cs - b * sn; ob[e] = a * sn + b * cs;
  }
  u32x4 wa = {cvtpk(oa[0], oa[1]), cvtpk(oa[2], oa[3]), cvtpk(oa[4], oa[5]), cvtpk(oa[6], oa[7])};
  u32x4 wb = {cvtpk(ob[0], ob[1]), cvtpk(ob[2], ob[3]), cvtpk(ob[4], ob[5]), cvtpk(ob[6], ob[7])};
  A = *reinterpret_cast<bf16x8*>(&wa); B = *reinterpret_cast<bf16x8*>(&wb);
}

__device__ __forceinline__ void attn_unit(const bf16_t* __restrict__ Q, const bf16_t* __restrict__ KV, const bf16_t* __restrict__ KR, bf16_t* __restrict__ MIX,
                                          int q0, int h, int kv0, int seq, bool rope_q, char* lds, bf16_t* __restrict__ part_o, float* __restrict__ part_ml) {
  const int tid = mk_tid(), wid = tid >> 6, lane = tid & 63, r32 = lane & 31, hi = lane >> 5;
  char* V_lds = lds; char* K_lds = lds + 3 * SHM_V;
  float* ws = (float*)(lds + 3 * SHM_V + 3 * SHM_K) + wid * 64; float* li_l = ws; float* al_l = ws + 32;
  float m_reg = -1e30f, l_reg = 0; f32x16 o[4] = {}; bf16x8 qr[12];
  const int qrow = q0 + wid * QBLK + r32;
  const bf16_t* Qw = Q + (size_t)qrow * 1536 + h * DQK + hi * 8;
#pragma unroll
  for (int d0 = 0; d0 < 12; ++d0) qr[d0] = *reinterpret_cast<const bf16x8*>(Qw + d0 * 16);
  if (rope_q) { const int tl = qrow - NCTX; rope_pair(qr[8], qr[9], (float)(tl >> 6), hi); rope_pair(qr[10], qr[11], (float)(tl & 63), hi); }
  char* qsp = lds + SHM_ATTN + tid * 16;
#pragma unroll
  for (int d0 = NQREG; d0 < 12; ++d0) *reinterpret_cast<bf16x8*>(qsp + (d0 - NQREG) * 8192) = qr[d0];
  const bf16_t* Kh = KV + (size_t)kv0 * 2048 + h * 256; const bf16_t* Vh = Kh + 128; KR += (size_t)kv0 * 64;
  const int sr = tid >> 4, sc = (tid & 15) * 8, vst0 = v_st(sr, sc), vst1 = v_st(32 + sr, sc);
  const int rr = tid >> 3, rc = (tid & 7) * 8;
  const int vb0 = (int)(uintptr_t)V_lds + v_rd_base(lane);
  bf16x8 vs0, vs1, ks0, ks1, ks2;
#define SLOAD(k0) do { vs0 = *(const bf16x8*)(Vh + (size_t)((k0) + sr) * 2048 + sc); vs1 = *(const bf16x8*)(Vh + (size_t)((k0) + 32 + sr) * 2048 + sc); \
    ks0 = *(const bf16x8*)(Kh + (size_t)((k0) + sr) * 2048 + sc); ks1 = *(const bf16x8*)(Kh + (size_t)((k0) + 32 + sr) * 2048 + sc); \
    ks2 = *(const bf16x8*)(KR + (size_t)((k0) + rr) * 64 + rc); } while (0)
#define SWRITE(b) do { *(bf16x8*)(V_lds + (b) * SHM_V + vst0) = vs0; *(bf16x8*)(V_lds + (b) * SHM_V + vst1) = vs1; const int kc = sc * 2; \
    *(bf16x8*)(K_lds + (b) * SHM_K + KSWZ(sr, kc)) = ks0; *(bf16x8*)(K_lds + (b) * SHM_K + KSWZ(32 + sr, kc)) = ks1; \
    *(bf16x8*)(K_lds + (b) * SHM_K + KSWZ(rr, 256 + rc * 2)) = ks2; } while (0)
#define SWAIT() asm volatile("s_waitcnt vmcnt(0)" ::: "memory")
#define RESC(a) do { if (__any((a) < 1.f)) { if (hi == 0) al_l[r32] = (a); asm volatile("s_waitcnt lgkmcnt(0)" ::: "memory"); \
    _Pragma("unroll") for (int d = 0; d < 4; ++d) _Pragma("unroll") for (int r = 0; r < 16; ++r) o[d][r] *= al_l[crow(r, hi)]; } } while (0)
  f32x16 pA0, pA1, pB0, pB1; float mnA, mnB, alA, alB; bf16x8 pa0, pa1, pa2, pa3; const int NT = seq / KVBLK;
  SLOAD(0); SWAIT(); SWRITE(0); __syncthreads();
  qkt(pA0, pA1, K_lds, qr, qsp, r32, hi); partialSM(pA0, pA1, m_reg, mnA, alA);
  SLOAD(KVBLK);
  SWAIT(); SWRITE(1); __syncthreads();
  int bp = 0, bc = 1, bn = 2;
  for (int j = 1; j + 1 < NT; j += 2) {
    SBAR(); qkt(pB0, pB1, K_lds + bc * SHM_K, qr, qsp, r32, hi);
    finishSM(pA0, pA1, alA, l_reg, pa0, pa1, pa2, pa3); SBAR();
    SLOAD((j + 1) * KVBLK); SBAR();
    pv_d0(o, vb0 + bp * SHM_V, pa0, pa1, pa2, pa3); partialSM(pB0, pB1, m_reg, mnB, alB);
    SWAIT(); SWRITE(bn);
    RESC(alB); __syncthreads();
    bp = bc; bc = bn; bn = (bn == 2) ? 0 : bn + 1;
    SBAR(); qkt(pA0, pA1, K_lds + bc * SHM_K, qr, qsp, r32, hi);
    finishSM(pB0, pB1, alB, l_reg, pa0, pa1, pa2, pa3); SBAR();
    SLOAD((j + 2) * KVBLK); SBAR();
    pv_d0(o, vb0 + bp * SHM_V, pa0, pa1, pa2, pa3); partialSM(pA0, pA1, m_reg, mnA, alA);
    SWAIT(); SWRITE(bn);
    RESC(alA); __syncthreads();
    bp = bc; bc = bn; bn = (bn == 2) ? 0 : bn + 1;
  }
  SBAR(); qkt(pB0, pB1, K_lds + bc * SHM_K, qr, qsp, r32, hi);
  finishSM(pA0, pA1, alA, l_reg, pa0, pa1, pa2, pa3); SBAR();
  pv_d0(o, vb0 + bp * SHM_V, pa0, pa1, pa2, pa3); partialSM(pB0, pB1, m_reg, mnB, alB);
  __syncthreads(); RESC(alB);
  finishSM(pB0, pB1, alB, l_reg, pa0, pa1, pa2, pa3); SBAR();
  pv_d0(o, vb0 + bc * SHM_V, pa0, pa1, pa2, pa3);
  if (hi == 0) li_l[r32] = l_reg; asm volatile("s_waitcnt lgkmcnt(0)" ::: "memory");
  float rli[16];
#pragma unroll
  for (int r = 0; r < 16; ++r) rli[r] = __builtin_amdgcn_rcpf(li_l[crow(r, hi)]);
  if (part_o == nullptr) {
    bf16_t* Ow = MIX + (size_t)(q0 + wid * QBLK) * DM + 1024 + h * DV;
#pragma unroll
    for (int r = 0; r < 16; ++r) { const int orow = crow(r, hi);
#pragma unroll
      for (int d0 = 0; d0 < 4; ++d0) Ow[(size_t)orow * DM + d0 * 32 + r32] = f2bf(o[d0][r] * rli[r]); }
  } else {
    bf16_t* Ow = part_o + (size_t)(wid * QBLK) * DV;
#pragma unroll
    for (int r = 0; r < 16; ++r) { const int orow = crow(r, hi);
#pragma unroll
      for (int d0 = 0; d0 < 4; ++d0) Ow[(size_t)orow * DV + d0 * 32 + r32] = f2bf(o[d0][r] * rli[r]); }
    if (hi == 0) { part_ml[(wid * QBLK + r32) * 2] = m_reg; part_ml[(wid * QBLK + r32) * 2 + 1] = l_reg; }
  }
  __syncthreads();
#undef SLOAD
#undef SWRITE
#undef SWAIT
#undef RESC
}
}

__device__ __forceinline__ int attn_np(int nwg) { return nwg == 192 ? 3 : (nwg == 224 ? 7 : 0); }
__device__ __forceinline__ int attn_part_tiles(int np, int p) { return 2 * (130 / np) + (p < (130 % np) ? 2 : 0); }
__device__ __forceinline__ void phase_attention(const Params& P, int layer, char* lds, int wg, int nwg) {
  const bf16_t* Q = (const bf16_t*)(PWS() + WS_Q); const bf16_t* KV = (const bf16_t*)(PWS() + WS_KV); const bf16_t* KR = (const bf16_t*)(PWS() + WS_KR);
  bf16_t* MIX = (bf16_t*)(PWS() + WS_H); bf16_t* PO = (bf16_t*)(PWS() + WS_PARTO); float* PML = (float*)(PWS() + WS_PARTML);
  const int np = attn_np(nwg);
  const int nwhole = np ? (512 / nwg) * nwg : 512, nparts = (512 - nwhole) * np, nctx = (layer == 0) ? 8 : 0;
  for (int it = wg; it < nwhole + nparts + nctx; it += nwg) {
    int q0, h, kv0 = 0, seq = T; bool lat = true; bf16_t* po = nullptr; float* pml = nullptr;
    if (it < nwhole) { q0 = NCTX + (it & 63) * 256; h = it >> 6; }
    else if (it < nwhole + nparts) { const int q = it - nwhole, u = nwhole + q / np, p = q % np; q0 = NCTX + (u & 63) * 256; h = u >> 6;
      int t0 = 0; for (int pp = 0; pp < p; ++pp) t0 += attn_part_tiles(np, pp);
      kv0 = t0 * 64; seq = attn_part_tiles(np, p) * 64; po = PO + (size_t)q * 256 * 128; pml = PML + (size_t)q * 512; }
    else { q0 = 0; h = it - nwhole - nparts; seq = NCTX; lat = false; }
    at2::attn_unit(Q, KV, KR, MIX, q0, h, kv0, seq, lat, lds, po, pml);
  }
}
__device__ __forceinline__ void phase_attn_merge(const Params& P, int wg, int nwg) {
  const int np = attn_np(nwg); if (np == 0) return;
  const int nwhole = (512 / nwg) * nwg;
  const bf16_t* PO = (const bf16_t*)(PWS() + WS_PARTO); const float* PML = (const float*)(PWS() + WS_PARTML); bf16_t* MIX = (bf16_t*)(PWS() + WS_H);
  constexpr float C = at2::SCALE * 1.4426950408889634f;
  const int tid = mk_tid(), row = tid >> 1, c0 = (tid & 1) * 64;
  for (int us = wg; us < 512 - nwhole; us += nwg) {
    const int u = nwhole + us, q0 = NCTX + (u & 63) * 256, h = u >> 6;
    float M = -3.0e38f;
    for (int p = 0; p < np; ++p) M = fmaxf(M, PML[(size_t)(us * np + p) * 512 + row * 2]);
    float acc[64];
#pragma unroll
    for (int i = 0; i < 64; ++i) acc[i] = 0.f;
    float ws = 0.f;
#pragma unroll 1
    for (int p = 0; p < np; ++p) {
      const float* ml = PML + (size_t)(us * np + p) * 512 + row * 2;
      const float w = ml[1] * exp2f((ml[0] - M) * C); ws += w;
      const bf16_t* src = PO + ((size_t)(us * np + p) * 256 + row) * 128 + c0;
#pragma unroll
      for (int cc = 0; cc < 64; cc += 8) { const bf16x8 x = *(const bf16x8*)(src + cc);
#pragma unroll
        for (int i = 0; i < 8; ++i) acc[cc + i] += w * bf2f((bf16_t)x[i]); }
    }
    const float inv = 1.0f / ws;
#pragma unroll
    for (int cc = 0; cc < 64; cc += 8) {
      u32x4 o; o.x = cvtpk(acc[cc] * inv, acc[cc + 1] * inv); o.y = cvtpk(acc[cc + 2] * inv, acc[cc + 3] * inv); o.z = cvtpk(acc[cc + 4] * inv, acc[cc + 5] * inv); o.w = cvtpk(acc[cc + 6] * inv, acc[cc + 7] * inv);
      *(u32x4*)(MIX + (size_t)(q0 + row) * DM + 1024 + h * 128 + c0 + cc) = o;
    }
  }
}

#ifndef REP_ATT
#define REP_ATT 1
#endif
#ifndef REP_SCAN
#define REP_SCAN 1
#endif
#ifndef REP_PREP
#define REP_PREP 1
#endif
#ifndef REP_GU
#define REP_GU 1
#endif
#ifndef REP_MISC
#define REP_MISC 1
#endif
#ifndef N_SCAN_WG
#define N_SCAN_WG 64
#endif
__device__ __forceinline__ void grid_barrier(unsigned* ctr, unsigned target) {
  asm volatile("s_waitcnt vmcnt(0) lgkmcnt(0)" ::: "memory");
  __syncthreads();
  if (mk_tid() == 0) {
    __builtin_amdgcn_fence(__ATOMIC_RELEASE, "agent");
    __hip_atomic_fetch_add(ctr, 1u, __ATOMIC_RELAXED, __HIP_MEMORY_SCOPE_AGENT);
    while (__hip_atomic_load(ctr, __ATOMIC_RELAXED, __HIP_MEMORY_SCOPE_AGENT) < target) __builtin_amdgcn_s_sleep(2);
    __builtin_amdgcn_fence(__ATOMIC_ACQUIRE, "agent");
  }
  __syncthreads();
}
__device__ __forceinline__ void grid_arrive(unsigned* ctr) {
  asm volatile("s_waitcnt vmcnt(0) lgkmcnt(0)" ::: "memory");
  __syncthreads();
  if (mk_tid() == 0) { __builtin_amdgcn_fence(__ATOMIC_RELEASE, "agent"); __hip_atomic_fetch_add(ctr, 1u, __ATOMIC_RELAXED, __HIP_MEMORY_SCOPE_AGENT); }
}
enum { K_MOD = 0, K_NORM1, K_GEMM_IN, K_PREP, K_MIX, K_RWOUT, K_GEMM_OUT, K_NORM2, K_GEMM_GU, K_ACT, K_GEMM_DN, K_FINAL };
constexpr int STEPS_PER_LAYER = 10, N_STEPS = 1 + 2 * STEPS_PER_LAYER + 1;
__global__ void __launch_bounds__(NTH) fwd_megakernel(Params P_arg) {
  extern __shared__ __attribute__((aligned(16))) unsigned char lds[];
  cg::grid_group grid = cg::this_grid();
  const int lo = P_arg.ph_lo, hi = P_arg.ph_hi;
  unsigned nbar = 0, nsub = 0, nscn = 0;
#pragma unroll 1
  for (int st = lo; st < hi; ++st) {
    const Params& P = P_arg;
    int kind, layer = 0;
    if (st == 0) kind = K_MOD; else if (st == N_STEPS - 1) kind = K_FINAL; else { layer = (st - 1) / STEPS_PER_LAYER; kind = K_NORM1 + (st - 1) % STEPS_PER_LAYER; }
    const bool last = (layer == 1);
    float* ldsf = (float*)lds;
    bool sync_after = true;
    switch (kind) {
      case K_MOD: for (int rep = 0; rep < REP_MISC; ++rep) phase_mod(P, ldsf); break;
      case K_NORM1: for (int rep = 0; rep < REP_MISC; ++rep) phase_convert(P, layer, ldsf); break;
      case K_PREP: for (int rep = 0; rep < REP_PREP; ++rep) phase_prep<0>(P, layer, ldsf, mk_bid(), mk_nblk()); break;
      case K_MIX: {
        const int G = mk_nblk();
        const int vcu = (G % 8 == 0) ? (mk_bid() % 8) * (G / 8) + mk_bid() / 8 : mk_bid();
        const int nscan = (G >= 2 * N_SCAN_WG) ? N_SCAN_WG : 0;
        unsigned* sbar = (unsigned*)(PWS() + WS_BAR) + 32;
        const int sg = vcu - nscan, SG = G - nscan;
        const unsigned per_layer = (unsigned)(G + 2 * SG), base = per_layer * (unsigned)layer;
        phase_prep<1>(P, layer, ldsf, vcu, G);
        if (vcu < nscan) {
          grid_arrive(sbar);
          for (int sc = vcu; sc < ((N_SCAN_WG == 32) ? 32 : 64); sc += nscan) rwkv_scan<(N_SCAN_WG == 32) ? 8 : 4>(P, sc, ldsf);
        } else {
          grid_barrier(sbar, base + (unsigned)G);
          if (nscan == 0) { for (int sc = vcu; sc < ((N_SCAN_WG == 32) ? 32 : 64); sc += G) rwkv_scan<(N_SCAN_WG == 32) ? 8 : 4>(P, sc, ldsf); __syncthreads(); }
#pragma unroll 1
          for (int q = 0; q < 2; ++q) {
            const size_t ro = (q == 0 && last) ? NCTX : 0;
            const bf16_t* A = (const bf16_t*)(PWS() + (q ? WS_KVN : WS_QN)) + ro * 512; const bf16_t* Bt = (const bf16_t*)(PWS() + (q ? WS_WKV : WS_WQ));
            EpiStore E{(bf16_t*)(PWS() + (q ? WS_KV : WS_Q)) + ro * 1536, q ? 2048 : 1536};
            run_gemm(lds, A, Bt, T - (int)ro, q ? 2048 : 1536, q ? 256 : 512, E, sg, SG);
          }
          phase_lru_agg(P, sg, SG);
          grid_barrier(sbar, base + (unsigned)(G + SG));
          phase_attention(P, layer, (char*)lds, sg, SG);
          __syncthreads();
          phase_lru_out(P, layer, ldsf, sg, SG);
          grid_barrier(sbar, base + per_layer);
          phase_attn_merge(P, sg, SG);
        }
      } break;
      case K_RWOUT: phase_rwkv_out(P, layer, mk_bid(), mk_nblk()); break;
      case K_ACT: for (int rep = 0; rep < REP_MISC; ++rep) phase_ffn_act(P, layer); break;
      case K_FINAL: phase_final_norm(P); break;
      default: break;
    }
    if (kind == K_NORM1 || kind == K_NORM2) for (int rep = 0; rep < REP_MISC; ++rep) phase_norm(P, layer, kind == K_NORM2 ? 1 : 0, kind == K_NORM2 && last);
    if (kind == K_GEMM_IN || kind == K_GEMM_GU) {
      const bf16_t* A; const bf16_t* Bt; bf16_t* O; int M = T, N, K;
      if (kind == K_GEMM_IN) { A = (const bf16_t*)(PWS() + WS_H); Bt = (const bf16_t*)(PWS() + WS_WIN); O = (bf16_t*)(PWS() + WS_COLS); N = NIN; K = DM; }
      else { const size_t ro = last ? NCTX : 0; A = (const bf16_t*)(PWS() + WS_H) + ro * DM; Bt = (const bf16_t*)(PWS() + WS_WGU); O = (bf16_t*)(PWS() + WS_GU) + ro * NGU; M = last ? T - NCTX : T; N = NGU; K = DM; }
      EpiStore E{O, N};
      run_gemm(lds, A, Bt, M, N, K, E, mk_bid(), mk_nblk());
    }
    if (kind == K_GEMM_OUT || kind == K_GEMM_DN) {
      const float* mod_l = (const float*)(PWS() + WS_MOD) + (size_t)(layer * 2 + 0) * 12288; const float* mod_c = mod_l + 12288;
      const int goff = (kind == K_GEMM_OUT) ? 4096 : 10240;
      EpiResid E{(const float*)(PWS() + WS_XC), POUT(), (float*)(PWS() + WS_XC), POUT(), mod_c + goff, mod_l + goff, NCTX};
      if (kind == K_GEMM_OUT && layer == 0) { E.src_c = PIN(I_CTX); E.src_l = PIN(I_X); }
      const int Kf = (kind == K_GEMM_OUT) ? DM : DFF;
      const bf16_t* A0 = (kind == K_GEMM_OUT) ? (const bf16_t*)(PWS() + WS_H) : (const bf16_t*)(PWS() + WS_ACT);
      const bf16_t* Bt = (kind == K_GEMM_OUT) ? (const bf16_t*)(PWS() + WS_WOUT) : (const bf16_t*)(PWS() + WS_WDN);
      run_gemm(lds, A0 + (size_t)NCTX * Kf, Bt, T - NCTX, DM, Kf, E, mk_bid(), mk_nblk());
      if (!last) {
        EpiResidAtomic EA{(float*)(PWS() + WS_XC), mod_c + goff};
        run_gemm(lds, A0, Bt, (Kf / 512) * 256, DM, 512, EA, mk_bid(), mk_nblk(), Kf, 512);
      }
    }
    if (sync_after && st + 1 < hi) {
      if (st == lo) grid.sync();
      else { ++nbar; grid_barrier((unsigned*)(PWS() + WS_BAR), nbar * mk_nblk()); }
    }
  }
}

#ifndef MK_PER_PHASE
#define MK_PER_PHASE 0
#endif
extern "C" void kernel_launch(void* const* d_in, const int* in_sizes, int n_in, void* d_out, int out_size, void* d_ws, size_t ws_size, hipStream_t stream) {
  static int grid = 0;
  if (grid == 0) {
    if (n_in != 42 || out_size != (T - NCTX) * DM || ws_size < WS_END) { fprintf(stderr, "kernel_launch: unexpected shapes (n_in %d out %d ws %zu need %zu)\n", n_in, out_size, ws_size, (size_t)WS_END); grid = -1; return; }
    int dev = 0, cus = 0, per_cu = 0;
    (void)hipGetDevice(&dev); (void)hipDeviceGetAttribute(&cus, hipDeviceAttributeMultiprocessorCount, dev);
    if (hipFuncSetAttribute((const void*)fwd_megakernel, hipFuncAttributeMaxDynamicSharedMemorySize, LDS_BYTES) != hipSuccess) { fprintf(stderr, "kernel_launch: hipFuncSetAttribute failed\n"); grid = -1; return; }
    if (hipOccupancyMaxActiveBlocksPerMultiprocessor(&per_cu, (const void*)fwd_megakernel, NTH, LDS_BYTES) != hipSuccess || per_cu < 1) per_cu = 1;
    (void)hipGetLastError();
    grid = (cus > 0 ? cus : 256) * per_cu;
  }
  if (grid < 0) return;
  if (hipMemsetAsync((char*)d_ws + WS_BAR, 0, 256, stream) != hipSuccess) { fprintf(stderr, "kernel_launch: memset failed\n"); return; }
  Params p{};
  for (int i = 0; i < 42; ++i) p.in[i] = (const float*)d_in[i];
  p.out = (float*)d_out; p.ws = (unsigned char*)d_ws;
#if MK_PER_PHASE
  for (int st = 0; st < N_STEPS; ++st) { p.ph_lo = st; p.ph_hi = st + 1; hipLaunchKernelGGL(fwd_megakernel, dim3(grid), dim3(NTH), LDS_BYTES, stream, p); }
#else
  p.ph_lo = 0; p.ph_hi = N_STEPS;
  void* args[] = {&p};
  hipError_t e = hipLaunchCooperativeKernel((const void*)fwd_megakernel, dim3(grid), dim3(NTH), args, LDS_BYTES, stream);
  if (e != hipSuccess) fprintf(stderr, "cooperative launch failed: %s (grid %d)\n", hipGetErrorString(e), grid);
#endif
}
```

```cpp
#include <hip/hip_runtime.h>
#include <hip/hip_cooperative_groups.h>
#include <cstdio>
#include <cstdint>
__device__ __forceinline__ int mk_tid() { int t = (int)threadIdx.x; asm volatile("" : "+v"(t)); return t; }
__device__ __forceinline__ int mk_bid() { int b = (int)blockIdx.x; asm volatile("" : "+s"(b)); return b; }
__device__ __forceinline__ int mk_nblk() { int g = (int)gridDim.x; asm volatile("" : "+s"(g)); return g; }
template <int OFF> __device__ __forceinline__ unsigned long long kp_load() {
  unsigned long long r; auto kp = __builtin_amdgcn_kernarg_segment_ptr();
  asm volatile("s_load_dwordx2 %0, %1, %2\n\ts_waitcnt lgkmcnt(0)" : "=s"(r) : "s"(kp), "i"(OFF));
  return r;
}
#define PIN(i) ((const float*)kp_load<8 * (i)>())
#define POUT() ((float*)kp_load<8 * 42>())
#define PWS() ((unsigned char*)kp_load<8 * 43>())
namespace pg8 {
#define PG8_LAS __attribute__((address_space(3)))
typedef unsigned short bf16_t;
typedef short bf16x8 __attribute__((ext_vector_type(8)));
typedef float f32x4 __attribute__((ext_vector_type(4)));
typedef unsigned u32x4 __attribute__((ext_vector_type(4)));
constexpr int BM = 256, BK = 64, HALF = 128, HTB = HALF * BK * 2  , STAGE_BYTES = 8 * HTB, NXCD = 8, WGM = 8;

__host__ __device__ __forceinline__ int lds_byte(int r, int c) { const int st = (r >> 4) * 2 + (c >> 5), rr = r & 15, cc = c & 31, ob = rr * 64 + cc * 2; return st * 1024 + (ob ^ (((ob >> 9) & 1) << 5)); }
__host__ __device__ __forceinline__ void stage_rc(int b, int& R, int& C) { const int st = b / 1024, sb = b % 1024, swz = sb ^ (((sb >> 9) & 1) << 5); R = (st >> 1) * 16 + swz / 64; C = (st & 1) * 32 + (swz % 64) / 2; }
__host__ __device__ __forceinline__ int perm32(int rho) { const int n = rho >> 4, i = rho & 15; return 8 * (i >> 2) + 4 * n + (i & 3); }

struct Unit { int pm, pn; };
struct Gemm { const bf16_t* A; const bf16_t* Bt; int M, N, K; int ld; int ksplit; };

struct StaticOrder {
    int nM, nN, nwg, G, c;
    __host__ __device__ void init(int M, int N, int G_, int c_) { nM = M / BM; nN = N / BM; nwg = nM * nN; G = G_; c = c_; }
    __host__ __device__ bool next(int i, Unit& u) const {
        const long L = (long)i * G + c; if (L >= nwg) return false;
        int wgid = (int)L; { const int q = nwg / NXCD, r = nwg % NXCD, xcd = wgid % NXCD, off = wgid / NXCD; wgid = (xcd < r ? xcd * (q + 1) : r * (q + 1) + (xcd - r) * q) + off; }
        const int nig = WGM * nN, gid = wgid / nig, fm = gid * WGM, gsz = (nM - fm) < WGM ? (nM - fm) : WGM;
        u.pm = fm + ((wgid % nig) % gsz); u.pn = (wgid % nig) / gsz; return true;
    }
    __device__ __forceinline__ void a_ready(const Unit&) const {}
    __device__ __forceinline__ void done(const Unit&) const {}
};
__device__ __forceinline__ unsigned cvt_pk_bf16(float lo, float hi) { unsigned r; asm volatile("v_cvt_pk_bf16_f32 %0, %1, %2" : "=v"(r) : "v"(lo), "v"(hi)); return r; }
typedef float f32x2 __attribute__((ext_vector_type(2)));
template <class Epi, class Sched, bool STAMP = false>
__device__ __forceinline__ void gemm_phase(PG8_LAS unsigned char* lds, const Gemm g, const Sched& S, const Epi& E, unsigned long long* stamps) {
    const int tid = mk_tid(), wid = __builtin_amdgcn_readfirstlane(tid >> 6), lane = tid & 63, wr = wid >> 2, wc = wid & 3, fr = lane & 15, fq = lane >> 4;
    const int K = g.K, nt = K / BK, LD = g.ld; const size_t ksb = (size_t)g.ksplit * 2;
    int ts_lo = 0, ts_hi = 0, nts = 0; const unsigned long long rt_entry = STAMP ? (unsigned long long)wall_clock64() : 0ull;
#define PG8_STAMP() do { if (STAMP && wid == 0 && nts < 64) { const unsigned long long _c = (unsigned long long)clock64(); \
        ts_lo = (lane == nts) ? (int)(unsigned)_c : ts_lo; ts_hi = (lane == nts) ? (int)(unsigned)(_c >> 32) : ts_hi; ++nts; } } while (0)
    PG8_STAMP();
    unsigned voffA[2], voffB[2];
#pragma unroll
    for (int i = 0; i < 2; ++i) { int R, C; stage_rc(tid * 16 + i * 8192, R, C); const int Rb = Epi::PERM ? ((R & ~31) + perm32(R & 31)) : R;
        voffA[i] = (unsigned)(R * LD + C) * 2u; voffB[i] = (unsigned)(Rb * LD + C) * 2u; }
    const size_t kstep = (size_t)(BK * 2);
    const size_t hstep = (size_t)HALF * LD * 2;
    const size_t tstep = 2 * hstep;
    const unsigned ldsw = (unsigned)wid * 1024u;
    const int aoff = lds_byte(wr * 64 + fr, fq * 8), boff = lds_byte(wc * 32 + fr, fq * 8);
#define PG8_SA(b, h) (((b) * 2 + (h)) * HTB)
#define PG8_SB(b, h) ((4 + (b) * 2 + (h)) * HTB)
#define PG8_STAGE(bufoff, gbase, voff) do { _Pragma("unroll") for (int _i = 0; _i < 2; ++_i) \
        __builtin_amdgcn_global_load_lds((const unsigned*)((const char*)(gbase) + (voff)[_i]), (PG8_LAS unsigned*)(lds + (bufoff) + ldsw + _i * 8192), 16, 0, 0); } while (0)
#define PG8_LDA(dst, b, h) do { _Pragma("unroll") for (int m = 0; m < 4; ++m) _Pragma("unroll") for (int k = 0; k < 2; ++k) dst[m][k] = *(const PG8_LAS bf16x8*)(lds + PG8_SA(b, h) + aoff + m * 2048 + k * 1024); } while (0)
#define PG8_LDB(dst, b, h) do { _Pragma("unroll") for (int n = 0; n < 2; ++n) _Pragma("unroll") for (int k = 0; k < 2; ++k) dst[n][k] = *(const PG8_LAS bf16x8*)(lds + PG8_SB(b, h) + boff + n * 2048 + k * 1024); } while (0)
#define PG8_MMA(ai, bj, At, Bt) do { __builtin_amdgcn_s_setprio(1); _Pragma("unroll") for (int m = 0; m < 4; ++m) _Pragma("unroll") for (int n = 0; n < 2; ++n) _Pragma("unroll") for (int k = 0; k < 2; ++k) \
        acc[ai][bj][m][n] = __builtin_amdgcn_mfma_f32_16x16x32_bf16(Bt[n][k], At[m][k], acc[ai][bj][m][n], 0, 0, 0); __builtin_amdgcn_s_setprio(0); } while (0)
#define PG8_WAIT_V(n) asm volatile("s_waitcnt vmcnt(" #n ")" ::: "memory")
#define PG8_WAIT_L(n) asm volatile("s_waitcnt lgkmcnt(" #n ")" ::: "memory")
#define PG8_BAR __builtin_amdgcn_s_barrier()
#define PG8_SCHED __builtin_amdgcn_sched_barrier(0)
    Unit cur, nxt; int ui = 0;
    if (!S.next(0, cur)) return;
    f32x4 acc[2][2][4][2];
#pragma unroll
    for (int a = 0; a < 2; ++a)
#pragma unroll
        for (int b = 0; b < 2; ++b)
#pragma unroll
            for (int m = 0; m < 4; ++m)
#pragma unroll
                for (int n = 0; n < 2; ++n) acc[a][b][m][n] = (f32x4){0.f, 0.f, 0.f, 0.f};
    bf16x8 At[4][2], B0[2][2], B1[2][2];
    const char* cA = (const char*)g.A + (ksb ? (size_t)cur.pm * ksb : (size_t)cur.pm * tstep); const char* cB = (const char*)g.Bt + (size_t)cur.pn * tstep + (size_t)cur.pm * ksb;
    S.a_ready(cur);
    PG8_STAGE(PG8_SB(0, 0), cB, voffB); PG8_STAGE(PG8_SA(0, 0), cA, voffA); PG8_STAGE(PG8_SB(0, 1), cB + hstep, voffB); PG8_STAGE(PG8_SA(0, 1), cA + hstep, voffA);
    if (wr == 1) PG8_BAR;
    PG8_WAIT_V(4); PG8_BAR;
    PG8_STAGE(PG8_SB(1, 0), cB + kstep, voffB); PG8_STAGE(PG8_SA(1, 0), cA + kstep, voffA); PG8_STAGE(PG8_SB(1, 1), cB + hstep + kstep, voffB);
    PG8_WAIT_V(6); PG8_BAR;
    PG8_STAMP();
    for (;;) {
        const bool has_next = S.next(ui + 1, nxt);
        const char* nA = has_next ? (const char*)g.A + (ksb ? (size_t)nxt.pm * ksb : (size_t)nxt.pm * tstep) : cA; const char* nB = has_next ? (const char*)g.Bt + (size_t)nxt.pn * tstep + (size_t)nxt.pm * ksb : cB;
        for (int t = 0; t < nt; t += 2) {
            const bool last = (t == nt - 2);
            const char* a1 = cA + (size_t)(t + 1) * kstep;
            const char* a2 = last ? nA : cA + (size_t)(t + 2) * kstep; const char* b2 = last ? nB : cB + (size_t)(t + 2) * kstep;
            const char* a3 = a2 + kstep; const char* b3 = b2 + kstep;
            if (last && has_next) S.a_ready(nxt);
            PG8_LDB(B0, 0, 0); PG8_SCHED; PG8_LDA(At, 0, 0); PG8_STAGE(PG8_SA(1, 1), a1 + hstep, voffA);
            PG8_WAIT_L(8); PG8_BAR; PG8_WAIT_L(0); PG8_MMA(0, 0, At, B0); PG8_BAR; PG8_SCHED;
            PG8_LDB(B1, 0, 1); PG8_STAGE(PG8_SB(0, 0), b2, voffB);
            PG8_BAR; PG8_WAIT_L(0); PG8_MMA(0, 1, At, B1); PG8_BAR;
            PG8_LDA(At, 0, 1); PG8_STAGE(PG8_SA(0, 0), a2, voffA);
            PG8_BAR; PG8_WAIT_L(0); PG8_MMA(1, 0, At, B0); PG8_BAR; PG8_SCHED;
            PG8_STAGE(PG8_SB(0, 1), b2 + hstep, voffB);
            PG8_WAIT_V(6); PG8_BAR; PG8_MMA(1, 1, At, B1); PG8_BAR;
            PG8_LDB(B0, 1, 0); PG8_SCHED; PG8_LDA(At, 1, 0); PG8_STAGE(PG8_SA(0, 1), a2 + hstep, voffA);
            PG8_WAIT_L(8); PG8_BAR; PG8_WAIT_L(0); PG8_MMA(0, 0, At, B0); PG8_BAR; PG8_SCHED;
            PG8_LDB(B1, 1, 1); PG8_STAGE(PG8_SB(1, 0), b3, voffB);
            PG8_BAR; PG8_WAIT_L(0); PG8_MMA(0, 1, At, B1); PG8_BAR;
            PG8_LDA(At, 1, 1); PG8_STAGE(PG8_SA(1, 0), a3, voffA);
            PG8_BAR; PG8_WAIT_L(0); PG8_MMA(1, 0, At, B0); PG8_BAR; PG8_SCHED;
            PG8_STAGE(PG8_SB(1, 1), b3 + hstep, voffB);
            PG8_WAIT_V(6); PG8_BAR; PG8_MMA(1, 1, At, B1); PG8_BAR;
        }
        PG8_STAMP();
        if constexpr (!Epi::AFTER_DRAIN) { E(acc, cur, wr, wc, fr, fq); S.done(cur); }
        PG8_STAMP();
        if (!has_next) break;
#pragma unroll
        for (int a = 0; a < 2; ++a)
#pragma unroll
            for (int b = 0; b < 2; ++b)
#pragma unroll
                for (int m = 0; m < 4; ++m)
#pragma unroll
                    for (int n = 0; n < 2; ++n) acc[a][b][m][n] = (f32x4){0.f, 0.f, 0.f, 0.f};
        cur = nxt; cA = nA; cB = nB; ++ui;
    }
    PG8_WAIT_V(0);
    if (wr == 0) PG8_BAR;
    PG8_BAR;
    if constexpr (Epi::AFTER_DRAIN) { E.fused(acc, cur, wr, wc, fr, fq, lds, wid, lane); S.done(cur); }
    PG8_STAMP();
    if (STAMP && wid == 0) { stamps[lane] = lane < nts ? (((unsigned long long)(unsigned)ts_hi << 32) | (unsigned)ts_lo) : 0ull;
        if (lane == 62) stamps[62] = rt_entry; if (lane == 63) stamps[63] = (unsigned long long)wall_clock64(); }
#undef PG8_STAMP
#undef PG8_SA
#undef PG8_SB
#undef PG8_STAGE
#undef PG8_LDA
#undef PG8_LDB
#undef PG8_MMA
#undef PG8_WAIT_V
#undef PG8_WAIT_L
#undef PG8_BAR
#undef PG8_SCHED
}
}

namespace cg = cooperative_groups;
typedef unsigned short bf16_t;
typedef short bf16x8 __attribute__((ext_vector_type(8)));
typedef short s16x4 __attribute__((ext_vector_type(4)));
typedef float f32x4 __attribute__((ext_vector_type(4)));
typedef float f32x8 __attribute__((ext_vector_type(8)));
typedef float f32x16 __attribute__((ext_vector_type(16)));
typedef unsigned u32x4 __attribute__((ext_vector_type(4)));
typedef unsigned u32x2 __attribute__((ext_vector_type(2)));

constexpr int T = 16640, NCTX = 256, DM = 2048, NTH = 512;
constexpr int NIN = 3840;
constexpr int DFF = 5632, NGU = 2 * DFF;
constexpr int C_LRU = 1760, C_MLA = 2784, C_VD = 3616;
constexpr int RECB = 896;
constexpr int LDS_BYTES = 150528;

constexpr size_t al256(size_t x) { return (x + 255) / 256 * 256; }
constexpr size_t WS_BAR = 0;
constexpr size_t WS_MOD = 256;
constexpr size_t WS_XC = al256(WS_MOD + 2 * 2 * 12288 * 4);
constexpr size_t WS_H = al256(WS_XC + (size_t)NCTX * DM * 4);
constexpr size_t WS_VF = al256(WS_H + (size_t)T * DM * 2);
constexpr size_t WS_WIN = al256(WS_VF + (size_t)T * 512 * 2);
constexpr size_t WS_WOUT = al256(WS_WIN + (size_t)NIN * DM * 2);
constexpr size_t WS_WQ = al256(WS_WOUT + (size_t)DM * DM * 2);
constexpr size_t WS_WKV = al256(WS_WQ + (size_t)1536 * 512 * 2);
constexpr size_t WS_WGU = al256(WS_WKV + (size_t)2048 * 256 * 2);
constexpr size_t WS_WDN = al256(WS_WGU + (size_t)NGU * DM * 2);
constexpr size_t WS_R = al256(WS_WDN + (size_t)DM * DFF * 2);
constexpr size_t WS_COLS = WS_R;
constexpr size_t WS_Q = WS_COLS;
constexpr size_t WS_KV = al256(WS_Q + (size_t)T * 1536 * 2);
constexpr size_t WS_REC = al256(WS_COLS + (size_t)T * NIN * 2);
constexpr size_t WS_Y = al256(WS_REC + (size_t)16 * T * RECB);
constexpr size_t WS_LAB = al256(WS_Y + (size_t)2 * T * 512 * 4);
constexpr size_t WS_GG = al256(WS_LAB + (size_t)T * 2048 * 2);
constexpr size_t WS_QN = al256(WS_GG + (size_t)T * 512 * 2);
constexpr size_t WS_KVN = al256(WS_QN + (size_t)T * 512 * 2);
constexpr size_t WS_KR = al256(WS_KVN + (size_t)T * 256 * 2);
constexpr size_t WS_RG = al256(WS_KR + (size_t)T * 64 * 2);
constexpr size_t WS_CV = al256(WS_RG + (size_t)T * 512 * 2);
constexpr size_t WS_AGG = al256(WS_CV + (size_t)T * 512 * 2);
constexpr size_t WS_MIX_END = al256(WS_AGG + (size_t)260 * 2048 * 4);
constexpr size_t WS_GU = WS_R;
constexpr size_t WS_ACT = al256(WS_GU + (size_t)T * NGU * 2);
constexpr size_t WS_FFN_END = al256(WS_ACT + (size_t)T * DFF * 2);
constexpr size_t WS_REND = WS_MIX_END > WS_FFN_END ? WS_MIX_END : WS_FFN_END;
constexpr size_t WS_PARTO = WS_REND;
constexpr size_t WS_PARTML = al256(WS_PARTO + (size_t)448 * 256 * 128 * 2);
constexpr size_t WS_END = al256(WS_PARTML + (size_t)448 * 512 * 4);
static_assert(WS_KV + (size_t)T * 2048 * 2 <= WS_REC, "Q|KV must fit in the cols buffer");

struct Params { const float* in[42]; float* out; unsigned char* ws; int ph_lo, ph_hi; };

enum { I_X = 0, I_C, I_CTX, I_CCTX, I_ADAW, I_ADAB, I_NORM1, I_NORM2, I_WIN, I_WOUT, I_RWCONV, I_RWCONVB, I_RWW0, I_RWWUP, I_RWA0, I_RWAUP, I_RWGUP,
       I_RWKK, I_RWKA, I_RWRK, I_RWLNG, I_RWLNB, I_RWV0, I_RWVDOWN, I_RWVUP, I_LRUCONV, I_LRUCONVB, I_LRUWA, I_LRUBA, I_LRUWX, I_LRUBX, I_LRULAM,
       I_QNORM, I_WQB, I_KVNORM, I_WKVB, I_WGATE, I_WUP, I_FCONV, I_FCONVB, I_WDOWN, I_FNORM };

__device__ __forceinline__ float bf2f(bf16_t b) { return __uint_as_float(((unsigned)b) << 16); }
__device__ __forceinline__ unsigned cvtpk(float lo, float hi) { unsigned r; asm volatile("v_cvt_pk_bf16_f32 %0, %1, %2" : "=v"(r) : "v"(lo), "v"(hi)); return r; }
__device__ __forceinline__ bf16_t f2bf(float f) { return (bf16_t)(cvtpk(f, 0.f) & 0xffffu); }
__device__ __forceinline__ float sigmoidf_(float x) { return __builtin_amdgcn_rcpf(1.0f + __expf(-x)); }
__device__ __forceinline__ float tanhf_(float x) { return 1.0f - 2.0f * __builtin_amdgcn_rcpf(1.0f + __expf(2.0f * x)); }
__device__ __forceinline__ float siluf_(float x) { return x * sigmoidf_(x); }
__device__ __forceinline__ float gelu_tanh(float x) { const float u = 0.7978845608028654f * (x + 0.044715f * x * x * x); return 0.5f * x * (1.0f + tanhf_(u)); }
__device__ __forceinline__ float wave_sum(float v) {
#pragma unroll
  for (int o = 32; o >= 1; o >>= 1) v += __shfl_xor(v, o);
  return v;
}
template <int CTRL> __device__ __forceinline__ float dpp_add(float x) {
  const int xi = __float_as_int(x);
  const int yi = __builtin_amdgcn_update_dpp(xi, xi, CTRL, 0xF, 0xF, false);
  return x + __int_as_float(yi);
}
__device__ __forceinline__ float fma_(float a, float b, float c) { float r; asm("v_fma_f32 %0, %1, %2, %3" : "=v"(r) : "v"(a), "v"(b), "v"(c)); return r; }
__device__ __forceinline__ float mul_(float a, float b) { float r; asm("v_mul_f32 %0, %1, %2" : "=v"(r) : "v"(a), "v"(b)); return r; }
__device__ __forceinline__ float add_(float a, float b) { float r; asm("v_add_f32 %0, %1, %2" : "=v"(r) : "v"(a), "v"(b)); return r; }
typedef float f32x2 __attribute__((ext_vector_type(2)));
__device__ __forceinline__ float dot4(f32x4 a, f32x4 b) { const f32x2 t = a.lo * b.lo + a.hi * b.hi; return t.x + t.y; }
__device__ __forceinline__ float row16_sum(float x) {
  x = dpp_add<0xB1>(x);
  x = dpp_add<0x4E>(x);
  x = dpp_add<0x141>(x);
  x = dpp_add<0x140>(x);
  return x;
}
__device__ __forceinline__ const float* resid_src(const Params& P, int layer, int t) {
  if (layer == 0) return t < NCTX ? PIN(I_CTX) + (size_t)t * DM : PIN(I_X) + (size_t)(t - NCTX) * DM;
  return t < NCTX ? (const float*)(PWS() + WS_XC) + (size_t)t * DM : POUT() + (size_t)(t - NCTX) * DM;
}
__device__ __forceinline__ float* resid_dst(const Params& P, int t) {
  return t < NCTX ? (float*)(PWS() + WS_XC) + (size_t)t * DM : POUT() + (size_t)(t - NCTX) * DM;
}
__device__ __forceinline__ int scan_pos_rev(int t) { return t < NCTX ? (NCTX - 1 - t) : (T + NCTX - 1 - t); }

__device__ __forceinline__ void phase_mod(const Params& P, float* lds) {
  const int tid = mk_tid(), cgp = tid & 15, rg = tid >> 4;
  float* mod = (float*)(PWS() + WS_MOD);
  const float* cvec = PIN(I_C); const float* ccvec = PIN(I_CCTX); const float* adaw = PIN(I_ADAW); const float* adab = PIN(I_ADAB);
  for (int item = mk_bid(); item < 2 * 192; item += mk_nblk()) {
    const int layer = item / 192, col0 = (item % 192) * 64;
    const float* W = adaw + (size_t)layer * DM * 12288 + col0 + cgp * 4;
    f32x4 al = {0.f, 0.f, 0.f, 0.f}, ac = {0.f, 0.f, 0.f, 0.f};
#pragma unroll 1
    for (int r0 = 0; r0 < 64; r0 += 8) {
      f32x4 wv[8]; float sl[8], sc[8];
#pragma unroll
      for (int r = 0; r < 8; ++r) { const int row = rg * 64 + r0 + r; wv[r] = *(const f32x4*)(W + (size_t)row * 12288); sl[r] = cvec[row]; sc[r] = ccvec[row]; }
#pragma unroll
      for (int r = 0; r < 8; ++r) { al += siluf_(sl[r]) * wv[r]; ac += siluf_(sc[r]) * wv[r]; }
    }
#pragma unroll
    for (int i = 0; i < 4; ++i) { lds[(rg * 2 + 0) * 64 + cgp * 4 + i] = al[i]; lds[(rg * 2 + 1) * 64 + cgp * 4 + i] = ac[i]; }
    __syncthreads();
    if (tid < 128) {
      const int which = tid >> 6, col = tid & 63; float sacc = 0.f;
      for (int g = 0; g < 32; ++g) sacc += lds[(g * 2 + which) * 64 + col];
      mod[(size_t)(layer * 2 + which) * 12288 + col0 + col] = sacc + adab[(size_t)layer * 12288 + col0 + col];
    }
    __syncthreads();
  }
}

struct CvtItem { const float* src; bf16_t* dst; int K, N, kt, ntile; bool valid; };
__device__ __forceinline__ CvtItem cvt_decode(const Params& P, int layer, int it) {
  CvtItem r; r.src = nullptr; r.dst = nullptr; r.K = 64; r.N = 0; r.kt = 0; r.ntile = 0; r.valid = false;
  int base = 0;
#define CVT_JOB(SRC, DST, KK, NN) do { const int nkt_ = (KK) / 64, cnt_ = nkt_ * (((NN) + 63) / 64); \
    if (!r.valid && it < base + cnt_) { const int tl_ = it - base; r.src = (SRC); r.dst = (DST); r.K = (KK); r.N = (NN); r.kt = tl_ % nkt_; r.ntile = tl_ / nkt_; r.valid = true; } base += cnt_; } while (0)
  CVT_JOB(PIN(I_WIN) + (size_t)layer * DM * 3616, (bf16_t*)(PWS() + WS_WIN), DM, 3616);
  CVT_JOB(PIN(I_RWVDOWN), (bf16_t*)(PWS() + WS_WIN) + (size_t)C_VD * DM, DM, (layer == 0) ? 0 : 32);
  CVT_JOB(PIN(I_WOUT) + (size_t)layer * DM * DM, (bf16_t*)(PWS() + WS_WOUT), DM, DM);
  CVT_JOB(PIN(I_WQB) + (size_t)layer * 512 * 1536, (bf16_t*)(PWS() + WS_WQ), 512, 1536);
  CVT_JOB(PIN(I_WKVB) + (size_t)layer * 256 * 2048, (bf16_t*)(PWS() + WS_WKV), 256, 2048);
  CVT_JOB(PIN(I_WGATE) + (size_t)layer * DM * DFF, (bf16_t*)(PWS() + WS_WGU), DM, DFF);
  CVT_JOB(PIN(I_WUP) + (size_t)layer * DM * DFF, (bf16_t*)(PWS() + WS_WGU) + (size_t)DFF * DM, DM, DFF);
  CVT_JOB(PIN(I_WDOWN) + (size_t)layer * DFF * DM, (bf16_t*)(PWS() + WS_WDN), DFF, DM);
#undef CVT_JOB
  return r;
}
__device__ __forceinline__ void cvt_load(const CvtItem& c, f32x4 (&v)[2]) {
  const int tid = mk_tid(), kr = tid >> 4, nc = (tid & 15) * 4, k0 = c.kt * 64, n0 = c.ntile * 64;
#pragma unroll
  for (int i = 0; i < 2; ++i) { v[i] = (f32x4){0.f, 0.f, 0.f, 0.f}; if (c.valid && n0 + nc < c.N) v[i] = *(const f32x4*)(c.src + (size_t)(k0 + kr + 32 * i) * c.N + n0 + nc); }
}
__device__ __forceinline__ void phase_convert(const Params& P, int layer, float* lds) {
  const int tid = mk_tid(), kr = tid >> 4, nc = (tid & 15) * 4, n = tid >> 3, kc = (tid & 7) * 8, G = mk_nblk();
  int it = mk_bid();
  CvtItem cur = cvt_decode(P, layer, it); f32x4 v[2]; cvt_load(cur, v);
  while (cur.valid) {
    const CvtItem nxt = cvt_decode(P, layer, it + G); f32x4 nv[2]; cvt_load(nxt, nv);
#pragma unroll
    for (int i = 0; i < 2; ++i) { const int k = kr + 32 * i;
      lds[(nc + 0) * 65 + k] = v[i][0]; lds[(nc + 1) * 65 + k] = v[i][1]; lds[(nc + 2) * 65 + k] = v[i][2]; lds[(nc + 3) * 65 + k] = v[i][3]; }
    __syncthreads();
    if (cur.ntile * 64 + n < cur.N) {
      const float* p = lds + n * 65 + kc;
      u32x4 w; w.x = cvtpk(p[0], p[1]); w.y = cvtpk(p[2], p[3]); w.z = cvtpk(p[4], p[5]); w.w = cvtpk(p[6], p[7]);
      *(u32x4*)(cur.dst + (size_t)(cur.ntile * 64 + n) * cur.K + cur.kt * 64 + kc) = w;
    }
    __syncthreads();
    cur = nxt; v[0] = nv[0]; v[1] = nv[1]; it += G;
  }
}

__device__ __forceinline__ void phase_norm(const Params& P, int layer, int which, bool skip_ctx) {
  const int lane = mk_tid() & 63, wave = mk_tid() >> 6;
  const float* g = P.in[which ? I_NORM2 : I_NORM1] + (size_t)layer * DM;
  const float* mod = (const float*)(PWS() + WS_MOD) + (size_t)layer * 2 * 12288;
  bf16_t* H = (bf16_t*)(PWS() + WS_H);
  const int soff = which ? 6144 : 0;
  const float* src_c = (which == 0 && layer == 0) ? PIN(I_CTX) : (const float*)(PWS() + WS_XC);
  const float* src_l = (which == 0 && layer == 0) ? PIN(I_X) : (const float*)POUT();
  const int stride = mk_nblk() * 8;
  for (int row = mk_bid() * 8 + wave; row < T; row += 2 * stride) {
    int rows[2] = {row, row + stride}; f32x4 v[2][8]; bool ok[2];
#pragma unroll
    for (int u = 0; u < 2; ++u) { ok[u] = rows[u] < T && !(skip_ctx && rows[u] < NCTX);
      if (ok[u]) { const float* xr = rows[u] < NCTX ? src_c + (size_t)rows[u] * DM : src_l + (size_t)(rows[u] - NCTX) * DM;
#pragma unroll
        for (int i = 0; i < 8; ++i) v[u][i] = *(const f32x4*)(xr + i * 256 + lane * 4);
        if (which == 0 && layer == 0 && rows[u] < NCTX) { float* xc = (float*)(PWS() + WS_XC) + (size_t)rows[u] * DM;
#pragma unroll
          for (int i = 0; i < 8; ++i) *(f32x4*)(xc + i * 256 + lane * 4) = v[u][i]; } } }
#pragma unroll
    for (int u = 0; u < 2; ++u) if (ok[u]) {
      const float* m = mod + (rows[u] < NCTX ? 12288 : 0) + soff; float ss = 0.f;
#pragma unroll
      for (int i = 0; i < 8; ++i) ss += v[u][i][0] * v[u][i][0] + v[u][i][1] * v[u][i][1] + v[u][i][2] * v[u][i][2] + v[u][i][3] * v[u][i][3];
      ss = wave_sum(ss);
      const float rstd = rsqrtf(ss * (1.0f / DM) + 1e-6f);
#pragma unroll
      for (int i = 0; i < 8; ++i) {
        const int c = i * 256 + lane * 4;
        const f32x4 gv = *(const f32x4*)(g + c), sh = *(const f32x4*)(m + c), sc = *(const f32x4*)(m + 2048 + c);
        float o[4];
#pragma unroll
        for (int q = 0; q < 4; ++q) o[q] = (v[u][i][q] * rstd * gv[q]) * (1.0f + sc[q]) + sh[q];
        u32x2 w; w.x = cvtpk(o[0], o[1]); w.y = cvtpk(o[2], o[3]);
        *(u32x2*)(H + (size_t)rows[u] * DM + c) = w;
      }
    }
  }
}

__device__ __forceinline__ void phase_final_norm(const Params& P) {
  const int lane = mk_tid() & 63, wave = mk_tid() >> 6;
  const float* g = PIN(I_FNORM); float* out = POUT();
  const int stride = mk_nblk() * 8;
  for (int row = mk_bid() * 8 + wave; row < T - NCTX; row += 2 * stride) {
    int rows[2] = {row, row + stride}; f32x4 v[2][8]; bool ok[2];
#pragma unroll
    for (int u = 0; u < 2; ++u) { ok[u] = rows[u] < T - NCTX;
      if (ok[u]) {
#pragma unroll
        for (int i = 0; i < 8; ++i) v[u][i] = *(const f32x4*)(out + (size_t)rows[u] * DM + i * 256 + lane * 4); } }
#pragma unroll
    for (int u = 0; u < 2; ++u) if (ok[u]) {
      float ss = 0.f;
#pragma unroll
      for (int i = 0; i < 8; ++i) ss += v[u][i][0] * v[u][i][0] + v[u][i][1] * v[u][i][1] + v[u][i][2] * v[u][i][2] + v[u][i][3] * v[u][i][3];
      ss = wave_sum(ss);
      const float rstd = rsqrtf(ss * (1.0f / DM) + 1e-6f);
#pragma unroll
      for (int i = 0; i < 8; ++i) { const int c = i * 256 + lane * 4; const f32x4 gv = *(const f32x4*)(g + c); *(f32x4*)(out + (size_t)rows[u] * DM + c) = v[u][i] * rstd * gv; }
    }
  }
}

struct EpiStore {
  static constexpr bool PERM = true, AFTER_DRAIN = false;
  bf16_t* O; int ldc;
  __device__ __forceinline__ void operator()(const f32x4 (&acc)[2][2][4][2], const pg8::Unit& u, int wr, int wc, int fr, int fq) const {
    const int row0 = u.pm * 256 + wr * 64 + fr, col0 = u.pn * 256 + wc * 32 + 8 * fq;
#pragma unroll
    for (int ai = 0; ai < 2; ++ai)
#pragma unroll
      for (int m = 0; m < 4; ++m) { bf16_t* rowp = O + (size_t)(row0 + ai * 128 + m * 16) * ldc + col0;
#pragma unroll
        for (int bj = 0; bj < 2; ++bj) { const f32x4 v0 = acc[ai][bj][m][0], v1 = acc[ai][bj][m][1];
          u32x4 w; w.x = cvtpk(v0[0], v0[1]); w.y = cvtpk(v0[2], v0[3]); w.z = cvtpk(v1[0], v1[1]); w.w = cvtpk(v1[2], v1[3]);
          *(u32x4*)(rowp + bj * 128) = w; } }
  }
};
struct EpiResid {
  static constexpr bool PERM = false, AFTER_DRAIN = false;
  const float* src_c; const float* src_l; float* dst_c; float* dst_l; const float* gate_c; const float* gate_l; int row_off;
  __device__ __forceinline__ void operator()(const f32x4 (&acc)[2][2][4][2], const pg8::Unit& u, int wr, int wc, int fr, int fq) const {
    const int t0 = row_off + u.pm * 256;
    const bool isc = t0 < NCTX;
    const float* src = isc ? src_c : src_l - (size_t)NCTX * DM; float* dst = isc ? dst_c : dst_l - (size_t)NCTX * DM; const float* gate = isc ? gate_c : gate_l;
    const int row0 = t0 + wr * 64 + fr, col0 = u.pn * 256 + wc * 32 + 4 * fq;
    f32x4 gv[2][2];
#pragma unroll
    for (int bj = 0; bj < 2; ++bj)
#pragma unroll
      for (int n = 0; n < 2; ++n) gv[bj][n] = *(const f32x4*)(gate + col0 + bj * 128 + n * 16);
#pragma unroll
    for (int ai = 0; ai < 2; ++ai)
#pragma unroll
      for (int m = 0; m < 4; ++m) { const size_t off = (size_t)(row0 + ai * 128 + m * 16) * DM + col0;
#pragma unroll
        for (int bj = 0; bj < 2; ++bj)
#pragma unroll
          for (int n = 0; n < 2; ++n) { const f32x4 xs = *(const f32x4*)(src + off + bj * 128 + n * 16);
            *(f32x4*)(dst + off + bj * 128 + n * 16) = xs + gv[bj][n] * acc[ai][bj][m][n]; } }
  }
};

struct EpiResidAtomic {
  static constexpr bool PERM = false, AFTER_DRAIN = false;
  float* dst; const float* gate;
  __device__ __forceinline__ void operator()(const f32x4 (&acc)[2][2][4][2], const pg8::Unit& u, int wr, int wc, int fr, int fq) const {
    const int row0 = wr * 64 + fr, col0 = u.pn * 256 + wc * 32 + 4 * fq;
    f32x4 gv[2][2];
#pragma unroll
    for (int bj = 0; bj < 2; ++bj)
#pragma unroll
      for (int n = 0; n < 2; ++n) gv[bj][n] = *(const f32x4*)(gate + col0 + bj * 128 + n * 16);
#pragma unroll
    for (int ai = 0; ai < 2; ++ai)
#pragma unroll
      for (int m = 0; m < 4; ++m) { float* rp = dst + (size_t)(row0 + ai * 128 + m * 16) * DM + col0;
#pragma unroll
        for (int bj = 0; bj < 2; ++bj)
#pragma unroll
          for (int n = 0; n < 2; ++n) { const f32x4 v = gv[bj][n] * acc[ai][bj][m][n];
#pragma unroll
            for (int q = 0; q < 4; ++q) __hip_atomic_fetch_add(rp + bj * 128 + n * 16 + q, v[q], __ATOMIC_RELAXED, __HIP_MEMORY_SCOPE_AGENT); } }
  }
};
template <class Epi>
__device__ __forceinline__ void run_gemm(unsigned char* lds, const bf16_t* A, const bf16_t* Bt, int M, int N, int K, const Epi& E, int wg, int nwg, int ld = 0, int ksplit = 0) {
  pg8::Gemm g{A, Bt, M, N, K, ld ? ld : K, ksplit}; pg8::StaticOrder S; S.init(M, N, nwg, wg);
  pg8::gemm_phase<Epi, pg8::StaticOrder, false>((PG8_LAS unsigned char*)lds, g, S, E, nullptr);
}

__device__ __forceinline__ float colv(const bf16_t* cols, int t, int c) { return bf2f(cols[(size_t)t * NIN + c]); }
__device__ __forceinline__ float rwconv3(const bf16_t* cols, const float* cw, const float* cb, int t, int c, int lo, int hi) {
  float u = cb[c] + cw[1760 + c] * colv(cols, t, c);
  if (t - 1 >= lo) u += cw[c] * colv(cols, t - 1, c);
  if (t + 1 < hi) u += cw[2 * 1760 + c] * colv(cols, t + 1, c);
  return u;
}

__device__ __forceinline__ float rwconv3w(const bf16_t* cols, float w0, float w1, float w2, float b, int t, int c, int lo, int hi) {
  float u = b + w1 * colv(cols, t, c);
  if (t - 1 >= lo) u += w0 * colv(cols, t - 1, c);
  if (t + 1 < hi) u += w2 * colv(cols, t + 1, c);
  return u;
}
template <int PART>
__device__ __forceinline__ void phase_prep(const Params& P, int layer, float* lds, int wg, int nwg) {
  constexpr int NTK = 13;
  const int tid = mk_tid(), lane = tid & 63, wave = tid >> 6;
  float* lin = lds;
  float* xs = lds + 16 * 256;
  const bf16_t* cols = (const bf16_t*)(PWS() + WS_COLS);
  const float* cw = PIN(I_RWCONV) + (size_t)layer * 3 * 1760; const float* cb = PIN(I_RWCONVB) + (size_t)layer * 1760;
  const float* lcw = PIN(I_LRUCONV) + (size_t)layer * 4 * 512; const float* lcb = PIN(I_LRUCONVB) + (size_t)layer * 512;
  const int c = tid, hd = c >> 6, n = c & 63;
  bf16_t* VF = (bf16_t*)(PWS() + WS_VF); bf16_t* RG = (bf16_t*)(PWS() + WS_RG); bf16_t* CV = (bf16_t*)(PWS() + WS_CV);
  bf16_t* LAB = (bf16_t*)(PWS() + WS_LAB); bf16_t* GG = (bf16_t*)(PWS() + WS_GG);
  bf16_t* QN = (bf16_t*)(PWS() + WS_QN); bf16_t* KVN = (bf16_t*)(PWS() + WS_KVN); bf16_t* KR = (bf16_t*)(PWS() + WS_KR);
  unsigned char* REC = PWS() + WS_REC;
  const float w0_0 = PIN(I_RWW0)[(layer * 2 + 0) * 512 + c], w0_1 = PIN(I_RWW0)[(layer * 2 + 1) * 512 + c];
  const float a0_0 = PIN(I_RWA0)[(layer * 2 + 0) * 512 + c], a0_1 = PIN(I_RWA0)[(layer * 2 + 1) * 512 + c];
  const float kkc = PIN(I_RWKK)[layer * 512 + c], kac = PIN(I_RWKA)[layer * 512 + c], rkc = PIN(I_RWRK)[layer * 512 + c];
  const float v0c = (layer > 0) ? PIN(I_RWV0)[c] : 0.f;
  const float* wup = PIN(I_RWWUP) + (size_t)layer * 2 * 32 * 512 + c; const float* aup = PIN(I_RWAUP) + (size_t)layer * 2 * 32 * 512 + c;
  const float* gup = PIN(I_RWGUP) + (size_t)layer * 96 * 512 + c; const float* vup = PIN(I_RWVUP) + c;
  const float* lwa = PIN(I_LRUWA) + (size_t)layer * 2 * 8 * 4096 + (size_t)hd * 4096 + n; const float* lwx = PIN(I_LRUWX) + (size_t)layer * 2 * 8 * 4096 + (size_t)hd * 4096 + n;
  const float lba0 = PIN(I_LRUBA)[(layer * 2 + 0) * 512 + c], lba1 = PIN(I_LRUBA)[(layer * 2 + 1) * 512 + c];
  const float lbx0 = PIN(I_LRUBX)[(layer * 2 + 0) * 512 + c], lbx1 = PIN(I_LRUBX)[(layer * 2 + 1) * 512 + c];
  const float lam0 = PIN(I_LRULAM)[(layer * 2 + 0) * 512 + c], lam1 = PIN(I_LRULAM)[(layer * 2 + 1) * 512 + c];
  const float sp0 = log1pf(__expf(-lam0)), sp1 = log1pf(__expf(-lam1));
  float cwr[3], cwk[3], cwv[3], cwe[3], cbr = 0.f, cbk = 0.f, cbv = 0.f, cbe = 0.f;
  const int ecol = 1536 + ((tid & 255) < 224 ? (tid & 255) : 0);
#pragma unroll
  for (int q = 0; q < 3; ++q) { cwr[q] = (PART == 0) ? cw[q * 1760 + c] : 0.f; cwk[q] = (PART == 0) ? cw[q * 1760 + 512 + c] : 0.f; cwv[q] = (PART == 0) ? cw[q * 1760 + 1024 + c] : 0.f; cwe[q] = (PART == 0) ? cw[q * 1760 + ecol] : 0.f; }
  if (PART == 0) { cbr = cb[c]; cbk = cb[512 + c]; cbv = cb[1024 + c]; cbe = cb[ecol]; }

  for (int tile = wg; tile < T / NTK; tile += nwg) {
    const int t0 = tile * NTK;
    const int lo = t0 < NCTX ? 0 : NCTX, hi = t0 < NCTX ? NCTX : T;
    if (PART == 0) {
#pragma unroll
    for (int i = 0; i < (NTK * 256 + 511) / 512; ++i) {
      const int idx = tid + 512 * i, tt = idx >> 8, e = idx & 255, t = t0 + tt; float v;
      if (idx >= NTK * 256) continue;
      const int lo_t = t < NCTX ? 0 : NCTX, hi_t = t < NCTX ? NCTX : T;
      if (e < 224) { v = rwconv3w(cols, cwe[0], cwe[1], cwe[2], cbe, t, 1536 + e, lo_t, hi_t); if (e < 64) v = tanhf_(v); else if (e >= 128) v = sigmoidf_(v); }
      else v = (layer > 0) ? colv(cols, t, C_VD + e - 224) : 0.f;
      lin[tt * 256 + e] = v;
    }
    }
    if (PART == 1) {
#pragma unroll
    for (int tt = 0; tt < NTK; ++tt) {
      const int t = t0 + tt; float u = lcb[c]; const int lo_t = t < NCTX ? 0 : NCTX, hi_t = t < NCTX ? NCTX : T;
#pragma unroll
      for (int j = 0; j < 4; ++j) { const int ts = t + j - 2; if (ts >= lo_t && ts < hi_t) u += lcw[j * 512 + c] * colv(cols, ts, C_LRU + c); }
      xs[tt * 512 + c] = u;
    }
#pragma unroll 1
    for (int tw = wave; tw < NTK; tw += 8) {
      const int t = t0 + tw; const bf16_t* cr = cols + (size_t)t * NIN;
      float q[8]; float ss = 0.f;
      { const bf16x8 raw = *(const bf16x8*)(cr + C_MLA + lane * 8);
#pragma unroll
        for (int i = 0; i < 8; ++i) { q[i] = bf2f((bf16_t)raw[i]); ss += q[i] * q[i]; } }
      ss = wave_sum(ss); float rstd = rsqrtf(ss * (1.0f / 512.0f) + 1e-6f);
      { const float* gq = PIN(I_QNORM) + layer * 512 + lane * 8; u32x4 w;
        w.x = cvtpk(q[0] * rstd * gq[0], q[1] * rstd * gq[1]); w.y = cvtpk(q[2] * rstd * gq[2], q[3] * rstd * gq[3]);
        w.z = cvtpk(q[4] * rstd * gq[4], q[5] * rstd * gq[5]); w.w = cvtpk(q[6] * rstd * gq[6], q[7] * rstd * gq[7]);
        *(u32x4*)(QN + (size_t)t * 512 + lane * 8) = w; }
      float k4[4]; ss = 0.f;
      { const s16x4 raw = *(const s16x4*)(cr + C_MLA + 512 + lane * 4);
#pragma unroll
        for (int i = 0; i < 4; ++i) { k4[i] = bf2f((bf16_t)raw[i]); ss += k4[i] * k4[i]; } }
      ss = wave_sum(ss); rstd = rsqrtf(ss * (1.0f / 256.0f) + 1e-6f);
      { const float* gk = PIN(I_KVNORM) + layer * 256 + lane * 4; u32x2 w;
        w.x = cvtpk(k4[0] * rstd * gk[0], k4[1] * rstd * gk[1]); w.y = cvtpk(k4[2] * rstd * gk[2], k4[3] * rstd * gk[3]);
        *(u32x2*)(KVN + (size_t)t * 256 + lane * 4) = w; }
      const float own = bf2f(cr[C_MLA + 768 + lane]); const float oth = __shfl_xor(own, 16);
      float res = own;
      if (t >= NCTX) {
        const int tl = t - NCTX, axis = lane >> 5, half = (lane >> 4) & 1, f = lane & 15;
        const float pos = (float)(axis == 0 ? (tl >> 6) : (tl & 63));
        const float inv = exp2f(-(float)f * (13.287712379549449f / 16.0f));
        const float sn = __sinf(pos * inv), cs = __cosf(pos * inv);
        res = half == 0 ? own * cs - oth * sn : oth * sn + own * cs;
      }
      KR[(size_t)t * 64 + lane] = f2bf(res);
    }
    }
    __syncthreads();
    if (PART == 0) {
      float zw0[NTK], zw1[NTK], za0[NTK], za1[NTK], gg[NTK], mx[NTK];
#pragma unroll
      for (int tt = 0; tt < NTK; ++tt) { zw0[tt] = 0.f; zw1[tt] = 0.f; za0[tt] = 0.f; za1[tt] = 0.f; gg[tt] = 0.f; mx[tt] = 0.f; }
#pragma unroll 1
      for (int e = 0; e < 32; e += 4) {
        float wa[4], wb[4], aa[4], ab[4], vv[4];
#pragma unroll
        for (int i = 0; i < 4; ++i) { wa[i] = wup[(size_t)(e + i) * 512]; wb[i] = wup[(size_t)(32 + e + i) * 512]; aa[i] = aup[(size_t)(e + i) * 512]; ab[i] = aup[(size_t)(32 + e + i) * 512];
          vv[i] = (layer > 0) ? vup[(size_t)(e + i) * 512] : 0.f; }
#pragma unroll
        for (int tt = 0; tt < NTK; ++tt) {
          const f32x4 x0 = *(const f32x4*)(lin + tt * 256 + e), x1 = *(const f32x4*)(lin + tt * 256 + 32 + e), y0 = *(const f32x4*)(lin + tt * 256 + 64 + e),
                      y1 = *(const f32x4*)(lin + tt * 256 + 96 + e), hv = *(const f32x4*)(lin + tt * 256 + 224 + e);
#pragma unroll
          for (int i = 0; i < 4; ++i) { zw0[tt] += x0[i] * wa[i]; zw1[tt] += x1[i] * wb[i]; za0[tt] += y0[i] * aa[i]; za1[tt] += y1[i] * ab[i]; mx[tt] += hv[i] * vv[i]; }
        }
      }
#pragma unroll 1
      for (int e = 0; e < 96; e += 4) {
        float gw[4];
#pragma unroll
        for (int i = 0; i < 4; ++i) gw[i] = gup[(size_t)(e + i) * 512];
#pragma unroll
        for (int tt = 0; tt < NTK; ++tt) { const f32x4 s4 = *(const f32x4*)(lin + tt * 256 + 128 + e);
#pragma unroll
          for (int i = 0; i < 4; ++i) gg[tt] += s4[i] * gw[i]; }
      }
#pragma unroll
      for (int tt = 0; tt < NTK; ++tt) {
        const int t = t0 + tt; const int lo_t = t < NCTX ? 0 : NCTX, hi_t = t < NCTX ? NCTX : T;
        const float r = rwconv3w(cols, cwr[0], cwr[1], cwr[2], cbr, t, c, lo_t, hi_t), k = rwconv3w(cols, cwk[0], cwk[1], cwk[2], cbk, t, 512 + c, lo_t, hi_t);
        float v = rwconv3w(cols, cwv[0], cwv[1], cwv[2], cbv, t, 1024 + c, lo_t, hi_t);
        const float wd0 = __expf(-0.606531f * sigmoidf_(w0_0 + zw0[tt])), wd1 = __expf(-0.606531f * sigmoidf_(w0_1 + zw1[tt]));
        const float ic0 = sigmoidf_(a0_0 + za0[tt]), ic1 = sigmoidf_(a0_1 + za1[tt]);
        if (layer > 0) { const float mixv = sigmoidf_(v0c + mx[tt]); const float vf = bf2f(VF[(size_t)t * 512 + c]); v = v + (vf - v) * mixv; }
        else VF[(size_t)t * 512 + c] = f2bf(v);
        float kk = k * kkc; const float ssq = wave_sum(kk * kk); kk *= rsqrtf(fmaxf(ssq, 1e-24f));
        const float kd0 = k * (1.0f + (ic0 - 1.0f) * kac), kd1 = k * (1.0f + (ic1 - 1.0f) * kac);
        const float b0 = kk * ic0, b1 = kk * ic1;
        const float coef = wave_sum(r * (kd0 + kd1) * rkc);
        RG[(size_t)t * 512 + c] = f2bf(gg[tt]); CV[(size_t)t * 512 + c] = f2bf(coef * v);
        const bf16_t ab_ = f2bf(-kk), rb_ = f2bf(r), vb_ = f2bf(v);
        { unsigned char* rp = REC + ((size_t)(0 * 8 + hd) * T + t) * RECB;
          ((float*)rp)[n] = wd0; bf16_t* q = (bf16_t*)(rp + 256); q[n] = f2bf(kd0); q[64 + n] = ab_; q[128 + n] = f2bf(b0); q[192 + n] = rb_; q[256 + n] = vb_; }
        { unsigned char* rp = REC + ((size_t)(1 * 8 + hd) * T + scan_pos_rev(t)) * RECB;
          ((float*)rp)[n] = wd1; bf16_t* q = (bf16_t*)(rp + 256); q[n] = f2bf(kd1); q[64 + n] = ab_; q[128 + n] = f2bf(b1); q[192 + n] = rb_; q[256 + n] = vb_; }
        asm volatile("" ::: "memory");
      }
    }
    if (PART == 1) {
      float pa0[NTK], pa1[NTK], px0[NTK], px1[NTK];
#pragma unroll
      for (int tt = 0; tt < NTK; ++tt) { pa0[tt] = 0.f; pa1[tt] = 0.f; px0[tt] = 0.f; px1[tt] = 0.f; }
      {
        float a0w[4], a1w[4], x0w[4], x1w[4];
#pragma unroll
        for (int i = 0; i < 4; ++i) { a0w[i] = lwa[(size_t)i * 64]; a1w[i] = lwa[(size_t)8 * 4096 + (size_t)i * 64]; x0w[i] = lwx[(size_t)i * 64]; x1w[i] = lwx[(size_t)8 * 4096 + (size_t)i * 64]; }
#pragma unroll 1
        for (int i0 = 0; i0 < 64; i0 += 4) {
          float na0[4], na1[4], nx0[4], nx1[4];
          const int in_ = (i0 + 4 < 64) ? i0 + 4 : i0;
#pragma unroll
          for (int i = 0; i < 4; ++i) { na0[i] = lwa[(size_t)(in_ + i) * 64]; na1[i] = lwa[(size_t)8 * 4096 + (size_t)(in_ + i) * 64]; nx0[i] = lwx[(size_t)(in_ + i) * 64]; nx1[i] = lwx[(size_t)8 * 4096 + (size_t)(in_ + i) * 64]; }
#pragma unroll
          for (int tt = 0; tt < NTK; ++tt) { const f32x4 x = *(const f32x4*)(xs + tt * 512 + hd * 64 + i0);
#pragma unroll
            for (int i = 0; i < 4; ++i) { pa0[tt] += x[i] * a0w[i]; pa1[tt] += x[i] * a1w[i]; px0[tt] += x[i] * x0w[i]; px1[tt] += x[i] * x1w[i]; } }
#pragma unroll
          for (int i = 0; i < 4; ++i) { a0w[i] = na0[i]; a1w[i] = na1[i]; x0w[i] = nx0[i]; x1w[i] = nx1[i]; }
        }
      }
      float gt8[NTK];
#pragma unroll
      for (int tt = 0; tt < NTK; ++tt) gt8[tt] = colv(cols, t0 + tt, C_LRU + 512 + c);
#pragma unroll
      for (int tt = 0; tt < NTK; ++tt) {
        const int t = t0 + tt; const float xb = xs[tt * 512 + c];
        const float la0 = -8.0f * sigmoidf_(pa0[tt] + lba0) * sp0, la1 = -8.0f * sigmoidf_(pa1[tt] + lba1) * sp1;
        const float bb0 = sqrtf(fmaxf(1.0f - __expf(2.0f * la0), 0.f)) * sigmoidf_(px0[tt] + lbx0) * xb;
        const float bb1 = sqrtf(fmaxf(1.0f - __expf(2.0f * la1), 0.f)) * sigmoidf_(px1[tt] + lbx1) * xb;
        bf16_t* lp = LAB + (size_t)t * 2048;
        lp[c] = f2bf(la0); lp[512 + c] = f2bf(bb0); lp[1024 + c] = f2bf(la1); lp[1536 + c] = f2bf(bb1);
        GG[(size_t)t * 512 + c] = f2bf(gelu_tanh(gt8[tt]));
        asm volatile("" ::: "memory");
      }
    }
    __syncthreads();
  }
}

__device__ __forceinline__ void phase_lru_agg(const Params& P, int wg, int nwg) {
  const int c = mk_tid(); const bf16_t* LAB = (const bf16_t*)(PWS() + WS_LAB); float* AGG = (float*)(PWS() + WS_AGG);
  for (int ck = wg; ck < T / 64; ck += nwg) {
    float A0 = 1.f, B0 = 0.f, A1 = 1.f, B1 = 0.f;
#pragma unroll 1
    for (int t8 = 0; t8 < 64; t8 += 8) {
      bf16_t x[8][4];
#pragma unroll
      for (int u = 0; u < 8; ++u) { const bf16_t* lp = LAB + (size_t)(ck * 64 + t8 + u) * 2048; x[u][0] = lp[c]; x[u][1] = lp[512 + c]; x[u][2] = lp[1024 + c]; x[u][3] = lp[1536 + c]; }
#pragma unroll
      for (int u = 0; u < 8; ++u) {
        const float a0 = __expf(bf2f(x[u][0])), b0 = bf2f(x[u][1]), a1 = __expf(bf2f(x[u][2])), b1 = bf2f(x[u][3]);
        A0 = a0 * A0; B0 = a0 * B0 + b0;
        B1 = B1 + A1 * b1; A1 = A1 * a1;
      }
    }
    float* ap = AGG + (size_t)ck * 2048; ap[c] = A0; ap[512 + c] = B0; ap[1024 + c] = A1; ap[1536 + c] = B1;
  }
}
__device__ __forceinline__ float lru_compose(const float* AGG, int c, int off, int q0, int dq, int n, float h) {
  int i = 0;
#pragma unroll 1
  for (; i + 8 <= n; i += 8) {
    float a[8], b[8];
#pragma unroll
    for (int u = 0; u < 8; ++u) { const float* ap = AGG + (size_t)(q0 + (i + u) * dq) * 2048 + off; a[u] = ap[c]; b[u] = ap[512 + c]; }
#pragma unroll
    for (int u = 0; u < 8; ++u) h = a[u] * h + b[u];
  }
#pragma unroll 1
  for (; i < n; ++i) { const float* ap = AGG + (size_t)(q0 + i * dq) * 2048 + off; h = ap[c] * h + ap[512 + c]; }
  return h;
}
__device__ __forceinline__ void phase_lru_out(const Params& P, int layer, float* lds, int wg, int nwg) {
  const int c = mk_tid(); const bf16_t* LAB = (const bf16_t*)(PWS() + WS_LAB); const float* AGG = (const float*)(PWS() + WS_AGG);
  const bf16_t* GG = (const bf16_t*)(PWS() + WS_GG); bf16_t* MIX = (bf16_t*)(PWS() + WS_H);
  const int ck_lo = (layer == 1) ? 4 : 0;
  for (int ck = ck_lo + wg; ck < T / 64; ck += nwg) {
    float h0 = lru_compose(AGG, c, 0, 0, 1, ck, 0.f);
    float h1;
    if (ck < 4) h1 = lru_compose(AGG, c, 1024, 3, -1, 3 - ck, 0.f);
    else { h1 = lru_compose(AGG, c, 1024, 3, -1, 4, 0.f); h1 = lru_compose(AGG, c, 1024, T / 64 - 1, -1, T / 64 - 1 - ck, h1); }
#pragma unroll 1
    for (int t8 = 0; t8 < 64; t8 += 8) {
      bf16_t x[8][2];
#pragma unroll
      for (int u = 0; u < 8; ++u) { const bf16_t* lp = LAB + (size_t)(ck * 64 + t8 + u) * 2048; x[u][0] = lp[c]; x[u][1] = lp[512 + c]; }
#pragma unroll
      for (int u = 0; u < 8; ++u) { h0 = __expf(bf2f(x[u][0])) * h0 + bf2f(x[u][1]); lds[(t8 + u) * 512 + c] = h0; }
    }
#pragma unroll 1
    for (int t8 = 56; t8 >= 0; t8 -= 8) {
      bf16_t x[8][3];
#pragma unroll
      for (int u = 0; u < 8; ++u) { const int t = ck * 64 + t8 + u; const bf16_t* lp = LAB + (size_t)t * 2048; x[u][0] = lp[1024 + c]; x[u][1] = lp[1536 + c]; x[u][2] = GG[(size_t)t * 512 + c]; }
#pragma unroll
      for (int u = 7; u >= 0; --u) { const int t = ck * 64 + t8 + u; h1 = __expf(bf2f(x[u][0])) * h1 + bf2f(x[u][1]);
        MIX[(size_t)t * DM + 512 + c] = f2bf((lds[(t8 + u) * 512 + c] + h1) * bf2f(x[u][2])); }
    }
  }
}

template <int NCW>
__device__ __forceinline__ void rwkv_scan(const Params& P, int s, float* lds) {
  const int d = (NCW == 4) ? (s >> 5) : (s >> 4), h = (NCW == 4) ? ((s >> 2) & 7) : ((s >> 1) & 7), part = (NCW == 4) ? (s & 3) : (s & 1);
  const int tid = mk_tid(), lane = tid & 63, wave = tid >> 6, rgp = lane >> 4, j = lane & 15, row = part * (NCW * 4) + (wave & (NCW - 1)) * 4 + rgp;
  const unsigned char* rec = PWS() + WS_REC + (size_t)(d * 8 + h) * T * RECB;
  float* Y = (float*)(PWS() + WS_Y) + (size_t)d * T * 512 + h * 64 + row;
  constexpr int NST = (NCW == 4) ? 7 : 4, STS = (NCW == 4) ? 256 : 512;
  const bool stager = (NCW == 4) ? (wave >= 4) : true; const int stid = (NCW == 4) ? (tid - 256) : tid;
  int goff[NST], loff[NST]; bool isw[NST], val[NST];
#pragma unroll
  for (int i = 0; i < NST; ++i) { const int q = stid + STS * i; val[i] = stager && q >= 0 && q < 1792; const int rc = q / 56, pr = q % 56; goff[i] = rc * RECB + pr * 16; isw[i] = pr < 16;
    loff[i] = rc * 384 + (isw[i] ? pr * 4 : 64 + ((pr - 16) >> 3) * 64 + ((pr - 16) & 7) * 8); }
  u32x4 stA[NST], stB[NST];
#define RS_LOAD(st, ch) do { _Pragma("unroll") for (int i = 0; i < NST; ++i) if (val[i]) st[i] = *(const u32x4*)(rec + (size_t)(ch) * 32 * RECB + goff[i]); } while (0)
#define RS_WRITE(st, buf) do { _Pragma("unroll") for (int i = 0; i < NST; ++i) if (val[i]) { float* dp = (buf) + loff[i]; \
    if (isw[i]) { *(u32x4*)dp = st[i]; } else { u32x4 lo_, hi_; lo_.x = st[i].x << 16; lo_.y = st[i].x & 0xffff0000u; lo_.z = st[i].y << 16; lo_.w = st[i].y & 0xffff0000u; \
      hi_.x = st[i].z << 16; hi_.y = st[i].z & 0xffff0000u; hi_.z = st[i].w << 16; hi_.w = st[i].w & 0xffff0000u; *(u32x4*)dp = lo_; *(u32x4*)(dp + 4) = hi_; } } } while (0)
  f32x4 S = {0.f, 0.f, 0.f, 0.f}; float ykeep = 0.f, yprev = 0.f;
  constexpr int NCH = T / 32;
#define RS_COMPUTE(ch) do { const float* buf = lds + ((ch) & 1) * 12288; \
    if (wave < NCW) { \
      const float* sp = buf + j * 4; \
      f32x4 w4 = *(const f32x4*)(sp), kd4 = *(const f32x4*)(sp + 64), a4 = *(const f32x4*)(sp + 128), b4 = *(const f32x4*)(sp + 192), r4 = *(const f32x4*)(sp + 256); \
      float v = buf[320 + row]; \
      _Pragma("unroll 8") \
      for (int stp = 0; stp < 32; ++stp) { \
        float sa = dot4(S, a4); \
          \
        __builtin_amdgcn_sched_barrier(0); \
        const float* np = sp + (stp + 1) * 384;            \
        const f32x4 nw4 = *(const f32x4*)(np), nkd4 = *(const f32x4*)(np + 64), na4 = *(const f32x4*)(np + 128), nb4 = *(const f32x4*)(np + 192), nr4 = *(const f32x4*)(np + 256); \
        const float nv = buf[(stp + 1) * 384 + 320 + row]; \
        __builtin_amdgcn_sched_barrier(0); \
          \
          \
        f32x2 q01, t23, vv; vv[0] = v; vv[1] = v; \
        { const f32x2 kd01 = kd4.lo, kd23 = kd4.hi, S01 = S.lo, w01 = w4.lo; \
        asm volatile("v_add_f32_dpp %0, %0, %0 quad_perm:[1,0,3,2] row_mask:0xf bank_mask:0xf\n\t" \
                     "v_add_f32_dpp %1, %1, %1 quad_perm:[1,0,3,2] row_mask:0xf bank_mask:0xf\n\t" \
                     "v_pk_mul_f32 %2, %4, %6 op_sel_hi:[1,0]\n\t" \
                     "v_add_f32_dpp %0, %0, %0 quad_perm:[2,3,0,1] row_mask:0xf bank_mask:0xf\n\t" \
                     "v_add_f32_dpp %1, %1, %1 quad_perm:[2,3,0,1] row_mask:0xf bank_mask:0xf\n\t" \
                     "v_pk_mul_f32 %3, %5, %6 op_sel_hi:[1,0]\n\t" \
                     "v_add_f32_dpp %0, %0, %0 row_half_mirror row_mask:0xf bank_mask:0xf\n\t" \
                     "v_add_f32_dpp %1, %1, %1 row_half_mirror row_mask:0xf bank_mask:0xf\n\t" \
                     "v_pk_fma_f32 %2, %7, %8, %2\n\t" \
                     "v_add_f32_dpp %0, %0, %0 row_mirror row_mask:0xf bank_mask:0xf\n\t" \
                     "v_add_f32_dpp %1, %1, %1 row_mirror row_mask:0xf bank_mask:0xf" \
                     : "+v"(sa), "+v"(yprev), "=&v"(q01), "=&v"(t23) \
                     : "v"(kd01), "v"(kd23), "v"(vv), "v"(S01), "v"(w01)); } \
        const f32x2 q23 = S.hi * w4.hi + t23; \
        ykeep = (((stp + 15) & 15) == j) ? yprev : ykeep;         \
        if ((stp & 15) == 0 && ((ch) > 0 || stp > 0)) { const int p = (ch) * 32 + stp - 16 + j; const int tok = d ? scan_pos_rev(p) : p; Y[(size_t)tok * 512] = ykeep; } \
        S.lo = sa * b4.lo + q01; S.hi = sa * b4.hi + q23; \
        yprev = dot4(S, r4); \
        w4 = nw4; kd4 = nkd4; a4 = na4; b4 = nb4; r4 = nr4; v = nv; \
      } \
    } } while (0)
  RS_LOAD(stA, 0); RS_WRITE(stA, lds); RS_LOAD(stA, 1); __syncthreads();
  static_assert(NCH % 2 == 0, "the chunk loop is unrolled by two");
  for (int ch = 0; ch < NCH; ch += 2) {
    if (ch + 2 < NCH) RS_LOAD(stB, ch + 2);
    RS_COMPUTE(ch);
    RS_WRITE(stA, lds + 12288);
    __syncthreads();
    if (ch + 3 < NCH) RS_LOAD(stA, ch + 3);
    RS_COMPUTE(ch + 1);
    if (ch + 2 < NCH) RS_WRITE(stB, lds);
    __syncthreads();
  }
  if (wave < NCW) {
    yprev = row16_sum(yprev);
    ykeep = (j == 15) ? yprev : ykeep;
    const int p = T - 16 + j; const int tok = d ? scan_pos_rev(p) : p; Y[(size_t)tok * 512] = ykeep;
  }
#undef RS_COMPUTE
#undef RS_LOAD
#undef RS_WRITE
}

__device__ __forceinline__ void phase_rwkv_out(const Params& P, int layer, int wg, int nwg) {
  const int c = mk_tid();
  const float* Y0 = (const float*)(PWS() + WS_Y); const float* Y1 = Y0 + (size_t)T * 512;
  const bf16_t* RG = (const bf16_t*)(PWS() + WS_RG); const bf16_t* CV = (const bf16_t*)(PWS() + WS_CV); bf16_t* MIX = (bf16_t*)(PWS() + WS_H);
  const float lg = PIN(I_RWLNG)[layer * 512 + c], lb = PIN(I_RWLNB)[layer * 512 + c];
  const int G = nwg;
  for (int t0 = (layer == 1 ? NCTX : 0) + wg; t0 < T; t0 += 4 * G) {
    float y[4], cv[4], rg[4];
#pragma unroll
    for (int u = 0; u < 4; ++u) { const int t = t0 + u * G; if (t < T) { y[u] = Y0[(size_t)t * 512 + c] + Y1[(size_t)t * 512 + c]; cv[u] = bf2f(CV[(size_t)t * 512 + c]); rg[u] = bf2f(RG[(size_t)t * 512 + c]); } else { y[u] = 0.f; cv[u] = 0.f; rg[u] = 0.f; } }
#pragma unroll
    for (int u = 0; u < 4; ++u) { const int t = t0 + u * G;
      const float mu = wave_sum(y[u]) * (1.0f / 64.0f); const float dlt = y[u] - mu; const float var = wave_sum(dlt * dlt) * (1.0f / 64.0f);
      const float yn = dlt * rsqrtf(var + 64e-5f) * lg + lb;
      if (t < T) MIX[(size_t)t * DM + c] = f2bf((yn + cv[u]) * rg[u]); }
  }
}

__device__ __forceinline__ void phase_ffn_act(const Params& P, int layer) {
  const bf16_t* GU = (const bf16_t*)(PWS() + WS_GU); bf16_t* ACT = (bf16_t*)(PWS() + WS_ACT);
  const float* fw = PIN(I_FCONV) + (size_t)layer * 3 * DFF; const float* fb = PIN(I_FCONVB) + (size_t)layer * DFF;
  const int run_lo = (layer == 1) ? NCTX / 32 : 0, nruns = T / 32 - run_lo;
  for (int idx = mk_bid() * NTH + mk_tid(); idx < nruns * 704; idx += mk_nblk() * NTH) {
    const int cgp = idx % 704, run = run_lo + idx / 704, c0 = cgp * 8, t0 = run * 32;
    const int lo = t0 < NCTX ? 0 : NCTX, hi = t0 < NCTX ? NCTX : T;
    float w0[8], w1[8], w2[8], bb[8];
#pragma unroll
    for (int i = 0; i < 8; ++i) { w0[i] = fw[c0 + i]; w1[i] = fw[DFF + c0 + i]; w2[i] = fw[2 * DFF + c0 + i]; bb[i] = fb[c0 + i]; }
    const bf16x8 zero = {0, 0, 0, 0, 0, 0, 0, 0};
    bf16x8 prev = (t0 - 1 >= lo) ? *(const bf16x8*)(GU + (size_t)(t0 - 1) * NGU + c0) : zero;
    bf16x8 cur = *(const bf16x8*)(GU + (size_t)t0 * NGU + c0);
    for (int tt = 0; tt < 32; ++tt) {
      const int t = t0 + tt;
      const bf16x8 nxt = (t + 1 < hi) ? *(const bf16x8*)(GU + (size_t)(t + 1) * NGU + c0) : zero;
      const bf16x8 up = *(const bf16x8*)(GU + (size_t)t * NGU + DFF + c0);
      float o[8];
#pragma unroll
      for (int i = 0; i < 8; ++i) { const float g = bb[i] + w0[i] * bf2f((bf16_t)prev[i]) + w1[i] * bf2f((bf16_t)cur[i]) + w2[i] * bf2f((bf16_t)nxt[i]); o[i] = siluf_(g) * bf2f((bf16_t)up[i]); }
      u32x4 w; w.x = cvtpk(o[0], o[1]); w.y = cvtpk(o[2], o[3]); w.z = cvtpk(o[4], o[5]); w.w = cvtpk(o[6], o[7]);
      *(u32x4*)(ACT + (size_t)t * DFF + c0) = w;
      prev = cur; cur = nxt;
    }
  }
}

namespace at2 {
constexpr int DQK = 192, DV = 128, QBLK = 32, KVBLK = 64;
constexpr float SCALE = 0.07216878364870322f;
constexpr float THR = 8.f;
#ifndef ATT_NQREG
#define ATT_NQREG 12
#endif
constexpr int NQREG = ATT_NQREG;
constexpr int SHM_V = KVBLK * DV * 2, SHM_K = KVBLK * DQK * 2, SHM_ATTN = 3 * SHM_V + 3 * SHM_K + 8 * 64 * 4,     SHM_TOTAL = SHM_ATTN + (12 - NQREG) * 8192;
#define KSWZ(row, colB) ((row) * 384 + ((colB) ^ (((row) & 7) << 4)))
#define SBAR() __builtin_amdgcn_sched_barrier(0)
__device__ __forceinline__ int crow(int r, int hi) { return (r & 3) + 8 * (r >> 2) + 4 * hi; }

__device__ __forceinline__ void partialSM(f32x16& p0, f32x16& p1, float& m_reg, float& mn, float& alpha) {
  constexpr float C = SCALE * 1.4426950408889634f;
  float pmax = p0[0];
#pragma unroll
  for (int r = 1; r < 16; ++r) pmax = fmaxf(pmax, p0[r]);
#pragma unroll
  for (int r = 0; r < 16; ++r) pmax = fmaxf(pmax, p1[r]);
  { auto rr = __builtin_amdgcn_permlane32_swap(__float_as_uint(pmax), __float_as_uint(pmax), false, false);
    pmax = fmaxf(__uint_as_float(rr[0]), __uint_as_float(rr[1])); }
  if (__builtin_expect(__all(pmax - m_reg <= THR / SCALE), 1)) { mn = m_reg; alpha = 1.f; }
  else { mn = fmaxf(m_reg, pmax); alpha = __builtin_amdgcn_exp2f((m_reg - mn) * C); m_reg = mn; }
  const float mnC = -mn * C;
#pragma unroll
  for (int r = 0; r < 16; ++r) p0[r] = fmaf(p0[r], C, mnC);
#pragma unroll
  for (int r = 0; r < 16; ++r) p1[r] = fmaf(p1[r], C, mnC);
#pragma unroll
  for (int r = 0; r < 16; ++r) p0[r] = __builtin_amdgcn_exp2f(p0[r]);
}
__device__ __forceinline__ void finishSM(f32x16& p0, f32x16& p1, float alpha, float& l_reg, bf16x8& pa0, bf16x8& pa1, bf16x8& pa2, bf16x8& pa3) {
#pragma unroll
  for (int r = 0; r < 16; ++r) p1[r] = __builtin_amdgcn_exp2f(p1[r]);
  float ps = 0;
#pragma unroll
  for (int r = 0; r < 16; ++r) ps += p0[r];
#pragma unroll
  for (int r = 0; r < 16; ++r) ps += p1[r];
  { auto rr = __builtin_amdgcn_permlane32_swap(__float_as_uint(ps), __float_as_uint(ps), false, false);
    ps = __uint_as_float(rr[0]) + __uint_as_float(rr[1]); }
  l_reg = l_reg * alpha + ps;
#define PK4(P, BASE, OUT) do { unsigned a0 = cvtpk(P[BASE + 0], P[BASE + 1]), a1 = cvtpk(P[BASE + 2], P[BASE + 3]);   \
    unsigned b0 = cvtpk(P[BASE + 4], P[BASE + 5]), b1 = cvtpk(P[BASE + 6], P[BASE + 7]);                              \
    auto r0 = __builtin_amdgcn_permlane32_swap(a0, b0, false, false); auto r1 = __builtin_amdgcn_permlane32_swap(a1, b1, false, false); \
    u32x4 w = {r0[0], r1[0], r0[1], r1[1]}; OUT = *reinterpret_cast<bf16x8*>(&w); } while (0)
  PK4(p0, 0, pa0); PK4(p0, 8, pa1); PK4(p1, 0, pa2); PK4(p1, 8, pa3);
#undef PK4
}
__device__ __forceinline__ void qkt(f32x16& p0, f32x16& p1, const char* Ks, const bf16x8* qr, const char* qsp, int r32, int hi) {
  p0 = f32x16{}; p1 = f32x16{};
#pragma unroll
  for (int d0 = 0; d0 < 12; ++d0) { const int cb = (d0 * 16 + hi * 8) * 2;
    const bf16x8 b0 = *reinterpret_cast<const bf16x8*>(Ks + KSWZ(r32, cb));
    const bf16x8 b1 = *reinterpret_cast<const bf16x8*>(Ks + KSWZ(32 + r32, cb));
    const bf16x8 qv = (d0 < NQREG) ? qr[d0 < NQREG ? d0 : 0] : *reinterpret_cast<const bf16x8*>(qsp + (d0 - NQREG) * 8192);
    p0 = __builtin_amdgcn_mfma_f32_32x32x16_bf16(b0, qv, p0, 0, 0, 0);
    p1 = __builtin_amdgcn_mfma_f32_32x32x16_bf16(b1, qv, p1, 0, 0, 0); }
}
__device__ __forceinline__ int v_st(int k, int c) { const int kk = (k & ~0xC) | ((k & 4) << 1) | ((k & 8) >> 1); return ((kk >> 3) * 4 + (c >> 5)) * 512 + ((kk & 7) * 32 + (c & 31)) * 2; }
__device__ __forceinline__ int v_rd_base(int lane) { return ((lane & 3) << 3) | (((lane >> 2) & 3) << 6) | (((lane >> 4) & 1) << 5) | (((lane >> 5) & 1) << 8); }
constexpr int v_rd_off(int d0, int ks, int half) { return d0 * 512 + ks * 4096 + half * 2048; }
template <int OFF> __device__ __forceinline__ s16x4 tr_read(int vb) {
  s16x4 r; asm volatile("ds_read_b64_tr_b16 %0, %1 offset:%2" : "=&v"(r) : "v"(vb), "i"(OFF) : "memory"); return r;
}
template <int D0> __device__ __forceinline__ void pv_one(f32x16& od, int vb, bf16x8 pa0, bf16x8 pa1, bf16x8 pa2, bf16x8 pa3) {
  const s16x4 l0 = tr_read<v_rd_off(D0, 0, 0)>(vb), h0 = tr_read<v_rd_off(D0, 0, 1)>(vb), l1 = tr_read<v_rd_off(D0, 1, 0)>(vb), h1 = tr_read<v_rd_off(D0, 1, 1)>(vb);
  const s16x4 l2 = tr_read<v_rd_off(D0, 2, 0)>(vb), h2 = tr_read<v_rd_off(D0, 2, 1)>(vb), l3 = tr_read<v_rd_off(D0, 3, 0)>(vb), h3 = tr_read<v_rd_off(D0, 3, 1)>(vb);
  asm volatile("s_waitcnt lgkmcnt(0)" ::: "memory"); SBAR();
#define PK(L, H) (bf16x8){L[0], L[1], L[2], L[3], H[0], H[1], H[2], H[3]}
  od = __builtin_amdgcn_mfma_f32_32x32x16_bf16(pa0, PK(l0, h0), od, 0, 0, 0);
  od = __builtin_amdgcn_mfma_f32_32x32x16_bf16(pa1, PK(l1, h1), od, 0, 0, 0);
  od = __builtin_amdgcn_mfma_f32_32x32x16_bf16(pa2, PK(l2, h2), od, 0, 0, 0);
  od = __builtin_amdgcn_mfma_f32_32x32x16_bf16(pa3, PK(l3, h3), od, 0, 0, 0);
#undef PK
}
__device__ __forceinline__ void pv_d0(f32x16* o, int vb, bf16x8 pa0, bf16x8 pa1, bf16x8 pa2, bf16x8 pa3) {
  pv_one<0>(o[0], vb, pa0, pa1, pa2, pa3); pv_one<1>(o[1], vb, pa0, pa1, pa2, pa3); pv_one<2>(o[2], vb, pa0, pa1, pa2, pa3); pv_one<3>(o[3], vb, pa0, pa1, pa2, pa3);
}
__device__ __forceinline__ void rope_pair(bf16x8& A, bf16x8& B, float pos, int hi) {
  float oa[8], ob[8];
#pragma unroll
  for (int e = 0; e < 8; ++e) {
    const float inv = exp2f(-(float)(hi * 8 + e) * (13.287712379549449f / 16.0f));
    const float sn = __sinf(pos * inv), cs = __cosf(pos * inv);
    const float a = bf2f((bf16_t)A[e]), b = bf2f((bf16_t)B[e]);
    oa[e] = a * cs - b * sn; ob[e] = a * sn + b * cs;
  }
  u32x4 wa = {cvtpk(oa[0], oa[1]), cvtpk(oa[2], oa[3]), cvtpk(oa[4], oa[5]), cvtpk(oa[6], oa[7])};
  u32x4 wb = {cvtpk(ob[0], ob[1]), cvtpk(ob[2], ob[3]), cvtpk(ob[4], ob[5]), cvtpk(ob[6], ob[7])};
  A = *reinterpret_cast<bf16x8*>(&wa); B = *reinterpret_cast<bf16x8*>(&wb);
}

__device__ __forceinline__ void attn_unit(const bf16_t* __restrict__ Q, const bf16_t* __restrict__ KV, const bf16_t* __restrict__ KR, bf16_t* __restrict__ MIX,
                                          int q0, int h, int kv0, int seq, bool rope_q, char* lds, bf16_t* __restrict__ part_o, float* __restrict__ part_ml) {
  const int tid = mk_tid(), wid = tid >> 6, lane = tid & 63, r32 = lane & 31, hi = lane >> 5;
  char* V_lds = lds; char* K_lds = lds + 3 * SHM_V;
  float* ws = (float*)(lds + 3 * SHM_V + 3 * SHM_K) + wid * 64; float* li_l = ws; float* al_l = ws + 32;
  float m_reg = -1e30f, l_reg = 0; f32x16 o[4] = {}; bf16x8 qr[12];
  const int qrow = q0 + wid * QBLK + r32;
  const bf16_t* Qw = Q + (size_t)qrow * 1536 + h * DQK + hi * 8;
#pragma unroll
  for (int d0 = 0; d0 < 12; ++d0) qr[d0] = *reinterpret_cast<const bf16x8*>(Qw + d0 * 16);
  if (rope_q) { const int tl = qrow - NCTX; rope_pair(qr[8], qr[9], (float)(tl >> 6), hi); rope_pair(qr[10], qr[11], (float)(tl & 63), hi); }
  char* qsp = lds + SHM_ATTN + tid * 16;
#pragma unroll
  for (int d0 = NQREG; d0 < 12; ++d0) *reinterpret_cast<bf16x8*>(qsp + (d0 - NQREG) * 8192) = qr[d0];
  const bf16_t* Kh = KV + (size_t)kv0 * 2048 + h * 256; const bf16_t* Vh = Kh + 128; KR += (size_t)kv0 * 64;
  const int sr = tid >> 4, sc = (tid & 15) * 8, vst0 = v_st(sr, sc), vst1 = v_st(32 + sr, sc);
  const int rr = tid >> 3, rc = (tid & 7) * 8;
  const int vb0 = (int)(uintptr_t)V_lds + v_rd_base(lane);
  bf16x8 vs0, vs1, ks0, ks1, ks2;
#define SLOAD(k0) do { vs0 = *(const bf16x8*)(Vh + (size_t)((k0) + sr) * 2048 + sc); vs1 = *(const bf16x8*)(Vh + (size_t)((k0) + 32 + sr) * 2048 + sc); \
    ks0 = *(const bf16x8*)(Kh + (size_t)((k0) + sr) * 2048 + sc); ks1 = *(const bf16x8*)(Kh + (size_t)((k0) + 32 + sr) * 2048 + sc); \
    ks2 = *(const bf16x8*)(KR + (size_t)((k0) + rr) * 64 + rc); } while (0)
#define SWRITE(b) do { *(bf16x8*)(V_lds + (b) * SHM_V + vst0) = vs0; *(bf16x8*)(V_lds + (b) * SHM_V + vst1) = vs1; const int kc = sc * 2; \
    *(bf16x8*)(K_lds + (b) * SHM_K + KSWZ(sr, kc)) = ks0; *(bf16x8*)(K_lds + (b) * SHM_K + KSWZ(32 + sr, kc)) = ks1; \
    *(bf16x8*)(K_lds + (b) * SHM_K + KSWZ(rr, 256 + rc * 2)) = ks2; } while (0)
#define SWAIT() asm volatile("s_waitcnt vmcnt(0)" ::: "memory")
#define RESC(a) do { if (__any((a) < 1.f)) { if (hi == 0) al_l[r32] = (a); asm volatile("s_waitcnt lgkmcnt(0)" ::: "memory"); \
    _Pragma("unroll") for (int d = 0; d < 4; ++d) _Pragma("unroll") for (int r = 0; r < 16; ++r) o[d][r] *= al_l[crow(r, hi)]; } } while (0)
  f32x16 pA0, pA1, pB0, pB1; float mnA, mnB, alA, alB; bf16x8 pa0, pa1, pa2, pa3; const int NT = seq / KVBLK;
  SLOAD(0); SWAIT(); SWRITE(0); __syncthreads();
  qkt(pA0, pA1, K_lds, qr, qsp, r32, hi); partialSM(pA0, pA1, m_reg, mnA, alA);
  SLOAD(KVBLK);
  SWAIT(); SWRITE(1); __syncthreads();
  int bp = 0, bc = 1, bn = 2;
  for (int j = 1; j + 1 < NT; j += 2) {
    SBAR(); qkt(pB0, pB1, K_lds + bc * SHM_K, qr, qsp, r32, hi);
    finishSM(pA0, pA1, alA, l_reg, pa0, pa1, pa2, pa3); SBAR();
    SLOAD((j + 1) * KVBLK); SBAR();
    pv_d0(o, vb0 + bp * SHM_V, pa0, pa1, pa2, pa3); partialSM(pB0, pB1, m_reg, mnB, alB);
    SWAIT(); SWRITE(bn);
    RESC(alB); __syncthreads();
    bp = bc; bc = bn; bn = (bn == 2) ? 0 : bn + 1;
    SBAR(); qkt(pA0, pA1, K_lds + bc * SHM_K, qr, qsp, r32, hi);
    finishSM(pB0, pB1, alB, l_reg, pa0, pa1, pa2, pa3); SBAR();
    SLOAD((j + 2) * KVBLK); SBAR();
    pv_d0(o, vb0 + bp * SHM_V, pa0, pa1, pa2, pa3); partialSM(pA0, pA1, m_reg, mnA, alA);
    SWAIT(); SWRITE(bn);
    RESC(alA); __syncthreads();
    bp = bc; bc = bn; bn = (bn == 2) ? 0 : bn + 1;
  }
  SBAR(); qkt(pB0, pB1, K_lds + bc * SHM_K, qr, qsp, r32, hi);
  finishSM(pA0, pA1, alA, l_reg, pa0, pa1, pa2, pa3); SBAR();
  pv_d0(o, vb0 + bp * SHM_V, pa0, pa1, pa2, pa3); partialSM(pB0, pB1, m_reg, mnB, alB);
  __syncthreads(); RESC(alB);
  finishSM(pB0, pB1, alB, l_reg, pa0, pa1, pa2, pa3); SBAR();
  pv_d0(o, vb0 + bc * SHM_V, pa0, pa1, pa2, pa3);
  if (hi == 0) li_l[r32] = l_reg; asm volatile("s_waitcnt lgkmcnt(0)" ::: "memory");
  float rli[16];
#pragma unroll
  for (int r = 0; r < 16; ++r) rli[r] = __builtin_amdgcn_rcpf(li_l[crow(r, hi)]);
  if (part_o == nullptr) {
    bf16_t* Ow = MIX + (size_t)(q0 + wid * QBLK) * DM + 1024 + h * DV;
#pragma unroll
    for (int r = 0; r < 16; ++r) { const int orow = crow(r, hi);
#pragma unroll
      for (int d0 = 0; d0 < 4; ++d0) Ow[(size_t)orow * DM + d0 * 32 + r32] = f2bf(o[d0][r] * rli[r]); }
  } else {
    bf16_t* Ow = part_o + (size_t)(wid * QBLK) * DV;
#pragma unroll
    for (int r = 0; r < 16; ++r) { const int orow = crow(r, hi);
#pragma unroll
      for (int d0 = 0; d0 < 4; ++d0) Ow[(size_t)orow * DV + d0 * 32 + r32] = f2bf(o[d0][r] * rli[r]); }
    if (hi == 0) { part_ml[(wid * QBLK + r32) * 2] = m_reg; part_ml[(wid * QBLK + r32) * 2 + 1] = l_reg; }
  }
  __syncthreads();
#undef SLOAD
#undef SWRITE
#undef SWAIT
#undef RESC
}
}

__device__ __forceinline__ int attn_np(int nwg) { return nwg == 192 ? 3 : (nwg == 224 ? 7 : 0); }
__device__ __forceinline__ int attn_part_tiles(int np, int p) { return 2 * (130 / np) + (p < (130 % np) ? 2 : 0); }
__device__ __forceinline__ void phase_attention(const Params& P, int layer, char* lds, int wg, int nwg) {
  const bf16_t* Q = (const bf16_t*)(PWS() + WS_Q); const bf16_t* KV = (const bf16_t*)(PWS() + WS_KV); const bf16_t* KR = (const bf16_t*)(PWS() + WS_KR);
  bf16_t* MIX = (bf16_t*)(PWS() + WS_H); bf16_t* PO = (bf16_t*)(PWS() + WS_PARTO); float* PML = (float*)(PWS() + WS_PARTML);
  const int np = attn_np(nwg);
  const int nwhole = np ? (512 / nwg) * nwg : 512, nparts = (512 - nwhole) * np, nctx = (layer == 0) ? 8 : 0;
  for (int it = wg; it < nwhole + nparts + nctx; it += nwg) {
    int q0, h, kv0 = 0, seq = T; bool lat = true; bf16_t* po = nullptr; float* pml = nullptr;
    if (it < nwhole) { q0 = NCTX + (it & 63) * 256; h = it >> 6; }
    else if (it < nwhole + nparts) { const int q = it - nwhole, u = nwhole + q / np, p = q % np; q0 = NCTX + (u & 63) * 256; h = u >> 6;
      int t0 = 0; for (int pp = 0; pp < p; ++pp) t0 += attn_part_tiles(np, pp);
      kv0 = t0 * 64; seq = attn_part_tiles(np, p) * 64; po = PO + (size_t)q * 256 * 128; pml = PML + (size_t)q * 512; }
    else { q0 = 0; h = it - nwhole - nparts; seq = NCTX; lat = false; }
    at2::attn_unit(Q, KV, KR, MIX, q0, h, kv0, seq, lat, lds, po, pml);
  }
}
__device__ __forceinline__ void phase_attn_merge(const Params& P, int wg, int nwg) {
  const int np = attn_np(nwg); if (np == 0) return;
  const int nwhole = (512 / nwg) * nwg;
  const bf16_t* PO = (const bf16_t*)(PWS() + WS_PARTO); const float* PML = (const float*)(PWS() + WS_PARTML); bf16_t* MIX = (bf16_t*)(PWS() + WS_H);
  constexpr float C = at2::SCALE * 1.4426950408889634f;
  const int tid = mk_tid(), row = tid >> 1, c0 = (tid & 1) * 64;
  for (int us = wg; us < 512 - nwhole; us += nwg) {
    const int u = nwhole + us, q0 = NCTX + (u & 63) * 256, h = u >> 6;
    float M = -3.0e38f;
    for (int p = 0; p < np; ++p) M = fmaxf(M, PML[(size_t)(us * np + p) * 512 + row * 2]);
    float acc[64];
#pragma unroll
    for (int i = 0; i < 64; ++i) acc[i] = 0.f;
    float ws = 0.f;
#pragma unroll 1
    for (int p = 0; p < np; ++p) {
      const float* ml = PML + (size_t)(us * np + p) * 512 + row * 2;
      const float w = ml[1] * exp2f((ml[0] - M) * C); ws += w;
      const bf16_t* src = PO + ((size_t)(us * np + p) * 256 + row) * 128 + c0;
#pragma unroll
      for (int cc = 0; cc < 64; cc += 8) { const bf16x8 x = *(const bf16x8*)(src + cc);
#pragma unroll
        for (int i = 0; i < 8; ++i) acc[cc + i] += w * bf2f((bf16_t)x[i]); }
    }
    const float inv = 1.0f / ws;
#pragma unroll
    for (int cc = 0; cc < 64; cc += 8) {
      u32x4 o; o.x = cvtpk(acc[cc] * inv, acc[cc + 1] * inv); o.y = cvtpk(acc[cc + 2] * inv, acc[cc + 3] * inv); o.z = cvtpk(acc[cc + 4] * inv, acc[cc + 5] * inv); o.w = cvtpk(acc[cc + 6] * inv, acc[cc + 7] * inv);
      *(u32x4*)(MIX + (size_t)(q0 + row) * DM + 1024 + h * 128 + c0 + cc) = o;
    }
  }
}

#ifndef REP_ATT
#define REP_ATT 1
#endif
#ifndef REP_SCAN
#define REP_SCAN 1
#endif
#ifndef REP_PREP
#define REP_PREP 1
#endif
#ifndef REP_GU
#define REP_GU 1
#endif
#ifndef REP_MISC
#define REP_MISC 1
#endif
#ifndef N_SCAN_WG
#define N_SCAN_WG 64
#endif
__device__ __forceinline__ void grid_barrier(unsigned* ctr, unsigned target) {
  asm volatile("s_waitcnt vmcnt(0) lgkmcnt(0)" ::: "memory");
  __syncthreads();
  if (mk_tid() == 0) {
    __builtin_amdgcn_fence(__ATOMIC_RELEASE, "agent");
    __hip_atomic_fetch_add(ctr, 1u, __ATOMIC_RELAXED, __HIP_MEMORY_SCOPE_AGENT);
    while (__hip_atomic_load(ctr, __ATOMIC_RELAXED, __HIP_MEMORY_SCOPE_AGENT) < target) __builtin_amdgcn_s_sleep(2);
    __builtin_amdgcn_fence(__ATOMIC_ACQUIRE, "agent");
  }
  __syncthreads();
}
__device__ __forceinline__ void grid_arrive(unsigned* ctr) {
  asm volatile("s_waitcnt vmcnt(0) lgkmcnt(0)" ::: "memory");
  __syncthreads();
  if (mk_tid() == 0) { __builtin_amdgcn_fence(__ATOMIC_RELEASE, "agent"); __hip_atomic_fetch_add(ctr, 1u, __ATOMIC_RELAXED, __HIP_MEMORY_SCOPE_AGENT); }
}
enum { K_MOD = 0, K_NORM1, K_GEMM_IN, K_PREP, K_MIX, K_RWOUT, K_GEMM_OUT, K_NORM2, K_GEMM_GU, K_ACT, K_GEMM_DN, K_FINAL };
constexpr int STEPS_PER_LAYER = 10, N_STEPS = 1 + 2 * STEPS_PER_LAYER + 1;
__global__ void __launch_bounds__(NTH) fwd_megakernel(Params P_arg) {
  extern __shared__ __attribute__((aligned(16))) unsigned char lds[];
  cg::grid_group grid = cg::this_grid();
  const int lo = P_arg.ph_lo, hi = P_arg.ph_hi;
  unsigned nbar = 0, nsub = 0, nscn = 0;
#pragma unroll 1
  for (int st = lo; st < hi; ++st) {
    const Params& P = P_arg;
    int kind, layer = 0;
    if (st == 0) kind = K_MOD; else if (st == N_STEPS - 1) kind = K_FINAL; else { layer = (st - 1) / STEPS_PER_LAYER; kind = K_NORM1 + (st - 1) % STEPS_PER_LAYER; }
    const bool last = (layer == 1);
    float* ldsf = (float*)lds;
    bool sync_after = true;
    switch (kind) {
      case K_MOD: for (int rep = 0; rep < REP_MISC; ++rep) phase_mod(P, ldsf); break;
      case K_NORM1: for (int rep = 0; rep < REP_MISC; ++rep) phase_convert(P, layer, ldsf); break;
      case K_PREP: for (int rep = 0; rep < REP_PREP; ++rep) phase_prep<0>(P, layer, ldsf, mk_bid(), mk_nblk()); break;
      case K_MIX: {
        const int G = mk_nblk();
        const int vcu = (G % 8 == 0) ? (mk_bid() % 8) * (G / 8) + mk_bid() / 8 : mk_bid();
        const int nscan = (G >= 2 * N_SCAN_WG) ? N_SCAN_WG : 0;
        unsigned* sbar = (unsigned*)(PWS() + WS_BAR) + 32;
        const int sg = vcu - nscan, SG = G - nscan;
        const unsigned per_layer = (unsigned)(G + 2 * SG), base = per_layer * (unsigned)layer;
        phase_prep<1>(P, layer, ldsf, vcu, G);
        if (vcu < nscan) {
          grid_arrive(sbar);
          for (int sc = vcu; sc < ((N_SCAN_WG == 32) ? 32 : 64); sc += nscan) rwkv_scan<(N_SCAN_WG == 32) ? 8 : 4>(P, sc, ldsf);
        } else {
          grid_barrier(sbar, base + (unsigned)G);
          if (nscan == 0) { for (int sc = vcu; sc < ((N_SCAN_WG == 32) ? 32 : 64); sc += G) rwkv_scan<(N_SCAN_WG == 32) ? 8 : 4>(P, sc, ldsf); __syncthreads(); }
#pragma unroll 1
          for (int q = 0; q < 2; ++q) {
            const size_t ro = (q == 0 && last) ? NCTX : 0;
            const bf16_t* A = (const bf16_t*)(PWS() + (q ? WS_KVN : WS_QN)) + ro * 512; const bf16_t* Bt = (const bf16_t*)(PWS() + (q ? WS_WKV : WS_WQ));
            EpiStore E{(bf16_t*)(PWS() + (q ? WS_KV : WS_Q)) + ro * 1536, q ? 2048 : 1536};
            run_gemm(lds, A, Bt, T - (int)ro, q ? 2048 : 1536, q ? 256 : 512, E, sg, SG);
          }
          phase_lru_agg(P, sg, SG);
          grid_barrier(sbar, base + (unsigned)(G + SG));
          phase_attention(P, layer, (char*)lds, sg, SG);
          __syncthreads();
          phase_lru_out(P, layer, ldsf, sg, SG);
          grid_barrier(sbar, base + per_layer);
          phase_attn_merge(P, sg, SG);
        }
      } break;
      case K_RWOUT: phase_rwkv_out(P, layer, mk_bid(), mk_nblk()); break;
      case K_ACT: for (int rep = 0; rep < REP_MISC; ++rep) phase_ffn_act(P, layer); break;
      case K_FINAL: phase_final_norm(P); break;
      default: break;
    }
    if (kind == K_NORM1 || kind == K_NORM2) for (int rep = 0; rep < REP_MISC; ++rep) phase_norm(P, layer, kind == K_NORM2 ? 1 : 0, kind == K_NORM2 && last);
    if (kind == K_GEMM_IN || kind == K_GEMM_GU) {
      const bf16_t* A; const bf16_t* Bt; bf16_t* O; int M = T, N, K;
      if (kind == K_GEMM_IN) { A = (const bf16_t*)(PWS() + WS_H); Bt = (const bf16_t*)(PWS() + WS_WIN); O = (bf16_t*)(PWS() + WS_COLS); N = NIN; K = DM; }
      else { const size_t ro = last ? NCTX : 0; A = (const bf16_t*)(PWS() + WS_H) + ro * DM; Bt = (const bf16_t*)(PWS() + WS_WGU); O = (bf16_t*)(PWS() + WS_GU) + ro * NGU; M = last ? T - NCTX : T; N = NGU; K = DM; }
      EpiStore E{O, N};
      run_gemm(lds, A, Bt, M, N, K, E, mk_bid(), mk_nblk());
    }
    if (kind == K_GEMM_OUT || kind == K_GEMM_DN) {
      const float* mod_l = (const float*)(PWS() + WS_MOD) + (size_t)(layer * 2 + 0) * 12288; const float* mod_c = mod_l + 12288;
      const int goff = (kind == K_GEMM_OUT) ? 4096 : 10240;
      EpiResid E{(const float*)(PWS() + WS_XC), POUT(), (float*)(PWS() + WS_XC), POUT(), mod_c + goff, mod_l + goff, NCTX};
      if (kind == K_GEMM_OUT && layer == 0) { E.src_c = PIN(I_CTX); E.src_l = PIN(I_X); }
      const int Kf = (kind == K_GEMM_OUT) ? DM : DFF;
      const bf16_t* A0 = (kind == K_GEMM_OUT) ? (const bf16_t*)(PWS() + WS_H) : (const bf16_t*)(PWS() + WS_ACT);
      const bf16_t* Bt = (kind == K_GEMM_OUT) ? (const bf16_t*)(PWS() + WS_WOUT) : (const bf16_t*)(PWS() + WS_WDN);
      run_gemm(lds, A0 + (size_t)NCTX * Kf, Bt, T - NCTX, DM, Kf, E, mk_bid(), mk_nblk());
      if (!last) {
        EpiResidAtomic EA{(float*)(PWS() + WS_XC), mod_c + goff};
        run_gemm(lds, A0, Bt, (Kf / 512) * 256, DM, 512, EA, mk_bid(), mk_nblk(), Kf, 512);
      }
    }
    if (sync_after && st + 1 < hi) {
      if (st == lo) grid.sync();
      else { ++nbar; grid_barrier((unsigned*)(PWS() + WS_BAR), nbar * mk_nblk()); }
    }
  }
}

#ifndef MK_PER_PHASE
#define MK_PER_PHASE 0
#endif
extern "C" void kernel_launch(void* const* d_in, const int* in_sizes, int n_in, void* d_out, int out_size, void* d_ws, size_t ws_size, hipStream_t stream) {
  static int grid = 0;
  if (grid == 0) {
    if (n_in != 42 || out_size != (T - NCTX) * DM || ws_size < WS_END) { fprintf(stderr, "kernel_launch: unexpected shapes (n_in %d out %d ws %zu need %zu)\n", n_in, out_size, ws_size, (size_t)WS_END); grid = -1; return; }
    int dev = 0, cus = 0, per_cu = 0;
    (void)hipGetDevice(&dev); (void)hipDeviceGetAttribute(&cus, hipDeviceAttributeMultiprocessorCount, dev);
    if (hipFuncSetAttribute((const void*)fwd_megakernel, hipFuncAttributeMaxDynamicSharedMemorySize, LDS_BYTES) != hipSuccess) { fprintf(stderr, "kernel_launch: hipFuncSetAttribute failed\n"); grid = -1; return; }
    if (hipOccupancyMaxActiveBlocksPerMultiprocessor(&per_cu, (const void*)fwd_megakernel, NTH, LDS_BYTES) != hipSuccess || per_cu < 1) per_cu = 1;
    (void)hipGetLastError();
    grid = (cus > 0 ? cus : 256) * per_cu;
  }
  if (grid < 0) return;
  if (hipMemsetAsync((char*)d_ws + WS_BAR, 0, 256, stream) != hipSuccess) { fprintf(stderr, "kernel_launch: memset failed\n"); return; }
  Params p{};
  for (int i = 0; i < 42; ++i) p.in[i] = (const float*)d_in[i];
  p.out = (float*)d_out; p.ws = (unsigned char*)d_ws;
#if MK_PER_PHASE
  for (int st = 0; st < N_STEPS; ++st) { p.ph_lo = st; p.ph_hi = st + 1; hipLaunchKernelGGL(fwd_megakernel, dim3(grid), dim3(NTH), LDS_BYTES, stream, p); }
#else
  p.ph_lo = 0; p.ph_hi = N_STEPS;
  void* args[] = {&p};
  hipError_t e = hipLaunchCooperativeKernel((const void*)fwd_megakernel, dim3(grid), dim3(NTH), args, LDS_BYTES, stream);
  if (e != hipSuccess) fprintf(stderr, "cooperative launch failed: %s (grid %d)\n", hipGetErrorString(e), grid);
#endif
}
```

```cpp
#include <hip/hip_runtime.h>
#include <hip/hip_cooperative_groups.h>
#include <cstdio>
#include <cstdint>
__device__ __forceinline__ int mk_tid() { int t = (int)threadIdx.x; asm volatile("" : "+v"(t)); return t; }
__device__ __forceinline__ int mk_bid() { int b = (int)blockIdx.x; asm volatile("" : "+s"(b)); return b; }
__device__ __forceinline__ int mk_nblk() { int g = (int)gridDim.x; asm volatile("" : "+s"(g)); return g; }
template <int OFF> __device__ __forceinline__ unsigned long long kp_load() {
  unsigned long long r; auto kp = __builtin_amdgcn_kernarg_segment_ptr();
  asm volatile("s_load_dwordx2 %0, %1, %2\n\ts_waitcnt lgkmcnt(0)" : "=s"(r) : "s"(kp), "i"(OFF));
  return r;
}
#define PIN(i) ((const float*)kp_load<8 * (i)>())
#define POUT() ((float*)kp_load<8 * 42>())
#define PWS() ((unsigned char*)kp_load<8 * 43>())
namespace pg8 {
#define PG8_LAS __attribute__((address_space(3)))
typedef unsigned short bf16_t;
typedef short bf16x8 __attribute__((ext_vector_type(8)));
typedef float f32x4 __attribute__((ext_vector_type(4)));
typedef unsigned u32x4 __attribute__((ext_vector_type(4)));
constexpr int BM = 256, BK = 64, HALF = 128, HTB = HALF * BK * 2  , STAGE_BYTES = 8 * HTB, NXCD = 8, WGM = 8;

__host__ __device__ __forceinline__ int lds_byte(int r, int c) { const int st = (r >> 4) * 2 + (c >> 5), rr = r & 15, cc = c & 31, ob = rr * 64 + cc * 2; return st * 1024 + (ob ^ (((ob >> 9) & 1) << 5)); }
__host__ __device__ __forceinline__ void stage_rc(int b, int& R, int& C) { const int st = b / 1024, sb = b % 1024, swz = sb ^ (((sb >> 9) & 1) << 5); R = (st >> 1) * 16 + swz / 64; C = (st & 1) * 32 + (swz % 64) / 2; }
__host__ __device__ __forceinline__ int perm32(int rho) { const int n = rho >> 4, i = rho & 15; return 8 * (i >> 2) + 4 * n + (i & 3); }

struct Unit { int pm, pn; };
struct Gemm { const bf16_t* A; const bf16_t* Bt; int M, N, K; int ld; int ksplit; };

struct StaticOrder {
    int nM, nN, nwg, G, c;
    __host__ __device__ void init(int M, int N, int G_, int c_) { nM = M / BM; nN = N / BM; nwg = nM * nN; G = G_; c = c_; }
    __host__ __device__ bool next(int i, Unit& u) const {
        const long L = (long)i * G + c; if (L >= nwg) return false;
        int wgid = (int)L; { const int q = nwg / NXCD, r = nwg % NXCD, xcd = wgid % NXCD, off = wgid / NXCD; wgid = (xcd < r ? xcd * (q + 1) : r * (q + 1) + (xcd - r) * q) + off; }
        const int nig = WGM * nN, gid = wgid / nig, fm = gid * WGM, gsz = (nM - fm) < WGM ? (nM - fm) : WGM;
        u.pm = fm + ((wgid % nig) % gsz); u.pn = (wgid % nig) / gsz; return true;
    }
    __device__ __forceinline__ void a_ready(const Unit&) const {}
    __device__ __forceinline__ void done(const Unit&) const {}
};
__device__ __forceinline__ unsigned cvt_pk_bf16(float lo, float hi) { unsigned r; asm volatile("v_cvt_pk_bf16_f32 %0, %1, %2" : "=v"(r) : "v"(lo), "v"(hi)); return r; }
typedef float f32x2 __attribute__((ext_vector_type(2)));
template <class Epi, class Sched, bool STAMP = false>
__device__ __forceinline__ void gemm_phase(PG8_LAS unsigned char* lds, const Gemm g, const Sched& S, const Epi& E, unsigned long long* stamps) {
    const int tid = mk_tid(), wid = __builtin_amdgcn_readfirstlane(tid >> 6), lane = tid & 63, wr = wid >> 2, wc = wid & 3, fr = lane & 15, fq = lane >> 4;
    const int K = g.K, nt = K / BK, LD = g.ld; const size_t ksb = (size_t)g.ksplit * 2;
    int ts_lo = 0, ts_hi = 0, nts = 0; const unsigned long long rt_entry = STAMP ? (unsigned long long)wall_clock64() : 0ull;
#define PG8_STAMP() do { if (STAMP && wid == 0 && nts < 64) { const unsigned long long _c = (unsigned long long)clock64(); \
        ts_lo = (lane == nts) ? (int)(unsigned)_c : ts_lo; ts_hi = (lane == nts) ? (int)(unsigned)(_c >> 32) : ts_hi; ++nts; } } while (0)
    PG8_STAMP();
    unsigned voffA[2], voffB[2];
#pragma unroll
    for (int i = 0; i < 2; ++i) { int R, C; stage_rc(tid * 16 + i * 8192, R, C); const int Rb = Epi::PERM ? ((R & ~31) + perm32(R & 31)) : R;
        voffA[i] = (unsigned)(R * LD + C) * 2u; voffB[i] = (unsigned)(Rb * LD + C) * 2u; }
    const size_t kstep = (size_t)(BK * 2);
    const size_t hstep = (size_t)HALF * LD * 2;
    const size_t tstep = 2 * hstep;
    const unsigned ldsw = (unsigned)wid * 1024u;
    const int aoff = lds_byte(wr * 64 + fr, fq * 8), boff = lds_byte(wc * 32 + fr, fq * 8);
#define PG8_SA(b, h) (((b) * 2 + (h)) * HTB)
#define PG8_SB(b, h) ((4 + (b) * 2 + (h)) * HTB)
#define PG8_STAGE(bufoff, gbase, voff) do { _Pragma("unroll") for (int _i = 0; _i < 2; ++_i) \
        __builtin_amdgcn_global_load_lds((const unsigned*)((const char*)(gbase) + (voff)[_i]), (PG8_LAS unsigned*)(lds + (bufoff) + ldsw + _i * 8192), 16, 0, 0); } while (0)
#define PG8_LDA(dst, b, h) do { _Pragma("unroll") for (int m = 0; m < 4; ++m) _Pragma("unroll") for (int k = 0; k < 2; ++k) dst[m][k] = *(const PG8_LAS bf16x8*)(lds + PG8_SA(b, h) + aoff + m * 2048 + k * 1024); } while (0)
#define PG8_LDB(dst, b, h) do { _Pragma("unroll") for (int n = 0; n < 2; ++n) _Pragma("unroll") for (int k = 0; k < 2; ++k) dst[n][k] = *(const PG8_LAS bf16x8*)(lds + PG8_SB(b, h) + boff + n * 2048 + k * 1024); } while (0)
#define PG8_MMA(ai, bj, At, Bt) do { __builtin_amdgcn_s_setprio(1); _Pragma("unroll") for (int m = 0; m < 4; ++m) _Pragma("unroll") for (int n = 0; n < 2; ++n) _Pragma("unroll") for (int k = 0; k < 2; ++k) \
        acc[ai][bj][m][n] = __builtin_amdgcn_mfma_f32_16x16x32_bf16(Bt[n][k], At[m][k], acc[ai][bj][m][n], 0, 0, 0); __builtin_amdgcn_s_setprio(0); } while (0)
#define PG8_WAIT_V(n) asm volatile("s_waitcnt vmcnt(" #n ")" ::: "memory")
#define PG8_WAIT_L(n) asm volatile("s_waitcnt lgkmcnt(" #n ")" ::: "memory")
#define PG8_BAR __builtin_amdgcn_s_barrier()
#define PG8_SCHED __builtin_amdgcn_sched_barrier(0)
    Unit cur, nxt; int ui = 0;
    if (!S.next(0, cur)) return;
    f32x4 acc[2][2][4][2];
#pragma unroll
    for (int a = 0; a < 2; ++a)
#pragma unroll
        for (int b = 0; b < 2; ++b)
#pragma unroll
            for (int m = 0; m < 4; ++m)
#pragma unroll
                for (int n = 0; n < 2; ++n) acc[a][b][m][n] = (f32x4){0.f, 0.f, 0.f, 0.f};
    bf16x8 At[4][2], B0[2][2], B1[2][2];
    const char* cA = (const char*)g.A + (ksb ? (size_t)cur.pm * ksb : (size_t)cur.pm * tstep); const char* cB = (const char*)g.Bt + (size_t)cur.pn * tstep + (size_t)cur.pm * ksb;
    S.a_ready(cur);
    PG8_STAGE(PG8_SB(0, 0), cB, voffB); PG8_STAGE(PG8_SA(0, 0), cA, voffA); PG8_STAGE(PG8_SB(0, 1), cB + hstep, voffB); PG8_STAGE(PG8_SA(0, 1), cA + hstep, voffA);
    if (wr == 1) PG8_BAR;
    PG8_WAIT_V(4); PG8_BAR;
    PG8_STAGE(PG8_SB(1, 0), cB + kstep, voffB); PG8_STAGE(PG8_SA(1, 0), cA + kstep, voffA); PG8_STAGE(PG8_SB(1, 1), cB + hstep + kstep, voffB);
    PG8_WAIT_V(6); PG8_BAR;
    PG8_STAMP();
    for (;;) {
        const bool has_next = S.next(ui + 1, nxt);
        const char* nA = has_next ? (const char*)g.A + (ksb ? (size_t)nxt.pm * ksb : (size_t)nxt.pm * tstep) : cA; const char* nB = has_next ? (const char*)g.Bt + (size_t)nxt.pn * tstep + (size_t)nxt.pm * ksb : cB;
        for (int t = 0; t < nt; t += 2) {
            const bool last = (t == nt - 2);
            const char* a1 = cA + (size_t)(t + 1) * kstep;
            const char* a2 = last ? nA : cA + (size_t)(t + 2) * kstep; const char* b2 = last ? nB : cB + (size_t)(t + 2) * kstep;
            const char* a3 = a2 + kstep; const char* b3 = b2 + kstep;
            if (last && has_next) S.a_ready(nxt);
            PG8_LDB(B0, 0, 0); PG8_SCHED; PG8_LDA(At, 0, 0); PG8_STAGE(PG8_SA(1, 1), a1 + hstep, voffA);
            PG8_WAIT_L(8); PG8_BAR; PG8_WAIT_L(0); PG8_MMA(0, 0, At, B0); PG8_BAR; PG8_SCHED;
            PG8_LDB(B1, 0, 1); PG8_STAGE(PG8_SB(0, 0), b2, voffB);
            PG8_BAR; PG8_WAIT_L(0); PG8_MMA(0, 1, At, B1); PG8_BAR;
            PG8_LDA(At, 0, 1); PG8_STAGE(PG8_SA(0, 0), a2, voffA);
            PG8_BAR; PG8_WAIT_L(0); PG8_MMA(1, 0, At, B0); PG8_BAR; PG8_SCHED;
            PG8_STAGE(PG8_SB(0, 1), b2 + hstep, voffB);
            PG8_WAIT_V(6); PG8_BAR; PG8_MMA(1, 1, At, B1); PG8_BAR;
            PG8_LDB(B0, 1, 0); PG8_SCHED; PG8_LDA(At, 1, 0); PG8_STAGE(PG8_SA(0, 1), a2 + hstep, voffA);
            PG8_WAIT_L(8); PG8_BAR; PG8_WAIT_L(0); PG8_MMA(0, 0, At, B0); PG8_BAR; PG8_SCHED;
            PG8_LDB(B1, 1, 1); PG8_STAGE(PG8_SB(1, 0), b3, voffB);
            PG8_BAR; PG8_WAIT_L(0); PG8_MMA(0, 1, At, B1); PG8_BAR;
            PG8_LDA(At, 1, 1); PG8_STAGE(PG8_SA(1, 0), a3, voffA);
            PG8_BAR; PG8_WAIT_L(0); PG8_MMA(1, 0, At, B0); PG8_BAR; PG8_SCHED;
            PG8_STAGE(PG8_SB(1, 1), b3 + hstep, voffB);
            PG8_WAIT_V(6); PG8_BAR; PG8_MMA(1, 1, At, B1); PG8_BAR;
        }
        PG8_STAMP();
        if constexpr (!Epi::AFTER_DRAIN) { E(acc, cur, wr, wc, fr, fq); S.done(cur); }
        PG8_STAMP();
        if (!has_next) break;
#pragma unroll
        for (int a = 0; a < 2; ++a)
#pragma unroll
            for (int b = 0; b < 2; ++b)
#pragma unroll
                for (int m = 0; m < 4; ++m)
#pragma unroll
                    for (int n = 0; n < 2; ++n) acc[a][b][m][n] = (f32x4){0.f, 0.f, 0.f, 0.f};
        cur = nxt; cA = nA; cB = nB; ++ui;
    }
    PG8_WAIT_V(0);
    if (wr == 0) PG8_BAR;
    PG8_BAR;
    if constexpr (Epi::AFTER_DRAIN) { E.fused(acc, cur, wr, wc, fr, fq, lds, wid, lane); S.done(cur); }
    PG8_STAMP();
    if (STAMP && wid == 0) { stamps[lane] = lane < nts ? (((unsigned long long)(unsigned)ts_hi << 32) | (unsigned)ts_lo) : 0ull;
        if (lane == 62) stamps[62] = rt_entry; if (lane == 63) stamps[63] = (unsigned long long)wall_clock64(); }
#undef PG8_STAMP
#undef PG8_SA
#undef PG8_SB
#undef PG8_STAGE
#undef PG8_LDA
#undef PG8_LDB
#undef PG8_MMA
#undef PG8_WAIT_V
#undef PG8_WAIT_L
#undef PG8_BAR
#undef PG8_SCHED
}
}

namespace cg = cooperative_groups;
typedef unsigned short bf16_t;
typedef short bf16x8 __attribute__((ext_vector_type(8)));
typedef short s16x4 __attribute__((ext_vector_type(4)));
typedef float f32x4 __attribute__((ext_vector_type(4)));
typedef float f32x8 __attribute__((ext_vector_type(8)));
typedef float f32x16 __attribute__((ext_vector_type(16)));
typedef unsigned u32x4 __attribute__((ext_vector_type(4)));
typedef unsigned u32x2 __attribute__((ext_vector_type(2)));

constexpr int T = 16640, NCTX = 256, DM = 2048, NTH = 512;
constexpr int NIN = 3840;
constexpr int DFF = 5632, NGU = 2 * DFF;
constexpr int C_LRU = 1760, C_MLA = 2784, C_VD = 3616;
constexpr int RECB = 896;
constexpr int LDS_BYTES = 150528;

constexpr size_t al256(size_t x) { return (x + 255) / 256 * 256; }
constexpr size_t WS_BAR = 0;
constexpr size_t WS_MOD = 256;
constexpr size_t WS_XC = al256(WS_MOD + 2 * 2 * 12288 * 4);
constexpr size_t WS_H = al256(WS_XC + (size_t)NCTX * DM * 4);
constexpr size_t WS_VF = al256(WS_H + (size_t)T * DM * 2);
constexpr size_t WS_WIN = al256(WS_VF + (size_t)T * 512 * 2);
constexpr size_t WS_WOUT = al256(WS_WIN + (size_t)NIN * DM * 2);
constexpr size_t WS_WQ = al256(WS_WOUT + (size_t)DM * DM * 2);
constexpr size_t WS_WKV = al256(WS_WQ + (size_t)1536 * 512 * 2);
constexpr size_t WS_WGU = al256(WS_WKV + (size_t)2048 * 256 * 2);
constexpr size_t WS_WDN = al256(WS_WGU + (size_t)NGU * DM * 2);
constexpr size_t WS_R = al256(WS_WDN + (size_t)DM * DFF * 2);
constexpr size_t WS_COLS = WS_R;
constexpr size_t WS_Q = WS_COLS;
constexpr size_t WS_KV = al256(WS_Q + (size_t)T * 1536 * 2);
constexpr size_t WS_REC = al256(WS_COLS + (size_t)T * NIN * 2);
constexpr size_t WS_Y = al256(WS_REC + (size_t)16 * T * RECB);
constexpr size_t WS_LAB = al256(WS_Y + (size_t)2 * T * 512 * 4);
constexpr size_t WS_GG = al256(WS_LAB + (size_t)T * 2048 * 2);
constexpr size_t WS_QN = al256(WS_GG + (size_t)T * 512 * 2);
constexpr size_t WS_KVN = al256(WS_QN + (size_t)T * 512 * 2);
constexpr size_t WS_KR = al256(WS_KVN + (size_t)T * 256 * 2);
constexpr size_t WS_RG = al256(WS_KR + (size_t)T * 64 * 2);
constexpr size_t WS_CV = al256(WS_RG + (size_t)T * 512 * 2);
constexpr size_t WS_AGG = al256(WS_CV + (size_t)T * 512 * 2);
constexpr size_t WS_MIX_END = al256(WS_AGG + (size_t)260 * 2048 * 4);
constexpr size_t WS_GU = WS_R;
constexpr size_t WS_ACT = al256(WS_GU + (size_t)T * NGU * 2);
constexpr size_t WS_FFN_END = al256(WS_ACT + (size_t)T * DFF * 2);
constexpr size_t WS_REND = WS_MIX_END > WS_FFN_END ? WS_MIX_END : WS_FFN_END;
constexpr size_t WS_PARTO = WS_REND;
constexpr size_t WS_PARTML = al256(WS_PARTO + (size_t)448 * 256 * 128 * 2);
constexpr size_t WS_END = al256(WS_PARTML + (size_t)448 * 512 * 4);
static_assert(WS_KV + (size_t)T * 2048 * 2 <= WS_REC, "Q|KV must fit in the cols buffer");

struct Params { const float* in[42]; float* out; unsigned char* ws; int ph_lo, ph_hi; };

enum { I_X = 0, I_C, I_CTX, I_CCTX, I_ADAW, I_ADAB, I_NORM1, I_NORM2, I_WIN, I_WOUT, I_RWCONV, I_RWCONVB, I_RWW0, I_RWWUP, I_RWA0, I_RWAUP, I_RWGUP,
       I_RWKK, I_RWKA, I_RWRK, I_RWLNG, I_RWLNB, I_RWV0, I_RWVDOWN, I_RWVUP, I_LRUCONV, I_LRUCONVB, I_LRUWA, I_LRUBA, I_LRUWX, I_LRUBX, I_LRULAM,
       I_QNORM, I_WQB, I_KVNORM, I_WKVB, I_WGATE, I_WUP, I_FCONV, I_FCONVB, I_WDOWN, I_FNORM };

__device__ __forceinline__ float bf2f(bf16_t b) { return __uint_as_float(((unsigned)b) << 16); }
__device__ __forceinline__ unsigned cvtpk(float lo, float hi) { unsigned r; asm volatile("v_cvt_pk_bf16_f32 %0, %1, %2" : "=v"(r) : "v"(lo), "v"(hi)); return r; }
__device__ __forceinline__ bf16_t f2bf(float f) { return (bf16_t)(cvtpk(f, 0.f) & 0xffffu); }
__device__ __forceinline__ float sigmoidf_(float x) { return __builtin_amdgcn_rcpf(1.0f + __expf(-x)); }
__device__ __forceinline__ float tanhf_(float x) { return 1.0f - 2.0f * __builtin_amdgcn_rcpf(1.0f + __expf(2.0f * x)); }
__device__ __forceinline__ float siluf_(float x) { return x * sigmoidf_(x); }
__device__ __forceinline__ float gelu_tanh(float x) { const float u = 0.7978845608028654f * (x + 0.044715f * x * x * x); return 0.5f * x * (1.0f + tanhf_(u)); }
__device__ __forceinline__ float wave_sum(float v) {
#pragma unroll
  for (int o = 32; o >= 1; o >>= 1) v += __shfl_xor(v, o);
  return v;
}
template <int CTRL> __device__ __forceinline__ float dpp_add(float x) {
  const int xi = __float_as_int(x);
  const int yi = __builtin_amdgcn_update_dpp(xi, xi, CTRL, 0xF, 0xF, false);
  return x + __int_as_float(yi);
}
__device__ __forceinline__ float fma_(float a, float b, float c) { float r; asm("v_fma_f32 %0, %1, %2, %3" : "=v"(r) : "v"(a), "v"(b), "v"(c)); return r; }
__device__ __forceinline__ float mul_(float a, float b) { float r; asm("v_mul_f32 %0, %1, %2" : "=v"(r) : "v"(a), "v"(b)); return r; }
__device__ __forceinline__ float add_(float a, float b) { float r; asm("v_add_f32 %0, %1, %2" : "=v"(r) : "v"(a), "v"(b)); return r; }
typedef float f32x2 __attribute__((ext_vector_type(2)));
__device__ __forceinline__ float dot4(f32x4 a, f32x4 b) { const f32x2 t = a.lo * b.lo + a.hi * b.hi; return t.x + t.y; }
__device__ __forceinline__ float row16_sum(float x) {
  x = dpp_add<0xB1>(x);
  x = dpp_add<0x4E>(x);
  x = dpp_add<0x141>(x);
  x = dpp_add<0x140>(x);
  return x;
}
__device__ __forceinline__ const float* resid_src(const Params& P, int layer, int t) {
  if (layer == 0) return t < NCTX ? PIN(I_CTX) + (size_t)t * DM : PIN(I_X) + (size_t)(t - NCTX) * DM;
  return t < NCTX ? (const float*)(PWS() + WS_XC) + (size_t)t * DM : POUT() + (size_t)(t - NCTX) * DM;
}
__device__ __forceinline__ float* resid_dst(const Params& P, int t) {
  return t < NCTX ? (float*)(PWS() + WS_XC) + (size_t)t * DM : POUT() + (size_t)(t - NCTX) * DM;
}
__device__ __forceinline__ int scan_pos_rev(int t) { return t < NCTX ? (NCTX - 1 - t) : (T + NCTX - 1 - t); }

__device__ __forceinline__ void phase_mod(const Params& P, float* lds) {
  const int tid = mk_tid(), cgp = tid & 15, rg = tid >> 4;
  float* mod = (float*)(PWS() + WS_MOD);
  const float* cvec = PIN(I_C); const float* ccvec = PIN(I_CCTX); const float* adaw = PIN(I_ADAW); const float* adab = PIN(I_ADAB);
  for (int item = mk_bid(); item < 2 * 192; item += mk_nblk()) {
    const int layer = item / 192, col0 = (item % 192) * 64;
    const float* W = adaw + (size_t)layer * DM * 12288 + col0 + cgp * 4;
    f32x4 al = {0.f, 0.f, 0.f, 0.f}, ac = {0.f, 0.f, 0.f, 0.f};
#pragma unroll 1
    for (int r0 = 0; r0 < 64; r0 += 8) {
      f32x4 wv[8]; float sl[8], sc[8];
#pragma unroll
      for (int r = 0; r < 8; ++r) { const int row = rg * 64 + r0 + r; wv[r] = *(const f32x4*)(W + (size_t)row * 12288); sl[r] = cvec[row]; sc[r] = ccvec[row]; }
#pragma unroll
      for (int r = 0; r < 8; ++r) { al += siluf_(sl[r]) * wv[r]; ac += siluf_(sc[r]) * wv[r]; }
    }
#pragma unroll
    for (int i = 0; i < 4; ++i) { lds[(rg * 2 + 0) * 64 + cgp * 4 + i] = al[i]; lds[(rg * 2 + 1) * 64 + cgp * 4 + i] = ac[i]; }
    __syncthreads();
    if (tid < 128) {
      const int which = tid >> 6, col = tid & 63; float sacc = 0.f;
      for (int g = 0; g < 32; ++g) sacc += lds[(g * 2 + which) * 64 + col];
      mod[(size_t)(layer * 2 + which) * 12288 + col0 + col] = sacc + adab[(size_t)layer * 12288 + col0 + col];
    }
    __syncthreads();
  }
}

struct CvtItem { const float* src; bf16_t* dst; int K, N, kt, ntile; bool valid; };
__device__ __forceinline__ CvtItem cvt_decode(const Params& P, int layer, int it) {
  CvtItem r; r.src = nullptr; r.dst = nullptr; r.K = 64; r.N = 0; r.kt = 0; r.ntile = 0; r.valid = false;
  int base = 0;
#define CVT_JOB(SRC, DST, KK, NN) do { const int nkt_ = (KK) / 64, cnt_ = nkt_ * (((NN) + 63) / 64); \
    if (!r.valid && it < base + cnt_) { const int tl_ = it - base; r.src = (SRC); r.dst = (DST); r.K = (KK); r.N = (NN); r.kt = tl_ % nkt_; r.ntile = tl_ / nkt_; r.valid = true; } base += cnt_; } while (0)
  CVT_JOB(PIN(I_WIN) + (size_t)layer * DM * 3616, (bf16_t*)(PWS() + WS_WIN), DM, 3616);
  CVT_JOB(PIN(I_RWVDOWN), (bf16_t*)(PWS() + WS_WIN) + (size_t)C_VD * DM, DM, (layer == 0) ? 0 : 32);
  CVT_JOB(PIN(I_WOUT) + (size_t)layer * DM * DM, (bf16_t*)(PWS() + WS_WOUT), DM, DM);
  CVT_JOB(PIN(I_WQB) + (size_t)layer * 512 * 1536, (bf16_t*)(PWS() + WS_WQ), 512, 1536);
  CVT_JOB(PIN(I_WKVB) + (size_t)layer * 256 * 2048, (bf16_t*)(PWS() + WS_WKV), 256, 2048);
  CVT_JOB(PIN(I_WGATE) + (size_t)layer * DM * DFF, (bf16_t*)(PWS() + WS_WGU), DM, DFF);
  CVT_JOB(PIN(I_WUP) + (size_t)layer * DM * DFF, (bf16_t*)(PWS() + WS_WGU) + (size_t)DFF * DM, DM, DFF);
  CVT_JOB(PIN(I_WDOWN) + (size_t)layer * DFF * DM, (bf16_t*)(PWS() + WS_WDN), DFF, DM);
#undef CVT_JOB
  return r;
}
__device__ __forceinline__ void cvt_load(const CvtItem& c, f32x4 (&v)[2]) {
  const int tid = mk_tid(), kr = tid >> 4, nc = (tid & 15) * 4, k0 = c.kt * 64, n0 = c.ntile * 64;
#pragma unroll
  for (int i = 0; i < 2; ++i) { v[i] = (f32x4){0.f, 0.f, 0.f, 0.f}; if (c.valid && n0 + nc < c.N) v[i] = *(const f32x4*)(c.src + (size_t)(k0 + kr + 32 * i) * c.N + n0 + nc); }
}
__device__ __forceinline__ void phase_convert(const Params& P, int layer, float* lds) {
  const int tid = mk_tid(), kr = tid >> 4, nc = (tid & 15) * 4, n = tid >> 3, kc = (tid & 7) * 8, G = mk_nblk();
  int it = mk_bid();
  CvtItem cur = cvt_decode(P, layer, it); f32x4 v[2]; cvt_load(cur, v);
  while (cur.valid) {
    const CvtItem nxt = cvt_decode(P, layer, it + G); f32x4 nv[2]; cvt_load(nxt, nv);
#pragma unroll
    for (int i = 0; i < 2; ++i) { const int k = kr + 32 * i;
      lds[(nc + 0) * 65 + k] = v[i][0]; lds[(nc + 1) * 65 + k] = v[i][1]; lds[(nc + 2) * 65 + k] = v[i][2]; lds[(nc + 3) * 65 + k] = v[i][3]; }
    __syncthreads();
    if (cur.ntile * 64 + n < cur.N) {
      const float* p = lds + n * 65 + kc;
      u32x4 w; w.x = cvtpk(p[0], p[1]); w.y = cvtpk(p[2], p[3]); w.z = cvtpk(p[4], p[5]); w.w = cvtpk(p[6], p[7]);
      *(u32x4*)(cur.dst + (size_t)(cur.ntile * 64 + n) * cur.K + cur.kt * 64 + kc) = w;
    }
    __syncthreads();
    cur = nxt; v[0] = nv[0]; v[1] = nv[1]; it += G;
  }
}

__device__ __forceinline__ void phase_norm(const Params& P, int layer, int which, bool skip_ctx) {
  const int lane = mk_tid() & 63, wave = mk_tid() >> 6;
  const float* g = P.in[which ? I_NORM2 : I_NORM1] + (size_t)layer * DM;
  const float* mod = (const float*)(PWS() + WS_MOD) + (size_t)layer * 2 * 12288;
  bf16_t* H = (bf16_t*)(PWS() + WS_H);
  const int soff = which ? 6144 : 0;
  const float* src_c = (which == 0 && layer == 0) ? PIN(I_CTX) : (const float*)(PWS() + WS_XC);
  const float* src_l = (which == 0 && layer == 0) ? PIN(I_X) : (const float*)POUT();
  const int stride = mk_nblk() * 8;
  for (int row = mk_bid() * 8 + wave; row < T; row += 2 * stride) {
    int rows[2] = {row, row + stride}; f32x4 v[2][8]; bool ok[2];
#pragma unroll
    for (int u = 0; u < 2; ++u) { ok[u] = rows[u] < T && !(skip_ctx && rows[u] < NCTX);
      if (ok[u]) { const float* xr = rows[u] < NCTX ? src_c + (size_t)rows[u] * DM : src_l + (size_t)(rows[u] - NCTX) * DM;
#pragma unroll
        for (int i = 0; i < 8; ++i) v[u][i] = *(const f32x4*)(xr + i * 256 + lane * 4);
        if (which == 0 && layer == 0 && rows[u] < NCTX) { float* xc = (float*)(PWS() + WS_XC) + (size_t)rows[u] * DM;
#pragma unroll
          for (int i = 0; i < 8; ++i) *(f32x4*)(xc + i * 256 + lane * 4) = v[u][i]; } } }
#pragma unroll
    for (int u = 0; u < 2; ++u) if (ok[u]) {
      const float* m = mod + (rows[u] < NCTX ? 12288 : 0) + soff; float ss = 0.f;
#pragma unroll
      for (int i = 0; i < 8; ++i) ss += v[u][i][0] * v[u][i][0] + v[u][i][1] * v[u][i][1] + v[u][i][2] * v[u][i][2] + v[u][i][3] * v[u][i][3];
      ss = wave_sum(ss);
      const float rstd = rsqrtf(ss * (1.0f / DM) + 1e-6f);
#pragma unroll
      for (int i = 0; i < 8; ++i) {
        const int c = i * 256 + lane * 4;
        const f32x4 gv = *(const f32x4*)(g + c), sh = *(const f32x4*)(m + c), sc = *(const f32x4*)(m + 2048 + c);
        float o[4];
#pragma unroll
        for (int q = 0; q < 4; ++q) o[q] = (v[u][i][q] * rstd * gv[q]) * (1.0f + sc[q]) + sh[q];
        u32x2 w; w.x = cvtpk(o[0], o[1]); w.y = cvtpk(o[2], o[3]);
        *(u32x2*)(H + (size_t)rows[u] * DM + c) = w;
      }
    }
  }
}

__device__ __forceinline__ void phase_final_norm(const Params& P) {
  const int lane = mk_tid() & 63, wave = mk_tid() >> 6;
  const float* g = PIN(I_FNORM); float* out = POUT();
  const int stride = mk_nblk() * 8;
  for (int row = mk_bid() * 8 + wave; row < T - NCTX; row += 2 * stride) {
    int rows[2] = {row, row + stride}; f32x4 v[2][8]; bool ok[2];
#pragma unroll
    for (int u = 0; u < 2; ++u) { ok[u] = rows[u] < T - NCTX;
      if (ok[u]) {
#pragma unroll
        for (int i = 0; i < 8; ++i) v[u][i] = *(const f32x4*)(out + (size_t)rows[u] * DM + i * 256 + lane * 4); } }
#pragma unroll
    for (int u = 0; u < 2; ++u) if (ok[u]) {
      float ss = 0.f;
#pragma unroll
      for (int i = 0; i < 8; ++i) ss += v[u][i][0] * v[u][i][0] + v[u][i][1] * v[u][i][1] + v[u][i][2] * v[u][i][2] + v[u][i][3] * v[u][i][3];
      ss = wave_sum(ss);
      const float rstd = rsqrtf(ss * (1.0f / DM) + 1e-6f);
#pragma unroll
      for (int i = 0; i < 8; ++i) { const int c = i * 256 + lane * 4; const f32x4 gv = *(const f32x4*)(g + c); *(f32x4*)(out + (size_t)rows[u] * DM + c) = v[u][i] * rstd * gv; }
    }
  }
}

struct EpiStore {
  static constexpr bool PERM = true, AFTER_DRAIN = false;
  bf16_t* O; int ldc;
  __device__ __forceinline__ void operator()(const f32x4 (&acc)[2][2][4][2], const pg8::Unit& u, int wr, int wc, int fr, int fq) const {
    const int row0 = u.pm * 256 + wr * 64 + fr, col0 = u.pn * 256 + wc * 32 + 8 * fq;
#pragma unroll
    for (int ai = 0; ai < 2; ++ai)
#pragma unroll
      for (int m = 0; m < 4; ++m) { bf16_t* rowp = O + (size_t)(row0 + ai * 128 + m * 16) * ldc + col0;
#pragma unroll
        for (int bj = 0; bj < 2; ++bj) { const f32x4 v0 = acc[ai][bj][m][0], v1 = acc[ai][bj][m][1];
          u32x4 w; w.x = cvtpk(v0[0], v0[1]); w.y = cvtpk(v0[2], v0[3]); w.z = cvtpk(v1[0], v1[1]); w.w = cvtpk(v1[2], v1[3]);
          *(u32x4*)(rowp + bj * 128) = w; } }
  }
};
struct EpiResid {
  static constexpr bool PERM = false, AFTER_DRAIN = false;
  const float* src_c; const float* src_l; float* dst_c; float* dst_l; const float* gate_c; const float* gate_l; int row_off;
  __device__ __forceinline__ void operator()(const f32x4 (&acc)[2][2][4][2], const pg8::Unit& u, int wr, int wc, int fr, int fq) const {
    const int t0 = row_off + u.pm * 256;
    const bool isc = t0 < NCTX;
    const float* src = isc ? src_c : src_l - (size_t)NCTX * DM; float* dst = isc ? dst_c : dst_l - (size_t)NCTX * DM; const float* gate = isc ? gate_c : gate_l;
    const int row0 = t0 + wr * 64 + fr, col0 = u.pn * 256 + wc * 32 + 4 * fq;
    f32x4 gv[2][2];
#pragma unroll
    for (int bj = 0; bj < 2; ++bj)
#pragma unroll
      for (int n = 0; n < 2; ++n) gv[bj][n] = *(const f32x4*)(gate + col0 + bj * 128 + n * 16);
#pragma unroll
    for (int ai = 0; ai < 2; ++ai)
#pragma unroll
      for (int m = 0; m < 4; ++m) { const size_t off = (size_t)(row0 + ai * 128 + m * 16) * DM + col0;
#pragma unroll
        for (int bj = 0; bj < 2; ++bj)
#pragma unroll
          for (int n = 0; n < 2; ++n) { const f32x4 xs = *(const f32x4*)(src + off + bj * 128 + n * 16);
            *(f32x4*)(dst + off + bj * 128 + n * 16) = xs + gv[bj][n] * acc[ai][bj][m][n]; } }
  }
};

struct EpiResidAtomic {
  static constexpr bool PERM = false, AFTER_DRAIN = false;
  float* dst; const float* gate;
  __device__ __forceinline__ void operator()(const f32x4 (&acc)[2][2][4][2], const pg8::Unit& u, int wr, int wc, int fr, int fq) const {
    const int row0 = wr * 64 + fr, col0 = u.pn * 256 + wc * 32 + 4 * fq;
    f32x4 gv[2][2];
#pragma unroll
    for (int bj = 0; bj < 2; ++bj)
#pragma unroll
      for (int n = 0; n < 2; ++n) gv[bj][n] = *(const f32x4*)(gate + col0 + bj * 128 + n * 16);
#pragma unroll
    for (int ai = 0; ai < 2; ++ai)
#pragma unroll
      for (int m = 0; m < 4; ++m) { float* rp = dst + (size_t)(row0 + ai * 128 + m * 16) * DM + col0;
#pragma unroll
        for (int bj = 0; bj < 2; ++bj)
#pragma unroll
          for (int n = 0; n < 2; ++n) { const f32x4 v = gv[bj][n] * acc[ai][bj][m][n];
#pragma unroll
            for (int q = 0; q < 4; ++q) __hip_atomic_fetch_add(rp + bj * 128 + n * 16 + q, v[q], __ATOMIC_RELAXED, __HIP_MEMORY_SCOPE_AGENT); } }
  }
};
template <class Epi>
__device__ __forceinline__ void run_gemm(unsigned char* lds, const bf16_t* A, const bf16_t* Bt, int M, int N, int K, const Epi& E, int wg, int nwg, int ld = 0, int ksplit = 0) {
  pg8::Gemm g{A, Bt, M, N, K, ld ? ld : K, ksplit}; pg8::StaticOrder S; S.init(M, N, nwg, wg);
  pg8::gemm_phase<Epi, pg8::StaticOrder, false>((PG8_LAS unsigned char*)lds, g, S, E, nullptr);
}

__device__ __forceinline__ float colv(const bf16_t* cols, int t, int c) { return bf2f(cols[(size_t)t * NIN + c]); }
__device__ __forceinline__ float rwconv3(const bf16_t* cols, const float* cw, const float* cb, int t, int c, int lo, int hi) {
  float u = cb[c] + cw[1760 + c] * colv(cols, t, c);
  if (t - 1 >= lo) u += cw[c] * colv(cols, t - 1, c);
  if (t + 1 < hi) u += cw[2 * 1760 + c] * colv(cols, t + 1, c);
  return u;
}

__device__ __forceinline__ float rwconv3w(const bf16_t* cols, float w0, float w1, float w2, float b, int t, int c, int lo, int hi) {
  float u = b + w1 * colv(cols, t, c);
  if (t - 1 >= lo) u += w0 * colv(cols, t - 1, c);
  if (t + 1 < hi) u += w2 * colv(cols, t + 1, c);
  return u;
}
template <int PART>
__device__ __forceinline__ void phase_prep(const Params& P, int layer, float* lds, int wg, int nwg) {
  constexpr int NTK = 13;
  const int tid = mk_tid(), lane = tid & 63, wave = tid >> 6;
  float* lin = lds;
  float* xs = lds + 16 * 256;
  const bf16_t* cols = (const bf16_t*)(PWS() + WS_COLS);
  const float* cw = PIN(I_RWCONV) + (size_t)layer * 3 * 1760; const float* cb = PIN(I_RWCONVB) + (size_t)layer * 1760;
  const float* lcw = PIN(I_LRUCONV) + (size_t)layer * 4 * 512; const float* lcb = PIN(I_LRUCONVB) + (size_t)layer * 512;
  const int c = tid, hd = c >> 6, n = c & 63;
  bf16_t* VF = (bf16_t*)(PWS() + WS_VF); bf16_t* RG = (bf16_t*)(PWS() + WS_RG); bf16_t* CV = (bf16_t*)(PWS() + WS_CV);
  bf16_t* LAB = (bf16_t*)(PWS() + WS_LAB); bf16_t* GG = (bf16_t*)(PWS() + WS_GG);
  bf16_t* QN = (bf16_t*)(PWS() + WS_QN); bf16_t* KVN = (bf16_t*)(PWS() + WS_KVN); bf16_t* KR = (bf16_t*)(PWS() + WS_KR);
  unsigned char* REC = PWS() + WS_REC;
  const float w0_0 = PIN(I_RWW0)[(layer * 2 + 0) * 512 + c], w0_1 = PIN(I_RWW0)[(layer * 2 + 1) * 512 + c];
  const float a0_0 = PIN(I_RWA0)[(layer * 2 + 0) * 512 + c], a0_1 = PIN(I_RWA0)[(layer * 2 + 1) * 512 + c];
  const float kkc = PIN(I_RWKK)[layer * 512 + c], kac = PIN(I_RWKA)[layer * 512 + c], rkc = PIN(I_RWRK)[layer * 512 + c];
  const float v0c = (layer > 0) ? PIN(I_RWV0)[c] : 0.f;
  const float* wup = PIN(I_RWWUP) + (size_t)layer * 2 * 32 * 512 + c; const float* aup = PIN(I_RWAUP) + (size_t)layer * 2 * 32 * 512 + c;
  const float* gup = PIN(I_RWGUP) + (size_t)layer * 96 * 512 + c; const float* vup = PIN(I_RWVUP) + c;
  const float* lwa = PIN(I_LRUWA) + (size_t)layer * 2 * 8 * 4096 + (size_t)hd * 4096 + n; const float* lwx = PIN(I_LRUWX) + (size_t)layer * 2 * 8 * 4096 + (size_t)hd * 4096 + n;
  const float lba0 = PIN(I_LRUBA)[(layer * 2 + 0) * 512 + c], lba1 = PIN(I_LRUBA)[(layer * 2 + 1) * 512 + c];
  const float lbx0 = PIN(I_LRUBX)[(layer * 2 + 0) * 512 + c], lbx1 = PIN(I_LRUBX)[(layer * 2 + 1) * 512 + c];
  const float lam0 = PIN(I_LRULAM)[(layer * 2 + 0) * 512 + c], lam1 = PIN(I_LRULAM)[(layer * 2 + 1) * 512 + c];
  const float sp0 = log1pf(__expf(-lam0)), sp1 = log1pf(__expf(-lam1));
  float cwr[3], cwk[3], cwv[3], cwe[3], cbr = 0.f, cbk = 0.f, cbv = 0.f, cbe = 0.f;
  const int ecol = 1536 + ((tid & 255) < 224 ? (tid & 255) : 0);
#pragma unroll
  for (int q = 0; q < 3; ++q) { cwr[q] = (PART == 0) ? cw[q * 1760 + c] : 0.f; cwk[q] = (PART == 0) ? cw[q * 1760 + 512 + c] : 0.f; cwv[q] = (PART == 0) ? cw[q * 1760 + 1024 + c] : 0.f; cwe[q] = (PART == 0) ? cw[q * 1760 + ecol] : 0.f; }
  if (PART == 0) { cbr = cb[c]; cbk = cb[512 + c]; cbv = cb[1024 + c]; cbe = cb[ecol]; }

  for (int tile = wg; tile < T / NTK; tile += nwg) {
    const int t0 = tile * NTK;
    const int lo = t0 < NCTX ? 0 : NCTX, hi = t0 < NCTX ? NCTX : T;
    if (PART == 0) {
#pragma unroll
    for (int i = 0; i < (NTK * 256 + 511) / 512; ++i) {
      const int idx = tid + 512 * i, tt = idx >> 8, e = idx & 255, t = t0 + tt; float v;
      if (idx >= NTK * 256) continue;
      const int lo_t = t < NCTX ? 0 : NCTX, hi_t = t < NCTX ? NCTX : T;
      if (e < 224) { v = rwconv3w(cols, cwe[0], cwe[1], cwe[2], cbe, t, 1536 + e, lo_t, hi_t); if (e < 64) v = tanhf_(v); else if (e >= 128) v = sigmoidf_(v); }
      else v = (layer > 0) ? colv(cols, t, C_VD + e - 224) : 0.f;
      lin[tt * 256 + e] = v;
    }
    }
    if (PART == 1) {
#pragma unroll
    for (int tt = 0; tt < NTK; ++tt) {
      const int t = t0 + tt; float u = lcb[c]; const int lo_t = t < NCTX ? 0 : NCTX, hi_t = t < NCTX ? NCTX : T;
#pragma unroll
      for (int j = 0; j < 4; ++j) { const int ts = t + j - 2; if (ts >= lo_t && ts < hi_t) u += lcw[j * 512 + c] * colv(cols, ts, C_LRU + c); }
      xs[tt * 512 + c] = u;
    }
#pragma unroll 1
    for (int tw = wave; tw < NTK; tw += 8) {
      const int t = t0 + tw; const bf16_t* cr = cols + (size_t)t * NIN;
      float q[8]; float ss = 0.f;
      { const bf16x8 raw = *(const bf16x8*)(cr + C_MLA + lane * 8);
#pragma unroll
        for (int i = 0; i < 8; ++i) { q[i] = bf2f((bf16_t)raw[i]); ss += q[i] * q[i]; } }
      ss = wave_sum(ss); float rstd = rsqrtf(ss * (1.0f / 512.0f) + 1e-6f);
      { const float* gq = PIN(I_QNORM) + layer * 512 + lane * 8; u32x4 w;
        w.x = cvtpk(q[0] * rstd * gq[0], q[1] * rstd * gq[1]); w.y = cvtpk(q[2] * rstd * gq[2], q[3] * rstd * gq[3]);
        w.z = cvtpk(q[4] * rstd * gq[4], q[5] * rstd * gq[5]); w.w = cvtpk(q[6] * rstd * gq[6], q[7] * rstd * gq[7]);
        *(u32x4*)(QN + (size_t)t * 512 + lane * 8) = w; }
      float k4[4]; ss = 0.f;
      { const s16x4 raw = *(const s16x4*)(cr + C_MLA + 512 + lane * 4);
#pragma unroll
        for (int i = 0; i < 4; ++i) { k4[i] = bf2f((bf16_t)raw[i]); ss += k4[i] * k4[i]; } }
      ss = wave_sum(ss); rstd = rsqrtf(ss * (1.0f / 256.0f) + 1e-6f);
      { const float* gk = PIN(I_KVNORM) + layer * 256 + lane * 4; u32x2 w;
        w.x = cvtpk(k4[0] * rstd * gk[0], k4[1] * rstd * gk[1]); w.y = cvtpk(k4[2] * rstd * gk[2], k4[3] * rstd * gk[3]);
        *(u32x2*)(KVN + (size_t)t * 256 + lane * 4) = w; }
      const float own = bf2f(cr[C_MLA + 768 + lane]); const float oth = __shfl_xor(own, 16);
      float res = own;
      if (t >= NCTX) {
        const int tl = t - NCTX, axis = lane >> 5, half = (lane >> 4) & 1, f = lane & 15;
        const float pos = (float)(axis == 0 ? (tl >> 6) : (tl & 63));
        const float inv = exp2f(-(float)f * (13.287712379549449f / 16.0f));
        const float sn = __sinf(pos * inv), cs = __cosf(pos * inv);
        res = half == 0 ? own * cs - oth * sn : oth * sn + own * cs;
      }
      KR[(size_t)t * 64 + lane] = f2bf(res);
    }
    }
    __syncthreads();
    if (PART == 0) {
      float zw0[NTK], zw1[NTK], za0[NTK], za1[NTK], gg[NTK], mx[NTK];
#pragma unroll
      for (int tt = 0; tt < NTK; ++tt) { zw0[tt] = 0.f; zw1[tt] = 0.f; za0[tt] = 0.f; za1[tt] = 0.f; gg[tt] = 0.f; mx[tt] = 0.f; }
#pragma unroll 1
      for (int e = 0; e < 32; e += 4) {
        float wa[4], wb[4], aa[4], ab[4], vv[4];
#pragma unroll
        for (int i = 0; i < 4; ++i) { wa[i] = wup[(size_t)(e + i) * 512]; wb[i] = wup[(size_t)(32 + e + i) * 512]; aa[i] = aup[(size_t)(e + i) * 512]; ab[i] = aup[(size_t)(32 + e + i) * 512];
          vv[i] = (layer > 0) ? vup[(size_t)(e + i) * 512] : 0.f; }
#pragma unroll
        for (int tt = 0; tt < NTK; ++tt) {
          const f32x4 x0 = *(const f32x4*)(lin + tt * 256 + e), x1 = *(const f32x4*)(lin + tt * 256 + 32 + e), y0 = *(const f32x4*)(lin + tt * 256 + 64 + e),
                      y1 = *(const f32x4*)(lin + tt * 256 + 96 + e), hv = *(const f32x4*)(lin + tt * 256 + 224 + e);
#pragma unroll
          for (int i = 0; i < 4; ++i) { zw0[tt] += x0[i] * wa[i]; zw1[tt] += x1[i] * wb[i]; za0[tt] += y0[i] * aa[i]; za1[tt] += y1[i] * ab[i]; mx[tt] += hv[i] * vv[i]; }
        }
      }
      { float gw[4];
#pragma unroll
        for (int i = 0; i < 4; ++i) gw[i] = gup[(size_t)i * 512];
#pragma unroll 1
        for (int e = 0; e < 96; e += 4) {
          float ngw[4]; const int en = (e + 4 < 96) ? e + 4 : e;
#pragma unroll
          for (int i = 0; i < 4; ++i) ngw[i] = gup[(size_t)(en + i) * 512];
#pragma unroll
          for (int tt = 0; tt < NTK; ++tt) { const f32x4 s4 = *(const f32x4*)(lin + tt * 256 + 128 + e);
#pragma unroll
            for (int i = 0; i < 4; ++i) gg[tt] += s4[i] * gw[i]; }
#pragma unroll
          for (int i = 0; i < 4; ++i) gw[i] = ngw[i];
        } }
#pragma unroll
      for (int tt = 0; tt < NTK; ++tt) {
        const int t = t0 + tt; const int lo_t = t < NCTX ? 0 : NCTX, hi_t = t < NCTX ? NCTX : T;
        const float r = rwconv3w(cols, cwr[0], cwr[1], cwr[2], cbr, t, c, lo_t, hi_t), k = rwconv3w(cols, cwk[0], cwk[1], cwk[2], cbk, t, 512 + c, lo_t, hi_t);
        float v = rwconv3w(cols, cwv[0], cwv[1], cwv[2], cbv, t, 1024 + c, lo_t, hi_t);
        const float wd0 = __expf(-0.606531f * sigmoidf_(w0_0 + zw0[tt])), wd1 = __expf(-0.606531f * sigmoidf_(w0_1 + zw1[tt]));
        const float ic0 = sigmoidf_(a0_0 + za0[tt]), ic1 = sigmoidf_(a0_1 + za1[tt]);
        if (layer > 0) { const float mixv = sigmoidf_(v0c + mx[tt]); const float vf = bf2f(VF[(size_t)t * 512 + c]); v = v + (vf - v) * mixv; }
        else VF[(size_t)t * 512 + c] = f2bf(v);
        float kk = k * kkc; const float ssq = wave_sum(kk * kk); kk *= rsqrtf(fmaxf(ssq, 1e-24f));
        const float kd0 = k * (1.0f + (ic0 - 1.0f) * kac), kd1 = k * (1.0f + (ic1 - 1.0f) * kac);
        const float b0 = kk * ic0, b1 = kk * ic1;
        const float coef = wave_sum(r * (kd0 + kd1) * rkc);
        RG[(size_t)t * 512 + c] = f2bf(gg[tt]); CV[(size_t)t * 512 + c] = f2bf(coef * v);
        const bf16_t ab_ = f2bf(-kk), rb_ = f2bf(r), vb_ = f2bf(v);
        { unsigned char* rp = REC + ((size_t)(0 * 8 + hd) * T + t) * RECB;
          ((float*)rp)[n] = wd0; bf16_t* q = (bf16_t*)(rp + 256); q[n] = f2bf(kd0); q[64 + n] = ab_; q[128 + n] = f2bf(b0); q[192 + n] = rb_; q[256 + n] = vb_; }
        { unsigned char* rp = REC + ((size_t)(1 * 8 + hd) * T + scan_pos_rev(t)) * RECB;
          ((float*)rp)[n] = wd1; bf16_t* q = (bf16_t*)(rp + 256); q[n] = f2bf(kd1); q[64 + n] = ab_; q[128 + n] = f2bf(b1); q[192 + n] = rb_; q[256 + n] = vb_; }
        asm volatile("" ::: "memory");
      }
    }
    if (PART == 1) {
      float pa0[NTK], pa1[NTK], px0[NTK], px1[NTK];
#pragma unroll
      for (int tt = 0; tt < NTK; ++tt) { pa0[tt] = 0.f; pa1[tt] = 0.f; px0[tt] = 0.f; px1[tt] = 0.f; }
      {
        float a0w[4], a1w[4], x0w[4], x1w[4];
#pragma unroll
        for (int i = 0; i < 4; ++i) { a0w[i] = lwa[(size_t)i * 64]; a1w[i] = lwa[(size_t)8 * 4096 + (size_t)i * 64]; x0w[i] = lwx[(size_t)i * 64]; x1w[i] = lwx[(size_t)8 * 4096 + (size_t)i * 64]; }
#pragma unroll 1
        for (int i0 = 0; i0 < 64; i0 += 4) {
          float na0[4], na1[4], nx0[4], nx1[4];
          const int in_ = (i0 + 4 < 64) ? i0 + 4 : i0;
#pragma unroll
          for (int i = 0; i < 4; ++i) { na0[i] = lwa[(size_t)(in_ + i) * 64]; na1[i] = lwa[(size_t)8 * 4096 + (size_t)(in_ + i) * 64]; nx0[i] = lwx[(size_t)(in_ + i) * 64]; nx1[i] = lwx[(size_t)8 * 4096 + (size_t)(in_ + i) * 64]; }
#pragma unroll
          for (int tt = 0; tt < NTK; ++tt) { const f32x4 x = *(const f32x4*)(xs + tt * 512 + hd * 64 + i0);
#pragma unroll
            for (int i = 0; i < 4; ++i) { pa0[tt] += x[i] * a0w[i]; pa1[tt] += x[i] * a1w[i]; px0[tt] += x[i] * x0w[i]; px1[tt] += x[i] * x1w[i]; } }
#pragma unroll
          for (int i = 0; i < 4; ++i) { a0w[i] = na0[i]; a1w[i] = na1[i]; x0w[i] = nx0[i]; x1w[i] = nx1[i]; }
        }
      }
      float gt8[NTK];
#pragma unroll
      for (int tt = 0; tt < NTK; ++tt) gt8[tt] = colv(cols, t0 + tt, C_LRU + 512 + c);
#pragma unroll
      for (int tt = 0; tt < NTK; ++tt) {
        const int t = t0 + tt; const float xb = xs[tt * 512 + c];
        const float la0 = -8.0f * sigmoidf_(pa0[tt] + lba0) * sp0, la1 = -8.0f * sigmoidf_(pa1[tt] + lba1) * sp1;
        const float bb0 = sqrtf(fmaxf(1.0f - __expf(2.0f * la0), 0.f)) * sigmoidf_(px0[tt] + lbx0) * xb;
        const float bb1 = sqrtf(fmaxf(1.0f - __expf(2.0f * la1), 0.f)) * sigmoidf_(px1[tt] + lbx1) * xb;
        bf16_t* lp = LAB + (size_t)t * 2048;
        lp[c] = f2bf(la0); lp[512 + c] = f2bf(bb0); lp[1024 + c] = f2bf(la1); lp[1536 + c] = f2bf(bb1);
        GG[(size_t)t * 512 + c] = f2bf(gelu_tanh(gt8[tt]));
        asm volatile("" ::: "memory");
      }
    }
    __syncthreads();
  }
}

__device__ __forceinline__ void phase_lru_agg(const Params& P, int wg, int nwg) {
  const int c = mk_tid(); const bf16_t* LAB = (const bf16_t*)(PWS() + WS_LAB); float* AGG = (float*)(PWS() + WS_AGG);
  for (int ck = wg; ck < T / 64; ck += nwg) {
    float A0 = 1.f, B0 = 0.f, A1 = 1.f, B1 = 0.f;
#pragma unroll 1
    for (int t8 = 0; t8 < 64; t8 += 8) {
      bf16_t x[8][4];
#pragma unroll
      for (int u = 0; u < 8; ++u) { const bf16_t* lp = LAB + (size_t)(ck * 64 + t8 + u) * 2048; x[u][0] = lp[c]; x[u][1] = lp[512 + c]; x[u][2] = lp[1024 + c]; x[u][3] = lp[1536 + c]; }
#pragma unroll
      for (int u = 0; u < 8; ++u) {
        const float a0 = __expf(bf2f(x[u][0])), b0 = bf2f(x[u][1]), a1 = __expf(bf2f(x[u][2])), b1 = bf2f(x[u][3]);
        A0 = a0 * A0; B0 = a0 * B0 + b0;
        B1 = B1 + A1 * b1; A1 = A1 * a1;
      }
    }
    float* ap = AGG + (size_t)ck * 2048; ap[c] = A0; ap[512 + c] = B0; ap[1024 + c] = A1; ap[1536 + c] = B1;
  }
}
__device__ __forceinline__ float lru_compose(const float* AGG, int c, int off, int q0, int dq, int n, float h) {
  int i = 0;
#pragma unroll 1
  for (; i + 8 <= n; i += 8) {
    float a[8], b[8];
#pragma unroll
    for (int u = 0; u < 8; ++u) { const float* ap = AGG + (size_t)(q0 + (i + u) * dq) * 2048 + off; a[u] = ap[c]; b[u] = ap[512 + c]; }
#pragma unroll
    for (int u = 0; u < 8; ++u) h = a[u] * h + b[u];
  }
#pragma unroll 1
  for (; i < n; ++i) { const float* ap = AGG + (size_t)(q0 + i * dq) * 2048 + off; h = ap[c] * h + ap[512 + c]; }
  return h;
}
__device__ __forceinline__ void phase_lru_out(const Params& P, int layer, float* lds, int wg, int nwg) {
  const int c = mk_tid(); const bf16_t* LAB = (const bf16_t*)(PWS() + WS_LAB); const float* AGG = (const float*)(PWS() + WS_AGG);
  const bf16_t* GG = (const bf16_t*)(PWS() + WS_GG); bf16_t* MIX = (bf16_t*)(PWS() + WS_H);
  const int ck_lo = (layer == 1) ? 4 : 0;
  for (int ck = ck_lo + wg; ck < T / 64; ck += nwg) {
    float h0 = lru_compose(AGG, c, 0, 0, 1, ck, 0.f);
    float h1;
    if (ck < 4) h1 = lru_compose(AGG, c, 1024, 3, -1, 3 - ck, 0.f);
    else { h1 = lru_compose(AGG, c, 1024, 3, -1, 4, 0.f); h1 = lru_compose(AGG, c, 1024, T / 64 - 1, -1, T / 64 - 1 - ck, h1); }
#pragma unroll 1
    for (int t8 = 0; t8 < 64; t8 += 8) {
      bf16_t x[8][2];
#pragma unroll
      for (int u = 0; u < 8; ++u) { const bf16_t* lp = LAB + (size_t)(ck * 64 + t8 + u) * 2048; x[u][0] = lp[c]; x[u][1] = lp[512 + c]; }
#pragma unroll
      for (int u = 0; u < 8; ++u) { h0 = __expf(bf2f(x[u][0])) * h0 + bf2f(x[u][1]); lds[(t8 + u) * 512 + c] = h0; }
    }
#pragma unroll 1
    for (int t8 = 56; t8 >= 0; t8 -= 8) {
      bf16_t x[8][3];
#pragma unroll
      for (int u = 0; u < 8; ++u) { const int t = ck * 64 + t8 + u; const bf16_t* lp = LAB + (size_t)t * 2048; x[u][0] = lp[1024 + c]; x[u][1] = lp[1536 + c]; x[u][2] = GG[(size_t)t * 512 + c]; }
#pragma unroll
      for (int u = 7; u >= 0; --u) { const int t = ck * 64 + t8 + u; h1 = __expf(bf2f(x[u][0])) * h1 + bf2f(x[u][1]);
        MIX[(size_t)t * DM + 512 + c] = f2bf((lds[(t8 + u) * 512 + c] + h1) * bf2f(x[u][2])); }
    }
  }
}

template <int NCW>
__device__ __forceinline__ void rwkv_scan(const Params& P, int s, float* lds) {
  const int d = (NCW == 4) ? (s >> 5) : (s >> 4), h = (NCW == 4) ? ((s >> 2) & 7) : ((s >> 1) & 7), part = (NCW == 4) ? (s & 3) : (s & 1);
  const int tid = mk_tid(), lane = tid & 63, wave = tid >> 6, rgp = lane >> 4, j = lane & 15, row = part * (NCW * 4) + (wave & (NCW - 1)) * 4 + rgp;
  const unsigned char* rec = PWS() + WS_REC + (size_t)(d * 8 + h) * T * RECB;
  float* Y = (float*)(PWS() + WS_Y) + (size_t)d * T * 512 + h * 64 + row;
  constexpr int NST = (NCW == 4) ? 7 : 4, STS = (NCW == 4) ? 256 : 512;
  const bool stager = (NCW == 4) ? (wave >= 4) : true; const int stid = (NCW == 4) ? (tid - 256) : tid;
  int goff[NST], loff[NST]; bool isw[NST], val[NST];
#pragma unroll
  for (int i = 0; i < NST; ++i) { const int q = stid + STS * i; val[i] = stager && q >= 0 && q < 1792; const int rc = q / 56, pr = q % 56; goff[i] = rc * RECB + pr * 16; isw[i] = pr < 16;
    loff[i] = rc * 384 + (isw[i] ? pr * 4 : 64 + ((pr - 16) >> 3) * 64 + ((pr - 16) & 7) * 8); }
  u32x4 stA[NST], stB[NST];
#define RS_LOAD(st, ch) do { _Pragma("unroll") for (int i = 0; i < NST; ++i) if (val[i]) st[i] = *(const u32x4*)(rec + (size_t)(ch) * 32 * RECB + goff[i]); } while (0)
#define RS_WRITE(st, buf) do { _Pragma("unroll") for (int i = 0; i < NST; ++i) if (val[i]) { float* dp = (buf) + loff[i]; \
    if (isw[i]) { *(u32x4*)dp = st[i]; } else { u32x4 lo_, hi_; lo_.x = st[i].x << 16; lo_.y = st[i].x & 0xffff0000u; lo_.z = st[i].y << 16; lo_.w = st[i].y & 0xffff0000u; \
      hi_.x = st[i].z << 16; hi_.y = st[i].z & 0xffff0000u; hi_.z = st[i].w << 16; hi_.w = st[i].w & 0xffff0000u; *(u32x4*)dp = lo_; *(u32x4*)(dp + 4) = hi_; } } } while (0)
  f32x4 S = {0.f, 0.f, 0.f, 0.f}; float ykeep = 0.f, yprev = 0.f;
  constexpr int NCH = T / 32;
#define RS_COMPUTE(ch) do { const float* buf = lds + ((ch) & 1) * 12288; \
    if (wave < NCW) { \
      const float* sp = buf + j * 4; \
      f32x4 w4 = *(const f32x4*)(sp), kd4 = *(const f32x4*)(sp + 64), a4 = *(const f32x4*)(sp + 128), b4 = *(const f32x4*)(sp + 192), r4 = *(const f32x4*)(sp + 256); \
      float v = buf[320 + row]; \
      _Pragma("unroll 8") \
      for (int stp = 0; stp < 32; ++stp) { \
        float sa = dot4(S, a4); \
          \
        __builtin_amdgcn_sched_barrier(0); \
        const float* np = sp + (stp + 1) * 384;            \
        const f32x4 nw4 = *(const f32x4*)(np), nkd4 = *(const f32x4*)(np + 64), na4 = *(const f32x4*)(np + 128), nb4 = *(const f32x4*)(np + 192), nr4 = *(const f32x4*)(np + 256); \
        const float nv = buf[(stp + 1) * 384 + 320 + row]; \
        __builtin_amdgcn_sched_barrier(0); \
          \
          \
        f32x2 q01, t23, vv; vv[0] = v; vv[1] = v; \
        { const f32x2 kd01 = kd4.lo, kd23 = kd4.hi, S01 = S.lo, w01 = w4.lo; \
        asm volatile("v_add_f32_dpp %0, %0, %0 quad_perm:[1,0,3,2] row_mask:0xf bank_mask:0xf\n\t" \
                     "v_add_f32_dpp %1, %1, %1 quad_perm:[1,0,3,2] row_mask:0xf bank_mask:0xf\n\t" \
                     "v_pk_mul_f32 %2, %4, %6 op_sel_hi:[1,0]\n\t" \
                     "v_add_f32_dpp %0, %0, %0 quad_perm:[2,3,0,1] row_mask:0xf bank_mask:0xf\n\t" \
                     "v_add_f32_dpp %1, %1, %1 quad_perm:[2,3,0,1] row_mask:0xf bank_mask:0xf\n\t" \
                     "v_pk_mul_f32 %3, %5, %6 op_sel_hi:[1,0]\n\t" \
                     "v_add_f32_dpp %0, %0, %0 row_half_mirror row_mask:0xf bank_mask:0xf\n\t" \
                     "v_add_f32_dpp %1, %1, %1 row_half_mirror row_mask:0xf bank_mask:0xf\n\t" \
                     "v_pk_fma_f32 %2, %7, %8, %2\n\t" \
                     "v_add_f32_dpp %0, %0, %0 row_mirror row_mask:0xf bank_mask:0xf\n\t" \
                     "v_add_f32_dpp %1, %1, %1 row_mirror row_mask:0xf bank_mask:0xf" \
                     : "+v"(sa), "+v"(yprev), "=&v"(q01), "=&v"(t23) \
                     : "v"(kd01), "v"(kd23), "v"(vv), "v"(S01), "v"(w01)); } \
        const f32x2 q23 = S.hi * w4.hi + t23; \
        ykeep = (((stp + 15) & 15) == j) ? yprev : ykeep;         \
        if ((stp & 15) == 0 && ((ch) > 0 || stp > 0)) { const int p = (ch) * 32 + stp - 16 + j; const int tok = d ? scan_pos_rev(p) : p; Y[(size_t)tok * 512] = ykeep; } \
        S.lo = sa * b4.lo + q01; S.hi = sa * b4.hi + q23; \
        yprev = dot4(S, r4); \
        w4 = nw4; kd4 = nkd4; a4 = na4; b4 = nb4; r4 = nr4; v = nv; \
      } \
    } } while (0)
  RS_LOAD(stA, 0); RS_WRITE(stA, lds); RS_LOAD(stA, 1); __syncthreads();
  static_assert(NCH % 2 == 0, "the chunk loop is unrolled by two");
  for (int ch = 0; ch < NCH; ch += 2) {
    if (ch + 2 < NCH) RS_LOAD(stB, ch + 2);
    RS_COMPUTE(ch);
    RS_WRITE(stA, lds + 12288);
    __syncthreads();
    if (ch + 3 < NCH) RS_LOAD(stA, ch + 3);
    RS_COMPUTE(ch + 1);
    if (ch + 2 < NCH) RS_WRITE(stB, lds);
    __syncthreads();
  }
  if (wave < NCW) {
    yprev = row16_sum(yprev);
    ykeep = (j == 15) ? yprev : ykeep;
    const int p = T - 16 + j; const int tok = d ? scan_pos_rev(p) : p; Y[(size_t)tok * 512] = ykeep;
  }
#undef RS_COMPUTE
#undef RS_LOAD
#undef RS_WRITE
}

__device__ __forceinline__ void phase_rwkv_out(const Params& P, int layer, int wg, int nwg) {
  const int c = mk_tid();
  const float* Y0 = (const float*)(PWS() + WS_Y); const float* Y1 = Y0 + (size_t)T * 512;
  const bf16_t* RG = (const bf16_t*)(PWS() + WS_RG); const bf16_t* CV = (const bf16_t*)(PWS() + WS_CV); bf16_t* MIX = (bf16_t*)(PWS() + WS_H);
  const float lg = PIN(I_RWLNG)[layer * 512 + c], lb = PIN(I_RWLNB)[layer * 512 + c];
  const int G = nwg;
  for (int t0 = (layer == 1 ? NCTX : 0) + wg; t0 < T; t0 += 4 * G) {
    float y[4], cv[4], rg[4];
#pragma unroll
    for (int u = 0; u < 4; ++u) { const int t = t0 + u * G; if (t < T) { y[u] = Y0[(size_t)t * 512 + c] + Y1[(size_t)t * 512 + c]; cv[u] = bf2f(CV[(size_t)t * 512 + c]); rg[u] = bf2f(RG[(size_t)t * 512 + c]); } else { y[u] = 0.f; cv[u] = 0.f; rg[u] = 0.f; } }
#pragma unroll
    for (int u = 0; u < 4; ++u) { const int t = t0 + u * G;
      const float mu = wave_sum(y[u]) * (1.0f / 64.0f); const float dlt = y[u] - mu; const float var = wave_sum(dlt * dlt) * (1.0f / 64.0f);
      const float yn = dlt * rsqrtf(var + 64e-5f) * lg + lb;
      if (t < T) MIX[(size_t)t * DM + c] = f2bf((yn + cv[u]) * rg[u]); }
  }
}

__device__ __forceinline__ void phase_ffn_act(const Params& P, int layer) {
  const bf16_t* GU = (const bf16_t*)(PWS() + WS_GU); bf16_t* ACT = (bf16_t*)(PWS() + WS_ACT);
  const float* fw = PIN(I_FCONV) + (size_t)layer * 3 * DFF; const float* fb = PIN(I_FCONVB) + (size_t)layer * DFF;
  const int run_lo = (layer == 1) ? NCTX / 32 : 0, nruns = T / 32 - run_lo;
  for (int idx = mk_bid() * NTH + mk_tid(); idx < nruns * 704; idx += mk_nblk() * NTH) {
    const int cgp = idx % 704, run = run_lo + idx / 704, c0 = cgp * 8, t0 = run * 32;
    const int lo = t0 < NCTX ? 0 : NCTX, hi = t0 < NCTX ? NCTX : T;
    float w0[8], w1[8], w2[8], bb[8];
#pragma unroll
    for (int i = 0; i < 8; ++i) { w0[i] = fw[c0 + i]; w1[i] = fw[DFF + c0 + i]; w2[i] = fw[2 * DFF + c0 + i]; bb[i] = fb[c0 + i]; }
    const bf16x8 zero = {0, 0, 0, 0, 0, 0, 0, 0};
    bf16x8 prev = (t0 - 1 >= lo) ? *(const bf16x8*)(GU + (size_t)(t0 - 1) * NGU + c0) : zero;
    bf16x8 cur = *(const bf16x8*)(GU + (size_t)t0 * NGU + c0);
    for (int tt = 0; tt < 32; ++tt) {
      const int t = t0 + tt;
      const bf16x8 nxt = (t + 1 < hi) ? *(const bf16x8*)(GU + (size_t)(t + 1) * NGU + c0) : zero;
      const bf16x8 up = *(const bf16x8*)(GU + (size_t)t * NGU + DFF + c0);
      float o[8];
#pragma unroll
      for (int i = 0; i < 8; ++i) { const float g = bb[i] + w0[i] * bf2f((bf16_t)prev[i]) + w1[i] * bf2f((bf16_t)cur[i]) + w2[i] * bf2f((bf16_t)nxt[i]); o[i] = siluf_(g) * bf2f((bf16_t)up[i]); }
      u32x4 w; w.x = cvtpk(o[0], o[1]); w.y = cvtpk(o[2], o[3]); w.z = cvtpk(o[4], o[5]); w.w = cvtpk(o[6], o[7]);
      *(u32x4*)(ACT + (size_t)t * DFF + c0) = w;
      prev = cur; cur = nxt;
    }
  }
}

namespace at2 {
constexpr int DQK = 192, DV = 128, QBLK = 32, KVBLK = 64;
constexpr float SCALE = 0.07216878364870322f;
constexpr float THR = 8.f;
#ifndef ATT_NQREG
#define ATT_NQREG 12
#endif
constexpr int NQREG = ATT_NQREG;
constexpr int SHM_V = KVBLK * DV * 2, SHM_K = KVBLK * DQK * 2, SHM_ATTN = 3 * SHM_V + 3 * SHM_K + 8 * 64 * 4,     SHM_TOTAL = SHM_ATTN + (12 - NQREG) * 8192;
#define KSWZ(row, colB) ((row) * 384 + ((colB) ^ (((row) & 7) << 4)))
#define SBAR() __builtin_amdgcn_sched_barrier(0)
__device__ __forceinline__ int crow(int r, int hi) { return (r & 3) + 8 * (r >> 2) + 4 * hi; }

__device__ __forceinline__ void partialSM(f32x16& p0, f32x16& p1, float& m_reg, float& mn, float& alpha) {
  constexpr float C = SCALE * 1.4426950408889634f;
  float pmax = p0[0];
#pragma unroll
  for (int r = 1; r < 16; ++r) pmax = fmaxf(pmax, p0[r]);
#pragma unroll
  for (int r = 0; r < 16; ++r) pmax = fmaxf(pmax, p1[r]);
  { auto rr = __builtin_amdgcn_permlane32_swap(__float_as_uint(pmax), __float_as_uint(pmax), false, false);
    pmax = fmaxf(__uint_as_float(rr[0]), __uint_as_float(rr[1])); }
  if (__builtin_expect(__all(pmax - m_reg <= THR / SCALE), 1)) { mn = m_reg; alpha = 1.f; }
  else { mn = fmaxf(m_reg, pmax); alpha = __builtin_amdgcn_exp2f((m_reg - mn) * C); m_reg = mn; }
  const float mnC = -mn * C;
#pragma unroll
  for (int r = 0; r < 16; ++r) p0[r] = fmaf(p0[r], C, mnC);
#pragma unroll
  for (int r = 0; r < 16; ++r) p1[r] = fmaf(p1[r], C, mnC);
#pragma unroll
  for (int r = 0; r < 16; ++r) p0[r] = __builtin_amdgcn_exp2f(p0[r]);
}
__device__ __forceinline__ void finishSM(f32x16& p0, f32x16& p1, float alpha, float& l_reg, bf16x8& pa0, bf16x8& pa1, bf16x8& pa2, bf16x8& pa3) {
#pragma unroll
  for (int r = 0; r < 16; ++r) p1[r] = __builtin_amdgcn_exp2f(p1[r]);
  float ps = 0;
#pragma unroll
  for (int r = 0; r < 16; ++r) ps += p0[r];
#pragma unroll
  for (int r = 0; r < 16; ++r) ps += p1[r];
  { auto rr = __builtin_amdgcn_permlane32_swap(__float_as_uint(ps), __float_as_uint(ps), false, false);
    ps = __uint_as_float(rr[0]) + __uint_as_float(rr[1]); }
  l_reg = l_reg * alpha + ps;
#define PK4(P, BASE, OUT) do { unsigned a0 = cvtpk(P[BASE + 0], P[BASE + 1]), a1 = cvtpk(P[BASE + 2], P[BASE + 3]);   \
    unsigned b0 = cvtpk(P[BASE + 4], P[BASE + 5]), b1 = cvtpk(P[BASE + 6], P[BASE + 7]);                              \
    auto r0 = __builtin_amdgcn_permlane32_swap(a0, b0, false, false); auto r1 = __builtin_amdgcn_permlane32_swap(a1, b1, false, false); \
    u32x4 w = {r0[0], r1[0], r0[1], r1[1]}; OUT = *reinterpret_cast<bf16x8*>(&w); } while (0)
  PK4(p0, 0, pa0); PK4(p0, 8, pa1); PK4(p1, 0, pa2); PK4(p1, 8, pa3);
#undef PK4
}
__device__ __forceinline__ void qkt(f32x16& p0, f32x16& p1, const char* Ks, const bf16x8* qr, const char* qsp, int r32, int hi) {
  p0 = f32x16{}; p1 = f32x16{};
#pragma unroll
  for (int d0 = 0; d0 < 12; ++d0) { const int cb = (d0 * 16 + hi * 8) * 2;
    const bf16x8 b0 = *reinterpret_cast<const bf16x8*>(Ks + KSWZ(r32, cb));
    const bf16x8 b1 = *reinterpret_cast<const bf16x8*>(Ks + KSWZ(32 + r32, cb));
    const bf16x8 qv = (d0 < NQREG) ? qr[d0 < NQREG ? d0 : 0] : *reinterpret_cast<const bf16x8*>(qsp + (d0 - NQREG) * 8192);
    p0 = __builtin_amdgcn_mfma_f32_32x32x16_bf16(b0, qv, p0, 0, 0, 0);
    p1 = __builtin_amdgcn_mfma_f32_32x32x16_bf16(b1, qv, p1, 0, 0, 0); }
}
__device__ __forceinline__ int v_st(int k, int c) { const int kk = (k & ~0xC) | ((k & 4) << 1) | ((k & 8) >> 1); return ((kk >> 3) * 4 + (c >> 5)) * 512 + ((kk & 7) * 32 + (c & 31)) * 2; }
__device__ __forceinline__ int v_rd_base(int lane) { return ((lane & 3) << 3) | (((lane >> 2) & 3) << 6) | (((lane >> 4) & 1) << 5) | (((lane >> 5) & 1) << 8); }
constexpr int v_rd_off(int d0, int ks, int half) { return d0 * 512 + ks * 4096 + half * 2048; }
template <int OFF> __device__ __forceinline__ s16x4 tr_read(int vb) {
  s16x4 r; asm volatile("ds_read_b64_tr_b16 %0, %1 offset:%2" : "=&v"(r) : "v"(vb), "i"(OFF) : "memory"); return r;
}
template <int D0> __device__ __forceinline__ void pv_one(f32x16& od, int vb, bf16x8 pa0, bf16x8 pa1, bf16x8 pa2, bf16x8 pa3) {
  const s16x4 l0 = tr_read<v_rd_off(D0, 0, 0)>(vb), h0 = tr_read<v_rd_off(D0, 0, 1)>(vb), l1 = tr_read<v_rd_off(D0, 1, 0)>(vb), h1 = tr_read<v_rd_off(D0, 1, 1)>(vb);
  const s16x4 l2 = tr_read<v_rd_off(D0, 2, 0)>(vb), h2 = tr_read<v_rd_off(D0, 2, 1)>(vb), l3 = tr_read<v_rd_off(D0, 3, 0)>(vb), h3 = tr_read<v_rd_off(D0, 3, 1)>(vb);
  asm volatile("s_waitcnt lgkmcnt(0)" ::: "memory"); SBAR();
#define PK(L, H) (bf16x8){L[0], L[1], L[2], L[3], H[0], H[1], H[2], H[3]}
  od = __builtin_amdgcn_mfma_f32_32x32x16_bf16(pa0, PK(l0, h0), od, 0, 0, 0);
  od = __builtin_amdgcn_mfma_f32_32x32x16_bf16(pa1, PK(l1, h1), od, 0, 0, 0);
  od = __builtin_amdgcn_mfma_f32_32x32x16_bf16(pa2, PK(l2, h2), od, 0, 0, 0);
  od = __builtin_amdgcn_mfma_f32_32x32x16_bf16(pa3, PK(l3, h3), od, 0, 0, 0);
#undef PK
}
__device__ __forceinline__ void pv_d0(f32x16* o, int vb, bf16x8 pa0, bf16x8 pa1, bf16x8 pa2, bf16x8 pa3) {
  pv_one<0>(o[0], vb, pa0, pa1, pa2, pa3); pv_one<1>(o[1], vb, pa0, pa1, pa2, pa3); pv_one<2>(o[2], vb, pa0, pa1, pa2, pa3); pv_one<3>(o[3], vb, pa0, pa1, pa2, pa3);
}
__device__ __forceinline__ void rope_pair(bf16x8& A, bf16x8& B, float pos, int hi) {
  float oa[8], ob[8];
#pragma unroll
  for (int e = 0; e < 8; ++e) {
    const float inv = exp2f(-(float)(hi * 8 + e) * (13.287712379549449f / 16.0f));
    const float sn = __sinf(pos * inv), cs = __cosf(pos * inv);
    const float a = bf2f((bf16_t)A[e]), b = bf2f((bf16_t)B[e]);
    oa[e] = a * cs - b * sn; ob[e] = a * sn + b * cs;
  }
  u32x4 wa = {cvtpk(oa[0], oa[1]), cvtpk(oa[2], oa[3]), cvtpk(oa[4], oa[5]), cvtpk(oa[6], oa[7])};
  u32x4 wb = {cvtpk(ob[0], ob[1]), cvtpk(ob[2], ob[3]), cvtpk(ob[4], ob[5]), cvtpk(ob[6], ob[7])};
  A = *reinterpret_cast<bf16x8*>(&wa); B = *reinterpret_cast<bf16x8*>(&wb);
}

__device__ __forceinline__ void attn_unit(const bf16_t* __restrict__ Q, const bf16_t* __restrict__ KV, const bf16_t* __restrict__ KR, bf16_t* __restrict__ MIX,
                                          int q0, int h, int kv0, int seq, bool rope_q, char* lds, bf16_t* __restrict__ part_o, float* __restrict__ part_ml) {
  const int tid = mk_tid(), wid = tid >> 6, lane = tid & 63, r32 = lane & 31, hi = lane >> 5;
  char* V_lds = lds; char* K_lds = lds + 3 * SHM_V;
  float* ws = (float*)(lds + 3 * SHM_V + 3 * SHM_K) + wid * 64; float* li_l = ws; float* al_l = ws + 32;
  float m_reg = -1e30f, l_reg = 0; f32x16 o[4] = {}; bf16x8 qr[12];
  const int qrow = q0 + wid * QBLK + r32;
  const bf16_t* Qw = Q + (size_t)qrow * 1536 + h * DQK + hi * 8;
#pragma unroll
  for (int d0 = 0; d0 < 12; ++d0) qr[d0] = *reinterpret_cast<const bf16x8*>(Qw + d0 * 16);
  if (rope_q) { const int tl = qrow - NCTX; rope_pair(qr[8], qr[9], (float)(tl >> 6), hi); rope_pair(qr[10], qr[11], (float)(tl & 63), hi); }
  char* qsp = lds + SHM_ATTN + tid * 16;
#pragma unroll
  for (int d0 = NQREG; d0 < 12; ++d0) *reinterpret_cast<bf16x8*>(qsp + (d0 - NQREG) * 8192) = qr[d0];
  const bf16_t* Kh = KV + (size_t)kv0 * 2048 + h * 256; const bf16_t* Vh = Kh + 128; KR += (size_t)kv0 * 64;
  const int sr = tid >> 4, sc = (tid & 15) * 8, vst0 = v_st(sr, sc), vst1 = v_st(32 + sr, sc);
  const int rr = tid >> 3, rc = (tid & 7) * 8;
  const int vb0 = (int)(uintptr_t)V_lds + v_rd_base(lane);
  bf16x8 vs0, vs1, ks0, ks1, ks2;
#define SLOAD(k0) do { vs0 = *(const bf16x8*)(Vh + (size_t)((k0) + sr) * 2048 + sc); vs1 = *(const bf16x8*)(Vh + (size_t)((k0) + 32 + sr) * 2048 + sc); \
    ks0 = *(const bf16x8*)(Kh + (size_t)((k0) + sr) * 2048 + sc); ks1 = *(const bf16x8*)(Kh + (size_t)((k0) + 32 + sr) * 2048 + sc); \
    ks2 = *(const bf16x8*)(KR + (size_t)((k0) + rr) * 64 + rc); } while (0)
#define SWRITE(b) do { *(bf16x8*)(V_lds + (b) * SHM_V + vst0) = vs0; *(bf16x8*)(V_lds + (b) * SHM_V + vst1) = vs1; const int kc = sc * 2; \
    *(bf16x8*)(K_lds + (b) * SHM_K + KSWZ(sr, kc)) = ks0; *(bf16x8*)(K_lds + (b) * SHM_K + KSWZ(32 + sr, kc)) = ks1; \
    *(bf16x8*)(K_lds + (b) * SHM_K + KSWZ(rr, 256 + rc * 2)) = ks2; } while (0)
#define SWAIT() asm volatile("s_waitcnt vmcnt(0)" ::: "memory")
#define RESC(a) do { if (__any((a) < 1.f)) { if (hi == 0) al_l[r32] = (a); asm volatile("s_waitcnt lgkmcnt(0)" ::: "memory"); \
    _Pragma("unroll") for (int d = 0; d < 4; ++d) _Pragma("unroll") for (int r = 0; r < 16; ++r) o[d][r] *= al_l[crow(r, hi)]; } } while (0)
  f32x16 pA0, pA1, pB0, pB1; float mnA, mnB, alA, alB; bf16x8 pa0, pa1, pa2, pa3; const int NT = seq / KVBLK;
  SLOAD(0); SWAIT(); SWRITE(0); __syncthreads();
  qkt(pA0, pA1, K_lds, qr, qsp, r32, hi); partialSM(pA0, pA1, m_reg, mnA, alA);
  SLOAD(KVBLK);
  SWAIT(); SWRITE(1); __syncthreads();
  int bp = 0, bc = 1, bn = 2;
  for (int j = 1; j + 1 < NT; j += 2) {
    SBAR(); qkt(pB0, pB1, K_lds + bc * SHM_K, qr, qsp, r32, hi);
    finishSM(pA0, pA1, alA, l_reg, pa0, pa1, pa2, pa3); SBAR();
    SLOAD((j + 1) * KVBLK); SBAR();
    pv_d0(o, vb0 + bp * SHM_V, pa0, pa1, pa2, pa3); partialSM(pB0, pB1, m_reg, mnB, alB);
    SWAIT(); SWRITE(bn);
    RESC(alB); __syncthreads();
    bp = bc; bc = bn; bn = (bn == 2) ? 0 : bn + 1;
    SBAR(); qkt(pA0, pA1, K_lds + bc * SHM_K, qr, qsp, r32, hi);
    finishSM(pB0, pB1, alB, l_reg, pa0, pa1, pa2, pa3); SBAR();
    SLOAD((j + 2) * KVBLK); SBAR();
    pv_d0(o, vb0 + bp * SHM_V, pa0, pa1, pa2, pa3); partialSM(pA0, pA1, m_reg, mnA, alA);
    SWAIT(); SWRITE(bn);
    RESC(alA); __syncthreads();
    bp = bc; bc = bn; bn = (bn == 2) ? 0 : bn + 1;
  }
  SBAR(); qkt(pB0, pB1, K_lds + bc * SHM_K, qr, qsp, r32, hi);
  finishSM(pA0, pA1, alA, l_reg, pa0, pa1, pa2, pa3); SBAR();
  pv_d0(o, vb0 + bp * SHM_V, pa0, pa1, pa2, pa3); partialSM(pB0, pB1, m_reg, mnB, alB);
  __syncthreads(); RESC(alB);
  finishSM(pB0, pB1, alB, l_reg, pa0, pa1, pa2, pa3); SBAR();
  pv_d0(o, vb0 + bc * SHM_V, pa0, pa1, pa2, pa3);
  if (hi == 0) li_l[r32] = l_reg; asm volatile("s_waitcnt lgkmcnt(0)" ::: "memory");
  float rli[16];
#pragma unroll
  for (int r = 0; r < 16; ++r) rli[r] = __builtin_amdgcn_rcpf(li_l[crow(r, hi)]);
  if (part_o == nullptr) {
    bf16_t* Ow = MIX + (size_t)(q0 + wid * QBLK) * DM + 1024 + h * DV;
#pragma unroll
    for (int r = 0; r < 16; ++r) { const int orow = crow(r, hi);
#pragma unroll
      for (int d0 = 0; d0 < 4; ++d0) Ow[(size_t)orow * DM + d0 * 32 + r32] = f2bf(o[d0][r] * rli[r]); }
  } else {
    bf16_t* Ow = part_o + (size_t)(wid * QBLK) * DV;
#pragma unroll
    for (int r = 0; r < 16; ++r) { const int orow = crow(r, hi);
#pragma unroll
      for (int d0 = 0; d0 < 4; ++d0) Ow[(size_t)orow * DV + d0 * 32 + r32] = f2bf(o[d0][r] * rli[r]); }
    if (hi == 0) { part_ml[(wid * QBLK + r32) * 2] = m_reg; part_ml[(wid * QBLK + r32) * 2 + 1] = l_reg; }
  }
  __syncthreads();
#undef SLOAD
#undef SWRITE
#undef SWAIT
#undef RESC
}
}

__device__ __forceinline__ int attn_np(int nwg) { return nwg == 192 ? 3 : (nwg == 224 ? 7 : 0); }
__device__ __forceinline__ int attn_part_tiles(int np, int p) { return 2 * (130 / np) + (p < (130 % np) ? 2 : 0); }
__device__ __forceinline__ void phase_attention(const Params& P, int layer, char* lds, int wg, int nwg) {
  const bf16_t* Q = (const bf16_t*)(PWS() + WS_Q); const bf16_t* KV = (const bf16_t*)(PWS() + WS_KV); const bf16_t* KR = (const bf16_t*)(PWS() + WS_KR);
  bf16_t* MIX = (bf16_t*)(PWS() + WS_H); bf16_t* PO = (bf16_t*)(PWS() + WS_PARTO); float* PML = (float*)(PWS() + WS_PARTML);
  const int np = attn_np(nwg);
  const int nwhole = np ? (512 / nwg) * nwg : 512, nparts = (512 - nwhole) * np, nctx = (layer == 0) ? 8 : 0;
  for (int it = wg; it < nwhole + nparts + nctx; it += nwg) {
    int q0, h, kv0 = 0, seq = T; bool lat = true; bf16_t* po = nullptr; float* pml = nullptr;
    if (it < nwhole) { q0 = NCTX + (it & 63) * 256; h = it >> 6; }
    else if (it < nwhole + nparts) { const int q = it - nwhole, u = nwhole + q / np, p = q % np; q0 = NCTX + (u & 63) * 256; h = u >> 6;
      int t0 = 0; for (int pp = 0; pp < p; ++pp) t0 += attn_part_tiles(np, pp);
      kv0 = t0 * 64; seq = attn_part_tiles(np, p) * 64; po = PO + (size_t)q * 256 * 128; pml = PML + (size_t)q * 512; }
    else { q0 = 0; h = it - nwhole - nparts; seq = NCTX; lat = false; }
    at2::attn_unit(Q, KV, KR, MIX, q0, h, kv0, seq, lat, lds, po, pml);
  }
}
__device__ __forceinline__ void phase_attn_merge(const Params& P, int wg, int nwg) {
  const int np = attn_np(nwg); if (np == 0) return;
  const int nwhole = (512 / nwg) * nwg;
  const bf16_t* PO = (const bf16_t*)(PWS() + WS_PARTO); const float* PML = (const float*)(PWS() + WS_PARTML); bf16_t* MIX = (bf16_t*)(PWS() + WS_H);
  constexpr float C = at2::SCALE * 1.4426950408889634f;
  const int tid = mk_tid(), row = tid >> 1, c0 = (tid & 1) * 64;
  for (int us = wg; us < 512 - nwhole; us += nwg) {
    const int u = nwhole + us, q0 = NCTX + (u & 63) * 256, h = u >> 6;
    float M = -3.0e38f;
    for (int p = 0; p < np; ++p) M = fmaxf(M, PML[(size_t)(us * np + p) * 512 + row * 2]);
    float acc[64];
#pragma unroll
    for (int i = 0; i < 64; ++i) acc[i] = 0.f;
    float ws = 0.f;
#pragma unroll 1
    for (int p = 0; p < np; ++p) {
      const float* ml = PML + (size_t)(us * np + p) * 512 + row * 2;
      const float w = ml[1] * exp2f((ml[0] - M) * C); ws += w;
      const bf16_t* src = PO + ((size_t)(us * np + p) * 256 + row) * 128 + c0;
#pragma unroll
      for (int cc = 0; cc < 64; cc += 8) { const bf16x8 x = *(const bf16x8*)(src + cc);
#pragma unroll
        for (int i = 0; i < 8; ++i) acc[cc + i] += w * bf2f((bf16_t)x[i]); }
    }
    const float inv = 1.0f / ws;
#pragma unroll
    for (int cc = 0; cc < 64; cc += 8) {
      u32x4 o; o.x = cvtpk(acc[cc] * inv, acc[cc + 1] * inv); o.y = cvtpk(acc[cc + 2] * inv, acc[cc + 3] * inv); o.z = cvtpk(acc[cc + 4] * inv, acc[cc + 5] * inv); o.w = cvtpk(acc[cc + 6] * inv, acc[cc + 7] * inv);
      *(u32x4*)(MIX + (size_t)(q0 + row) * DM + 1024 + h * 128 + c0 + cc) = o;
    }
  }
}

#ifndef REP_ATT
#define REP_ATT 1
#endif
#ifndef REP_SCAN
#define REP_SCAN 1
#endif
#ifndef REP_PREP
#define REP_PREP 1
#endif
#ifndef REP_GU
#define REP_GU 1
#endif
#ifndef REP_MISC
#define REP_MISC 1
#endif
#ifndef N_SCAN_WG
#define N_SCAN_WG 64
#endif
__device__ __forceinline__ void grid_barrier(unsigned* ctr, unsigned target) {
  asm volatile("s_waitcnt vmcnt(0) lgkmcnt(0)" ::: "memory");
  __syncthreads();
  if (mk_tid() == 0) {
    __builtin_amdgcn_fence(__ATOMIC_RELEASE, "agent");
    __hip_atomic_fetch_add(ctr, 1u, __ATOMIC_RELAXED, __HIP_MEMORY_SCOPE_AGENT);
    while (__hip_atomic_load(ctr, __ATOMIC_RELAXED, __HIP_MEMORY_SCOPE_AGENT) < target) __builtin_amdgcn_s_sleep(2);
    __builtin_amdgcn_fence(__ATOMIC_ACQUIRE, "agent");
  }
  __syncthreads();
}
__device__ __forceinline__ void grid_arrive(unsigned* ctr) {
  asm volatile("s_waitcnt vmcnt(0) lgkmcnt(0)" ::: "memory");
  __syncthreads();
  if (mk_tid() == 0) { __builtin_amdgcn_fence(__ATOMIC_RELEASE, "agent"); __hip_atomic_fetch_add(ctr, 1u, __ATOMIC_RELAXED, __HIP_MEMORY_SCOPE_AGENT); }
}
enum { K_MOD = 0, K_NORM1, K_GEMM_IN, K_PREP, K_MIX, K_RWOUT, K_GEMM_OUT, K_NORM2, K_GEMM_GU, K_ACT, K_GEMM_DN, K_FINAL };
constexpr int STEPS_PER_LAYER = 10, N_STEPS = 1 + 2 * STEPS_PER_LAYER + 1;
__global__ void __launch_bounds__(NTH) fwd_megakernel(Params P_arg) {
  extern __shared__ __attribute__((aligned(16))) unsigned char lds[];
  cg::grid_group grid = cg::this_grid();
  const int lo = P_arg.ph_lo, hi = P_arg.ph_hi;
  unsigned nbar = 0, nsub = 0, nscn = 0;
#pragma unroll 1
  for (int st = lo; st < hi; ++st) {
    const Params& P = P_arg;
    int kind, layer = 0;
    if (st == 0) kind = K_MOD; else if (st == N_STEPS - 1) kind = K_FINAL; else { layer = (st - 1) / STEPS_PER_LAYER; kind = K_NORM1 + (st - 1) % STEPS_PER_LAYER; }
    const bool last = (layer == 1);
    float* ldsf = (float*)lds;
    bool sync_after = true;
    switch (kind) {
      case K_MOD: for (int rep = 0; rep < REP_MISC; ++rep) phase_mod(P, ldsf); break;
      case K_NORM1: for (int rep = 0; rep < REP_MISC; ++rep) phase_convert(P, layer, ldsf); break;
      case K_PREP: for (int rep = 0; rep < REP_PREP; ++rep) phase_prep<0>(P, layer, ldsf, mk_bid(), mk_nblk()); break;
      case K_MIX: {
        const int G = mk_nblk();
        const int vcu = (G % 8 == 0) ? (mk_bid() % 8) * (G / 8) + mk_bid() / 8 : mk_bid();
        const int nscan = (G >= 2 * N_SCAN_WG) ? N_SCAN_WG : 0;
        unsigned* sbar = (unsigned*)(PWS() + WS_BAR) + 32;
        const int sg = vcu - nscan, SG = G - nscan;
        const unsigned per_layer = (unsigned)(G + 2 * SG), base = per_layer * (unsigned)layer;
        phase_prep<1>(P, layer, ldsf, vcu, G);
        if (vcu < nscan) {
          grid_arrive(sbar);
          for (int sc = vcu; sc < ((N_SCAN_WG == 32) ? 32 : 64); sc += nscan) rwkv_scan<(N_SCAN_WG == 32) ? 8 : 4>(P, sc, ldsf);
        } else {
          grid_barrier(sbar, base + (unsigned)G);
          if (nscan == 0) { for (int sc = vcu; sc < ((N_SCAN_WG == 32) ? 32 : 64); sc += G) rwkv_scan<(N_SCAN_WG == 32) ? 8 : 4>(P, sc, ldsf); __syncthreads(); }
#pragma unroll 1
          for (int q = 0; q < 2; ++q) {
            const size_t ro = (q == 0 && last) ? NCTX : 0;
            const bf16_t* A = (const bf16_t*)(PWS() + (q ? WS_KVN : WS_QN)) + ro * 512; const bf16_t* Bt = (const bf16_t*)(PWS() + (q ? WS_WKV : WS_WQ));
            EpiStore E{(bf16_t*)(PWS() + (q ? WS_KV : WS_Q)) + ro * 1536, q ? 2048 : 1536};
            run_gemm(lds, A, Bt, T - (int)ro, q ? 2048 : 1536, q ? 256 : 512, E, sg, SG);
          }
          phase_lru_agg(P, sg, SG);
          grid_barrier(sbar, base + (unsigned)(G + SG));
          phase_attention(P, layer, (char*)lds, sg, SG);
          __syncthreads();
          phase_lru_out(P, layer, ldsf, sg, SG);
          grid_barrier(sbar, base + per_layer);
          phase_attn_merge(P, sg, SG);
        }
      } break;
      case K_RWOUT: phase_rwkv_out(P, layer, mk_bid(), mk_nblk()); break;
      case K_ACT: for (int rep = 0; rep < REP_MISC; ++rep) phase_ffn_act(P, layer); break;
      case K_FINAL: phase_final_norm(P); break;
      default: break;
    }
    if (kind == K_NORM1 || kind == K_NORM2) for (int rep = 0; rep < REP_MISC; ++rep) phase_norm(P, layer, kind == K_NORM2 ? 1 : 0, kind == K_NORM2 && last);
    if (kind == K_GEMM_IN || kind == K_GEMM_GU) {
      const bf16_t* A; const bf16_t* Bt; bf16_t* O; int M = T, N, K;
      if (kind == K_GEMM_IN) { A = (const bf16_t*)(PWS() + WS_H); Bt = (const bf16_t*)(PWS() + WS_WIN); O = (bf16_t*)(PWS() + WS_COLS); N = NIN; K = DM; }
      else { const size_t ro = last ? NCTX : 0; A = (const bf16_t*)(PWS() + WS_H) + ro * DM; Bt = (const bf16_t*)(PWS() + WS_WGU); O = (bf16_t*)(PWS() + WS_GU) + ro * NGU; M = last ? T - NCTX : T; N = NGU; K = DM; }
      EpiStore E{O, N};
      run_gemm(lds, A, Bt, M, N, K, E, mk_bid(), mk_nblk());
    }
    if (kind == K_GEMM_OUT || kind == K_GEMM_DN) {
      const float* mod_l = (const float*)(PWS() + WS_MOD) + (size_t)(layer * 2 + 0) * 12288; const float* mod_c = mod_l + 12288;
      const int goff = (kind == K_GEMM_OUT) ? 4096 : 10240;
      EpiResid E{(const float*)(PWS() + WS_XC), POUT(), (float*)(PWS() + WS_XC), POUT(), mod_c + goff, mod_l + goff, NCTX};
      if (kind == K_GEMM_OUT && layer == 0) { E.src_c = PIN(I_CTX); E.src_l = PIN(I_X); }
      const int Kf = (kind == K_GEMM_OUT) ? DM : DFF;
      const bf16_t* A0 = (kind == K_GEMM_OUT) ? (const bf16_t*)(PWS() + WS_H) : (const bf16_t*)(PWS() + WS_ACT);
      const bf16_t* Bt = (kind == K_GEMM_OUT) ? (const bf16_t*)(PWS() + WS_WOUT) : (const bf16_t*)(PWS() + WS_WDN);
      run_gemm(lds, A0 + (size_t)NCTX * Kf, Bt, T - NCTX, DM, Kf, E, mk_bid(), mk_nblk());
      if (!last) {
        EpiResidAtomic EA{(float*)(PWS() + WS_XC), mod_c + goff};
        run_gemm(lds, A0, Bt, (Kf / 512) * 256, DM, 512, EA, mk_bid(), mk_nblk(), Kf, 512);
      }
    }
    if (sync_after && st + 1 < hi) {
      if (st == lo) grid.sync();
      else { ++nbar; grid_barrier((unsigned*)(PWS() + WS_BAR), nbar * mk_nblk()); }
    }
  }
}

#ifndef MK_PER_PHASE
#define MK_PER_PHASE 0
#endif
extern "C" void kernel_launch(void* const* d_in, const int* in_sizes, int n_in, void* d_out, int out_size, void* d_ws, size_t ws_size, hipStream_t stream) {
  static int grid = 0;
  if (grid == 0) {
    if (n_in != 42 || out_size != (T - NCTX) * DM || ws_size < WS_END) { fprintf(stderr, "kernel_launch: unexpected shapes (n_in %d out %d ws %zu need %zu)\n", n_in, out_size, ws_size, (size_t)WS_END); grid = -1; return; }
    int dev = 0, cus = 0, per_cu = 0;
    (void)hipGetDevice(&dev); (void)hipDeviceGetAttribute(&cus, hipDeviceAttributeMultiprocessorCount, dev);
    if (hipFuncSetAttribute((const void*)fwd_megakernel, hipFuncAttributeMaxDynamicSharedMemorySize, LDS_BYTES) != hipSuccess) { fprintf(stderr, "kernel_launch: hipFuncSetAttribute failed\n"); grid = -1; return; }
    if (hipOccupancyMaxActiveBlocksPerMultiprocessor(&per_cu, (const void*)fwd_megakernel, NTH, LDS_BYTES) != hipSuccess || per_cu < 1) per_cu = 1;
    (void)hipGetLastError();
    grid = (cus > 0 ? cus : 256) * per_cu;
  }
  if (grid < 0) return;
  if (hipMemsetAsync((char*)d_ws + WS_BAR, 0, 256, stream) != hipSuccess) { fprintf(stderr, "kernel_launch: memset failed\n"); return; }
  Params p{};
  for (int i = 0; i < 42; ++i) p.in[i] = (const float*)d_in[i];
  p.out = (float*)d_out; p.ws = (unsigned char*)d_ws;
#if MK_PER_PHASE
  for (int st = 0; st < N_STEPS; ++st) { p.ph_lo = st; p.ph_hi = st + 1; hipLaunchKernelGGL(fwd_megakernel, dim3(grid), dim3(NTH), LDS_BYTES, stream, p); }
#else
  p.ph_lo = 0; p.ph_hi = N_STEPS;
  void* args[] = {&p};
  hipError_t e = hipLaunchCooperativeKernel((const void*)fwd_megakernel, dim3(grid), dim3(NTH), args, LDS_BYTES, stream);
  if (e != hipSuccess) fprintf(stderr, "cooperative launch failed: %s (grid %d)\n", hipGetErrorString(e), grid);
#endif
}
```

```cpp
#include <hip/hip_runtime.h>
#include <hip/hip_cooperative_groups.h>
#include <cstdio>
#include <cstdint>
__device__ __forceinline__ int mk_tid() { int t = (int)threadIdx.x; asm volatile("" : "+v"(t)); return t; }
__device__ __forceinline__ int mk_bid() { int b = (int)blockIdx.x; asm volatile("" : "+s"(b)); return b; }
__device__ __forceinline__ int mk_nblk() { int g = (int)gridDim.x; asm volatile("" : "+s"(g)); return g; }
template <int OFF> __device__ __forceinline__ unsigned long long kp_load() {
  unsigned long long r; auto kp = __builtin_amdgcn_kernarg_segment_ptr();
  asm volatile("s_load_dwordx2 %0, %1, %2\n\ts_waitcnt lgkmcnt(0)" : "=s"(r) : "s"(kp), "i"(OFF));
  return r;
}
#define PIN(i) ((const float*)kp_load<8 * (i)>())
#define POUT() ((float*)kp_load<8 * 42>())
#define PWS() ((unsigned char*)kp_load<8 * 43>())
namespace pg8 {
#define PG8_LAS __attribute__((address_space(3)))
typedef unsigned short bf16_t;
typedef short bf16x8 __attribute__((ext_vector_type(8)));
typedef float f32x4 __attribute__((ext_vector_type(4)));
typedef unsigned u32x4 __attribute__((ext_vector_type(4)));
constexpr int BM = 256, BK = 64, HALF = 128, HTB = HALF * BK * 2  , STAGE_BYTES = 8 * HTB, NXCD = 8, WGM = 8;

__host__ __device__ __forceinline__ int lds_byte(int r, int c) { const int st = (r >> 4) * 2 + (c >> 5), rr = r & 15, cc = c & 31, ob = rr * 64 + cc * 2; return st * 1024 + (ob ^ (((ob >> 9) & 1) << 5)); }
__host__ __device__ __forceinline__ void stage_rc(int b, int& R, int& C) { const int st = b / 1024, sb = b % 1024, swz = sb ^ (((sb >> 9) & 1) << 5); R = (st >> 1) * 16 + swz / 64; C = (st & 1) * 32 + (swz % 64) / 2; }
__host__ __device__ __forceinline__ int perm32(int rho) { const int n = rho >> 4, i = rho & 15; return 8 * (i >> 2) + 4 * n + (i & 3); }

struct Unit { int pm, pn; };
struct Gemm { const bf16_t* A; const bf16_t* Bt; int M, N, K; int ld; int ksplit; };

struct StaticOrder {
    int nM, nN, nwg, G, c;
    __host__ __device__ void init(int M, int N, int G_, int c_) { nM = M / BM; nN = N / BM; nwg = nM * nN; G = G_; c = c_; }
    __host__ __device__ bool next(int i, Unit& u) const {
        const long L = (long)i * G + c; if (L >= nwg) return false;
        int wgid = (int)L; { const int q = nwg / NXCD, r = nwg % NXCD, xcd = wgid % NXCD, off = wgid / NXCD; wgid = (xcd < r ? xcd * (q + 1) : r * (q + 1) + (xcd - r) * q) + off; }
        const int nig = WGM * nN, gid = wgid / nig, fm = gid * WGM, gsz = (nM - fm) < WGM ? (nM - fm) : WGM;
        u.pm = fm + ((wgid % nig) % gsz); u.pn = (wgid % nig) / gsz; return true;
    }
    __device__ __forceinline__ void a_ready(const Unit&) const {}
    __device__ __forceinline__ void done(const Unit&) const {}
};
__device__ __forceinline__ unsigned cvt_pk_bf16(float lo, float hi) { unsigned r; asm volatile("v_cvt_pk_bf16_f32 %0, %1, %2" : "=v"(r) : "v"(lo), "v"(hi)); return r; }
typedef float f32x2 __attribute__((ext_vector_type(2)));
template <class Epi, class Sched, bool STAMP = false>
__device__ __forceinline__ void gemm_phase(PG8_LAS unsigned char* lds, const Gemm g, const Sched& S, const Epi& E, unsigned long long* stamps) {
    const int tid = mk_tid(), wid = __builtin_amdgcn_readfirstlane(tid >> 6), lane = tid & 63, wr = wid >> 2, wc = wid & 3, fr = lane & 15, fq = lane >> 4;
    const int K = g.K, nt = K / BK, LD = g.ld; const size_t ksb = (size_t)g.ksplit * 2;
    int ts_lo = 0, ts_hi = 0, nts = 0; const unsigned long long rt_entry = STAMP ? (unsigned long long)wall_clock64() : 0ull;
#define PG8_STAMP() do { if (STAMP && wid == 0 && nts < 64) { const unsigned long long _c = (unsigned long long)clock64(); \
        ts_lo = (lane == nts) ? (int)(unsigned)_c : ts_lo; ts_hi = (lane == nts) ? (int)(unsigned)(_c >> 32) : ts_hi; ++nts; } } while (0)
    PG8_STAMP();
    unsigned voffA[2], voffB[2];
#pragma unroll
    for (int i = 0; i < 2; ++i) { int R, C; stage_rc(tid * 16 + i * 8192, R, C); const int Rb = Epi::PERM ? ((R & ~31) + perm32(R & 31)) : R;
        voffA[i] = (unsigned)(R * LD + C) * 2u; voffB[i] = (unsigned)(Rb * LD + C) * 2u; }
    const size_t kstep = (size_t)(BK * 2);
    const size_t hstep = (size_t)HALF * LD * 2;
    const size_t tstep = 2 * hstep;
    const unsigned ldsw = (unsigned)wid * 1024u;
    const int aoff = lds_byte(wr * 64 + fr, fq * 8), boff = lds_byte(wc * 32 + fr, fq * 8);
#define PG8_SA(b, h) (((b) * 2 + (h)) * HTB)
#define PG8_SB(b, h) ((4 + (b) * 2 + (h)) * HTB)
#define PG8_STAGE(bufoff, gbase, voff) do { _Pragma("unroll") for (int _i = 0; _i < 2; ++_i) \
        __builtin_amdgcn_global_load_lds((const unsigned*)((const char*)(gbase) + (voff)[_i]), (PG8_LAS unsigned*)(lds + (bufoff) + ldsw + _i * 8192), 16, 0, 0); } while (0)
#define PG8_LDA(dst, b, h) do { _Pragma("unroll") for (int m = 0; m < 4; ++m) _Pragma("unroll") for (int k = 0; k < 2; ++k) dst[m][k] = *(const PG8_LAS bf16x8*)(lds + PG8_SA(b, h) + aoff + m * 2048 + k * 1024); } while (0)
#define PG8_LDB(dst, b, h) do { _Pragma("unroll") for (int n = 0; n < 2; ++n) _Pragma("unroll") for (int k = 0; k < 2; ++k) dst[n][k] = *(const PG8_LAS bf16x8*)(lds + PG8_SB(b, h) + boff + n * 2048 + k * 1024); } while (0)
#define PG8_MMA(ai, bj, At, Bt) do { __builtin_amdgcn_s_setprio(1); _Pragma("unroll") for (int m = 0; m < 4; ++m) _Pragma("unroll") for (int n = 0; n < 2; ++n) _Pragma("unroll") for (int k = 0; k < 2; ++k) \
        acc[ai][bj][m][n] = __builtin_amdgcn_mfma_f32_16x16x32_bf16(Bt[n][k], At[m][k], acc[ai][bj][m][n], 0, 0, 0); __builtin_amdgcn_s_setprio(0); } while (0)
#define PG8_WAIT_V(n) asm volatile("s_waitcnt vmcnt(" #n ")" ::: "memory")
#define PG8_WAIT_L(n) asm volatile("s_waitcnt lgkmcnt(" #n ")" ::: "memory")
#define PG8_BAR __builtin_amdgcn_s_barrier()
#define PG8_SCHED __builtin_amdgcn_sched_barrier(0)
    Unit cur, nxt; int ui = 0;
    if (!S.next(0, cur)) return;
    f32x4 acc[2][2][4][2];
#pragma unroll
    for (int a = 0; a < 2; ++a)
#pragma unroll
        for (int b = 0; b < 2; ++b)
#pragma unroll
            for (int m = 0; m < 4; ++m)
#pragma unroll
                for (int n = 0; n < 2; ++n) acc[a][b][m][n] = (f32x4){0.f, 0.f, 0.f, 0.f};
    bf16x8 At[4][2], B0[2][2], B1[2][2];
    const char* cA = (const char*)g.A + (ksb ? (size_t)cur.pm * ksb : (size_t)cur.pm * tstep); const char* cB = (const char*)g.Bt + (size_t)cur.pn * tstep + (size_t)cur.pm * ksb;
    S.a_ready(cur);
    PG8_STAGE(PG8_SB(0, 0), cB, voffB); PG8_STAGE(PG8_SA(0, 0), cA, voffA); PG8_STAGE(PG8_SB(0, 1), cB + hstep, voffB); PG8_STAGE(PG8_SA(0, 1), cA + hstep, voffA);
    if (wr == 1) PG8_BAR;
    PG8_WAIT_V(4); PG8_BAR;
    PG8_STAGE(PG8_SB(1, 0), cB + kstep, voffB); PG8_STAGE(PG8_SA(1, 0), cA + kstep, voffA); PG8_STAGE(PG8_SB(1, 1), cB + hstep + kstep, voffB);
    PG8_WAIT_V(6); PG8_BAR;
    PG8_STAMP();
    for (;;) {
        const bool has_next = S.next(ui + 1, nxt);
        const char* nA = has_next ? (const char*)g.A + (ksb ? (size_t)nxt.pm * ksb : (size_t)nxt.pm * tstep) : cA; const char* nB = has_next ? (const char*)g.Bt + (size_t)nxt.pn * tstep + (size_t)nxt.pm * ksb : cB;
        for (int t = 0; t < nt; t += 2) {
            const bool last = (t == nt - 2);
            const char* a1 = cA + (size_t)(t + 1) * kstep;
            const char* a2 = last ? nA : cA + (size_t)(t + 2) * kstep; const char* b2 = last ? nB : cB + (size_t)(t + 2) * kstep;
            const char* a3 = a2 + kstep; const char* b3 = b2 + kstep;
            if (last && has_next) S.a_ready(nxt);
            PG8_LDB(B0, 0, 0); PG8_SCHED; PG8_LDA(At, 0, 0); PG8_STAGE(PG8_SA(1, 1), a1 + hstep, voffA);
            PG8_WAIT_L(8); PG8_BAR; PG8_WAIT_L(0); PG8_MMA(0, 0, At, B0); PG8_BAR; PG8_SCHED;
            PG8_LDB(B1, 0, 1); PG8_STAGE(PG8_SB(0, 0), b2, voffB);
            PG8_BAR; PG8_WAIT_L(0); PG8_MMA(0, 1, At, B1); PG8_BAR;
            PG8_LDA(At, 0, 1); PG8_STAGE(PG8_SA(0, 0), a2, voffA);
            PG8_BAR; PG8_WAIT_L(0); PG8_MMA(1, 0, At, B0); PG8_BAR; PG8_SCHED;
            PG8_STAGE(PG8_SB(0, 1), b2 + hstep, voffB);
            PG8_WAIT_V(6); PG8_BAR; PG8_MMA(1, 1, At, B1); PG8_BAR;
            PG8_LDB(B0, 1, 0); PG8_SCHED; PG8_LDA(At, 1, 0); PG8_STAGE(PG8_SA(0, 1), a2 + hstep, voffA);
            PG8_WAIT_L(8); PG8_BAR; PG8_WAIT_L(0); PG8_MMA(0, 0, At, B0); PG8_BAR; PG8_SCHED;
            PG8_LDB(B1, 1, 1); PG8_STAGE(PG8_SB(1, 0), b3, voffB);
            PG8_BAR; PG8_WAIT_L(0); PG8_MMA(0, 1, At, B1); PG8_BAR;
            PG8_LDA(At, 1, 1); PG8_STAGE(PG8_SA(1, 0), a3, voffA);
            PG8_BAR; PG8_WAIT_L(0); PG8_MMA(1, 0, At, B0); PG8_BAR; PG8_SCHED;
            PG8_STAGE(PG8_SB(1, 1), b3 + hstep, voffB);
            PG8_WAIT_V(6); PG8_BAR; PG8_MMA(1, 1, At, B1); PG8_BAR;
        }
        PG8_STAMP();
        if constexpr (!Epi::AFTER_DRAIN) { E(acc, cur, wr, wc, fr, fq); S.done(cur); }
        PG8_STAMP();
        if (!has_next) break;
#pragma unroll
        for (int a = 0; a < 2; ++a)
#pragma unroll
            for (int b = 0; b < 2; ++b)
#pragma unroll
                for (int m = 0; m < 4; ++m)
#pragma unroll
                    for (int n = 0; n < 2; ++n) acc[a][b][m][n] = (f32x4){0.f, 0.f, 0.f, 0.f};
        cur = nxt; cA = nA; cB = nB; ++ui;
    }
    PG8_WAIT_V(0);
    if (wr == 0) PG8_BAR;
    PG8_BAR;
    if constexpr (Epi::AFTER_DRAIN) { E.fused(acc, cur, wr, wc, fr, fq, lds, wid, lane); S.done(cur); }
    PG8_STAMP();
    if (STAMP && wid == 0) { stamps[lane] = lane < nts ? (((unsigned long long)(unsigned)ts_hi << 32) | (unsigned)ts_lo) : 0ull;
        if (lane == 62) stamps[62] = rt_entry; if (lane == 63) stamps[63] = (unsigned long long)wall_clock64(); }
#undef PG8_STAMP
#undef PG8_SA
#undef PG8_SB
#undef PG8_STAGE
#undef PG8_LDA
#undef PG8_LDB
#undef PG8_MMA
#undef PG8_WAIT_V
#undef PG8_WAIT_L
#undef PG8_BAR
#undef PG8_SCHED
}
}

namespace cg = cooperative_groups;
typedef unsigned short bf16_t;
typedef short bf16x8 __attribute__((ext_vector_type(8)));
typedef short s16x4 __attribute__((ext_vector_type(4)));
typedef float f32x4 __attribute__((ext_vector_type(4)));
typedef float f32x8 __attribute__((ext_vector_type(8)));
typedef float f32x16 __attribute__((ext_vector_type(16)));
typedef unsigned u32x4 __attribute__((ext_vector_type(4)));
typedef unsigned u32x2 __attribute__((ext_vector_type(2)));

constexpr int T = 16640, NCTX = 256, DM = 2048, NTH = 512;
constexpr int NIN = 3840;
constexpr int DFF = 5632, NGU = 2 * DFF;
constexpr int C_LRU = 1760, C_MLA = 2784, C_VD = 3616;
constexpr int RECB = 896;
constexpr int LDS_BYTES = 150528;

constexpr size_t al256(size_t x) { return (x + 255) / 256 * 256; }
constexpr size_t WS_BAR = 0;
constexpr size_t WS_MOD = 256;
constexpr size_t WS_XC = al256(WS_MOD + 2 * 2 * 12288 * 4);
constexpr size_t WS_H = al256(WS_XC + (size_t)NCTX * DM * 4);
constexpr size_t WS_VF = al256(WS_H + (size_t)T * DM * 2);
constexpr size_t WS_WIN = al256(WS_VF + (size_t)T * 512 * 2);
constexpr size_t WS_WOUT = al256(WS_WIN + (size_t)NIN * DM * 2);
constexpr size_t WS_WQ = al256(WS_WOUT + (size_t)DM * DM * 2);
constexpr size_t WS_WKV = al256(WS_WQ + (size_t)1536 * 512 * 2);
constexpr size_t WS_WGU = al256(WS_WKV + (size_t)2048 * 256 * 2);
constexpr size_t WS_WDN = al256(WS_WGU + (size_t)NGU * DM * 2);
constexpr size_t WS_R = al256(WS_WDN + (size_t)DM * DFF * 2);
constexpr size_t WS_COLS = WS_R;
constexpr size_t WS_Q = WS_COLS;
constexpr size_t WS_KV = al256(WS_Q + (size_t)T * 1536 * 2);
constexpr size_t WS_REC = al256(WS_COLS + (size_t)T * NIN * 2);
constexpr size_t WS_Y = al256(WS_REC + (size_t)16 * T * RECB);
constexpr size_t WS_LAB = al256(WS_Y + (size_t)2 * T * 512 * 4);
constexpr size_t WS_GG = al256(WS_LAB + (size_t)T * 2048 * 2);
constexpr size_t WS_QN = al256(WS_GG + (size_t)T * 512 * 2);
constexpr size_t WS_KVN = al256(WS_QN + (size_t)T * 512 * 2);
constexpr size_t WS_KR = al256(WS_KVN + (size_t)T * 256 * 2);
constexpr size_t WS_RG = al256(WS_KR + (size_t)T * 64 * 2);
constexpr size_t WS_CV = al256(WS_RG + (size_t)T * 512 * 2);
constexpr size_t WS_AGG = al256(WS_CV + (size_t)T * 512 * 2);
constexpr size_t WS_MIX_END = al256(WS_AGG + (size_t)260 * 2048 * 4);
constexpr size_t WS_GU = WS_R;
constexpr size_t WS_ACT = al256(WS_GU + (size_t)T * NGU * 2);
constexpr size_t WS_FFN_END = al256(WS_ACT + (size_t)T * DFF * 2);
constexpr size_t WS_REND = WS_MIX_END > WS_FFN_END ? WS_MIX_END : WS_FFN_END;
constexpr size_t WS_PARTO = WS_REND;
constexpr size_t WS_PARTML = al256(WS_PARTO + (size_t)448 * 256 * 128 * 2);
constexpr size_t WS_END = al256(WS_PARTML + (size_t)448 * 512 * 4);
static_assert(WS_KV + (size_t)T * 2048 * 2 <= WS_REC, "Q|KV must fit in the cols buffer");

struct Params { const float* in[42]; float* out; unsigned char* ws; int ph_lo, ph_hi; };

enum { I_X = 0, I_C, I_CTX, I_CCTX, I_ADAW, I_ADAB, I_NORM1, I_NORM2, I_WIN, I_WOUT, I_RWCONV, I_RWCONVB, I_RWW0, I_RWWUP, I_RWA0, I_RWAUP, I_RWGUP,
       I_RWKK, I_RWKA, I_RWRK, I_RWLNG, I_RWLNB, I_RWV0, I_RWVDOWN, I_RWVUP, I_LRUCONV, I_LRUCONVB, I_LRUWA, I_LRUBA, I_LRUWX, I_LRUBX, I_LRULAM,
       I_QNORM, I_WQB, I_KVNORM, I_WKVB, I_WGATE, I_WUP, I_FCONV, I_FCONVB, I_WDOWN, I_FNORM };

__device__ __forceinline__ float bf2f(bf16_t b) { return __uint_as_float(((unsigned)b) << 16); }
__device__ __forceinline__ unsigned cvtpk(float lo, float hi) { unsigned r; asm volatile("v_cvt_pk_bf16_f32 %0, %1, %2" : "=v"(r) : "v"(lo), "v"(hi)); return r; }
__device__ __forceinline__ bf16_t f2bf(float f) { return (bf16_t)(cvtpk(f, 0.f) & 0xffffu); }
__device__ __forceinline__ float sigmoidf_(float x) { return __builtin_amdgcn_rcpf(1.0f + __expf(-x)); }
__device__ __forceinline__ float tanhf_(float x) { return 1.0f - 2.0f * __builtin_amdgcn_rcpf(1.0f + __expf(2.0f * x)); }
__device__ __forceinline__ float siluf_(float x) { return x * sigmoidf_(x); }
__device__ __forceinline__ float gelu_tanh(float x) { const float u = 0.7978845608028654f * (x + 0.044715f * x * x * x); return 0.5f * x * (1.0f + tanhf_(u)); }
__device__ __forceinline__ float wave_sum(float v) {
#pragma unroll
  for (int o = 32; o >= 1; o >>= 1) v += __shfl_xor(v, o);
  return v;
}
template <int CTRL> __device__ __forceinline__ float dpp_add(float x) {
  const int xi = __float_as_int(x);
  const int yi = __builtin_amdgcn_update_dpp(xi, xi, CTRL, 0xF, 0xF, false);
  return x + __int_as_float(yi);
}
__device__ __forceinline__ float fma_(float a, float b, float c) { float r; asm("v_fma_f32 %0, %1, %2, %3" : "=v"(r) : "v"(a), "v"(b), "v"(c)); return r; }
__device__ __forceinline__ float mul_(float a, float b) { float r; asm("v_mul_f32 %0, %1, %2" : "=v"(r) : "v"(a), "v"(b)); return r; }
__device__ __forceinline__ float add_(float a, float b) { float r; asm("v_add_f32 %0, %1, %2" : "=v"(r) : "v"(a), "v"(b)); return r; }
typedef float f32x2 __attribute__((ext_vector_type(2)));
__device__ __forceinline__ float dot4(f32x4 a, f32x4 b) { const f32x2 t = a.lo * b.lo + a.hi * b.hi; return t.x + t.y; }
__device__ __forceinline__ float row16_sum(float x) {
  x = dpp_add<0xB1>(x);
  x = dpp_add<0x4E>(x);
  x = dpp_add<0x141>(x);
  x = dpp_add<0x140>(x);
  return x;
}
__device__ __forceinline__ const float* resid_src(const Params& P, int layer, int t) {
  if (layer == 0) return t < NCTX ? PIN(I_CTX) + (size_t)t * DM : PIN(I_X) + (size_t)(t - NCTX) * DM;
  return t < NCTX ? (const float*)(PWS() + WS_XC) + (size_t)t * DM : POUT() + (size_t)(t - NCTX) * DM;
}
__device__ __forceinline__ float* resid_dst(const Params& P, int t) {
  return t < NCTX ? (float*)(PWS() + WS_XC) + (size_t)t * DM : POUT() + (size_t)(t - NCTX) * DM;
}
__device__ __forceinline__ int scan_pos_rev(int t) { return t < NCTX ? (NCTX - 1 - t) : (T + NCTX - 1 - t); }

__device__ __forceinline__ void phase_mod(const Params& P, float* lds) {
  const int tid = mk_tid(), cgp = tid & 15, rg = tid >> 4;
  float* mod = (float*)(PWS() + WS_MOD);
  const float* cvec = PIN(I_C); const float* ccvec = PIN(I_CCTX); const float* adaw = PIN(I_ADAW); const float* adab = PIN(I_ADAB);
  for (int item = mk_bid(); item < 2 * 192; item += mk_nblk()) {
    const int layer = item / 192, col0 = (item % 192) * 64;
    const float* W = adaw + (size_t)layer * DM * 12288 + col0 + cgp * 4;
    f32x4 al = {0.f, 0.f, 0.f, 0.f}, ac = {0.f, 0.f, 0.f, 0.f};
#pragma unroll 1
    for (int r0 = 0; r0 < 64; r0 += 8) {
      f32x4 wv[8]; float sl[8], sc[8];
#pragma unroll
      for (int r = 0; r < 8; ++r) { const int row = rg * 64 + r0 + r; wv[r] = *(const f32x4*)(W + (size_t)row * 12288); sl[r] = cvec[row]; sc[r] = ccvec[row]; }
#pragma unroll
      for (int r = 0; r < 8; ++r) { al += siluf_(sl[r]) * wv[r]; ac += siluf_(sc[r]) * wv[r]; }
    }
#pragma unroll
    for (int i = 0; i < 4; ++i) { lds[(rg * 2 + 0) * 64 + cgp * 4 + i] = al[i]; lds[(rg * 2 + 1) * 64 + cgp * 4 + i] = ac[i]; }
    __syncthreads();
    if (tid < 128) {
      const int which = tid >> 6, col = tid & 63; float sacc = 0.f;
      for (int g = 0; g < 32; ++g) sacc += lds[(g * 2 + which) * 64 + col];
      mod[(size_t)(layer * 2 + which) * 12288 + col0 + col] = sacc + adab[(size_t)layer * 12288 + col0 + col];
    }
    __syncthreads();
  }
}

struct CvtItem { const float* src; bf16_t* dst; int K, N, kt, ntile; bool valid; };
__device__ __forceinline__ CvtItem cvt_decode(const Params& P, int layer, int it) {
  CvtItem r; r.src = nullptr; r.dst = nullptr; r.K = 64; r.N = 0; r.kt = 0; r.ntile = 0; r.valid = false;
  int base = 0;
#define CVT_JOB(SRC, DST, KK, NN) do { const int nkt_ = (KK) / 64, cnt_ = nkt_ * (((NN) + 63) / 64); \
    if (!r.valid && it < base + cnt_) { const int tl_ = it - base; r.src = (SRC); r.dst = (DST); r.K = (KK); r.N = (NN); r.kt = tl_ % nkt_; r.ntile = tl_ / nkt_; r.valid = true; } base += cnt_; } while (0)
  CVT_JOB(PIN(I_WIN) + (size_t)layer * DM * 3616, (bf16_t*)(PWS() + WS_WIN), DM, 3616);
  CVT_JOB(PIN(I_RWVDOWN), (bf16_t*)(PWS() + WS_WIN) + (size_t)C_VD * DM, DM, (layer == 0) ? 0 : 32);
  CVT_JOB(PIN(I_WOUT) + (size_t)layer * DM * DM, (bf16_t*)(PWS() + WS_WOUT), DM, DM);
  CVT_JOB(PIN(I_WQB) + (size_t)layer * 512 * 1536, (bf16_t*)(PWS() + WS_WQ), 512, 1536);
  CVT_JOB(PIN(I_WKVB) + (size_t)layer * 256 * 2048, (bf16_t*)(PWS() + WS_WKV), 256, 2048);
  CVT_JOB(PIN(I_WGATE) + (size_t)layer * DM * DFF, (bf16_t*)(PWS() + WS_WGU), DM, DFF);
  CVT_JOB(PIN(I_WUP) + (size_t)layer * DM * DFF, (bf16_t*)(PWS() + WS_WGU) + (size_t)DFF * DM, DM, DFF);
  CVT_JOB(PIN(I_WDOWN) + (size_t)layer * DFF * DM, (bf16_t*)(PWS() + WS_WDN), DFF, DM);
#undef CVT_JOB
  return r;
}
__device__ __forceinline__ void cvt_load(const CvtItem& c, f32x4 (&v)[2]) {
  const int tid = mk_tid(), kr = tid >> 4, nc = (tid & 15) * 4, k0 = c.kt * 64, n0 = c.ntile * 64;
#pragma unroll
  for (int i = 0; i < 2; ++i) { v[i] = (f32x4){0.f, 0.f, 0.f, 0.f}; if (c.valid && n0 + nc < c.N) v[i] = *(const f32x4*)(c.src + (size_t)(k0 + kr + 32 * i) * c.N + n0 + nc); }
}
__device__ __forceinline__ void phase_convert(const Params& P, int layer, float* lds) {
  const int tid = mk_tid(), kr = tid >> 4, nc = (tid & 15) * 4, n = tid >> 3, kc = (tid & 7) * 8, G = mk_nblk();
  int it = mk_bid();
  CvtItem cur = cvt_decode(P, layer, it); f32x4 v[2]; cvt_load(cur, v);
  while (cur.valid) {
    const CvtItem nxt = cvt_decode(P, layer, it + G); f32x4 nv[2]; cvt_load(nxt, nv);
#pragma unroll
    for (int i = 0; i < 2; ++i) { const int k = kr + 32 * i;
      lds[(nc + 0) * 65 + k] = v[i][0]; lds[(nc + 1) * 65 + k] = v[i][1]; lds[(nc + 2) * 65 + k] = v[i][2]; lds[(nc + 3) * 65 + k] = v[i][3]; }
    __syncthreads();
    if (cur.ntile * 64 + n < cur.N) {
      const float* p = lds + n * 65 + kc;
      u32x4 w; w.x = cvtpk(p[0], p[1]); w.y = cvtpk(p[2], p[3]); w.z = cvtpk(p[4], p[5]); w.w = cvtpk(p[6], p[7]);
      *(u32x4*)(cur.dst + (size_t)(cur.ntile * 64 + n) * cur.K + cur.kt * 64 + kc) = w;
    }
    __syncthreads();
    cur = nxt; v[0] = nv[0]; v[1] = nv[1]; it += G;
  }
}

__device__ __forceinline__ void phase_norm(const Params& P, int layer, int which, bool skip_ctx) {
  const int lane = mk_tid() & 63, wave = mk_tid() >> 6;
  const float* g = P.in[which ? I_NORM2 : I_NORM1] + (size_t)layer * DM;
  const float* mod = (const float*)(PWS() + WS_MOD) + (size_t)layer * 2 * 12288;
  bf16_t* H = (bf16_t*)(PWS() + WS_H);
  const int soff = which ? 6144 : 0;
  const float* src_c = (which == 0 && layer == 0) ? PIN(I_CTX) : (const float*)(PWS() + WS_XC);
  const float* src_l = (which == 0 && layer == 0) ? PIN(I_X) : (const float*)POUT();
  const int stride = mk_nblk() * 8;
  for (int row = mk_bid() * 8 + wave; row < T; row += 2 * stride) {
    int rows[2] = {row, row + stride}; f32x4 v[2][8]; bool ok[2];
#pragma unroll
    for (int u = 0; u < 2; ++u) { ok[u] = rows[u] < T && !(skip_ctx && rows[u] < NCTX);
      if (ok[u]) { const float* xr = rows[u] < NCTX ? src_c + (size_t)rows[u] * DM : src_l + (size_t)(rows[u] - NCTX) * DM;
#pragma unroll
        for (int i = 0; i < 8; ++i) v[u][i] = *(const f32x4*)(xr + i * 256 + lane * 4);
        if (which == 0 && layer == 0 && rows[u] < NCTX) { float* xc = (float*)(PWS() + WS_XC) + (size_t)rows[u] * DM;
#pragma unroll
          for (int i = 0; i < 8; ++i) *(f32x4*)(xc + i * 256 + lane * 4) = v[u][i]; } } }
#pragma unroll
    for (int u = 0; u < 2; ++u) if (ok[u]) {
      const float* m = mod + (rows[u] < NCTX ? 12288 : 0) + soff; float ss = 0.f;
#pragma unroll
      for (int i = 0; i < 8; ++i) ss += v[u][i][0] * v[u][i][0] + v[u][i][1] * v[u][i][1] + v[u][i][2] * v[u][i][2] + v[u][i][3] * v[u][i][3];
      ss = wave_sum(ss);
      const float rstd = rsqrtf(ss * (1.0f / DM) + 1e-6f);
#pragma unroll
      for (int i = 0; i < 8; ++i) {
        const int c = i * 256 + lane * 4;
        const f32x4 gv = *(const f32x4*)(g + c), sh = *(const f32x4*)(m + c), sc = *(const f32x4*)(m + 2048 + c);
        float o[4];
#pragma unroll
        for (int q = 0; q < 4; ++q) o[q] = (v[u][i][q] * rstd * gv[q]) * (1.0f + sc[q]) + sh[q];
        u32x2 w; w.x = cvtpk(o[0], o[1]); w.y = cvtpk(o[2], o[3]);
        *(u32x2*)(H + (size_t)rows[u] * DM + c) = w;
      }
    }
  }
}

__device__ __forceinline__ void phase_final_norm(const Params& P) {
  const int lane = mk_tid() & 63, wave = mk_tid() >> 6;
  const float* g = PIN(I_FNORM); float* out = POUT();
  const int stride = mk_nblk() * 8;
  for (int row = mk_bid() * 8 + wave; row < T - NCTX; row += 2 * stride) {
    int rows[2] = {row, row + stride}; f32x4 v[2][8]; bool ok[2];
#pragma unroll
    for (int u = 0; u < 2; ++u) { ok[u] = rows[u] < T - NCTX;
      if (ok[u]) {
#pragma unroll
        for (int i = 0; i < 8; ++i) v[u][i] = *(const f32x4*)(out + (size_t)rows[u] * DM + i * 256 + lane * 4); } }
#pragma unroll
    for (int u = 0; u < 2; ++u) if (ok[u]) {
      float ss = 0.f;
#pragma unroll
      for (int i = 0; i < 8; ++i) ss += v[u][i][0] * v[u][i][0] + v[u][i][1] * v[u][i][1] + v[u][i][2] * v[u][i][2] + v[u][i][3] * v[u][i][3];
      ss = wave_sum(ss);
      const float rstd = rsqrtf(ss * (1.0f / DM) + 1e-6f);
#pragma unroll
      for (int i = 0; i < 8; ++i) { const int c = i * 256 + lane * 4; const f32x4 gv = *(const f32x4*)(g + c); *(f32x4*)(out + (size_t)rows[u] * DM + c) = v[u][i] * rstd * gv; }
    }
  }
}

struct EpiStore {
  static constexpr bool PERM = true, AFTER_DRAIN = false;
  bf16_t* O; int ldc;
  __device__ __forceinline__ void operator()(const f32x4 (&acc)[2][2][4][2], const pg8::Unit& u, int wr, int wc, int fr, int fq) const {
    const int row0 = u.pm * 256 + wr * 64 + fr, col0 = u.pn * 256 + wc * 32 + 8 * fq;
#pragma unroll
    for (int ai = 0; ai < 2; ++ai)
#pragma unroll
      for (int m = 0; m < 4; ++m) { bf16_t* rowp = O + (size_t)(row0 + ai * 128 + m * 16) * ldc + col0;
#pragma unroll
        for (int bj = 0; bj < 2; ++bj) { const f32x4 v0 = acc[ai][bj][m][0], v1 = acc[ai][bj][m][1];
          u32x4 w; w.x = cvtpk(v0[0], v0[1]); w.y = cvtpk(v0[2], v0[3]); w.z = cvtpk(v1[0], v1[1]); w.w = cvtpk(v1[2], v1[3]);
          *(u32x4*)(rowp + bj * 128) = w; } }
  }
};
struct EpiResid {
  static constexpr bool PERM = false, AFTER_DRAIN = false;
  const float* src_c; const float* src_l; float* dst_c; float* dst_l; const float* gate_c; const float* gate_l; int row_off;
  __device__ __forceinline__ void operator()(const f32x4 (&acc)[2][2][4][2], const pg8::Unit& u, int wr, int wc, int fr, int fq) const {
    const int t0 = row_off + u.pm * 256;
    const bool isc = t0 < NCTX;
    const float* src = isc ? src_c : src_l - (size_t)NCTX * DM; float* dst = isc ? dst_c : dst_l - (size_t)NCTX * DM; const float* gate = isc ? gate_c : gate_l;
    const int row0 = t0 + wr * 64 + fr, col0 = u.pn * 256 + wc * 32 + 4 * fq;
    f32x4 gv[2][2];
#pragma unroll
    for (int bj = 0; bj < 2; ++bj)
#pragma unroll
      for (int n = 0; n < 2; ++n) gv[bj][n] = *(const f32x4*)(gate + col0 + bj * 128 + n * 16);
#pragma unroll
    for (int ai = 0; ai < 2; ++ai)
#pragma unroll
      for (int m = 0; m < 4; ++m) { const size_t off = (size_t)(row0 + ai * 128 + m * 16) * DM + col0;
#pragma unroll
        for (int bj = 0; bj < 2; ++bj)
#pragma unroll
          for (int n = 0; n < 2; ++n) { const f32x4 xs = *(const f32x4*)(src + off + bj * 128 + n * 16);
            *(f32x4*)(dst + off + bj * 128 + n * 16) = xs + gv[bj][n] * acc[ai][bj][m][n]; } }
  }
};

struct EpiResidAtomic {
  static constexpr bool PERM = false, AFTER_DRAIN = false;
  float* dst; const float* gate;
  __device__ __forceinline__ void operator()(const f32x4 (&acc)[2][2][4][2], const pg8::Unit& u, int wr, int wc, int fr, int fq) const {
    const int row0 = wr * 64 + fr, col0 = u.pn * 256 + wc * 32 + 4 * fq;
    f32x4 gv[2][2];
#pragma unroll
    for (int bj = 0; bj < 2; ++bj)
#pragma unroll
      for (int n = 0; n < 2; ++n) gv[bj][n] = *(const f32x4*)(gate + col0 + bj * 128 + n * 16);
#pragma unroll
    for (int ai = 0; ai < 2; ++ai)
#pragma unroll
      for (int m = 0; m < 4; ++m) { float* rp = dst + (size_t)(row0 + ai * 128 + m * 16) * DM + col0;
#pragma unroll
        for (int bj = 0; bj < 2; ++bj)
#pragma unroll
          for (int n = 0; n < 2; ++n) { const f32x4 v = gv[bj][n] * acc[ai][bj][m][n];
#pragma unroll
            for (int q = 0; q < 4; ++q) __hip_atomic_fetch_add(rp + bj * 128 + n * 16 + q, v[q], __ATOMIC_RELAXED, __HIP_MEMORY_SCOPE_AGENT); } }
  }
};
template <class Epi>
__device__ __forceinline__ void run_gemm(unsigned char* lds, const bf16_t* A, const bf16_t* Bt, int M, int N, int K, const Epi& E, int wg, int nwg, int ld = 0, int ksplit = 0) {
  pg8::Gemm g{A, Bt, M, N, K, ld ? ld : K, ksplit}; pg8::StaticOrder S; S.init(M, N, nwg, wg);
  pg8::gemm_phase<Epi, pg8::StaticOrder, false>((PG8_LAS unsigned char*)lds, g, S, E, nullptr);
}

__device__ __forceinline__ float colv(const bf16_t* cols, int t, int c) { return bf2f(cols[(size_t)t * NIN + c]); }
__device__ __forceinline__ float rwconv3(const bf16_t* cols, const float* cw, const float* cb, int t, int c, int lo, int hi) {
  float u = cb[c] + cw[1760 + c] * colv(cols, t, c);
  if (t - 1 >= lo) u += cw[c] * colv(cols, t - 1, c);
  if (t + 1 < hi) u += cw[2 * 1760 + c] * colv(cols, t + 1, c);
  return u;
}

__device__ __forceinline__ float rwconv3w(const bf16_t* cols, float w0, float w1, float w2, float b, int t, int c, int lo, int hi) {
  float u = b + w1 * colv(cols, t, c);
  if (t - 1 >= lo) u += w0 * colv(cols, t - 1, c);
  if (t + 1 < hi) u += w2 * colv(cols, t + 1, c);
  return u;
}
template <int PART>
__device__ __forceinline__ void phase_prep(const Params& P, int layer, float* lds, int wg, int nwg) {
  constexpr int NTK = 13;
  const int tid = mk_tid(), lane = tid & 63, wave = tid >> 6;
  float* lin = lds;
  float* xs = lds + 16 * 256;
  const bf16_t* cols = (const bf16_t*)(PWS() + WS_COLS);
  const float* cw = PIN(I_RWCONV) + (size_t)layer * 3 * 1760; const float* cb = PIN(I_RWCONVB) + (size_t)layer * 1760;
  const float* lcw = PIN(I_LRUCONV) + (size_t)layer * 4 * 512; const float* lcb = PIN(I_LRUCONVB) + (size_t)layer * 512;
  const int c = tid, hd = c >> 6, n = c & 63;
  bf16_t* VF = (bf16_t*)(PWS() + WS_VF); bf16_t* RG = (bf16_t*)(PWS() + WS_RG); bf16_t* CV = (bf16_t*)(PWS() + WS_CV);
  bf16_t* LAB = (bf16_t*)(PWS() + WS_LAB); bf16_t* GG = (bf16_t*)(PWS() + WS_GG);
  bf16_t* QN = (bf16_t*)(PWS() + WS_QN); bf16_t* KVN = (bf16_t*)(PWS() + WS_KVN); bf16_t* KR = (bf16_t*)(PWS() + WS_KR);
  unsigned char* REC = PWS() + WS_REC;
  const float w0_0 = PIN(I_RWW0)[(layer * 2 + 0) * 512 + c], w0_1 = PIN(I_RWW0)[(layer * 2 + 1) * 512 + c];
  const float a0_0 = PIN(I_RWA0)[(layer * 2 + 0) * 512 + c], a0_1 = PIN(I_RWA0)[(layer * 2 + 1) * 512 + c];
  const float kkc = PIN(I_RWKK)[layer * 512 + c], kac = PIN(I_RWKA)[layer * 512 + c], rkc = PIN(I_RWRK)[layer * 512 + c];
  const float v0c = (layer > 0) ? PIN(I_RWV0)[c] : 0.f;
  const float* wup = PIN(I_RWWUP) + (size_t)layer * 2 * 32 * 512 + c; const float* aup = PIN(I_RWAUP) + (size_t)layer * 2 * 32 * 512 + c;
  const float* gup = PIN(I_RWGUP) + (size_t)layer * 96 * 512 + c; const float* vup = PIN(I_RWVUP) + c;
  const float* lwa = PIN(I_LRUWA) + (size_t)layer * 2 * 8 * 4096 + (size_t)hd * 4096 + n; const float* lwx = PIN(I_LRUWX) + (size_t)layer * 2 * 8 * 4096 + (size_t)hd * 4096 + n;
  const float lba0 = PIN(I_LRUBA)[(layer * 2 + 0) * 512 + c], lba1 = PIN(I_LRUBA)[(layer * 2 + 1) * 512 + c];
  const float lbx0 = PIN(I_LRUBX)[(layer * 2 + 0) * 512 + c], lbx1 = PIN(I_LRUBX)[(layer * 2 + 1) * 512 + c];
  const float lam0 = PIN(I_LRULAM)[(layer * 2 + 0) * 512 + c], lam1 = PIN(I_LRULAM)[(layer * 2 + 1) * 512 + c];
  const float sp0 = log1pf(__expf(-lam0)), sp1 = log1pf(__expf(-lam1));
  float cwr[3], cwk[3], cwv[3], cwe[3], cbr = 0.f, cbk = 0.f, cbv = 0.f, cbe = 0.f;
  const int ecol = 1536 + ((tid & 255) < 224 ? (tid & 255) : 0);
#pragma unroll
  for (int q = 0; q < 3; ++q) { cwr[q] = (PART == 0) ? cw[q * 1760 + c] : 0.f; cwk[q] = (PART == 0) ? cw[q * 1760 + 512 + c] : 0.f; cwv[q] = (PART == 0) ? cw[q * 1760 + 1024 + c] : 0.f; cwe[q] = (PART == 0) ? cw[q * 1760 + ecol] : 0.f; }
  if (PART == 0) { cbr = cb[c]; cbk = cb[512 + c]; cbv = cb[1024 + c]; cbe = cb[ecol]; }

  for (int tile = wg; tile < T / NTK; tile += nwg) {
    const int t0 = tile * NTK;
    const int lo = t0 < NCTX ? 0 : NCTX, hi = t0 < NCTX ? NCTX : T;
    if (PART == 0) {
#pragma unroll
    for (int i = 0; i < (NTK * 256 + 511) / 512; ++i) {
      const int idx = tid + 512 * i, tt = idx >> 8, e = idx & 255, t = t0 + tt; float v;
      if (idx >= NTK * 256) continue;
      const int lo_t = t < NCTX ? 0 : NCTX, hi_t = t < NCTX ? NCTX : T;
      if (e < 224) { v = rwconv3w(cols, cwe[0], cwe[1], cwe[2], cbe, t, 1536 + e, lo_t, hi_t); if (e < 64) v = tanhf_(v); else if (e >= 128) v = sigmoidf_(v); }
      else v = (layer > 0) ? colv(cols, t, C_VD + e - 224) : 0.f;
      lin[tt * 256 + e] = v;
    }
    }
    if (PART == 1) {
#pragma unroll
    for (int tt = 0; tt < NTK; ++tt) {
      const int t = t0 + tt; float u = lcb[c]; const int lo_t = t < NCTX ? 0 : NCTX, hi_t = t < NCTX ? NCTX : T;
#pragma unroll
      for (int j = 0; j < 4; ++j) { const int ts = t + j - 2; if (ts >= lo_t && ts < hi_t) u += lcw[j * 512 + c] * colv(cols, ts, C_LRU + c); }
      xs[tt * 512 + c] = u;
    }
#pragma unroll 1
    for (int tw = wave; tw < NTK; tw += 8) {
      const int t = t0 + tw; const bf16_t* cr = cols + (size_t)t * NIN;
      float q[8]; float ss = 0.f;
      { const bf16x8 raw = *(const bf16x8*)(cr + C_MLA + lane * 8);
#pragma unroll
        for (int i = 0; i < 8; ++i) { q[i] = bf2f((bf16_t)raw[i]); ss += q[i] * q[i]; } }
      ss = wave_sum(ss); float rstd = rsqrtf(ss * (1.0f / 512.0f) + 1e-6f);
      { const float* gq = PIN(I_QNORM) + layer * 512 + lane * 8; u32x4 w;
        w.x = cvtpk(q[0] * rstd * gq[0], q[1] * rstd * gq[1]); w.y = cvtpk(q[2] * rstd * gq[2], q[3] * rstd * gq[3]);
        w.z = cvtpk(q[4] * rstd * gq[4], q[5] * rstd * gq[5]); w.w = cvtpk(q[6] * rstd * gq[6], q[7] * rstd * gq[7]);
        *(u32x4*)(QN + (size_t)t * 512 + lane * 8) = w; }
      float k4[4]; ss = 0.f;
      { const s16x4 raw = *(const s16x4*)(cr + C_MLA + 512 + lane * 4);
#pragma unroll
        for (int i = 0; i < 4; ++i) { k4[i] = bf2f((bf16_t)raw[i]); ss += k4[i] * k4[i]; } }
      ss = wave_sum(ss); rstd = rsqrtf(ss * (1.0f / 256.0f) + 1e-6f);
      { const float* gk = PIN(I_KVNORM) + layer * 256 + lane * 4; u32x2 w;
        w.x = cvtpk(k4[0] * rstd * gk[0], k4[1] * rstd * gk[1]); w.y = cvtpk(k4[2] * rstd * gk[2], k4[3] * rstd * gk[3]);
        *(u32x2*)(KVN + (size_t)t * 256 + lane * 4) = w; }
      const float own = bf2f(cr[C_MLA + 768 + lane]); const float oth = __shfl_xor(own, 16);
      float res = own;
      if (t >= NCTX) {
        const int tl = t - NCTX, axis = lane >> 5, half = (lane >> 4) & 1, f = lane & 15;
        const float pos = (float)(axis == 0 ? (tl >> 6) : (tl & 63));
        const float inv = exp2f(-(float)f * (13.287712379549449f / 16.0f));
        const float sn = __sinf(pos * inv), cs = __cosf(pos * inv);
        res = half == 0 ? own * cs - oth * sn : oth * sn + own * cs;
      }
      KR[(size_t)t * 64 + lane] = f2bf(res);
    }
    }
    __syncthreads();
    if (PART == 0) {
      float zw0[NTK], zw1[NTK], za0[NTK], za1[NTK], gg[NTK], mx[NTK];
#pragma unroll
      for (int tt = 0; tt < NTK; ++tt) { zw0[tt] = 0.f; zw1[tt] = 0.f; za0[tt] = 0.f; za1[tt] = 0.f; gg[tt] = 0.f; mx[tt] = 0.f; }
#pragma unroll 1
      for (int e = 0; e < 32; e += 4) {
        float wa[4], wb[4], aa[4], ab[4], vv[4];
#pragma unroll
        for (int i = 0; i < 4; ++i) { wa[i] = wup[(size_t)(e + i) * 512]; wb[i] = wup[(size_t)(32 + e + i) * 512]; aa[i] = aup[(size_t)(e + i) * 512]; ab[i] = aup[(size_t)(32 + e + i) * 512];
          vv[i] = (layer > 0) ? vup[(size_t)(e + i) * 512] : 0.f; }
#pragma unroll
        for (int tt = 0; tt < NTK; ++tt) {
          const f32x4 x0 = *(const f32x4*)(lin + tt * 256 + e), x1 = *(const f32x4*)(lin + tt * 256 + 32 + e), y0 = *(const f32x4*)(lin + tt * 256 + 64 + e),
                      y1 = *(const f32x4*)(lin + tt * 256 + 96 + e), hv = *(const f32x4*)(lin + tt * 256 + 224 + e);
#pragma unroll
          for (int i = 0; i < 4; ++i) { zw0[tt] += x0[i] * wa[i]; zw1[tt] += x1[i] * wb[i]; za0[tt] += y0[i] * aa[i]; za1[tt] += y1[i] * ab[i]; mx[tt] += hv[i] * vv[i]; }
        }
      }
      { float gw[4];
#pragma unroll
        for (int i = 0; i < 4; ++i) gw[i] = gup[(size_t)i * 512];
#pragma unroll 1
        for (int e = 0; e < 96; e += 4) {
          float ngw[4]; const int en = (e + 4 < 96) ? e + 4 : e;
#pragma unroll
          for (int i = 0; i < 4; ++i) ngw[i] = gup[(size_t)(en + i) * 512];
#pragma unroll
          for (int tt = 0; tt < NTK; ++tt) { const f32x4 s4 = *(const f32x4*)(lin + tt * 256 + 128 + e);
#pragma unroll
            for (int i = 0; i < 4; ++i) gg[tt] += s4[i] * gw[i]; }
#pragma unroll
          for (int i = 0; i < 4; ++i) gw[i] = ngw[i];
        } }
#pragma unroll
      for (int tt = 0; tt < NTK; ++tt) {
        const int t = t0 + tt; const int lo_t = t < NCTX ? 0 : NCTX, hi_t = t < NCTX ? NCTX : T;
        const float r = rwconv3w(cols, cwr[0], cwr[1], cwr[2], cbr, t, c, lo_t, hi_t), k = rwconv3w(cols, cwk[0], cwk[1], cwk[2], cbk, t, 512 + c, lo_t, hi_t);
        float v = rwconv3w(cols, cwv[0], cwv[1], cwv[2], cbv, t, 1024 + c, lo_t, hi_t);
        const float wd0 = __expf(-0.606531f * sigmoidf_(w0_0 + zw0[tt])), wd1 = __expf(-0.606531f * sigmoidf_(w0_1 + zw1[tt]));
        const float ic0 = sigmoidf_(a0_0 + za0[tt]), ic1 = sigmoidf_(a0_1 + za1[tt]);
        if (layer > 0) { const float mixv = sigmoidf_(v0c + mx[tt]); const float vf = bf2f(VF[(size_t)t * 512 + c]); v = v + (vf - v) * mixv; }
        else VF[(size_t)t * 512 + c] = f2bf(v);
        float kk = k * kkc; const float ssq = wave_sum(kk * kk); kk *= rsqrtf(fmaxf(ssq, 1e-24f));
        const float kd0 = k * (1.0f + (ic0 - 1.0f) * kac), kd1 = k * (1.0f + (ic1 - 1.0f) * kac);
        const float b0 = kk * ic0, b1 = kk * ic1;
        const float coef = wave_sum(r * (kd0 + kd1) * rkc);
        RG[(size_t)t * 512 + c] = f2bf(gg[tt]); CV[(size_t)t * 512 + c] = f2bf(coef * v);
        const bf16_t ab_ = f2bf(-kk), rb_ = f2bf(r), vb_ = f2bf(v);
        { unsigned char* rp = REC + ((size_t)(0 * 8 + hd) * T + t) * RECB;
          __builtin_nontemporal_store(wd0, (float*)rp + n); bf16_t* q = (bf16_t*)(rp + 256);
          __builtin_nontemporal_store(f2bf(kd0), q + n); __builtin_nontemporal_store(ab_, q + 64 + n); __builtin_nontemporal_store(f2bf(b0), q + 128 + n);
          __builtin_nontemporal_store(rb_, q + 192 + n); __builtin_nontemporal_store(vb_, q + 256 + n); }
        { unsigned char* rp = REC + ((size_t)(1 * 8 + hd) * T + scan_pos_rev(t)) * RECB;
          __builtin_nontemporal_store(wd1, (float*)rp + n); bf16_t* q = (bf16_t*)(rp + 256);
          __builtin_nontemporal_store(f2bf(kd1), q + n); __builtin_nontemporal_store(ab_, q + 64 + n); __builtin_nontemporal_store(f2bf(b1), q + 128 + n);
          __builtin_nontemporal_store(rb_, q + 192 + n); __builtin_nontemporal_store(vb_, q + 256 + n); }
        asm volatile("" ::: "memory");
      }
    }
    if (PART == 1) {
      float pa0[NTK], pa1[NTK], px0[NTK], px1[NTK];
#pragma unroll
      for (int tt = 0; tt < NTK; ++tt) { pa0[tt] = 0.f; pa1[tt] = 0.f; px0[tt] = 0.f; px1[tt] = 0.f; }
      {
        float a0w[4], a1w[4], x0w[4], x1w[4];
#pragma unroll
        for (int i = 0; i < 4; ++i) { a0w[i] = lwa[(size_t)i * 64]; a1w[i] = lwa[(size_t)8 * 4096 + (size_t)i * 64]; x0w[i] = lwx[(size_t)i * 64]; x1w[i] = lwx[(size_t)8 * 4096 + (size_t)i * 64]; }
#pragma unroll 1
        for (int i0 = 0; i0 < 64; i0 += 4) {
          float na0[4], na1[4], nx0[4], nx1[4];
          const int in_ = (i0 + 4 < 64) ? i0 + 4 : i0;
#pragma unroll
          for (int i = 0; i < 4; ++i) { na0[i] = lwa[(size_t)(in_ + i) * 64]; na1[i] = lwa[(size_t)8 * 4096 + (size_t)(in_ + i) * 64]; nx0[i] = lwx[(size_t)(in_ + i) * 64]; nx1[i] = lwx[(size_t)8 * 4096 + (size_t)(in_ + i) * 64]; }
#pragma unroll
          for (int tt = 0; tt < NTK; ++tt) { const f32x4 x = *(const f32x4*)(xs + tt * 512 + hd * 64 + i0);
#pragma unroll
            for (int i = 0; i < 4; ++i) { pa0[tt] += x[i] * a0w[i]; pa1[tt] += x[i] * a1w[i]; px0[tt] += x[i] * x0w[i]; px1[tt] += x[i] * x1w[i]; } }
#pragma unroll
          for (int i = 0; i < 4; ++i) { a0w[i] = na0[i]; a1w[i] = na1[i]; x0w[i] = nx0[i]; x1w[i] = nx1[i]; }
        }
      }
      float gt8[NTK];
#pragma unroll
      for (int tt = 0; tt < NTK; ++tt) gt8[tt] = colv(cols, t0 + tt, C_LRU + 512 + c);
#pragma unroll
      for (int tt = 0; tt < NTK; ++tt) {
        const int t = t0 + tt; const float xb = xs[tt * 512 + c];
        const float la0 = -8.0f * sigmoidf_(pa0[tt] + lba0) * sp0, la1 = -8.0f * sigmoidf_(pa1[tt] + lba1) * sp1;
        const float bb0 = sqrtf(fmaxf(1.0f - __expf(2.0f * la0), 0.f)) * sigmoidf_(px0[tt] + lbx0) * xb;
        const float bb1 = sqrtf(fmaxf(1.0f - __expf(2.0f * la1), 0.f)) * sigmoidf_(px1[tt] + lbx1) * xb;
        bf16_t* lp = LAB + (size_t)t * 2048;
        lp[c] = f2bf(la0); lp[512 + c] = f2bf(bb0); lp[1024 + c] = f2bf(la1); lp[1536 + c] = f2bf(bb1);
        GG[(size_t)t * 512 + c] = f2bf(gelu_tanh(gt8[tt]));
        asm volatile("" ::: "memory");
      }
    }
    __syncthreads();
  }
}

__device__ __forceinline__ void phase_lru_agg(const Params& P, int wg, int nwg) {
  const int c = mk_tid(); const bf16_t* LAB = (const bf16_t*)(PWS() + WS_LAB); float* AGG = (float*)(PWS() + WS_AGG);
  for (int ck = wg; ck < T / 64; ck += nwg) {
    float A0 = 1.f, B0 = 0.f, A1 = 1.f, B1 = 0.f;
#pragma unroll 1
    for (int t8 = 0; t8 < 64; t8 += 8) {
      bf16_t x[8][4];
#pragma unroll
      for (int u = 0; u < 8; ++u) { const bf16_t* lp = LAB + (size_t)(ck * 64 + t8 + u) * 2048; x[u][0] = lp[c]; x[u][1] = lp[512 + c]; x[u][2] = lp[1024 + c]; x[u][3] = lp[1536 + c]; }
#pragma unroll
      for (int u = 0; u < 8; ++u) {
        const float a0 = __expf(bf2f(x[u][0])), b0 = bf2f(x[u][1]), a1 = __expf(bf2f(x[u][2])), b1 = bf2f(x[u][3]);
        A0 = a0 * A0; B0 = a0 * B0 + b0;
        B1 = B1 + A1 * b1; A1 = A1 * a1;
      }
    }
    float* ap = AGG + (size_t)ck * 2048; ap[c] = A0; ap[512 + c] = B0; ap[1024 + c] = A1; ap[1536 + c] = B1;
  }
}
__device__ __forceinline__ float lru_compose(const float* AGG, int c, int off, int q0, int dq, int n, float h) {
  int i = 0;
#pragma unroll 1
  for (; i + 8 <= n; i += 8) {
    float a[8], b[8];
#pragma unroll
    for (int u = 0; u < 8; ++u) { const float* ap = AGG + (size_t)(q0 + (i + u) * dq) * 2048 + off; a[u] = ap[c]; b[u] = ap[512 + c]; }
#pragma unroll
    for (int u = 0; u < 8; ++u) h = a[u] * h + b[u];
  }
#pragma unroll 1
  for (; i < n; ++i) { const float* ap = AGG + (size_t)(q0 + i * dq) * 2048 + off; h = ap[c] * h + ap[512 + c]; }
  return h;
}
__device__ __forceinline__ void phase_lru_out(const Params& P, int layer, float* lds, int wg, int nwg) {
  const int c = mk_tid(); const bf16_t* LAB = (const bf16_t*)(PWS() + WS_LAB); const float* AGG = (const float*)(PWS() + WS_AGG);
  const bf16_t* GG = (const bf16_t*)(PWS() + WS_GG); bf16_t* MIX = (bf16_t*)(PWS() + WS_H);
  const int ck_lo = (layer == 1) ? 4 : 0;
  for (int ck = ck_lo + wg; ck < T / 64; ck += nwg) {
    float h0 = lru_compose(AGG, c, 0, 0, 1, ck, 0.f);
    float h1;
    if (ck < 4) h1 = lru_compose(AGG, c, 1024, 3, -1, 3 - ck, 0.f);
    else { h1 = lru_compose(AGG, c, 1024, 3, -1, 4, 0.f); h1 = lru_compose(AGG, c, 1024, T / 64 - 1, -1, T / 64 - 1 - ck, h1); }
#pragma unroll 1
    for (int t8 = 0; t8 < 64; t8 += 8) {
      bf16_t x[8][2];
#pragma unroll
      for (int u = 0; u < 8; ++u) { const bf16_t* lp = LAB + (size_t)(ck * 64 + t8 + u) * 2048; x[u][0] = lp[c]; x[u][1] = lp[512 + c]; }
#pragma unroll
      for (int u = 0; u < 8; ++u) { h0 = __expf(bf2f(x[u][0])) * h0 + bf2f(x[u][1]); lds[(t8 + u) * 512 + c] = h0; }
    }
#pragma unroll 1
    for (int t8 = 56; t8 >= 0; t8 -= 8) {
      bf16_t x[8][3];
#pragma unroll
      for (int u = 0; u < 8; ++u) { const int t = ck * 64 + t8 + u; const bf16_t* lp = LAB + (size_t)t * 2048; x[u][0] = lp[1024 + c]; x[u][1] = lp[1536 + c]; x[u][2] = GG[(size_t)t * 512 + c]; }
#pragma unroll
      for (int u = 7; u >= 0; --u) { const int t = ck * 64 + t8 + u; h1 = __expf(bf2f(x[u][0])) * h1 + bf2f(x[u][1]);
        MIX[(size_t)t * DM + 512 + c] = f2bf((lds[(t8 + u) * 512 + c] + h1) * bf2f(x[u][2])); }
    }
  }
}

template <int NCW>
__device__ __forceinline__ void rwkv_scan(const Params& P, int s, float* lds) {
  const int d = (NCW == 4) ? (s >> 5) : (s >> 4), h = (NCW == 4) ? ((s >> 2) & 7) : ((s >> 1) & 7), part = (NCW == 4) ? (s & 3) : (s & 1);
  const int tid = mk_tid(), lane = tid & 63, wave = tid >> 6, rgp = lane >> 4, j = lane & 15, row = part * (NCW * 4) + (wave & (NCW - 1)) * 4 + rgp;
  const unsigned char* rec = PWS() + WS_REC + (size_t)(d * 8 + h) * T * RECB;
  float* Y = (float*)(PWS() + WS_Y) + (size_t)d * T * 512 + h * 64 + row;
  constexpr int NST = (NCW == 4) ? 7 : 4, STS = (NCW == 4) ? 256 : 512;
  const bool stager = (NCW == 4) ? (wave >= 4) : true; const int stid = (NCW == 4) ? (tid - 256) : tid;
  int goff[NST], loff[NST]; bool isw[NST], val[NST];
#pragma unroll
  for (int i = 0; i < NST; ++i) { const int q = stid + STS * i; val[i] = stager && q >= 0 && q < 1792; const int rc = q / 56, pr = q % 56; goff[i] = rc * RECB + pr * 16; isw[i] = pr < 16;
    loff[i] = rc * 384 + (isw[i] ? pr * 4 : 64 + ((pr - 16) >> 3) * 64 + ((pr - 16) & 7) * 8); }
  u32x4 stA[NST], stB[NST];
#define RS_LOAD(st, ch) do { _Pragma("unroll") for (int i = 0; i < NST; ++i) if (val[i]) st[i] = *(const u32x4*)(rec + (size_t)(ch) * 32 * RECB + goff[i]); } while (0)
#define RS_WRITE(st, buf) do { _Pragma("unroll") for (int i = 0; i < NST; ++i) if (val[i]) { float* dp = (buf) + loff[i]; \
    if (isw[i]) { *(u32x4*)dp = st[i]; } else { u32x4 lo_, hi_; lo_.x = st[i].x << 16; lo_.y = st[i].x & 0xffff0000u; lo_.z = st[i].y << 16; lo_.w = st[i].y & 0xffff0000u; \
      hi_.x = st[i].z << 16; hi_.y = st[i].z & 0xffff0000u; hi_.z = st[i].w << 16; hi_.w = st[i].w & 0xffff0000u; *(u32x4*)dp = lo_; *(u32x4*)(dp + 4) = hi_; } } } while (0)
  f32x4 S = {0.f, 0.f, 0.f, 0.f}; float ykeep = 0.f, yprev = 0.f;
  constexpr int NCH = T / 32;
#define RS_COMPUTE(ch) do { const float* buf = lds + ((ch) & 1) * 12288; \
    if (wave < NCW) { \
      const float* sp = buf + j * 4; \
      f32x4 w4 = *(const f32x4*)(sp), kd4 = *(const f32x4*)(sp + 64), a4 = *(const f32x4*)(sp + 128), b4 = *(const f32x4*)(sp + 192), r4 = *(const f32x4*)(sp + 256); \
      float v = buf[320 + row]; \
      _Pragma("unroll 8") \
      for (int stp = 0; stp < 32; ++stp) { \
        float sa = dot4(S, a4); \
          \
        __builtin_amdgcn_sched_barrier(0); \
        const float* np = sp + (stp + 1) * 384;            \
        const f32x4 nw4 = *(const f32x4*)(np), nkd4 = *(const f32x4*)(np + 64), na4 = *(const f32x4*)(np + 128), nb4 = *(const f32x4*)(np + 192), nr4 = *(const f32x4*)(np + 256); \
        const float nv = buf[(stp + 1) * 384 + 320 + row]; \
        __builtin_amdgcn_sched_barrier(0); \
          \
          \
        f32x2 q01, t23, vv; vv[0] = v; vv[1] = v; \
        { const f32x2 kd01 = kd4.lo, kd23 = kd4.hi, S01 = S.lo, w01 = w4.lo; \
        asm volatile("v_add_f32_dpp %0, %0, %0 quad_perm:[1,0,3,2] row_mask:0xf bank_mask:0xf\n\t" \
                     "v_add_f32_dpp %1, %1, %1 quad_perm:[1,0,3,2] row_mask:0xf bank_mask:0xf\n\t" \
                     "v_pk_mul_f32 %2, %4, %6 op_sel_hi:[1,0]\n\t" \
                     "v_add_f32_dpp %0, %0, %0 quad_perm:[2,3,0,1] row_mask:0xf bank_mask:0xf\n\t" \
                     "v_add_f32_dpp %1, %1, %1 quad_perm:[2,3,0,1] row_mask:0xf bank_mask:0xf\n\t" \
                     "v_pk_mul_f32 %3, %5, %6 op_sel_hi:[1,0]\n\t" \
                     "v_add_f32_dpp %0, %0, %0 row_half_mirror row_mask:0xf bank_mask:0xf\n\t" \
                     "v_add_f32_dpp %1, %1, %1 row_half_mirror row_mask:0xf bank_mask:0xf\n\t" \
                     "v_pk_fma_f32 %2, %7, %8, %2\n\t" \
                     "v_add_f32_dpp %0, %0, %0 row_mirror row_mask:0xf bank_mask:0xf\n\t" \
                     "v_add_f32_dpp %1, %1, %1 row_mirror row_mask:0xf bank_mask:0xf" \
                     : "+v"(sa), "+v"(yprev), "=&v"(q01), "=&v"(t23) \
                     : "v"(kd01), "v"(kd23), "v"(vv), "v"(S01), "v"(w01)); } \
        const f32x2 q23 = S.hi * w4.hi + t23; \
        ykeep = (((stp + 15) & 15) == j) ? yprev : ykeep;         \
        if ((stp & 15) == 0 && ((ch) > 0 || stp > 0)) { const int p = (ch) * 32 + stp - 16 + j; const int tok = d ? scan_pos_rev(p) : p; Y[(size_t)tok * 512] = ykeep; } \
        S.lo = sa * b4.lo + q01; S.hi = sa * b4.hi + q23; \
        yprev = dot4(S, r4); \
        w4 = nw4; kd4 = nkd4; a4 = na4; b4 = nb4; r4 = nr4; v = nv; \
      } \
    } } while (0)
  RS_LOAD(stA, 0); RS_WRITE(stA, lds); RS_LOAD(stA, 1); __syncthreads();
  static_assert(NCH % 2 == 0, "the chunk loop is unrolled by two");
  for (int ch = 0; ch < NCH; ch += 2) {
    if (ch + 2 < NCH) RS_LOAD(stB, ch + 2);
    RS_COMPUTE(ch);
    RS_WRITE(stA, lds + 12288);
    __syncthreads();
    if (ch + 3 < NCH) RS_LOAD(stA, ch + 3);
    RS_COMPUTE(ch + 1);
    if (ch + 2 < NCH) RS_WRITE(stB, lds);
    __syncthreads();
  }
  if (wave < NCW) {
    yprev = row16_sum(yprev);
    ykeep = (j == 15) ? yprev : ykeep;
    const int p = T - 16 + j; const int tok = d ? scan_pos_rev(p) : p; Y[(size_t)tok * 512] = ykeep;
  }
#undef RS_COMPUTE
#undef RS_LOAD
#undef RS_WRITE
}

__device__ __forceinline__ void phase_rwkv_out(const Params& P, int layer, int wg, int nwg) {
  const int c = mk_tid();
  const float* Y0 = (const float*)(PWS() + WS_Y); const float* Y1 = Y0 + (size_t)T * 512;
  const bf16_t* RG = (const bf16_t*)(PWS() + WS_RG); const bf16_t* CV = (const bf16_t*)(PWS() + WS_CV); bf16_t* MIX = (bf16_t*)(PWS() + WS_H);
  const float lg = PIN(I_RWLNG)[layer * 512 + c], lb = PIN(I_RWLNB)[layer * 512 + c];
  const int G = nwg;
  for (int t0 = (layer == 1 ? NCTX : 0) + wg; t0 < T; t0 += 4 * G) {
    float y[4], cv[4], rg[4];
#pragma unroll
    for (int u = 0; u < 4; ++u) { const int t = t0 + u * G; if (t < T) { y[u] = Y0[(size_t)t * 512 + c] + Y1[(size_t)t * 512 + c]; cv[u] = bf2f(CV[(size_t)t * 512 + c]); rg[u] = bf2f(RG[(size_t)t * 512 + c]); } else { y[u] = 0.f; cv[u] = 0.f; rg[u] = 0.f; } }
#pragma unroll
    for (int u = 0; u < 4; ++u) { const int t = t0 + u * G;
      const float mu = wave_sum(y[u]) * (1.0f / 64.0f); const float dlt = y[u] - mu; const float var = wave_sum(dlt * dlt) * (1.0f / 64.0f);
      const float yn = dlt * rsqrtf(var + 64e-5f) * lg + lb;
      if (t < T) MIX[(size_t)t * DM + c] = f2bf((yn + cv[u]) * rg[u]); }
  }
}

__device__ __forceinline__ void phase_ffn_act(const Params& P, int layer) {
  const bf16_t* GU = (const bf16_t*)(PWS() + WS_GU); bf16_t* ACT = (bf16_t*)(PWS() + WS_ACT);
  const float* fw = PIN(I_FCONV) + (size_t)layer * 3 * DFF; const float* fb = PIN(I_FCONVB) + (size_t)layer * DFF;
  const int run_lo = (layer == 1) ? NCTX / 32 : 0, nruns = T / 32 - run_lo;
  for (int idx = mk_bid() * NTH + mk_tid(); idx < nruns * 704; idx += mk_nblk() * NTH) {
    const int cgp = idx % 704, run = run_lo + idx / 704, c0 = cgp * 8, t0 = run * 32;
    const int lo = t0 < NCTX ? 0 : NCTX, hi = t0 < NCTX ? NCTX : T;
    float w0[8], w1[8], w2[8], bb[8];
#pragma unroll
    for (int i = 0; i < 8; ++i) { w0[i] = fw[c0 + i]; w1[i] = fw[DFF + c0 + i]; w2[i] = fw[2 * DFF + c0 + i]; bb[i] = fb[c0 + i]; }
    const bf16x8 zero = {0, 0, 0, 0, 0, 0, 0, 0};
    bf16x8 prev = (t0 - 1 >= lo) ? *(const bf16x8*)(GU + (size_t)(t0 - 1) * NGU + c0) : zero;
    bf16x8 cur = *(const bf16x8*)(GU + (size_t)t0 * NGU + c0);
    for (int tt = 0; tt < 32; ++tt) {
      const int t = t0 + tt;
      const bf16x8 nxt = (t + 1 < hi) ? *(const bf16x8*)(GU + (size_t)(t + 1) * NGU + c0) : zero;
      const bf16x8 up = *(const bf16x8*)(GU + (size_t)t * NGU + DFF + c0);
      float o[8];
#pragma unroll
      for (int i = 0; i < 8; ++i) { const float g = bb[i] + w0[i] * bf2f((bf16_t)prev[i]) + w1[i] * bf2f((bf16_t)cur[i]) + w2[i] * bf2f((bf16_t)nxt[i]); o[i] = siluf_(g) * bf2f((bf16_t)up[i]); }
      u32x4 w; w.x = cvtpk(o[0], o[1]); w.y = cvtpk(o[2], o[3]); w.z = cvtpk(o[4], o[5]); w.w = cvtpk(o[6], o[7]);
      *(u32x4*)(ACT + (size_t)t * DFF + c0) = w;
      prev = cur; cur = nxt;
    }
  }
}

namespace at2 {
constexpr int DQK = 192, DV = 128, QBLK = 32, KVBLK = 64;
constexpr float SCALE = 0.07216878364870322f;
constexpr float THR = 8.f;
#ifndef ATT_NQREG
#define ATT_NQREG 12
#endif
constexpr int NQREG = ATT_NQREG;
constexpr int SHM_V = KVBLK * DV * 2, SHM_K = KVBLK * DQK * 2, SHM_ATTN = 3 * SHM_V + 3 * SHM_K + 8 * 64 * 4,     SHM_TOTAL = SHM_ATTN + (12 - NQREG) * 8192;
#define KSWZ(row, colB) ((row) * 384 + ((colB) ^ (((row) & 7) << 4)))
#define SBAR() __builtin_amdgcn_sched_barrier(0)
__device__ __forceinline__ int crow(int r, int hi) { return (r & 3) + 8 * (r >> 2) + 4 * hi; }

__device__ __forceinline__ void partialSM(f32x16& p0, f32x16& p1, float& m_reg, float& mn, float& alpha) {
  constexpr float C = SCALE * 1.4426950408889634f;
  float pmax = p0[0];
#pragma unroll
  for (int r = 1; r < 16; ++r) pmax = fmaxf(pmax, p0[r]);
#pragma unroll
  for (int r = 0; r < 16; ++r) pmax = fmaxf(pmax, p1[r]);
  { auto rr = __builtin_amdgcn_permlane32_swap(__float_as_uint(pmax), __float_as_uint(pmax), false, false);
    pmax = fmaxf(__uint_as_float(rr[0]), __uint_as_float(rr[1])); }
  if (__builtin_expect(__all(pmax - m_reg <= THR / SCALE), 1)) { mn = m_reg; alpha = 1.f; }
  else { mn = fmaxf(m_reg, pmax); alpha = __builtin_amdgcn_exp2f((m_reg - mn) * C); m_reg = mn; }
  const float mnC = -mn * C;
#pragma unroll
  for (int r = 0; r < 16; ++r) p0[r] = fmaf(p0[r], C, mnC);
#pragma unroll
  for (int r = 0; r < 16; ++r) p1[r] = fmaf(p1[r], C, mnC);
#pragma unroll
  for (int r = 0; r < 16; ++r) p0[r] = __builtin_amdgcn_exp2f(p0[r]);
}
__device__ __forceinline__ void finishSM(f32x16& p0, f32x16& p1, float alpha, float& l_reg, bf16x8& pa0, bf16x8& pa1, bf16x8& pa2, bf16x8& pa3) {
#pragma unroll
  for (int r = 0; r < 16; ++r) p1[r] = __builtin_amdgcn_exp2f(p1[r]);
  float ps = 0;
#pragma unroll
  for (int r = 0; r < 16; ++r) ps += p0[r];
#pragma unroll
  for (int r = 0; r < 16; ++r) ps += p1[r];
  { auto rr = __builtin_amdgcn_permlane32_swap(__float_as_uint(ps), __float_as_uint(ps), false, false);
    ps = __uint_as_float(rr[0]) + __uint_as_float(rr[1]); }
  l_reg = l_reg * alpha + ps;
#define PK4(P, BASE, OUT) do { unsigned a0 = cvtpk(P[BASE + 0], P[BASE + 1]), a1 = cvtpk(P[BASE + 2], P[BASE + 3]);   \
    unsigned b0 = cvtpk(P[BASE + 4], P[BASE + 5]), b1 = cvtpk(P[BASE + 6], P[BASE + 7]);                              \
    auto r0 = __builtin_amdgcn_permlane32_swap(a0, b0, false, false); auto r1 = __builtin_amdgcn_permlane32_swap(a1, b1, false, false); \
    u32x4 w = {r0[0], r1[0], r0[1], r1[1]}; OUT = *reinterpret_cast<bf16x8*>(&w); } while (0)
  PK4(p0, 0, pa0); PK4(p0, 8, pa1); PK4(p1, 0, pa2); PK4(p1, 8, pa3);
#undef PK4
}
__device__ __forceinline__ void qkt(f32x16& p0, f32x16& p1, const char* Ks, const bf16x8* qr, const char* qsp, int r32, int hi) {
  p0 = f32x16{}; p1 = f32x16{};
#pragma unroll
  for (int d0 = 0; d0 < 12; ++d0) { const int cb = (d0 * 16 + hi * 8) * 2;
    const bf16x8 b0 = *reinterpret_cast<const bf16x8*>(Ks + KSWZ(r32, cb));
    const bf16x8 b1 = *reinterpret_cast<const bf16x8*>(Ks + KSWZ(32 + r32, cb));
    const bf16x8 qv = (d0 < NQREG) ? qr[d0 < NQREG ? d0 : 0] : *reinterpret_cast<const bf16x8*>(qsp + (d0 - NQREG) * 8192);
    p0 = __builtin_amdgcn_mfma_f32_32x32x16_bf16(b0, qv, p0, 0, 0, 0);
    p1 = __builtin_amdgcn_mfma_f32_32x32x16_bf16(b1, qv, p1, 0, 0, 0); }
}
__device__ __forceinline__ int v_st(int k, int c) { const int kk = (k & ~0xC) | ((k & 4) << 1) | ((k & 8) >> 1); return ((kk >> 3) * 4 + (c >> 5)) * 512 + ((kk & 7) * 32 + (c & 31)) * 2; }
__device__ __forceinline__ int v_rd_base(int lane) { return ((lane & 3) << 3) | (((lane >> 2) & 3) << 6) | (((lane >> 4) & 1) << 5) | (((lane >> 5) & 1) << 8); }
constexpr int v_rd_off(int d0, int ks, int half) { return d0 * 512 + ks * 4096 + half * 2048; }
template <int OFF> __device__ __forceinline__ s16x4 tr_read(int vb) {
  s16x4 r; asm volatile("ds_read_b64_tr_b16 %0, %1 offset:%2" : "=&v"(r) : "v"(vb), "i"(OFF) : "memory"); return r;
}
template <int D0> __device__ __forceinline__ void pv_one(f32x16& od, int vb, bf16x8 pa0, bf16x8 pa1, bf16x8 pa2, bf16x8 pa3) {
  const s16x4 l0 = tr_read<v_rd_off(D0, 0, 0)>(vb), h0 = tr_read<v_rd_off(D0, 0, 1)>(vb), l1 = tr_read<v_rd_off(D0, 1, 0)>(vb), h1 = tr_read<v_rd_off(D0, 1, 1)>(vb);
  const s16x4 l2 = tr_read<v_rd_off(D0, 2, 0)>(vb), h2 = tr_read<v_rd_off(D0, 2, 1)>(vb), l3 = tr_read<v_rd_off(D0, 3, 0)>(vb), h3 = tr_read<v_rd_off(D0, 3, 1)>(vb);
  asm volatile("s_waitcnt lgkmcnt(0)" ::: "memory"); SBAR();
#define PK(L, H) (bf16x8){L[0], L[1], L[2], L[3], H[0], H[1], H[2], H[3]}
  od = __builtin_amdgcn_mfma_f32_32x32x16_bf16(pa0, PK(l0, h0), od, 0, 0, 0);
  od = __builtin_amdgcn_mfma_f32_32x32x16_bf16(pa1, PK(l1, h1), od, 0, 0, 0);
  od = __builtin_amdgcn_mfma_f32_32x32x16_bf16(pa2, PK(l2, h2), od, 0, 0, 0);
  od = __builtin_amdgcn_mfma_f32_32x32x16_bf16(pa3, PK(l3, h3), od, 0, 0, 0);
#undef PK
}
__device__ __forceinline__ void pv_d0(f32x16* o, int vb, bf16x8 pa0, bf16x8 pa1, bf16x8 pa2, bf16x8 pa3) {
  pv_one<0>(o[0], vb, pa0, pa1, pa2, pa3); pv_one<1>(o[1], vb, pa0, pa1, pa2, pa3); pv_one<2>(o[2], vb, pa0, pa1, pa2, pa3); pv_one<3>(o[3], vb, pa0, pa1, pa2, pa3);
}
__device__ __forceinline__ void rope_pair(bf16x8& A, bf16x8& B, float pos, int hi) {
  float oa[8], ob[8];
#pragma unroll
  for (int e = 0; e < 8; ++e) {
    const float inv = exp2f(-(float)(hi * 8 + e) * (13.287712379549449f / 16.0f));
    const float sn = __sinf(pos * inv), cs = __cosf(pos * inv);
    const float a = bf2f((bf16_t)A[e]), b = bf2f((bf16_t)B[e]);
    oa[e] = a * cs - b * sn; ob[e] = a * sn + b * cs;
  }
  u32x4 wa = {cvtpk(oa[0], oa[1]), cvtpk(oa[2], oa[3]), cvtpk(oa[4], oa[5]), cvtpk(oa[6], oa[7])};
  u32x4 wb = {cvtpk(ob[0], ob[1]), cvtpk(ob[2], ob[3]), cvtpk(ob[4], ob[5]), cvtpk(ob[6], ob[7])};
  A = *reinterpret_cast<bf16x8*>(&wa); B = *reinterpret_cast<bf16x8*>(&wb);
}

__device__ __forceinline__ void attn_unit(const bf16_t* __restrict__ Q, const bf16_t* __restrict__ KV, const bf16_t* __restrict__ KR, bf16_t* __restrict__ MIX,
                                          int q0, int h, int kv0, int seq, bool rope_q, char* lds, bf16_t* __restrict__ part_o, float* __restrict__ part_ml) {
  const int tid = mk_tid(), wid = tid >> 6, lane = tid & 63, r32 = lane & 31, hi = lane >> 5;
  char* V_lds = lds; char* K_lds = lds + 3 * SHM_V;
  float* ws = (float*)(lds + 3 * SHM_V + 3 * SHM_K) + wid * 64; float* li_l = ws; float* al_l = ws + 32;
  float m_reg = -1e30f, l_reg = 0; f32x16 o[4] = {}; bf16x8 qr[12];
  const int qrow = q0 + wid * QBLK + r32;
  const bf16_t* Qw = Q + (size_t)qrow * 1536 + h * DQK + hi * 8;
#pragma unroll
  for (int d0 = 0; d0 < 12; ++d0) qr[d0] = *reinterpret_cast<const bf16x8*>(Qw + d0 * 16);
  if (rope_q) { const int tl = qrow - NCTX; rope_pair(qr[8], qr[9], (float)(tl >> 6), hi); rope_pair(qr[10], qr[11], (float)(tl & 63), hi); }
  char* qsp = lds + SHM_ATTN + tid * 16;
#pragma unroll
  for (int d0 = NQREG; d0 < 12; ++d0) *reinterpret_cast<bf16x8*>(qsp + (d0 - NQREG) * 8192) = qr[d0];
  const bf16_t* Kh = KV + (size_t)kv0 * 2048 + h * 256; const bf16_t* Vh = Kh + 128; KR += (size_t)kv0 * 64;
  const int sr = tid >> 4, sc = (tid & 15) * 8, vst0 = v_st(sr, sc), vst1 = v_st(32 + sr, sc);
  const int rr = tid >> 3, rc = (tid & 7) * 8;
  const int vb0 = (int)(uintptr_t)V_lds + v_rd_base(lane);
  bf16x8 vs0, vs1, ks0, ks1, ks2;
#define SLOAD(k0) do { vs0 = *(const bf16x8*)(Vh + (size_t)((k0) + sr) * 2048 + sc); vs1 = *(const bf16x8*)(Vh + (size_t)((k0) + 32 + sr) * 2048 + sc); \
    ks0 = *(const bf16x8*)(Kh + (size_t)((k0) + sr) * 2048 + sc); ks1 = *(const bf16x8*)(Kh + (size_t)((k0) + 32 + sr) * 2048 + sc); \
    ks2 = *(const bf16x8*)(KR + (size_t)((k0) + rr) * 64 + rc); } while (0)
#define SWRITE(b) do { *(bf16x8*)(V_lds + (b) * SHM_V + vst0) = vs0; *(bf16x8*)(V_lds + (b) * SHM_V + vst1) = vs1; const int kc = sc * 2; \
    *(bf16x8*)(K_lds + (b) * SHM_K + KSWZ(sr, kc)) = ks0; *(bf16x8*)(K_lds + (b) * SHM_K + KSWZ(32 + sr, kc)) = ks1; \
    *(bf16x8*)(K_lds + (b) * SHM_K + KSWZ(rr, 256 + rc * 2)) = ks2; } while (0)
#define SWAIT() asm volatile("s_waitcnt vmcnt(0)" ::: "memory")
#define RESC(a) do { if (__any((a) < 1.f)) { if (hi == 0) al_l[r32] = (a); asm volatile("s_waitcnt lgkmcnt(0)" ::: "memory"); \
    _Pragma("unroll") for (int d = 0; d < 4; ++d) _Pragma("unroll") for (int r = 0; r < 16; ++r) o[d][r] *= al_l[crow(r, hi)]; } } while (0)
  f32x16 pA0, pA1, pB0, pB1; float mnA, mnB, alA, alB; bf16x8 pa0, pa1, pa2, pa3; const int NT = seq / KVBLK;
  SLOAD(0); SWAIT(); SWRITE(0); __syncthreads();
  qkt(pA0, pA1, K_lds, qr, qsp, r32, hi); partialSM(pA0, pA1, m_reg, mnA, alA);
  SLOAD(KVBLK);
  SWAIT(); SWRITE(1); __syncthreads();
  int bp = 0, bc = 1, bn = 2;
  for (int j = 1; j + 1 < NT; j += 2) {
    SBAR(); qkt(pB0, pB1, K_lds + bc * SHM_K, qr, qsp, r32, hi);
    finishSM(pA0, pA1, alA, l_reg, pa0, pa1, pa2, pa3); SBAR();
    SLOAD((j + 1) * KVBLK); SBAR();
    pv_d0(o, vb0 + bp * SHM_V, pa0, pa1, pa2, pa3); partialSM(pB0, pB1, m_reg, mnB, alB);
    SWAIT(); SWRITE(bn);
    RESC(alB); __syncthreads();
    bp = bc; bc = bn; bn = (bn == 2) ? 0 : bn + 1;
    SBAR(); qkt(pA0, pA1, K_lds + bc * SHM_K, qr, qsp, r32, hi);
    finishSM(pB0, pB1, alB, l_reg, pa0, pa1, pa2, pa3); SBAR();
    SLOAD((j + 2) * KVBLK); SBAR();
    pv_d0(o, vb0 + bp * SHM_V, pa0, pa1, pa2, pa3); partialSM(pA0, pA1, m_reg, mnA, alA);
    SWAIT(); SWRITE(bn);
    RESC(alA); __syncthreads();
    bp = bc; bc = bn; bn = (bn == 2) ? 0 : bn + 1;
  }
  SBAR(); qkt(pB0, pB1, K_lds + bc * SHM_K, qr, qsp, r32, hi);
  finishSM(pA0, pA1, alA, l_reg, pa0, pa1, pa2, pa3); SBAR();
  pv_d0(o, vb0 + bp * SHM_V, pa0, pa1, pa2, pa3); partialSM(pB0, pB1, m_reg, mnB, alB);
  __syncthreads(); RESC(alB);
  finishSM(pB0, pB1, alB, l_reg, pa0, pa1, pa2, pa3); SBAR();
  pv_d0(o, vb0 + bc * SHM_V, pa0, pa1, pa2, pa3);
  if (hi == 0) li_l[r32] = l_reg; asm volatile("s_waitcnt lgkmcnt(0)" ::: "memory");
  float rli[16];
#pragma unroll
  for (int r = 0; r < 16; ++r) rli[r] = __builtin_amdgcn_rcpf(li_l[crow(r, hi)]);
  if (part_o == nullptr) {
    bf16_t* Ow = MIX + (size_t)(q0 + wid * QBLK) * DM + 1024 + h * DV;
#pragma unroll
    for (int r = 0; r < 16; ++r) { const int orow = crow(r, hi);
#pragma unroll
      for (int d0 = 0; d0 < 4; ++d0) Ow[(size_t)orow * DM + d0 * 32 + r32] = f2bf(o[d0][r] * rli[r]); }
  } else {
    bf16_t* Ow = part_o + (size_t)(wid * QBLK) * DV;
#pragma unroll
    for (int r = 0; r < 16; ++r) { const int orow = crow(r, hi);
#pragma unroll
      for (int d0 = 0; d0 < 4; ++d0) Ow[(size_t)orow * DV + d0 * 32 + r32] = f2bf(o[d0][r] * rli[r]); }
    if (hi == 0) { part_ml[(wid * QBLK + r32) * 2] = m_reg; part_ml[(wid * QBLK + r32) * 2 + 1] = l_reg; }
  }
  __syncthreads();
#undef SLOAD
#undef SWRITE
#undef SWAIT
#undef RESC
}
}

__device__ __forceinline__ int attn_np(int nwg) { return nwg == 192 ? 3 : (nwg == 224 ? 7 : 0); }
__device__ __forceinline__ int attn_part_tiles(int np, int p) { return 2 * (130 / np) + (p < (130 % np) ? 2 : 0); }
__device__ __forceinline__ void phase_attention(const Params& P, int layer, char* lds, int wg, int nwg) {
  const bf16_t* Q = (const bf16_t*)(PWS() + WS_Q); const bf16_t* KV = (const bf16_t*)(PWS() + WS_KV); const bf16_t* KR = (const bf16_t*)(PWS() + WS_KR);
  bf16_t* MIX = (bf16_t*)(PWS() + WS_H); bf16_t* PO = (bf16_t*)(PWS() + WS_PARTO); float* PML = (float*)(PWS() + WS_PARTML);
  const int np = attn_np(nwg);
  const int nwhole = np ? (512 / nwg) * nwg : 512, nparts = (512 - nwhole) * np, nctx = (layer == 0) ? 8 : 0;
  for (int it = wg; it < nwhole + nparts + nctx; it += nwg) {
    int q0, h, kv0 = 0, seq = T; bool lat = true; bf16_t* po = nullptr; float* pml = nullptr;
    if (it < nwhole) { q0 = NCTX + (it & 63) * 256; h = it >> 6; }
    else if (it < nwhole + nparts) { const int q = it - nwhole, u = nwhole + q / np, p = q % np; q0 = NCTX + (u & 63) * 256; h = u >> 6;
      int t0 = 0; for (int pp = 0; pp < p; ++pp) t0 += attn_part_tiles(np, pp);
      kv0 = t0 * 64; seq = attn_part_tiles(np, p) * 64; po = PO + (size_t)q * 256 * 128; pml = PML + (size_t)q * 512; }
    else { q0 = 0; h = it - nwhole - nparts; seq = NCTX; lat = false; }
    at2::attn_unit(Q, KV, KR, MIX, q0, h, kv0, seq, lat, lds, po, pml);
  }
}
__device__ __forceinline__ void phase_attn_merge(const Params& P, int wg, int nwg) {
  const int np = attn_np(nwg); if (np == 0) return;
  const int nwhole = (512 / nwg) * nwg;
  const bf16_t* PO = (const bf16_t*)(PWS() + WS_PARTO); const float* PML = (const float*)(PWS() + WS_PARTML); bf16_t* MIX = (bf16_t*)(PWS() + WS_H);
  constexpr float C = at2::SCALE * 1.4426950408889634f;
  const int tid = mk_tid(), row = tid >> 1, c0 = (tid & 1) * 64;
  for (int us = wg; us < 512 - nwhole; us += nwg) {
    const int u = nwhole + us, q0 = NCTX + (u & 63) * 256, h = u >> 6;
    float M = -3.0e38f;
    for (int p = 0; p < np; ++p) M = fmaxf(M, PML[(size_t)(us * np + p) * 512 + row * 2]);
    float acc[64];
#pragma unroll
    for (int i = 0; i < 64; ++i) acc[i] = 0.f;
    float ws = 0.f;
#pragma unroll 1
    for (int p = 0; p < np; ++p) {
      const float* ml = PML + (size_t)(us * np + p) * 512 + row * 2;
      const float w = ml[1] * exp2f((ml[0] - M) * C); ws += w;
      const bf16_t* src = PO + ((size_t)(us * np + p) * 256 + row) * 128 + c0;
#pragma unroll
      for (int cc = 0; cc < 64; cc += 8) { const bf16x8 x = *(const bf16x8*)(src + cc);
#pragma unroll
        for (int i = 0; i < 8; ++i) acc[cc + i] += w * bf2f((bf16_t)x[i]); }
    }
    const float inv = 1.0f / ws;
#pragma unroll
    for (int cc = 0; cc < 64; cc += 8) {
      u32x4 o; o.x = cvtpk(acc[cc] * inv, acc[cc + 1] * inv); o.y = cvtpk(acc[cc + 2] * inv, acc[cc + 3] * inv); o.z = cvtpk(acc[cc + 4] * inv, acc[cc + 5] * inv); o.w = cvtpk(acc[cc + 6] * inv, acc[cc + 7] * inv);
      *(u32x4*)(MIX + (size_t)(q0 + row) * DM + 1024 + h * 128 + c0 + cc) = o;
    }
  }
}

#ifndef REP_ATT
#define REP_ATT 1
#endif
#ifndef REP_SCAN
#define REP_SCAN 1
#endif
#ifndef REP_PREP
#define REP_PREP 1
#endif
#ifndef REP_GU
#define REP_GU 1
#endif
#ifndef REP_MISC
#define REP_MISC 1
#endif
#ifndef N_SCAN_WG
#define N_SCAN_WG 64
#endif
__device__ __forceinline__ void grid_barrier(unsigned* ctr, unsigned target) {
  asm volatile("s_waitcnt vmcnt(0) lgkmcnt(0)" ::: "memory");
  __syncthreads();
  if (mk_tid() == 0) {
    __builtin_amdgcn_fence(__ATOMIC_RELEASE, "agent");
    __hip_atomic_fetch_add(ctr, 1u, __ATOMIC_RELAXED, __HIP_MEMORY_SCOPE_AGENT);
    while (__hip_atomic_load(ctr, __ATOMIC_RELAXED, __HIP_MEMORY_SCOPE_AGENT) < target) __builtin_amdgcn_s_sleep(2);
    __builtin_amdgcn_fence(__ATOMIC_ACQUIRE, "agent");
  }
  __syncthreads();
}
__device__ __forceinline__ void grid_arrive(unsigned* ctr) {
  asm volatile("s_waitcnt vmcnt(0) lgkmcnt(0)" ::: "memory");
  __syncthreads();
  if (mk_tid() == 0) { __builtin_amdgcn_fence(__ATOMIC_RELEASE, "agent"); __hip_atomic_fetch_add(ctr, 1u, __ATOMIC_RELAXED, __HIP_MEMORY_SCOPE_AGENT); }
}
enum { K_MOD = 0, K_NORM1, K_GEMM_IN, K_PREP, K_MIX, K_RWOUT, K_GEMM_OUT, K_NORM2, K_GEMM_GU, K_ACT, K_GEMM_DN, K_FINAL };
constexpr int STEPS_PER_LAYER = 10, N_STEPS = 1 + 2 * STEPS_PER_LAYER + 1;
__global__ void __launch_bounds__(NTH) fwd_megakernel(Params P_arg) {
  extern __shared__ __attribute__((aligned(16))) unsigned char lds[];
  cg::grid_group grid = cg::this_grid();
  const int lo = P_arg.ph_lo, hi = P_arg.ph_hi;
  unsigned nbar = 0, nsub = 0, nscn = 0;
#pragma unroll 1
  for (int st = lo; st < hi; ++st) {
    const Params& P = P_arg;
    int kind, layer = 0;
    if (st == 0) kind = K_MOD; else if (st == N_STEPS - 1) kind = K_FINAL; else { layer = (st - 1) / STEPS_PER_LAYER; kind = K_NORM1 + (st - 1) % STEPS_PER_LAYER; }
    const bool last = (layer == 1);
    float* ldsf = (float*)lds;
    bool sync_after = true;
    switch (kind) {
      case K_MOD: for (int rep = 0; rep < REP_MISC; ++rep) phase_mod(P, ldsf); break;
      case K_NORM1: for (int rep = 0; rep < REP_MISC; ++rep) phase_convert(P, layer, ldsf); break;
      case K_PREP: for (int rep = 0; rep < REP_PREP; ++rep) phase_prep<0>(P, layer, ldsf, mk_bid(), mk_nblk()); break;
      case K_MIX: {
        const int G = mk_nblk();
        const int vcu = (G % 8 == 0) ? (mk_bid() % 8) * (G / 8) + mk_bid() / 8 : mk_bid();
        const int nscan = (G >= 2 * N_SCAN_WG) ? N_SCAN_WG : 0;
        unsigned* sbar = (unsigned*)(PWS() + WS_BAR) + 32;
        const int sg = vcu - nscan, SG = G - nscan;
        const unsigned per_layer = (unsigned)(G + 2 * SG), base = per_layer * (unsigned)layer;
        phase_prep<1>(P, layer, ldsf, vcu, G);
        if (vcu < nscan) {
          grid_arrive(sbar);
          for (int sc = vcu; sc < ((N_SCAN_WG == 32) ? 32 : 64); sc += nscan) rwkv_scan<(N_SCAN_WG == 32) ? 8 : 4>(P, sc, ldsf);
        } else {
          grid_barrier(sbar, base + (unsigned)G);
          if (nscan == 0) { for (int sc = vcu; sc < ((N_SCAN_WG == 32) ? 32 : 64); sc += G) rwkv_scan<(N_SCAN_WG == 32) ? 8 : 4>(P, sc, ldsf); __syncthreads(); }
#pragma unroll 1
          for (int q = 0; q < 2; ++q) {
            const size_t ro = (q == 0 && last) ? NCTX : 0;
            const bf16_t* A = (const bf16_t*)(PWS() + (q ? WS_KVN : WS_QN)) + ro * 512; const bf16_t* Bt = (const bf16_t*)(PWS() + (q ? WS_WKV : WS_WQ));
            EpiStore E{(bf16_t*)(PWS() + (q ? WS_KV : WS_Q)) + ro * 1536, q ? 2048 : 1536};
            run_gemm(lds, A, Bt, T - (int)ro, q ? 2048 : 1536, q ? 256 : 512, E, sg, SG);
          }
          phase_lru_agg(P, sg, SG);
          grid_barrier(sbar, base + (unsigned)(G + SG));
          phase_attention(P, layer, (char*)lds, sg, SG);
          __syncthreads();
          phase_lru_out(P, layer, ldsf, sg, SG);
          grid_barrier(sbar, base + per_layer);
          phase_attn_merge(P, sg, SG);
        }
      } break;
      case K_RWOUT: phase_rwkv_out(P, layer, mk_bid(), mk_nblk()); break;
      case K_ACT: for (int rep = 0; rep < REP_MISC; ++rep) phase_ffn_act(P, layer); break;
      case K_FINAL: phase_final_norm(P); break;
      default: break;
    }
    if (kind == K_NORM1 || kind == K_NORM2) for (int rep = 0; rep < REP_MISC; ++rep) phase_norm(P, layer, kind == K_NORM2 ? 1 : 0, kind == K_NORM2 && last);
    if (kind == K_GEMM_IN || kind == K_GEMM_GU) {
      const bf16_t* A; const bf16_t* Bt; bf16_t* O; int M = T, N, K;
      if (kind == K_GEMM_IN) { A = (const bf16_t*)(PWS() + WS_H); Bt = (const bf16_t*)(PWS() + WS_WIN); O = (bf16_t*)(PWS() + WS_COLS); N = NIN; K = DM; }
      else { const size_t ro = last ? NCTX : 0; A = (const bf16_t*)(PWS() + WS_H) + ro * DM; Bt = (const bf16_t*)(PWS() + WS_WGU); O = (bf16_t*)(PWS() + WS_GU) + ro * NGU; M = last ? T - NCTX : T; N = NGU; K = DM; }
      EpiStore E{O, N};
      run_gemm(lds, A, Bt, M, N, K, E, mk_bid(), mk_nblk());
    }
    if (kind == K_GEMM_OUT || kind == K_GEMM_DN) {
      const float* mod_l = (const float*)(PWS() + WS_MOD) + (size_t)(layer * 2 + 0) * 12288; const float* mod_c = mod_l + 12288;
      const int goff = (kind == K_GEMM_OUT) ? 4096 : 10240;
      EpiResid E{(const float*)(PWS() + WS_XC), POUT(), (float*)(PWS() + WS_XC), POUT(), mod_c + goff, mod_l + goff, NCTX};
      if (kind == K_GEMM_OUT && layer == 0) { E.src_c = PIN(I_CTX); E.src_l = PIN(I_X); }
      const int Kf = (kind == K_GEMM_OUT) ? DM : DFF;
      const bf16_t* A0 = (kind == K_GEMM_OUT) ? (const bf16_t*)(PWS() + WS_H) : (const bf16_t*)(PWS() + WS_ACT);
      const bf16_t* Bt = (kind == K_GEMM_OUT) ? (const bf16_t*)(PWS() + WS_WOUT) : (const bf16_t*)(PWS() + WS_WDN);
      run_gemm(lds, A0 + (size_t)NCTX * Kf, Bt, T - NCTX, DM, Kf, E, mk_bid(), mk_nblk());
      if (!last) {
        EpiResidAtomic EA{(float*)(PWS() + WS_XC), mod_c + goff};
        run_gemm(lds, A0, Bt, (Kf / 512) * 256, DM, 512, EA, mk_bid(), mk_nblk(), Kf, 512);
      }
    }
    if (sync_after && st + 1 < hi) {
      if (st == lo) grid.sync();
      else { ++nbar; grid_barrier((unsigned*)(PWS() + WS_BAR), nbar * mk_nblk()); }
    }
  }
}

#ifndef MK_PER_PHASE
#define MK_PER_PHASE 0
#endif
extern "C" void kernel_launch(void* const* d_in, const int* in_sizes, int n_in, void* d_out, int out_size, void* d_ws, size_t ws_size, hipStream_t stream) {
  static int grid = 0;
  if (grid == 0) {
    if (n_in != 42 || out_size != (T - NCTX) * DM || ws_size < WS_END) { fprintf(stderr, "kernel_launch: unexpected shapes (n_in %d out %d ws %zu need %zu)\n", n_in, out_size, ws_size, (size_t)WS_END); grid = -1; return; }
    int dev = 0, cus = 0, per_cu = 0;
    (void)hipGetDevice(&dev); (void)hipDeviceGetAttribute(&cus, hipDeviceAttributeMultiprocessorCount, dev);
    if (hipFuncSetAttribute((const void*)fwd_megakernel, hipFuncAttributeMaxDynamicSharedMemorySize, LDS_BYTES) != hipSuccess) { fprintf(stderr, "kernel_launch: hipFuncSetAttribute failed\n"); grid = -1; return; }
    if (hipOccupancyMaxActiveBlocksPerMultiprocessor(&per_cu, (const void*)fwd_megakernel, NTH, LDS_BYTES) != hipSuccess || per_cu < 1) per_cu = 1;
    (void)hipGetLastError();
    grid = (cus > 0 ? cus : 256) * per_cu;
  }
  if (grid < 0) return;
  if (hipMemsetAsync((char*)d_ws + WS_BAR, 0, 256, stream) != hipSuccess) { fprintf(stderr, "kernel_launch: memset failed\n"); return; }
  Params p{};
  for (int i = 0; i < 42; ++i) p.in[i] = (const float*)d_in[i];
  p.out = (float*)d_out; p.ws = (unsigned char*)d_ws;
#if MK_PER_PHASE
  for (int st = 0; st < N_STEPS; ++st) { p.ph_lo = st; p.ph_hi = st + 1; hipLaunchKernelGGL(fwd_megakernel, dim3(grid), dim3(NTH), LDS_BYTES, stream, p); }
#else
  p.ph_lo = 0; p.ph_hi = N_STEPS;
  void* args[] = {&p};
  hipError_t e = hipLaunchCooperativeKernel((const void*)fwd_megakernel, dim3(grid), dim3(NTH), args, LDS_BYTES, stream);
  if (e != hipSuccess) fprintf(stderr, "cooperative launch failed: %s (grid %d)\n", hipGetErrorString(e), grid);
#endif
}
```

```cpp
#include <hip/hip_runtime.h>
#include <hip/hip_cooperative_groups.h>
#include <cstdio>
#include <cstdint>
__device__ __forceinline__ int mk_tid() { int t = (int)threadIdx.x; asm volatile("" : "+v"(t)); return t; }
__device__ __forceinline__ int mk_bid() { int b = (int)blockIdx.x; asm volatile("" : "+s"(b)); return b; }
__device__ __forceinline__ int mk_nblk() { int g = (int)gridDim.x; asm volatile("" : "+s"(g)); return g; }
template <int OFF> __device__ __forceinline__ unsigned long long kp_load() {
  unsigned long long r; auto kp = __builtin_amdgcn_kernarg_segment_ptr();
  asm volatile("s_load_dwordx2 %0, %1, %2\n\ts_waitcnt lgkmcnt(0)" : "=s"(r) : "s"(kp), "i"(OFF));
  return r;
}
#define PIN(i) ((const float*)kp_load<8 * (i)>())
#define POUT() ((float*)kp_load<8 * 42>())
#define PWS() ((unsigned char*)kp_load<8 * 43>())
namespace pg8 {
#define PG8_LAS __attribute__((address_space(3)))
typedef unsigned short bf16_t;
typedef short bf16x8 __attribute__((ext_vector_type(8)));
typedef float f32x4 __attribute__((ext_vector_type(4)));
typedef unsigned u32x4 __attribute__((ext_vector_type(4)));
constexpr int BM = 256, BK = 64, HALF = 128, HTB = HALF * BK * 2  , STAGE_BYTES = 8 * HTB, NXCD = 8, WGM = 8;

__host__ __device__ __forceinline__ int lds_byte(int r, int c) { const int st = (r >> 4) * 2 + (c >> 5), rr = r & 15, cc = c & 31, ob = rr * 64 + cc * 2; return st * 1024 + (ob ^ (((ob >> 9) & 1) << 5)); }
__host__ __device__ __forceinline__ void stage_rc(int b, int& R, int& C) { const int st = b / 1024, sb = b % 1024, swz = sb ^ (((sb >> 9) & 1) << 5); R = (st >> 1) * 16 + swz / 64; C = (st & 1) * 32 + (swz % 64) / 2; }
__host__ __device__ __forceinline__ int perm32(int rho) { const int n = rho >> 4, i = rho & 15; return 8 * (i >> 2) + 4 * n + (i & 3); }

struct Unit { int pm, pn; };
struct Gemm { const bf16_t* A; const bf16_t* Bt; int M, N, K; int ld; int ksplit; };

struct StaticOrder {
    int nM, nN, nwg, G, c;
    __host__ __device__ void init(int M, int N, int G_, int c_) { nM = M / BM; nN = N / BM; nwg = nM * nN; G = G_; c = c_; }
    __host__ __device__ bool next(int i, Unit& u) const {
        const long L = (long)i * G + c; if (L >= nwg) return false;
        int wgid = (int)L; { const int q = nwg / NXCD, r = nwg % NXCD, xcd = wgid % NXCD, off = wgid / NXCD; wgid = (xcd < r ? xcd * (q + 1) : r * (q + 1) + (xcd - r) * q) + off; }
        const int nig = WGM * nN, gid = wgid / nig, fm = gid * WGM, gsz = (nM - fm) < WGM ? (nM - fm) : WGM;
        u.pm = fm + ((wgid % nig) % gsz); u.pn = (wgid % nig) / gsz; return true;
    }
    __device__ __forceinline__ void a_ready(const Unit&) const {}
    __device__ __forceinline__ void done(const Unit&) const {}
};
__device__ __forceinline__ unsigned cvt_pk_bf16(float lo, float hi) { unsigned r; asm volatile("v_cvt_pk_bf16_f32 %0, %1, %2" : "=v"(r) : "v"(lo), "v"(hi)); return r; }
typedef float f32x2 __attribute__((ext_vector_type(2)));
template <class Epi, class Sched, bool STAMP = false>
__device__ __forceinline__ void gemm_phase(PG8_LAS unsigned char* lds, const Gemm g, const Sched& S, const Epi& E, unsigned long long* stamps) {
    const int tid = mk_tid(), wid = __builtin_amdgcn_readfirstlane(tid >> 6), lane = tid & 63, wr = wid >> 2, wc = wid & 3, fr = lane & 15, fq = lane >> 4;
    const int K = g.K, nt = K / BK, LD = g.ld; const size_t ksb = (size_t)g.ksplit * 2;
    int ts_lo = 0, ts_hi = 0, nts = 0; const unsigned long long rt_entry = STAMP ? (unsigned long long)wall_clock64() : 0ull;
#define PG8_STAMP() do { if (STAMP && wid == 0 && nts < 64) { const unsigned long long _c = (unsigned long long)clock64(); \
        ts_lo = (lane == nts) ? (int)(unsigned)_c : ts_lo; ts_hi = (lane == nts) ? (int)(unsigned)(_c >> 32) : ts_hi; ++nts; } } while (0)
    PG8_STAMP();
    unsigned voffA[2], voffB[2];
#pragma unroll
    for (int i = 0; i < 2; ++i) { int R, C; stage_rc(tid * 16 + i * 8192, R, C); const int Rb = Epi::PERM ? ((R & ~31) + perm32(R & 31)) : R;
        voffA[i] = (unsigned)(R * LD + C) * 2u; voffB[i] = (unsigned)(Rb * LD + C) * 2u; }
    const size_t kstep = (size_t)(BK * 2);
    const size_t hstep = (size_t)HALF * LD * 2;
    const size_t tstep = 2 * hstep;
    const unsigned ldsw = (unsigned)wid * 1024u;
    const int aoff = lds_byte(wr * 64 + fr, fq * 8), boff = lds_byte(wc * 32 + fr, fq * 8);
#define PG8_SA(b, h) (((b) * 2 + (h)) * HTB)
#define PG8_SB(b, h) ((4 + (b) * 2 + (h)) * HTB)
#define PG8_STAGE(bufoff, gbase, voff) do { _Pragma("unroll") for (int _i = 0; _i < 2; ++_i) \
        __builtin_amdgcn_global_load_lds((const unsigned*)((const char*)(gbase) + (voff)[_i]), (PG8_LAS unsigned*)(lds + (bufoff) + ldsw + _i * 8192), 16, 0, 0); } while (0)
#define PG8_LDA(dst, b, h) do { _Pragma("unroll") for (int m = 0; m < 4; ++m) _Pragma("unroll") for (int k = 0; k < 2; ++k) dst[m][k] = *(const PG8_LAS bf16x8*)(lds + PG8_SA(b, h) + aoff + m * 2048 + k * 1024); } while (0)
#define PG8_LDB(dst, b, h) do { _Pragma("unroll") for (int n = 0; n < 2; ++n) _Pragma("unroll") for (int k = 0; k < 2; ++k) dst[n][k] = *(const PG8_LAS bf16x8*)(lds + PG8_SB(b, h) + boff + n * 2048 + k * 1024); } while (0)
#define PG8_MMA(ai, bj, At, Bt) do { __builtin_amdgcn_s_setprio(1); _Pragma("unroll") for (int m = 0; m < 4; ++m) _Pragma("unroll") for (int n = 0; n < 2; ++n) _Pragma("unroll") for (int k = 0; k < 2; ++k) \
        acc[ai][bj][m][n] = __builtin_amdgcn_mfma_f32_16x16x32_bf16(Bt[n][k], At[m][k], acc[ai][bj][m][n], 0, 0, 0); __builtin_amdgcn_s_setprio(0); } while (0)
#define PG8_WAIT_V(n) asm volatile("s_waitcnt vmcnt(" #n ")" ::: "memory")
#define PG8_WAIT_L(n) asm volatile("s_waitcnt lgkmcnt(" #n ")" ::: "memory")
#define PG8_BAR __builtin_amdgcn_s_barrier()
#define PG8_SCHED __builtin_amdgcn_sched_barrier(0)
    Unit cur, nxt; int ui = 0;
    if (!S.next(0, cur)) return;
    f32x4 acc[2][2][4][2];
#pragma unroll
    for (int a = 0; a < 2; ++a)
#pragma unroll
        for (int b = 0; b < 2; ++b)
#pragma unroll
            for (int m = 0; m < 4; ++m)
#pragma unroll
                for (int n = 0; n < 2; ++n) acc[a][b][m][n] = (f32x4){0.f, 0.f, 0.f, 0.f};
    bf16x8 At[4][2], B0[2][2], B1[2][2];
    const char* cA = (const char*)g.A + (ksb ? (size_t)cur.pm * ksb : (size_t)cur.pm * tstep); const char* cB = (const char*)g.Bt + (size_t)cur.pn * tstep + (size_t)cur.pm * ksb;
    S.a_ready(cur);
    PG8_STAGE(PG8_SB(0, 0), cB, voffB); PG8_STAGE(PG8_SA(0, 0), cA, voffA); PG8_STAGE(PG8_SB(0, 1), cB + hstep, voffB); PG8_STAGE(PG8_SA(0, 1), cA + hstep, voffA);
    if (wr == 1) PG8_BAR;
    PG8_WAIT_V(4); PG8_BAR;
    PG8_STAGE(PG8_SB(1, 0), cB + kstep, voffB); PG8_STAGE(PG8_SA(1, 0), cA + kstep, voffA); PG8_STAGE(PG8_SB(1, 1), cB + hstep + kstep, voffB);
    PG8_WAIT_V(6); PG8_BAR;
    PG8_STAMP();
    for (;;) {
        const bool has_next = S.next(ui + 1, nxt);
        const char* nA = has_next ? (const char*)g.A + (ksb ? (size_t)nxt.pm * ksb : (size_t)nxt.pm * tstep) : cA; const char* nB = has_next ? (const char*)g.Bt + (size_t)nxt.pn * tstep + (size_t)nxt.pm * ksb : cB;
        for (int t = 0; t < nt; t += 2) {
            const bool last = (t == nt - 2);
            const char* a1 = cA + (size_t)(t + 1) * kstep;
            const char* a2 = last ? nA : cA + (size_t)(t + 2) * kstep; const char* b2 = last ? nB : cB + (size_t)(t + 2) * kstep;
            const char* a3 = a2 + kstep; const char* b3 = b2 + kstep;
            if (last && has_next) S.a_ready(nxt);
            PG8_LDB(B0, 0, 0); PG8_SCHED; PG8_LDA(At, 0, 0); PG8_STAGE(PG8_SA(1, 1), a1 + hstep, voffA);
            PG8_WAIT_L(8); PG8_BAR; PG8_WAIT_L(0); PG8_MMA(0, 0, At, B0); PG8_BAR; PG8_SCHED;
            PG8_LDB(B1, 0, 1); PG8_STAGE(PG8_SB(0, 0), b2, voffB);
            PG8_BAR; PG8_WAIT_L(0); PG8_MMA(0, 1, At, B1); PG8_BAR;
            PG8_LDA(At, 0, 1); PG8_STAGE(PG8_SA(0, 0), a2, voffA);
            PG8_BAR; PG8_WAIT_L(0); PG8_MMA(1, 0, At, B0); PG8_BAR; PG8_SCHED;
            PG8_STAGE(PG8_SB(0, 1), b2 + hstep, voffB);
            PG8_WAIT_V(6); PG8_BAR; PG8_MMA(1, 1, At, B1); PG8_BAR;
            PG8_LDB(B0, 1, 0); PG8_SCHED; PG8_LDA(At, 1, 0); PG8_STAGE(PG8_SA(0, 1), a2 + hstep, voffA);
            PG8_WAIT_L(8); PG8_BAR; PG8_WAIT_L(0); PG8_MMA(0, 0, At, B0); PG8_BAR; PG8_SCHED;
            PG8_LDB(B1, 1, 1); PG8_STAGE(PG8_SB(1, 0), b3, voffB);
            PG8_BAR; PG8_WAIT_L(0); PG8_MMA(0, 1, At, B1); PG8_BAR;
            PG8_LDA(At, 1, 1); PG8_STAGE(PG8_SA(1, 0), a3, voffA);
            PG8_BAR; PG8_WAIT_L(0); PG8_MMA(1, 0, At, B0); PG8_BAR; PG8_SCHED;
            PG8_STAGE(PG8_SB(1, 1), b3 + hstep, voffB);
            PG8_WAIT_V(6); PG8_BAR; PG8_MMA(1, 1, At, B1); PG8_BAR;
        }
        PG8_STAMP();
        if constexpr (!Epi::AFTER_DRAIN) { E(acc, cur, wr, wc, fr, fq); S.done(cur); }
        PG8_STAMP();
        if (!has_next) break;
#pragma unroll
        for (int a = 0; a < 2; ++a)
#pragma unroll
            for (int b = 0; b < 2; ++b)
#pragma unroll
                for (int m = 0; m < 4; ++m)
#pragma unroll
                    for (int n = 0; n < 2; ++n) acc[a][b][m][n] = (f32x4){0.f, 0.f, 0.f, 0.f};
        cur = nxt; cA = nA; cB = nB; ++ui;
    }
    PG8_WAIT_V(0);
    if (wr == 0) PG8_BAR;
    PG8_BAR;
    if constexpr (Epi::AFTER_DRAIN) { E.fused(acc, cur, wr, wc, fr, fq, lds, wid, lane); S.done(cur); }
    PG8_STAMP();
    if (STAMP && wid == 0) { stamps[lane] = lane < nts ? (((unsigned long long)(unsigned)ts_hi << 32) | (unsigned)ts_lo) : 0ull;
        if (lane == 62) stamps[62] = rt_entry; if (lane == 63) stamps[63] = (unsigned long long)wall_clock64(); }
#undef PG8_STAMP
#undef PG8_SA
#undef PG8_SB
#undef PG8_STAGE
#undef PG8_LDA
#undef PG8_LDB
#undef PG8_MMA
#undef PG8_WAIT_V
#undef PG8_WAIT_L
#undef PG8_BAR
#undef PG8_SCHED
}
}

namespace cg = cooperative_groups;
typedef unsigned short bf16_t;
typedef short bf16x8 __attribute__((ext_vector_type(8)));
typedef short s16x4 __attribute__((ext_vector_type(4)));
typedef float f32x4 __attribute__((ext_vector_type(4)));
typedef float f32x8 __attribute__((ext_vector_type(8)));
typedef float f32x16 __attribute__((ext_vector_type(16)));
typedef unsigned u32x4 __attribute__((ext_vector_type(4)));
typedef unsigned u32x2 __attribute__((ext_vector_type(2)));

constexpr int T = 16640, NCTX = 256, DM = 2048, NTH = 512;
constexpr int NIN = 3840;
constexpr int DFF = 5632, NGU = 2 * DFF;
constexpr int C_LRU = 1760, C_MLA = 2784, C_VD = 3616;
constexpr int RECB = 896;
constexpr int LDS_BYTES = 150528;

constexpr size_t al256(size_t x) { return (x + 255) / 256 * 256; }
constexpr size_t WS_BAR = 0;
constexpr size_t WS_MOD = 256;
constexpr size_t WS_XC = al256(WS_MOD + 2 * 2 * 12288 * 4);
constexpr size_t WS_H = al256(WS_XC + (size_t)NCTX * DM * 4);
constexpr size_t WS_VF = al256(WS_H + (size_t)T * DM * 2);
constexpr size_t WS_WIN = al256(WS_VF + (size_t)T * 512 * 2);
constexpr size_t WS_WOUT = al256(WS_WIN + (size_t)NIN * DM * 2);
constexpr size_t WS_WQ = al256(WS_WOUT + (size_t)DM * DM * 2);
constexpr size_t WS_WKV = al256(WS_WQ + (size_t)1536 * 512 * 2);
constexpr size_t WS_WGU = al256(WS_WKV + (size_t)2048 * 256 * 2);
constexpr size_t WS_WDN = al256(WS_WGU + (size_t)NGU * DM * 2);
constexpr size_t WS_R = al256(WS_WDN + (size_t)DM * DFF * 2);
constexpr size_t WS_COLS = WS_R;
constexpr size_t WS_Q = WS_COLS;
constexpr size_t WS_KV = al256(WS_Q + (size_t)T * 1536 * 2);
constexpr size_t WS_REC = al256(WS_COLS + (size_t)T * NIN * 2);
constexpr size_t WS_Y = al256(WS_REC + (size_t)16 * T * RECB);
constexpr size_t WS_LAB = al256(WS_Y + (size_t)2 * T * 512 * 4);
constexpr size_t WS_GG = al256(WS_LAB + (size_t)T * 2048 * 2);
constexpr size_t WS_QN = al256(WS_GG + (size_t)T * 512 * 2);
constexpr size_t WS_KVN = al256(WS_QN + (size_t)T * 512 * 2);
constexpr size_t WS_KR = al256(WS_KVN + (size_t)T * 256 * 2);
constexpr size_t WS_RG = al256(WS_KR + (size_t)T * 64 * 2);
constexpr size_t WS_CV = al256(WS_RG + (size_t)T * 512 * 2);
constexpr size_t WS_AGG = al256(WS_CV + (size_t)T * 512 * 2);
constexpr size_t WS_MIX_END = al256(WS_AGG + (size_t)260 * 2048 * 4);
constexpr size_t WS_GU = WS_R;
constexpr size_t WS_ACT = al256(WS_GU + (size_t)T * NGU * 2);
constexpr size_t WS_FFN_END = al256(WS_ACT + (size_t)T * DFF * 2);
constexpr size_t WS_REND = WS_MIX_END > WS_FFN_END ? WS_MIX_END : WS_FFN_END;
constexpr size_t WS_PARTO = WS_REND;
constexpr size_t WS_PARTML = al256(WS_PARTO + (size_t)448 * 256 * 128 * 2);
constexpr size_t WS_END = al256(WS_PARTML + (size_t)448 * 512 * 4);
static_assert(WS_KV + (size_t)T * 2048 * 2 <= WS_REC, "Q|KV must fit in the cols buffer");

struct Params { const float* in[42]; float* out; unsigned char* ws; int ph_lo, ph_hi; };

enum { I_X = 0, I_C, I_CTX, I_CCTX, I_ADAW, I_ADAB, I_NORM1, I_NORM2, I_WIN, I_WOUT, I_RWCONV, I_RWCONVB, I_RWW0, I_RWWUP, I_RWA0, I_RWAUP, I_RWGUP,
       I_RWKK, I_RWKA, I_RWRK, I_RWLNG, I_RWLNB, I_RWV0, I_RWVDOWN, I_RWVUP, I_LRUCONV, I_LRUCONVB, I_LRUWA, I_LRUBA, I_LRUWX, I_LRUBX, I_LRULAM,
       I_QNORM, I_WQB, I_KVNORM, I_WKVB, I_WGATE, I_WUP, I_FCONV, I_FCONVB, I_WDOWN, I_FNORM };

__device__ __forceinline__ float bf2f(bf16_t b) { return __uint_as_float(((unsigned)b) << 16); }
__device__ __forceinline__ unsigned cvtpk(float lo, float hi) { unsigned r; asm volatile("v_cvt_pk_bf16_f32 %0, %1, %2" : "=v"(r) : "v"(lo), "v"(hi)); return r; }
__device__ __forceinline__ bf16_t f2bf(float f) { return (bf16_t)(cvtpk(f, 0.f) & 0xffffu); }
__device__ __forceinline__ float sigmoidf_(float x) { return __builtin_amdgcn_rcpf(1.0f + __expf(-x)); }
__device__ __forceinline__ float tanhf_(float x) { return 1.0f - 2.0f * __builtin_amdgcn_rcpf(1.0f + __expf(2.0f * x)); }
__device__ __forceinline__ float siluf_(float x) { return x * sigmoidf_(x); }
__device__ __forceinline__ float gelu_tanh(float x) { const float u = 0.7978845608028654f * (x + 0.044715f * x * x * x); return 0.5f * x * (1.0f + tanhf_(u)); }
__device__ __forceinline__ float wave_sum(float v) {
#pragma unroll
  for (int o = 32; o >= 1; o >>= 1) v += __shfl_xor(v, o);
  return v;
}
template <int CTRL> __device__ __forceinline__ float dpp_add(float x) {
  const int xi = __float_as_int(x);
  const int yi = __builtin_amdgcn_update_dpp(xi, xi, CTRL, 0xF, 0xF, false);
  return x + __int_as_float(yi);
}
__device__ __forceinline__ float fma_(float a, float b, float c) { float r; asm("v_fma_f32 %0, %1, %2, %3" : "=v"(r) : "v"(a), "v"(b), "v"(c)); return r; }
__device__ __forceinline__ float mul_(float a, float b) { float r; asm("v_mul_f32 %0, %1, %2" : "=v"(r) : "v"(a), "v"(b)); return r; }
__device__ __forceinline__ float add_(float a, float b) { float r; asm("v_add_f32 %0, %1, %2" : "=v"(r) : "v"(a), "v"(b)); return r; }
typedef float f32x2 __attribute__((ext_vector_type(2)));
__device__ __forceinline__ float dot4(f32x4 a, f32x4 b) { const f32x2 t = a.lo * b.lo + a.hi * b.hi; return t.x + t.y; }
__device__ __forceinline__ float row16_sum(float x) {
  x = dpp_add<0xB1>(x);
  x = dpp_add<0x4E>(x);
  x = dpp_add<0x141>(x);
  x = dpp_add<0x140>(x);
  return x;
}
__device__ __forceinline__ const float* resid_src(const Params& P, int layer, int t) {
  if (layer == 0) return t < NCTX ? PIN(I_CTX) + (size_t)t * DM : PIN(I_X) + (size_t)(t - NCTX) * DM;
  return t < NCTX ? (const float*)(PWS() + WS_XC) + (size_t)t * DM : POUT() + (size_t)(t - NCTX) * DM;
}
__device__ __forceinline__ float* resid_dst(const Params& P, int t) {
  return t < NCTX ? (float*)(PWS() + WS_XC) + (size_t)t * DM : POUT() + (size_t)(t - NCTX) * DM;
}
__device__ __forceinline__ int scan_pos_rev(int t) { return t < NCTX ? (NCTX - 1 - t) : (T + NCTX - 1 - t); }

__device__ __forceinline__ void phase_mod(const Params& P, float* lds) {
  const int tid = mk_tid(), cgp = tid & 15, rg = tid >> 4;
  float* mod = (float*)(PWS() + WS_MOD);
  const float* cvec = PIN(I_C); const float* ccvec = PIN(I_CCTX); const float* adaw = PIN(I_ADAW); const float* adab = PIN(I_ADAB);
  for (int item = mk_bid(); item < 2 * 192; item += mk_nblk()) {
    const int layer = item / 192, col0 = (item % 192) * 64;
    const float* W = adaw + (size_t)layer * DM * 12288 + col0 + cgp * 4;
    f32x4 al = {0.f, 0.f, 0.f, 0.f}, ac = {0.f, 0.f, 0.f, 0.f};
#pragma unroll 1
    for (int r0 = 0; r0 < 64; r0 += 8) {
      f32x4 wv[8]; float sl[8], sc[8];
#pragma unroll
      for (int r = 0; r < 8; ++r) { const int row = rg * 64 + r0 + r; wv[r] = *(const f32x4*)(W + (size_t)row * 12288); sl[r] = cvec[row]; sc[r] = ccvec[row]; }
#pragma unroll
      for (int r = 0; r < 8; ++r) { al += siluf_(sl[r]) * wv[r]; ac += siluf_(sc[r]) * wv[r]; }
    }
#pragma unroll
    for (int i = 0; i < 4; ++i) { lds[(rg * 2 + 0) * 64 + cgp * 4 + i] = al[i]; lds[(rg * 2 + 1) * 64 + cgp * 4 + i] = ac[i]; }
    __syncthreads();
    if (tid < 128) {
      const int which = tid >> 6, col = tid & 63; float sacc = 0.f;
      for (int g = 0; g < 32; ++g) sacc += lds[(g * 2 + which) * 64 + col];
      mod[(size_t)(layer * 2 + which) * 12288 + col0 + col] = sacc + adab[(size_t)layer * 12288 + col0 + col];
    }
    __syncthreads();
  }
}

struct CvtItem { const float* src; bf16_t* dst; int K, N, kt, ntile; bool valid; };
__device__ __forceinline__ CvtItem cvt_decode(const Params& P, int layer, int it) {
  CvtItem r; r.src = nullptr; r.dst = nullptr; r.K = 64; r.N = 0; r.kt = 0; r.ntile = 0; r.valid = false;
  int base = 0;
#define CVT_JOB(SRC, DST, KK, NN) do { const int nkt_ = (KK) / 64, cnt_ = nkt_ * (((NN) + 63) / 64); \
    if (!r.valid && it < base + cnt_) { const int tl_ = it - base; r.src = (SRC); r.dst = (DST); r.K = (KK); r.N = (NN); r.kt = tl_ % nkt_; r.ntile = tl_ / nkt_; r.valid = true; } base += cnt_; } while (0)
  CVT_JOB(PIN(I_WIN) + (size_t)layer * DM * 3616, (bf16_t*)(PWS() + WS_WIN), DM, 3616);
  CVT_JOB(PIN(I_RWVDOWN), (bf16_t*)(PWS() + WS_WIN) + (size_t)C_VD * DM, DM, (layer == 0) ? 0 : 32);
  CVT_JOB(PIN(I_WOUT) + (size_t)layer * DM * DM, (bf16_t*)(PWS() + WS_WOUT), DM, DM);
  CVT_JOB(PIN(I_WQB) + (size_t)layer * 512 * 1536, (bf16_t*)(PWS() + WS_WQ), 512, 1536);
  CVT_JOB(PIN(I_WKVB) + (size_t)layer * 256 * 2048, (bf16_t*)(PWS() + WS_WKV), 256, 2048);
  CVT_JOB(PIN(I_WGATE) + (size_t)layer * DM * DFF, (bf16_t*)(PWS() + WS_WGU), DM, DFF);
  CVT_JOB(PIN(I_WUP) + (size_t)layer * DM * DFF, (bf16_t*)(PWS() + WS_WGU) + (size_t)DFF * DM, DM, DFF);
  CVT_JOB(PIN(I_WDOWN) + (size_t)layer * DFF * DM, (bf16_t*)(PWS() + WS_WDN), DFF, DM);
#undef CVT_JOB
  return r;
}
__device__ __forceinline__ void cvt_load(const CvtItem& c, f32x4 (&v)[2]) {
  const int tid = mk_tid(), kr = tid >> 4, nc = (tid & 15) * 4, k0 = c.kt * 64, n0 = c.ntile * 64;
#pragma unroll
  for (int i = 0; i < 2; ++i) { v[i] = (f32x4){0.f, 0.f, 0.f, 0.f}; if (c.valid && n0 + nc < c.N) v[i] = *(const f32x4*)(c.src + (size_t)(k0 + kr + 32 * i) * c.N + n0 + nc); }
}
__device__ __forceinline__ void phase_convert(const Params& P, int layer, float* lds) {
  const int tid = mk_tid(), kr = tid >> 4, nc = (tid & 15) * 4, n = tid >> 3, kc = (tid & 7) * 8, G = mk_nblk();
  int it = mk_bid();
  CvtItem cur = cvt_decode(P, layer, it); f32x4 v[2]; cvt_load(cur, v);
  while (cur.valid) {
    const CvtItem nxt = cvt_decode(P, layer, it + G); f32x4 nv[2]; cvt_load(nxt, nv);
#pragma unroll
    for (int i = 0; i < 2; ++i) { const int k = kr + 32 * i;
      lds[(nc + 0) * 65 + k] = v[i][0]; lds[(nc + 1) * 65 + k] = v[i][1]; lds[(nc + 2) * 65 + k] = v[i][2]; lds[(nc + 3) * 65 + k] = v[i][3]; }
    __syncthreads();
    if (cur.ntile * 64 + n < cur.N) {
      const float* p = lds + n * 65 + kc;
      u32x4 w; w.x = cvtpk(p[0], p[1]); w.y = cvtpk(p[2], p[3]); w.z = cvtpk(p[4], p[5]); w.w = cvtpk(p[6], p[7]);
      *(u32x4*)(cur.dst + (size_t)(cur.ntile * 64 + n) * cur.K + cur.kt * 64 + kc) = w;
    }
    __syncthreads();
    cur = nxt; v[0] = nv[0]; v[1] = nv[1]; it += G;
  }
}

__device__ __forceinline__ void phase_norm(const Params& P, int layer, int which, bool skip_ctx) {
  const int lane = mk_tid() & 63, wave = mk_tid() >> 6;
  const float* g = P.in[which ? I_NORM2 : I_NORM1] + (size_t)layer * DM;
  const float* mod = (const float*)(PWS() + WS_MOD) + (size_t)layer * 2 * 12288;
  bf16_t* H = (bf16_t*)(PWS() + WS_H);
  const int soff = which ? 6144 : 0;
  const float* src_c = (which == 0 && layer == 0) ? PIN(I_CTX) : (const float*)(PWS() + WS_XC);
  const float* src_l = (which == 0 && layer == 0) ? PIN(I_X) : (const float*)POUT();
  const int stride = mk_nblk() * 8;
  for (int row = mk_bid() * 8 + wave; row < T; row += 2 * stride) {
    int rows[2] = {row, row + stride}; f32x4 v[2][8]; bool ok[2];
#pragma unroll
    for (int u = 0; u < 2; ++u) { ok[u] = rows[u] < T && !(skip_ctx && rows[u] < NCTX);
      if (ok[u]) { const float* xr = rows[u] < NCTX ? src_c + (size_t)rows[u] * DM : src_l + (size_t)(rows[u] - NCTX) * DM;
#pragma unroll
        for (int i = 0; i < 8; ++i) v[u][i] = *(const f32x4*)(xr + i * 256 + lane * 4);
        if (which == 0 && layer == 0 && rows[u] < NCTX) { float* xc = (float*)(PWS() + WS_XC) + (size_t)rows[u] * DM;
#pragma unroll
          for (int i = 0; i < 8; ++i) *(f32x4*)(xc + i * 256 + lane * 4) = v[u][i]; } } }
#pragma unroll
    for (int u = 0; u < 2; ++u) if (ok[u]) {
      const float* m = mod + (rows[u] < NCTX ? 12288 : 0) + soff; float ss = 0.f;
#pragma unroll
      for (int i = 0; i < 8; ++i) ss += v[u][i][0] * v[u][i][0] + v[u][i][1] * v[u][i][1] + v[u][i][2] * v[u][i][2] + v[u][i][3] * v[u][i][3];
      ss = wave_sum(ss);
      const float rstd = rsqrtf(ss * (1.0f / DM) + 1e-6f);
#pragma unroll
      for (int i = 0; i < 8; ++i) {
        const int c = i * 256 + lane * 4;
        const f32x4 gv = *(const f32x4*)(g + c), sh = *(const f32x4*)(m + c), sc = *(const f32x4*)(m + 2048 + c);
        float o[4];
#pragma unroll
        for (int q = 0; q < 4; ++q) o[q] = (v[u][i][q] * rstd * gv[q]) * (1.0f + sc[q]) + sh[q];
        u32x2 w; w.x = cvtpk(o[0], o[1]); w.y = cvtpk(o[2], o[3]);
        *(u32x2*)(H + (size_t)rows[u] * DM + c) = w;
      }
    }
  }
}

__device__ __forceinline__ void phase_final_norm(const Params& P) {
  const int lane = mk_tid() & 63, wave = mk_tid() >> 6;
  const float* g = PIN(I_FNORM); float* out = POUT();
  const int stride = mk_nblk() * 8;
  for (int row = mk_bid() * 8 + wave; row < T - NCTX; row += 2 * stride) {
    int rows[2] = {row, row + stride}; f32x4 v[2][8]; bool ok[2];
#pragma unroll
    for (int u = 0; u < 2; ++u) { ok[u] = rows[u] < T - NCTX;
      if (ok[u]) {
#pragma unroll
        for (int i = 0; i < 8; ++i) v[u][i] = *(const f32x4*)(out + (size_t)rows[u] * DM + i * 256 + lane * 4); } }
#pragma unroll
    for (int u = 0; u < 2; ++u) if (ok[u]) {
      float ss = 0.f;
#pragma unroll
      for (int i = 0; i < 8; ++i) ss += v[u][i][0] * v[u][i][0] + v[u][i][1] * v[u][i][1] + v[u][i][2] * v[u][i][2] + v[u][i][3] * v[u][i][3];
      ss = wave_sum(ss);
      const float rstd = rsqrtf(ss * (1.0f / DM) + 1e-6f);
#pragma unroll
      for (int i = 0; i < 8; ++i) { const int c = i * 256 + lane * 4; const f32x4 gv = *(const f32x4*)(g + c); *(f32x4*)(out + (size_t)rows[u] * DM + c) = v[u][i] * rstd * gv; }
    }
  }
}

struct EpiStore {
  static constexpr bool PERM = true, AFTER_DRAIN = false;
  bf16_t* O; int ldc;
  __device__ __forceinline__ void operator()(const f32x4 (&acc)[2][2][4][2], const pg8::Unit& u, int wr, int wc, int fr, int fq) const {
    const int row0 = u.pm * 256 + wr * 64 + fr, col0 = u.pn * 256 + wc * 32 + 8 * fq;
#pragma unroll
    for (int ai = 0; ai < 2; ++ai)
#pragma unroll
      for (int m = 0; m < 4; ++m) { bf16_t* rowp = O + (size_t)(row0 + ai * 128 + m * 16) * ldc + col0;
#pragma unroll
        for (int bj = 0; bj < 2; ++bj) { const f32x4 v0 = acc[ai][bj][m][0], v1 = acc[ai][bj][m][1];
          u32x4 w; w.x = cvtpk(v0[0], v0[1]); w.y = cvtpk(v0[2], v0[3]); w.z = cvtpk(v1[0], v1[1]); w.w = cvtpk(v1[2], v1[3]);
          *(u32x4*)(rowp + bj * 128) = w; } }
  }
};
struct EpiResid {
  static constexpr bool PERM = false, AFTER_DRAIN = false;
  const float* src_c; const float* src_l; float* dst_c; float* dst_l; const float* gate_c; const float* gate_l; int row_off;
  __device__ __forceinline__ void operator()(const f32x4 (&acc)[2][2][4][2], const pg8::Unit& u, int wr, int wc, int fr, int fq) const {
    const int t0 = row_off + u.pm * 256;
    const bool isc = t0 < NCTX;
    const float* src = isc ? src_c : src_l - (size_t)NCTX * DM; float* dst = isc ? dst_c : dst_l - (size_t)NCTX * DM; const float* gate = isc ? gate_c : gate_l;
    const int row0 = t0 + wr * 64 + fr, col0 = u.pn * 256 + wc * 32 + 4 * fq;
    f32x4 gv[2][2];
#pragma unroll
    for (int bj = 0; bj < 2; ++bj)
#pragma unroll
      for (int n = 0; n < 2; ++n) gv[bj][n] = *(const f32x4*)(gate + col0 + bj * 128 + n * 16);
#pragma unroll
    for (int ai = 0; ai < 2; ++ai)
#pragma unroll
      for (int m = 0; m < 4; ++m) { const size_t off = (size_t)(row0 + ai * 128 + m * 16) * DM + col0;
#pragma unroll
        for (int bj = 0; bj < 2; ++bj)
#pragma unroll
          for (int n = 0; n < 2; ++n) { const f32x4 xs = *(const f32x4*)(src + off + bj * 128 + n * 16);
            *(f32x4*)(dst + off + bj * 128 + n * 16) = xs + gv[bj][n] * acc[ai][bj][m][n]; } }
  }
};

struct EpiResidAtomic {
  static constexpr bool PERM = false, AFTER_DRAIN = false;
  float* dst; const float* gate;
  __device__ __forceinline__ void operator()(const f32x4 (&acc)[2][2][4][2], const pg8::Unit& u, int wr, int wc, int fr, int fq) const {
    const int row0 = wr * 64 + fr, col0 = u.pn * 256 + wc * 32 + 4 * fq;
    f32x4 gv[2][2];
#pragma unroll
    for (int bj = 0; bj < 2; ++bj)
#pragma unroll
      for (int n = 0; n < 2; ++n) gv[bj][n] = *(const f32x4*)(gate + col0 + bj * 128 + n * 16);
#pragma unroll
    for (int ai = 0; ai < 2; ++ai)
#pragma unroll
      for (int m = 0; m < 4; ++m) { float* rp = dst + (size_t)(row0 + ai * 128 + m * 16) * DM + col0;
#pragma unroll
        for (int bj = 0; bj < 2; ++bj)
#pragma unroll
          for (int n = 0; n < 2; ++n) { const f32x4 v = gv[bj][n] * acc[ai][bj][m][n];
#pragma unroll
            for (int q = 0; q < 4; ++q) __hip_atomic_fetch_add(rp + bj * 128 + n * 16 + q, v[q], __ATOMIC_RELAXED, __HIP_MEMORY_SCOPE_AGENT); } }
  }
};
template <class Epi>
__device__ __forceinline__ void run_gemm(unsigned char* lds, const bf16_t* A, const bf16_t* Bt, int M, int N, int K, const Epi& E, int wg, int nwg, int ld = 0, int ksplit = 0) {
  pg8::Gemm g{A, Bt, M, N, K, ld ? ld : K, ksplit}; pg8::StaticOrder S; S.init(M, N, nwg, wg);
  pg8::gemm_phase<Epi, pg8::StaticOrder, false>((PG8_LAS unsigned char*)lds, g, S, E, nullptr);
}

__device__ __forceinline__ float colv(const bf16_t* cols, int t, int c) { return bf2f(cols[(size_t)t * NIN + c]); }
__device__ __forceinline__ float rwconv3(const bf16_t* cols, const float* cw, const float* cb, int t, int c, int lo, int hi) {
  float u = cb[c] + cw[1760 + c] * colv(cols, t, c);
  if (t - 1 >= lo) u += cw[c] * colv(cols, t - 1, c);
  if (t + 1 < hi) u += cw[2 * 1760 + c] * colv(cols, t + 1, c);
  return u;
}

__device__ __forceinline__ float rwconv3w(const bf16_t* cols, float w0, float w1, float w2, float b, int t, int c, int lo, int hi) {
  float u = b + w1 * colv(cols, t, c);
  if (t - 1 >= lo) u += w0 * colv(cols, t - 1, c);
  if (t + 1 < hi) u += w2 * colv(cols, t + 1, c);
  return u;
}
template <int PART>
__device__ __forceinline__ void phase_prep(const Params& P, int layer, float* lds, int wg, int nwg) {
  constexpr int NTK = 13;
  const int tid = mk_tid(), lane = tid & 63, wave = tid >> 6;
  float* lin = lds;
  float* xs = lds + 16 * 256;
  const bf16_t* cols = (const bf16_t*)(PWS() + WS_COLS);
  const float* cw = PIN(I_RWCONV) + (size_t)layer * 3 * 1760; const float* cb = PIN(I_RWCONVB) + (size_t)layer * 1760;
  const float* lcw = PIN(I_LRUCONV) + (size_t)layer * 4 * 512; const float* lcb = PIN(I_LRUCONVB) + (size_t)layer * 512;
  const int c = tid, hd = c >> 6, n = c & 63;
  bf16_t* VF = (bf16_t*)(PWS() + WS_VF); bf16_t* RG = (bf16_t*)(PWS() + WS_RG); bf16_t* CV = (bf16_t*)(PWS() + WS_CV);
  bf16_t* LAB = (bf16_t*)(PWS() + WS_LAB); bf16_t* GG = (bf16_t*)(PWS() + WS_GG);
  bf16_t* QN = (bf16_t*)(PWS() + WS_QN); bf16_t* KVN = (bf16_t*)(PWS() + WS_KVN); bf16_t* KR = (bf16_t*)(PWS() + WS_KR);
  unsigned char* REC = PWS() + WS_REC;
  const float w0_0 = PIN(I_RWW0)[(layer * 2 + 0) * 512 + c], w0_1 = PIN(I_RWW0)[(layer * 2 + 1) * 512 + c];
  const float a0_0 = PIN(I_RWA0)[(layer * 2 + 0) * 512 + c], a0_1 = PIN(I_RWA0)[(layer * 2 + 1) * 512 + c];
  const float kkc = PIN(I_RWKK)[layer * 512 + c], kac = PIN(I_RWKA)[layer * 512 + c], rkc = PIN(I_RWRK)[layer * 512 + c];
  const float v0c = (layer > 0) ? PIN(I_RWV0)[c] : 0.f;
  const float* wup = PIN(I_RWWUP) + (size_t)layer * 2 * 32 * 512 + c; const float* aup = PIN(I_RWAUP) + (size_t)layer * 2 * 32 * 512 + c;
  const float* gup = PIN(I_RWGUP) + (size_t)layer * 96 * 512 + c; const float* vup = PIN(I_RWVUP) + c;
  const float* lwa = PIN(I_LRUWA) + (size_t)layer * 2 * 8 * 4096 + (size_t)hd * 4096 + n; const float* lwx = PIN(I_LRUWX) + (size_t)layer * 2 * 8 * 4096 + (size_t)hd * 4096 + n;
  const float lba0 = PIN(I_LRUBA)[(layer * 2 + 0) * 512 + c], lba1 = PIN(I_LRUBA)[(layer * 2 + 1) * 512 + c];
  const float lbx0 = PIN(I_LRUBX)[(layer * 2 + 0) * 512 + c], lbx1 = PIN(I_LRUBX)[(layer * 2 + 1) * 512 + c];
  const float lam0 = PIN(I_LRULAM)[(layer * 2 + 0) * 512 + c], lam1 = PIN(I_LRULAM)[(layer * 2 + 1) * 512 + c];
  const float sp0 = log1pf(__expf(-lam0)), sp1 = log1pf(__expf(-lam1));
  float cwr[3], cwk[3], cwv[3], cwe[3], cbr = 0.f, cbk = 0.f, cbv = 0.f, cbe = 0.f;
  const int ecol = 1536 + ((tid & 255) < 224 ? (tid & 255) : 0);
#pragma unroll
  for (int q = 0; q < 3; ++q) { cwr[q] = (PART == 0) ? cw[q * 1760 + c] : 0.f; cwk[q] = (PART == 0) ? cw[q * 1760 + 512 + c] : 0.f; cwv[q] = (PART == 0) ? cw[q * 1760 + 1024 + c] : 0.f; cwe[q] = (PART == 0) ? cw[q * 1760 + ecol] : 0.f; }
  if (PART == 0) { cbr = cb[c]; cbk = cb[512 + c]; cbv = cb[1024 + c]; cbe = cb[ecol]; }

  for (int tile = wg; tile < T / NTK; tile += nwg) {
    const int t0 = tile * NTK;
    const int lo = t0 < NCTX ? 0 : NCTX, hi = t0 < NCTX ? NCTX : T;
    if (PART == 0) {
#pragma unroll
    for (int i = 0; i < (NTK * 256 + 511) / 512; ++i) {
      const int idx = tid + 512 * i, tt = idx >> 8, e = idx & 255, t = t0 + tt; float v;
      if (idx >= NTK * 256) continue;
      const int lo_t = t < NCTX ? 0 : NCTX, hi_t = t < NCTX ? NCTX : T;
      if (e < 224) { v = rwconv3w(cols, cwe[0], cwe[1], cwe[2], cbe, t, 1536 + e, lo_t, hi_t); if (e < 64) v = tanhf_(v); else if (e >= 128) v = sigmoidf_(v); }
      else v = (layer > 0) ? colv(cols, t, C_VD + e - 224) : 0.f;
      lin[tt * 256 + e] = v;
    }
    }
    if (PART == 1) {
#pragma unroll
    for (int tt = 0; tt < NTK; ++tt) {
      const int t = t0 + tt; float u = lcb[c]; const int lo_t = t < NCTX ? 0 : NCTX, hi_t = t < NCTX ? NCTX : T;
#pragma unroll
      for (int j = 0; j < 4; ++j) { const int ts = t + j - 2; if (ts >= lo_t && ts < hi_t) u += lcw[j * 512 + c] * colv(cols, ts, C_LRU + c); }
      xs[tt * 512 + c] = u;
    }
#pragma unroll 1
    for (int tw = wave; tw < NTK; tw += 8) {
      const int t = t0 + tw; const bf16_t* cr = cols + (size_t)t * NIN;
      float q[8]; float ss = 0.f;
      { const bf16x8 raw = *(const bf16x8*)(cr + C_MLA + lane * 8);
#pragma unroll
        for (int i = 0; i < 8; ++i) { q[i] = bf2f((bf16_t)raw[i]); ss += q[i] * q[i]; } }
      ss = wave_sum(ss); float rstd = rsqrtf(ss * (1.0f / 512.0f) + 1e-6f);
      { const float* gq = PIN(I_QNORM) + layer * 512 + lane * 8; u32x4 w;
        w.x = cvtpk(q[0] * rstd * gq[0], q[1] * rstd * gq[1]); w.y = cvtpk(q[2] * rstd * gq[2], q[3] * rstd * gq[3]);
        w.z = cvtpk(q[4] * rstd * gq[4], q[5] * rstd * gq[5]); w.w = cvtpk(q[6] * rstd * gq[6], q[7] * rstd * gq[7]);
        *(u32x4*)(QN + (size_t)t * 512 + lane * 8) = w; }
      float k4[4]; ss = 0.f;
      { const s16x4 raw = *(const s16x4*)(cr + C_MLA + 512 + lane * 4);
#pragma unroll
        for (int i = 0; i < 4; ++i) { k4[i] = bf2f((bf16_t)raw[i]); ss += k4[i] * k4[i]; } }
      ss = wave_sum(ss); rstd = rsqrtf(ss * (1.0f / 256.0f) + 1e-6f);
      { const float* gk = PIN(I_KVNORM) + layer * 256 + lane * 4; u32x2 w;
        w.x = cvtpk(k4[0] * rstd * gk[0], k4[1] * rstd * gk[1]); w.y = cvtpk(k4[2] * rstd * gk[2], k4[3] * rstd * gk[3]);
        *(u32x2*)(KVN + (size_t)t * 256 + lane * 4) = w; }
      const float own = bf2f(cr[C_MLA + 768 + lane]); const float oth = __shfl_xor(own, 16);
      float res = own;
      if (t >= NCTX) {
        const int tl = t - NCTX, axis = lane >> 5, half = (lane >> 4) & 1, f = lane & 15;
        const float pos = (float)(axis == 0 ? (tl >> 6) : (tl & 63));
        const float inv = exp2f(-(float)f * (13.287712379549449f / 16.0f));
        const float sn = __sinf(pos * inv), cs = __cosf(pos * inv);
        res = half == 0 ? own * cs - oth * sn : oth * sn + own * cs;
      }
      KR[(size_t)t * 64 + lane] = f2bf(res);
    }
    }
    __syncthreads();
    if (PART == 0) {
      float zw0[NTK], zw1[NTK], za0[NTK], za1[NTK], gg[NTK], mx[NTK];
#pragma unroll
      for (int tt = 0; tt < NTK; ++tt) { zw0[tt] = 0.f; zw1[tt] = 0.f; za0[tt] = 0.f; za1[tt] = 0.f; gg[tt] = 0.f; mx[tt] = 0.f; }
#pragma unroll 1
      for (int e = 0; e < 32; e += 4) {
        float wa[4], wb[4], aa[4], ab[4], vv[4];
#pragma unroll
        for (int i = 0; i < 4; ++i) { wa[i] = wup[(size_t)(e + i) * 512]; wb[i] = wup[(size_t)(32 + e + i) * 512]; aa[i] = aup[(size_t)(e + i) * 512]; ab[i] = aup[(size_t)(32 + e + i) * 512];
          vv[i] = (layer > 0) ? vup[(size_t)(e + i) * 512] : 0.f; }
#pragma unroll
        for (int tt = 0; tt < NTK; ++tt) {
          const f32x4 x0 = *(const f32x4*)(lin + tt * 256 + e), x1 = *(const f32x4*)(lin + tt * 256 + 32 + e), y0 = *(const f32x4*)(lin + tt * 256 + 64 + e),
                      y1 = *(const f32x4*)(lin + tt * 256 + 96 + e), hv = *(const f32x4*)(lin + tt * 256 + 224 + e);
#pragma unroll
          for (int i = 0; i < 4; ++i) { zw0[tt] += x0[i] * wa[i]; zw1[tt] += x1[i] * wb[i]; za0[tt] += y0[i] * aa[i]; za1[tt] += y1[i] * ab[i]; mx[tt] += hv[i] * vv[i]; }
        }
      }
      { float gw[4];
#pragma unroll
        for (int i = 0; i < 4; ++i) gw[i] = gup[(size_t)i * 512];
#pragma unroll 1
        for (int e = 0; e < 96; e += 4) {
          float ngw[4]; const int en = (e + 4 < 96) ? e + 4 : e;
#pragma unroll
          for (int i = 0; i < 4; ++i) ngw[i] = gup[(size_t)(en + i) * 512];
#pragma unroll
          for (int tt = 0; tt < NTK; ++tt) { const f32x4 s4 = *(const f32x4*)(lin + tt * 256 + 128 + e);
#pragma unroll
            for (int i = 0; i < 4; ++i) gg[tt] += s4[i] * gw[i]; }
#pragma unroll
          for (int i = 0; i < 4; ++i) gw[i] = ngw[i];
        } }
#pragma unroll
      for (int tt = 0; tt < NTK; ++tt) {
        const int t = t0 + tt; const int lo_t = t < NCTX ? 0 : NCTX, hi_t = t < NCTX ? NCTX : T;
        const float r = rwconv3w(cols, cwr[0], cwr[1], cwr[2], cbr, t, c, lo_t, hi_t), k = rwconv3w(cols, cwk[0], cwk[1], cwk[2], cbk, t, 512 + c, lo_t, hi_t);
        float v = rwconv3w(cols, cwv[0], cwv[1], cwv[2], cbv, t, 1024 + c, lo_t, hi_t);
        const float wd0 = __expf(-0.606531f * sigmoidf_(w0_0 + zw0[tt])), wd1 = __expf(-0.606531f * sigmoidf_(w0_1 + zw1[tt]));
        const float ic0 = sigmoidf_(a0_0 + za0[tt]), ic1 = sigmoidf_(a0_1 + za1[tt]);
        if (layer > 0) { const float mixv = sigmoidf_(v0c + mx[tt]); const float vf = bf2f(VF[(size_t)t * 512 + c]); v = v + (vf - v) * mixv; }
        else __builtin_nontemporal_store(f2bf(v), VF + (size_t)t * 512 + c);
        float kk = k * kkc; const float ssq = wave_sum(kk * kk); kk *= rsqrtf(fmaxf(ssq, 1e-24f));
        const float kd0 = k * (1.0f + (ic0 - 1.0f) * kac), kd1 = k * (1.0f + (ic1 - 1.0f) * kac);
        const float b0 = kk * ic0, b1 = kk * ic1;
        const float coef = wave_sum(r * (kd0 + kd1) * rkc);
        __builtin_nontemporal_store(f2bf(gg[tt]), RG + (size_t)t * 512 + c); __builtin_nontemporal_store(f2bf(coef * v), CV + (size_t)t * 512 + c);
        const bf16_t ab_ = f2bf(-kk), rb_ = f2bf(r), vb_ = f2bf(v);
        { unsigned char* rp = REC + ((size_t)(0 * 8 + hd) * T + t) * RECB;
          __builtin_nontemporal_store(wd0, (float*)rp + n); bf16_t* q = (bf16_t*)(rp + 256);
          __builtin_nontemporal_store(f2bf(kd0), q + n); __builtin_nontemporal_store(ab_, q + 64 + n); __builtin_nontemporal_store(f2bf(b0), q + 128 + n);
          __builtin_nontemporal_store(rb_, q + 192 + n); __builtin_nontemporal_store(vb_, q + 256 + n); }
        { unsigned char* rp = REC + ((size_t)(1 * 8 + hd) * T + scan_pos_rev(t)) * RECB;
          __builtin_nontemporal_store(wd1, (float*)rp + n); bf16_t* q = (bf16_t*)(rp + 256);
          __builtin_nontemporal_store(f2bf(kd1), q + n); __builtin_nontemporal_store(ab_, q + 64 + n); __builtin_nontemporal_store(f2bf(b1), q + 128 + n);
          __builtin_nontemporal_store(rb_, q + 192 + n); __builtin_nontemporal_store(vb_, q + 256 + n); }
        asm volatile("" ::: "memory");
      }
    }
    if (PART == 1) {
      float pa0[NTK], pa1[NTK], px0[NTK], px1[NTK];
#pragma unroll
      for (int tt = 0; tt < NTK; ++tt) { pa0[tt] = 0.f; pa1[tt] = 0.f; px0[tt] = 0.f; px1[tt] = 0.f; }
      {
        float a0w[4], a1w[4], x0w[4], x1w[4];
#pragma unroll
        for (int i = 0; i < 4; ++i) { a0w[i] = lwa[(size_t)i * 64]; a1w[i] = lwa[(size_t)8 * 4096 + (size_t)i * 64]; x0w[i] = lwx[(size_t)i * 64]; x1w[i] = lwx[(size_t)8 * 4096 + (size_t)i * 64]; }
#pragma unroll 1
        for (int i0 = 0; i0 < 64; i0 += 4) {
          float na0[4], na1[4], nx0[4], nx1[4];
          const int in_ = (i0 + 4 < 64) ? i0 + 4 : i0;
#pragma unroll
          for (int i = 0; i < 4; ++i) { na0[i] = lwa[(size_t)(in_ + i) * 64]; na1[i] = lwa[(size_t)8 * 4096 + (size_t)(in_ + i) * 64]; nx0[i] = lwx[(size_t)(in_ + i) * 64]; nx1[i] = lwx[(size_t)8 * 4096 + (size_t)(in_ + i) * 64]; }
#pragma unroll
          for (int tt = 0; tt < NTK; ++tt) { const f32x4 x = *(const f32x4*)(xs + tt * 512 + hd * 64 + i0);
#pragma unroll
            for (int i = 0; i < 4; ++i) { pa0[tt] += x[i] * a0w[i]; pa1[tt] += x[i] * a1w[i]; px0[tt] += x[i] * x0w[i]; px1[tt] += x[i] * x1w[i]; } }
#pragma unroll
          for (int i = 0; i < 4; ++i) { a0w[i] = na0[i]; a1w[i] = na1[i]; x0w[i] = nx0[i]; x1w[i] = nx1[i]; }
        }
      }
      float gt8[NTK];
#pragma unroll
      for (int tt = 0; tt < NTK; ++tt) gt8[tt] = colv(cols, t0 + tt, C_LRU + 512 + c);
#pragma unroll
      for (int tt = 0; tt < NTK; ++tt) {
        const int t = t0 + tt; const float xb = xs[tt * 512 + c];
        const float la0 = -8.0f * sigmoidf_(pa0[tt] + lba0) * sp0, la1 = -8.0f * sigmoidf_(pa1[tt] + lba1) * sp1;
        const float bb0 = sqrtf(fmaxf(1.0f - __expf(2.0f * la0), 0.f)) * sigmoidf_(px0[tt] + lbx0) * xb;
        const float bb1 = sqrtf(fmaxf(1.0f - __expf(2.0f * la1), 0.f)) * sigmoidf_(px1[tt] + lbx1) * xb;
        bf16_t* lp = LAB + (size_t)t * 2048;
        lp[c] = f2bf(la0); lp[512 + c] = f2bf(bb0); lp[1024 + c] = f2bf(la1); lp[1536 + c] = f2bf(bb1);
        __builtin_nontemporal_store(f2bf(gelu_tanh(gt8[tt])), GG + (size_t)t * 512 + c);
        asm volatile("" ::: "memory");
      }
    }
    __syncthreads();
  }
}

__device__ __forceinline__ void phase_lru_agg(const Params& P, int wg, int nwg) {
  const int c = mk_tid(); const bf16_t* LAB = (const bf16_t*)(PWS() + WS_LAB); float* AGG = (float*)(PWS() + WS_AGG);
  for (int ck = wg; ck < T / 64; ck += nwg) {
    float A0 = 1.f, B0 = 0.f, A1 = 1.f, B1 = 0.f;
#pragma unroll 1
    for (int t8 = 0; t8 < 64; t8 += 8) {
      bf16_t x[8][4];
#pragma unroll
      for (int u = 0; u < 8; ++u) { const bf16_t* lp = LAB + (size_t)(ck * 64 + t8 + u) * 2048; x[u][0] = lp[c]; x[u][1] = lp[512 + c]; x[u][2] = lp[1024 + c]; x[u][3] = lp[1536 + c]; }
#pragma unroll
      for (int u = 0; u < 8; ++u) {
        const float a0 = __expf(bf2f(x[u][0])), b0 = bf2f(x[u][1]), a1 = __expf(bf2f(x[u][2])), b1 = bf2f(x[u][3]);
        A0 = a0 * A0; B0 = a0 * B0 + b0;
        B1 = B1 + A1 * b1; A1 = A1 * a1;
      }
    }
    float* ap = AGG + (size_t)ck * 2048; ap[c] = A0; ap[512 + c] = B0; ap[1024 + c] = A1; ap[1536 + c] = B1;
  }
}
__device__ __forceinline__ float lru_compose(const float* AGG, int c, int off, int q0, int dq, int n, float h) {
  int i = 0;
#pragma unroll 1
  for (; i + 8 <= n; i += 8) {
    float a[8], b[8];
#pragma unroll
    for (int u = 0; u < 8; ++u) { const float* ap = AGG + (size_t)(q0 + (i + u) * dq) * 2048 + off; a[u] = ap[c]; b[u] = ap[512 + c]; }
#pragma unroll
    for (int u = 0; u < 8; ++u) h = a[u] * h + b[u];
  }
#pragma unroll 1
  for (; i < n; ++i) { const float* ap = AGG + (size_t)(q0 + i * dq) * 2048 + off; h = ap[c] * h + ap[512 + c]; }
  return h;
}
__device__ __forceinline__ void phase_lru_out(const Params& P, int layer, float* lds, int wg, int nwg) {
  const int c = mk_tid(); const bf16_t* LAB = (const bf16_t*)(PWS() + WS_LAB); const float* AGG = (const float*)(PWS() + WS_AGG);
  const bf16_t* GG = (const bf16_t*)(PWS() + WS_GG); bf16_t* MIX = (bf16_t*)(PWS() + WS_H);
  const int ck_lo = (layer == 1) ? 4 : 0;
  for (int ck = ck_lo + wg; ck < T / 64; ck += nwg) {
    float h0 = lru_compose(AGG, c, 0, 0, 1, ck, 0.f);
    float h1;
    if (ck < 4) h1 = lru_compose(AGG, c, 1024, 3, -1, 3 - ck, 0.f);
    else { h1 = lru_compose(AGG, c, 1024, 3, -1, 4, 0.f); h1 = lru_compose(AGG, c, 1024, T / 64 - 1, -1, T / 64 - 1 - ck, h1); }
#pragma unroll 1
    for (int t8 = 0; t8 < 64; t8 += 8) {
      bf16_t x[8][2];
#pragma unroll
      for (int u = 0; u < 8; ++u) { const bf16_t* lp = LAB + (size_t)(ck * 64 + t8 + u) * 2048; x[u][0] = lp[c]; x[u][1] = lp[512 + c]; }
#pragma unroll
      for (int u = 0; u < 8; ++u) { h0 = __expf(bf2f(x[u][0])) * h0 + bf2f(x[u][1]); lds[(t8 + u) * 512 + c] = h0; }
    }
#pragma unroll 1
    for (int t8 = 56; t8 >= 0; t8 -= 8) {
      bf16_t x[8][3];
#pragma unroll
      for (int u = 0; u < 8; ++u) { const int t = ck * 64 + t8 + u; const bf16_t* lp = LAB + (size_t)t * 2048; x[u][0] = lp[1024 + c]; x[u][1] = lp[1536 + c]; x[u][2] = GG[(size_t)t * 512 + c]; }
#pragma unroll
      for (int u = 7; u >= 0; --u) { const int t = ck * 64 + t8 + u; h1 = __expf(bf2f(x[u][0])) * h1 + bf2f(x[u][1]);
        MIX[(size_t)t * DM + 512 + c] = f2bf((lds[(t8 + u) * 512 + c] + h1) * bf2f(x[u][2])); }
    }
  }
}

template <int NCW>
__device__ __forceinline__ void rwkv_scan(const Params& P, int s, float* lds) {
  const int d = (NCW == 4) ? (s >> 5) : (s >> 4), h = (NCW == 4) ? ((s >> 2) & 7) : ((s >> 1) & 7), part = (NCW == 4) ? (s & 3) : (s & 1);
  const int tid = mk_tid(), lane = tid & 63, wave = tid >> 6, rgp = lane >> 4, j = lane & 15, row = part * (NCW * 4) + (wave & (NCW - 1)) * 4 + rgp;
  const unsigned char* rec = PWS() + WS_REC + (size_t)(d * 8 + h) * T * RECB;
  float* Y = (float*)(PWS() + WS_Y) + (size_t)d * T * 512 + h * 64 + row;
  constexpr int NST = (NCW == 4) ? 7 : 4, STS = (NCW == 4) ? 256 : 512;
  const bool stager = (NCW == 4) ? (wave >= 4) : true; const int stid = (NCW == 4) ? (tid - 256) : tid;
  int goff[NST], loff[NST]; bool isw[NST], val[NST];
#pragma unroll
  for (int i = 0; i < NST; ++i) { const int q = stid + STS * i; val[i] = stager && q >= 0 && q < 1792; const int rc = q / 56, pr = q % 56; goff[i] = rc * RECB + pr * 16; isw[i] = pr < 16;
    loff[i] = rc * 384 + (isw[i] ? pr * 4 : 64 + ((pr - 16) >> 3) * 64 + ((pr - 16) & 7) * 8); }
  u32x4 stA[NST], stB[NST];
#define RS_LOAD(st, ch) do { _Pragma("unroll") for (int i = 0; i < NST; ++i) if (val[i]) st[i] = __builtin_nontemporal_load((const u32x4*)(rec + (size_t)(ch) * 32 * RECB + goff[i])); } while (0)
#define RS_WRITE(st, buf) do { _Pragma("unroll") for (int i = 0; i < NST; ++i) if (val[i]) { float* dp = (buf) + loff[i]; \
    if (isw[i]) { *(u32x4*)dp = st[i]; } else { u32x4 lo_, hi_; lo_.x = st[i].x << 16; lo_.y = st[i].x & 0xffff0000u; lo_.z = st[i].y << 16; lo_.w = st[i].y & 0xffff0000u; \
      hi_.x = st[i].z << 16; hi_.y = st[i].z & 0xffff0000u; hi_.z = st[i].w << 16; hi_.w = st[i].w & 0xffff0000u; *(u32x4*)dp = lo_; *(u32x4*)(dp + 4) = hi_; } } } while (0)
  f32x4 S = {0.f, 0.f, 0.f, 0.f}; float ykeep = 0.f, yprev = 0.f;
  constexpr int NCH = T / 32;
#define RS_COMPUTE(ch) do { const float* buf = lds + ((ch) & 1) * 12288; \
    if (wave < NCW) { \
      const float* sp = buf + j * 4; \
      f32x4 w4 = *(const f32x4*)(sp), kd4 = *(const f32x4*)(sp + 64), a4 = *(const f32x4*)(sp + 128), b4 = *(const f32x4*)(sp + 192), r4 = *(const f32x4*)(sp + 256); \
      float v = buf[320 + row]; \
      _Pragma("unroll 8") \
      for (int stp = 0; stp < 32; ++stp) { \
        float sa = dot4(S, a4); \
          \
        __builtin_amdgcn_sched_barrier(0); \
        const float* np = sp + (stp + 1) * 384;            \
        const f32x4 nw4 = *(const f32x4*)(np), nkd4 = *(const f32x4*)(np + 64), na4 = *(const f32x4*)(np + 128), nb4 = *(const f32x4*)(np + 192), nr4 = *(const f32x4*)(np + 256); \
        const float nv = buf[(stp + 1) * 384 + 320 + row]; \
        __builtin_amdgcn_sched_barrier(0); \
          \
          \
        f32x2 q01, t23, vv; vv[0] = v; vv[1] = v; \
        { const f32x2 kd01 = kd4.lo, kd23 = kd4.hi, S01 = S.lo, w01 = w4.lo; \
        asm volatile("v_add_f32_dpp %0, %0, %0 quad_perm:[1,0,3,2] row_mask:0xf bank_mask:0xf\n\t" \
                     "v_add_f32_dpp %1, %1, %1 quad_perm:[1,0,3,2] row_mask:0xf bank_mask:0xf\n\t" \
                     "v_pk_mul_f32 %2, %4, %6 op_sel_hi:[1,0]\n\t" \
                     "v_add_f32_dpp %0, %0, %0 quad_perm:[2,3,0,1] row_mask:0xf bank_mask:0xf\n\t" \
                     "v_add_f32_dpp %1, %1, %1 quad_perm:[2,3,0,1] row_mask:0xf bank_mask:0xf\n\t" \
                     "v_pk_mul_f32 %3, %5, %6 op_sel_hi:[1,0]\n\t" \
                     "v_add_f32_dpp %0, %0, %0 row_half_mirror row_mask:0xf bank_mask:0xf\n\t" \
                     "v_add_f32_dpp %1, %1, %1 row_half_mirror row_mask:0xf bank_mask:0xf\n\t" \
                     "v_pk_fma_f32 %2, %7, %8, %2\n\t" \
                     "v_add_f32_dpp %0, %0, %0 row_mirror row_mask:0xf bank_mask:0xf\n\t" \
                     "v_add_f32_dpp %1, %1, %1 row_mirror row_mask:0xf bank_mask:0xf" \
                     : "+v"(sa), "+v"(yprev), "=&v"(q01), "=&v"(t23) \
                     : "v"(kd01), "v"(kd23), "v"(vv), "v"(S01), "v"(w01)); } \
        const f32x2 q23 = S.hi * w4.hi + t23; \
        ykeep = (((stp + 15) & 15) == j) ? yprev : ykeep;         \
        if ((stp & 15) == 0 && ((ch) > 0 || stp > 0)) { const int p = (ch) * 32 + stp - 16 + j; const int tok = d ? scan_pos_rev(p) : p; __builtin_nontemporal_store(ykeep, Y + (size_t)tok * 512); } \
        S.lo = sa * b4.lo + q01; S.hi = sa * b4.hi + q23; \
        yprev = dot4(S, r4); \
        w4 = nw4; kd4 = nkd4; a4 = na4; b4 = nb4; r4 = nr4; v = nv; \
      } \
    } } while (0)
  RS_LOAD(stA, 0); RS_WRITE(stA, lds); RS_LOAD(stA, 1); __syncthreads();
  static_assert(NCH % 2 == 0, "the chunk loop is unrolled by two");
  for (int ch = 0; ch < NCH; ch += 2) {
    if (ch + 2 < NCH) RS_LOAD(stB, ch + 2);
    RS_COMPUTE(ch);
    RS_WRITE(stA, lds + 12288);
    __syncthreads();
    if (ch + 3 < NCH) RS_LOAD(stA, ch + 3);
    RS_COMPUTE(ch + 1);
    if (ch + 2 < NCH) RS_WRITE(stB, lds);
    __syncthreads();
  }
  if (wave < NCW) {
    yprev = row16_sum(yprev);
    ykeep = (j == 15) ? yprev : ykeep;
    const int p = T - 16 + j; const int tok = d ? scan_pos_rev(p) : p; __builtin_nontemporal_store(ykeep, Y + (size_t)tok * 512);
  }
#undef RS_COMPUTE
#undef RS_LOAD
#undef RS_WRITE
}

__device__ __forceinline__ void phase_rwkv_out(const Params& P, int layer, int wg, int nwg) {
  const int c = mk_tid();
  const float* Y0 = (const float*)(PWS() + WS_Y); const float* Y1 = Y0 + (size_t)T * 512;
  const bf16_t* RG = (const bf16_t*)(PWS() + WS_RG); const bf16_t* CV = (const bf16_t*)(PWS() + WS_CV); bf16_t* MIX = (bf16_t*)(PWS() + WS_H);
  const float lg = PIN(I_RWLNG)[layer * 512 + c], lb = PIN(I_RWLNB)[layer * 512 + c];
  const int G = nwg;
  for (int t0 = (layer == 1 ? NCTX : 0) + wg; t0 < T; t0 += 4 * G) {
    float y[4], cv[4], rg[4];
#pragma unroll
    for (int u = 0; u < 4; ++u) { const int t = t0 + u * G; if (t < T) { y[u] = Y0[(size_t)t * 512 + c] + Y1[(size_t)t * 512 + c]; cv[u] = bf2f(CV[(size_t)t * 512 + c]); rg[u] = bf2f(RG[(size_t)t * 512 + c]); } else { y[u] = 0.f; cv[u] = 0.f; rg[u] = 0.f; } }
#pragma unroll
    for (int u = 0; u < 4; ++u) { const int t = t0 + u * G;
      const float mu = wave_sum(y[u]) * (1.0f / 64.0f); const float dlt = y[u] - mu; const float var = wave_sum(dlt * dlt) * (1.0f / 64.0f);
      const float yn = dlt * rsqrtf(var + 64e-5f) * lg + lb;
      if (t < T) MIX[(size_t)t * DM + c] = f2bf((yn + cv[u]) * rg[u]); }
  }
}

__device__ __forceinline__ void phase_ffn_act(const Params& P, int layer) {
  const bf16_t* GU = (const bf16_t*)(PWS() + WS_GU); bf16_t* ACT = (bf16_t*)(PWS() + WS_ACT);
  const float* fw = PIN(I_FCONV) + (size_t)layer * 3 * DFF; const float* fb = PIN(I_FCONVB) + (size_t)layer * DFF;
  const int run_lo = (layer == 1) ? NCTX / 32 : 0, nruns = T / 32 - run_lo;
  for (int idx = mk_bid() * NTH + mk_tid(); idx < nruns * 704; idx += mk_nblk() * NTH) {
    const int cgp = idx % 704, run = run_lo + idx / 704, c0 = cgp * 8, t0 = run * 32;
    const int lo = t0 < NCTX ? 0 : NCTX, hi = t0 < NCTX ? NCTX : T;
    float w0[8], w1[8], w2[8], bb[8];
#pragma unroll
    for (int i = 0; i < 8; ++i) { w0[i] = fw[c0 + i]; w1[i] = fw[DFF + c0 + i]; w2[i] = fw[2 * DFF + c0 + i]; bb[i] = fb[c0 + i]; }
    const bf16x8 zero = {0, 0, 0, 0, 0, 0, 0, 0};
    bf16x8 prev = (t0 - 1 >= lo) ? *(const bf16x8*)(GU + (size_t)(t0 - 1) * NGU + c0) : zero;
    bf16x8 cur = *(const bf16x8*)(GU + (size_t)t0 * NGU + c0);
    for (int tt = 0; tt < 32; ++tt) {
      const int t = t0 + tt;
      const bf16x8 nxt = (t + 1 < hi) ? *(const bf16x8*)(GU + (size_t)(t + 1) * NGU + c0) : zero;
      const bf16x8 up = *(const bf16x8*)(GU + (size_t)t * NGU + DFF + c0);
      float o[8];
#pragma unroll
      for (int i = 0; i < 8; ++i) { const float g = bb[i] + w0[i] * bf2f((bf16_t)prev[i]) + w1[i] * bf2f((bf16_t)cur[i]) + w2[i] * bf2f((bf16_t)nxt[i]); o[i] = siluf_(g) * bf2f((bf16_t)up[i]); }
      u32x4 w; w.x = cvtpk(o[0], o[1]); w.y = cvtpk(o[2], o[3]); w.z = cvtpk(o[4], o[5]); w.w = cvtpk(o[6], o[7]);
      *(u32x4*)(ACT + (size_t)t * DFF + c0) = w;
      prev = cur; cur = nxt;
    }
  }
}

namespace at2 {
constexpr int DQK = 192, DV = 128, QBLK = 32, KVBLK = 64;
constexpr float SCALE = 0.07216878364870322f;
constexpr float THR = 8.f;
#ifndef ATT_NQREG
#define ATT_NQREG 12
#endif
constexpr int NQREG = ATT_NQREG;
constexpr int SHM_V = KVBLK * DV * 2, SHM_K = KVBLK * DQK * 2, SHM_ATTN = 3 * SHM_V + 3 * SHM_K + 8 * 64 * 4,     SHM_TOTAL = SHM_ATTN + (12 - NQREG) * 8192;
#define KSWZ(row, colB) ((row) * 384 + ((colB) ^ (((row) & 7) << 4)))
#define SBAR() __builtin_amdgcn_sched_barrier(0)
__device__ __forceinline__ int crow(int r, int hi) { return (r & 3) + 8 * (r >> 2) + 4 * hi; }

__device__ __forceinline__ void partialSM(f32x16& p0, f32x16& p1, float& m_reg, float& mn, float& alpha) {
  constexpr float C = SCALE * 1.4426950408889634f;
  float pmax = p0[0];
#pragma unroll
  for (int r = 1; r < 16; ++r) pmax = fmaxf(pmax, p0[r]);
#pragma unroll
  for (int r = 0; r < 16; ++r) pmax = fmaxf(pmax, p1[r]);
  { auto rr = __builtin_amdgcn_permlane32_swap(__float_as_uint(pmax), __float_as_uint(pmax), false, false);
    pmax = fmaxf(__uint_as_float(rr[0]), __uint_as_float(rr[1])); }
  if (__builtin_expect(__all(pmax - m_reg <= THR / SCALE), 1)) { mn = m_reg; alpha = 1.f; }
  else { mn = fmaxf(m_reg, pmax); alpha = __builtin_amdgcn_exp2f((m_reg - mn) * C); m_reg = mn; }
  const float mnC = -mn * C;
#pragma unroll
  for (int r = 0; r < 16; ++r) p0[r] = fmaf(p0[r], C, mnC);
#pragma unroll
  for (int r = 0; r < 16; ++r) p1[r] = fmaf(p1[r], C, mnC);
#pragma unroll
  for (int r = 0; r < 16; ++r) p0[r] = __builtin_amdgcn_exp2f(p0[r]);
}
__device__ __forceinline__ void finishSM(f32x16& p0, f32x16& p1, float alpha, float& l_reg, bf16x8& pa0, bf16x8& pa1, bf16x8& pa2, bf16x8& pa3) {
#pragma unroll
  for (int r = 0; r < 16; ++r) p1[r] = __builtin_amdgcn_exp2f(p1[r]);
  float ps = 0;
#pragma unroll
  for (int r = 0; r < 16; ++r) ps += p0[r];
#pragma unroll
  for (int r = 0; r < 16; ++r) ps += p1[r];
  { auto rr = __builtin_amdgcn_permlane32_swap(__float_as_uint(ps), __float_as_uint(ps), false, false);
    ps = __uint_as_float(rr[0]) + __uint_as_float(rr[1]); }
  l_reg = l_reg * alpha + ps;
#define PK4(P, BASE, OUT) do { unsigned a0 = cvtpk(P[BASE + 0], P[BASE + 1]), a1 = cvtpk(P[BASE + 2], P[BASE + 3]);   \
    unsigned b0 = cvtpk(P[BASE + 4], P[BASE + 5]), b1 = cvtpk(P[BASE + 6], P[BASE + 7]);                              \
    auto r0 = __builtin_amdgcn_permlane32_swap(a0, b0, false, false); auto r1 = __builtin_amdgcn_permlane32_swap(a1, b1, false, false); \
    u32x4 w = {r0[0], r1[0], r0[1], r1[1]}; OUT = *reinterpret_cast<bf16x8*>(&w); } while (0)
  PK4(p0, 0, pa0); PK4(p0, 8, pa1); PK4(p1, 0, pa2); PK4(p1, 8, pa3);
#undef PK4
}
__device__ __forceinline__ void qkt(f32x16& p0, f32x16& p1, const char* Ks, const bf16x8* qr, const char* qsp, int r32, int hi) {
  p0 = f32x16{}; p1 = f32x16{};
#pragma unroll
  for (int d0 = 0; d0 < 12; ++d0) { const int cb = (d0 * 16 + hi * 8) * 2;
    const bf16x8 b0 = *reinterpret_cast<const bf16x8*>(Ks + KSWZ(r32, cb));
    const bf16x8 b1 = *reinterpret_cast<const bf16x8*>(Ks + KSWZ(32 + r32, cb));
    const bf16x8 qv = (d0 < NQREG) ? qr[d0 < NQREG ? d0 : 0] : *reinterpret_cast<const bf16x8*>(qsp + (d0 - NQREG) * 8192);
    p0 = __builtin_amdgcn_mfma_f32_32x32x16_bf16(b0, qv, p0, 0, 0, 0);
    p1 = __builtin_amdgcn_mfma_f32_32x32x16_bf16(b1, qv, p1, 0, 0, 0); }
}
__device__ __forceinline__ int v_st(int k, int c) { const int kk = (k & ~0xC) | ((k & 4) << 1) | ((k & 8) >> 1); return ((kk >> 3) * 4 + (c >> 5)) * 512 + ((kk & 7) * 32 + (c & 31)) * 2; }
__device__ __forceinline__ int v_rd_base(int lane) { return ((lane & 3) << 3) | (((lane >> 2) & 3) << 6) | (((lane >> 4) & 1) << 5) | (((lane >> 5) & 1) << 8); }
constexpr int v_rd_off(int d0, int ks, int half) { return d0 * 512 + ks * 4096 + half * 2048; }
template <int OFF> __device__ __forceinline__ s16x4 tr_read(int vb) {
  s16x4 r; asm volatile("ds_read_b64_tr_b16 %0, %1 offset:%2" : "=&v"(r) : "v"(vb), "i"(OFF) : "memory"); return r;
}
template <int D0> __device__ __forceinline__ void pv_one(f32x16& od, int vb, bf16x8 pa0, bf16x8 pa1, bf16x8 pa2, bf16x8 pa3) {
  const s16x4 l0 = tr_read<v_rd_off(D0, 0, 0)>(vb), h0 = tr_read<v_rd_off(D0, 0, 1)>(vb), l1 = tr_read<v_rd_off(D0, 1, 0)>(vb), h1 = tr_read<v_rd_off(D0, 1, 1)>(vb);
  const s16x4 l2 = tr_read<v_rd_off(D0, 2, 0)>(vb), h2 = tr_read<v_rd_off(D0, 2, 1)>(vb), l3 = tr_read<v_rd_off(D0, 3, 0)>(vb), h3 = tr_read<v_rd_off(D0, 3, 1)>(vb);
  asm volatile("s_waitcnt lgkmcnt(0)" ::: "memory"); SBAR();
#define PK(L, H) (bf16x8){L[0], L[1], L[2], L[3], H[0], H[1], H[2], H[3]}
  od = __builtin_amdgcn_mfma_f32_32x32x16_bf16(pa0, PK(l0, h0), od, 0, 0, 0);
  od = __builtin_amdgcn_mfma_f32_32x32x16_bf16(pa1, PK(l1, h1), od, 0, 0, 0);
  od = __builtin_amdgcn_mfma_f32_32x32x16_bf16(pa2, PK(l2, h2), od, 0, 0, 0);
  od = __builtin_amdgcn_mfma_f32_32x32x16_bf16(pa3, PK(l3, h3), od, 0, 0, 0);
#undef PK
}
__device__ __forceinline__ void pv_d0(f32x16* o, int vb, bf16x8 pa0, bf16x8 pa1, bf16x8 pa2, bf16x8 pa3) {
  pv_one<0>(o[0], vb, pa0, pa1, pa2, pa3); pv_one<1>(o[1], vb, pa0, pa1, pa2, pa3); pv_one<2>(o[2], vb, pa0, pa1, pa2, pa3); pv_one<3>(o[3], vb, pa0, pa1, pa2, pa3);
}
__device__ __forceinline__ void rope_pair(bf16x8& A, bf16x8& B, float pos, int hi) {
  float oa[8], ob[8];
#pragma unroll
  for (int e = 0; e < 8; ++e) {
    const float inv = exp2f(-(float)(hi * 8 + e) * (13.287712379549449f / 16.0f));
    const float sn = __sinf(pos * inv), cs = __cosf(pos * inv);
    const float a = bf2f((bf16_t)A[e]), b = bf2f((bf16_t)B[e]);
    oa[e] = a * cs - b * sn; ob[e] = a * sn + b * cs;
  }
  u32x4 wa = {cvtpk(oa[0], oa[1]), cvtpk(oa[2], oa[3]), cvtpk(oa[4], oa[5]), cvtpk(oa[6], oa[7])};
  u32x4 wb = {cvtpk(ob[0], ob[1]), cvtpk(ob[2], ob[3]), cvtpk(ob[4], ob[5]), cvtpk(ob[6], ob[7])};
  A = *reinterpret_cast<bf16x8*>(&wa); B = *reinterpret_cast<bf16x8*>(&wb);
}

__device__ __forceinline__ void attn_unit(const bf16_t* __restrict__ Q, const bf16_t* __restrict__ KV, const bf16_t* __restrict__ KR, bf16_t* __restrict__ MIX,
                                          int q0, int h, int kv0, int seq, bool rope_q, char* lds, bf16_t* __restrict__ part_o, float* __restrict__ part_ml) {
  const int tid = mk_tid(), wid = tid >> 6, lane = tid & 63, r32 = lane & 31, hi = lane >> 5;
  char* V_lds = lds; char* K_lds = lds + 3 * SHM_V;
  float* ws = (float*)(lds + 3 * SHM_V + 3 * SHM_K) + wid * 64; float* li_l = ws; float* al_l = ws + 32;
  float m_reg = -1e30f, l_reg = 0; f32x16 o[4] = {}; bf16x8 qr[12];
  const int qrow = q0 + wid * QBLK + r32;
  const bf16_t* Qw = Q + (size_t)qrow * 1536 + h * DQK + hi * 8;
#pragma unroll
  for (int d0 = 0; d0 < 12; ++d0) qr[d0] = *reinterpret_cast<const bf16x8*>(Qw + d0 * 16);
  if (rope_q) { const int tl = qrow - NCTX; rope_pair(qr[8], qr[9], (float)(tl >> 6), hi); rope_pair(qr[10], qr[11], (float)(tl & 63), hi); }
  char* qsp = lds + SHM_ATTN + tid * 16;
#pragma unroll
  for (int d0 = NQREG; d0 < 12; ++d0) *reinterpret_cast<bf16x8*>(qsp + (d0 - NQREG) * 8192) = qr[d0];
  const bf16_t* Kh = KV + (size_t)kv0 * 2048 + h * 256; const bf16_t* Vh = Kh + 128; KR += (size_t)kv0 * 64;
  const int sr = tid >> 4, sc = (tid & 15) * 8, vst0 = v_st(sr, sc), vst1 = v_st(32 + sr, sc);
  const int rr = tid >> 3, rc = (tid & 7) * 8;
  const int vb0 = (int)(uintptr_t)V_lds + v_rd_base(lane);
  bf16x8 vs0, vs1, ks0, ks1, ks2;
#define SLOAD(k0) do { vs0 = *(const bf16x8*)(Vh + (size_t)((k0) + sr) * 2048 + sc); vs1 = *(const bf16x8*)(Vh + (size_t)((k0) + 32 + sr) * 2048 + sc); \
    ks0 = *(const bf16x8*)(Kh + (size_t)((k0) + sr) * 2048 + sc); ks1 = *(const bf16x8*)(Kh + (size_t)((k0) + 32 + sr) * 2048 + sc); \
    ks2 = *(const bf16x8*)(KR + (size_t)((k0) + rr) * 64 + rc); } while (0)
#define SWRITE(b) do { *(bf16x8*)(V_lds + (b) * SHM_V + vst0) = vs0; *(bf16x8*)(V_lds + (b) * SHM_V + vst1) = vs1; const int kc = sc * 2; \
    *(bf16x8*)(K_lds + (b) * SHM_K + KSWZ(sr, kc)) = ks0; *(bf16x8*)(K_lds + (b) * SHM_K + KSWZ(32 + sr, kc)) = ks1; \
    *(bf16x8*)(K_lds + (b) * SHM_K + KSWZ(rr, 256 + rc * 2)) = ks2; } while (0)
#define SWAIT() asm volatile("s_waitcnt vmcnt(0)" ::: "memory")
#define RESC(a) do { if (__any((a) < 1.f)) { if (hi == 0) al_l[r32] = (a); asm volatile("s_waitcnt lgkmcnt(0)" ::: "memory"); \
    _Pragma("unroll") for (int d = 0; d < 4; ++d) _Pragma("unroll") for (int r = 0; r < 16; ++r) o[d][r] *= al_l[crow(r, hi)]; } } while (0)
  f32x16 pA0, pA1, pB0, pB1; float mnA, mnB, alA, alB; bf16x8 pa0, pa1, pa2, pa3; const int NT = seq / KVBLK;
  SLOAD(0); SWAIT(); SWRITE(0); __syncthreads();
  qkt(pA0, pA1, K_lds, qr, qsp, r32, hi); partialSM(pA0, pA1, m_reg, mnA, alA);
  SLOAD(KVBLK);
  SWAIT(); SWRITE(1); __syncthreads();
  int bp = 0, bc = 1, bn = 2;
  for (int j = 1; j + 1 < NT; j += 2) {
    SBAR(); qkt(pB0, pB1, K_lds + bc * SHM_K, qr, qsp, r32, hi);
    finishSM(pA0, pA1, alA, l_reg, pa0, pa1, pa2, pa3); SBAR();
    SLOAD((j + 1) * KVBLK); SBAR();
    pv_d0(o, vb0 + bp * SHM_V, pa0, pa1, pa2, pa3); partialSM(pB0, pB1, m_reg, mnB, alB);
    SWAIT(); SWRITE(bn);
    RESC(alB); __syncthreads();
    bp = bc; bc = bn; bn = (bn == 2) ? 0 : bn + 1;
    SBAR(); qkt(pA0, pA1, K_lds + bc * SHM_K, qr, qsp, r32, hi);
    finishSM(pB0, pB1, alB, l_reg, pa0, pa1, pa2, pa3); SBAR();
    SLOAD((j + 2) * KVBLK); SBAR();
    pv_d0(o, vb0 + bp * SHM_V, pa0, pa1, pa2, pa3); partialSM(pA0, pA1, m_reg, mnA, alA);
    SWAIT(); SWRITE(bn);
    RESC(alA); __syncthreads();
    bp = bc; bc = bn; bn = (bn == 2) ? 0 : bn + 1;
  }
  SBAR(); qkt(pB0, pB1, K_lds + bc * SHM_K, qr, qsp, r32, hi);
  finishSM(pA0, pA1, alA, l_reg, pa0, pa1, pa2, pa3); SBAR();
  pv_d0(o, vb0 + bp * SHM_V, pa0, pa1, pa2, pa3); partialSM(pB0, pB1, m_reg, mnB, alB);
  __syncthreads(); RESC(alB);
  finishSM(pB0, pB1, alB, l_reg, pa0, pa1, pa2, pa3); SBAR();
  pv_d0(o, vb0 + bc * SHM_V, pa0, pa1, pa2, pa3);
  if (hi == 0) li_l[r32] = l_reg; asm volatile("s_waitcnt lgkmcnt(0)" ::: "memory");
  float rli[16];
#pragma unroll
  for (int r = 0; r < 16; ++r) rli[r] = __builtin_amdgcn_rcpf(li_l[crow(r, hi)]);
  if (part_o == nullptr) {
    bf16_t* Ow = MIX + (size_t)(q0 + wid * QBLK) * DM + 1024 + h * DV;
#pragma unroll
    for (int r = 0; r < 16; ++r) { const int orow = crow(r, hi);
#pragma unroll
      for (int d0 = 0; d0 < 4; ++d0) Ow[(size_t)orow * DM + d0 * 32 + r32] = f2bf(o[d0][r] * rli[r]); }
  } else {
    bf16_t* Ow = part_o + (size_t)(wid * QBLK) * DV;
#pragma unroll
    for (int r = 0; r < 16; ++r) { const int orow = crow(r, hi);
#pragma unroll
      for (int d0 = 0; d0 < 4; ++d0) Ow[(size_t)orow * DV + d0 * 32 + r32] = f2bf(o[d0][r] * rli[r]); }
    if (hi == 0) { part_ml[(wid * QBLK + r32) * 2] = m_reg; part_ml[(wid * QBLK + r32) * 2 + 1] = l_reg; }
  }
  __syncthreads();
#undef SLOAD
#undef SWRITE
#undef SWAIT
#undef RESC
}
}

__device__ __forceinline__ int attn_np(int nwg) { return nwg == 192 ? 3 : (nwg == 224 ? 7 : 0); }
__device__ __forceinline__ int attn_part_tiles(int np, int p) { return 2 * (130 / np) + (p < (130 % np) ? 2 : 0); }
__device__ __forceinline__ void phase_attention(const Params& P, int layer, char* lds, int wg, int nwg) {
  const bf16_t* Q = (const bf16_t*)(PWS() + WS_Q); const bf16_t* KV = (const bf16_t*)(PWS() + WS_KV); const bf16_t* KR = (const bf16_t*)(PWS() + WS_KR);
  bf16_t* MIX = (bf16_t*)(PWS() + WS_H); bf16_t* PO = (bf16_t*)(PWS() + WS_PARTO); float* PML = (float*)(PWS() + WS_PARTML);
  const int np = attn_np(nwg);
  const int nwhole = np ? (512 / nwg) * nwg : 512, nparts = (512 - nwhole) * np, nctx = (layer == 0) ? 8 : 0;
  for (int it = wg; it < nwhole + nparts + nctx; it += nwg) {
    int q0, h, kv0 = 0, seq = T; bool lat = true; bf16_t* po = nullptr; float* pml = nullptr;
    if (it < nwhole) { q0 = NCTX + (it & 63) * 256; h = it >> 6; }
    else if (it < nwhole + nparts) { const int q = it - nwhole, u = nwhole + q / np, p = q % np; q0 = NCTX + (u & 63) * 256; h = u >> 6;
      int t0 = 0; for (int pp = 0; pp < p; ++pp) t0 += attn_part_tiles(np, pp);
      kv0 = t0 * 64; seq = attn_part_tiles(np, p) * 64; po = PO + (size_t)q * 256 * 128; pml = PML + (size_t)q * 512; }
    else { q0 = 0; h = it - nwhole - nparts; seq = NCTX; lat = false; }
    at2::attn_unit(Q, KV, KR, MIX, q0, h, kv0, seq, lat, lds, po, pml);
  }
}
__device__ __forceinline__ void phase_attn_merge(const Params& P, int wg, int nwg) {
  const int np = attn_np(nwg); if (np == 0) return;
  const int nwhole = (512 / nwg) * nwg;
  const bf16_t* PO = (const bf16_t*)(PWS() + WS_PARTO); const float* PML = (const float*)(PWS() + WS_PARTML); bf16_t* MIX = (bf16_t*)(PWS() + WS_H);
  constexpr float C = at2::SCALE * 1.4426950408889634f;
  const int tid = mk_tid(), row = tid >> 1, c0 = (tid & 1) * 64;
  for (int us = wg; us < 512 - nwhole; us += nwg) {
    const int u = nwhole + us, q0 = NCTX + (u & 63) * 256, h = u >> 6;
    float M = -3.0e38f;
    for (int p = 0; p < np; ++p) M = fmaxf(M, PML[(size_t)(us * np + p) * 512 + row * 2]);
    float acc[64];
#pragma unroll
    for (int i = 0; i < 64; ++i) acc[i] = 0.f;
    float ws = 0.f;
#pragma unroll 1
    for (int p = 0; p < np; ++p) {
      const float* ml = PML + (size_t)(us * np + p) * 512 + row * 2;
      const float w = ml[1] * exp2f((ml[0] - M) * C); ws += w;
      const bf16_t* src = PO + ((size_t)(us * np + p) * 256 + row) * 128 + c0;
#pragma unroll
      for (int cc = 0; cc < 64; cc += 8) { const bf16x8 x = *(const bf16x8*)(src + cc);
#pragma unroll
        for (int i = 0; i < 8; ++i) acc[cc + i] += w * bf2f((bf16_t)x[i]); }
    }
    const float inv = 1.0f / ws;
#pragma unroll
    for (int cc = 0; cc < 64; cc += 8) {
      u32x4 o; o.x = cvtpk(acc[cc] * inv, acc[cc + 1] * inv); o.y = cvtpk(acc[cc + 2] * inv, acc[cc + 3] * inv); o.z = cvtpk(acc[cc + 4] * inv, acc[cc + 5] * inv); o.w = cvtpk(acc[cc + 6] * inv, acc[cc + 7] * inv);
      *(u32x4*)(MIX + (size_t)(q0 + row) * DM + 1024 + h * 128 + c0 + cc) = o;
    }
  }
}

#ifndef REP_ATT
#define REP_ATT 1
#endif
#ifndef REP_SCAN
#define REP_SCAN 1
#endif
#ifndef REP_PREP
#define REP_PREP 1
#endif
#ifndef REP_GU
#define REP_GU 1
#endif
#ifndef REP_MISC
#define REP_MISC 1
#endif
#ifndef N_SCAN_WG
#define N_SCAN_WG 64
#endif
__device__ __forceinline__ void grid_barrier(unsigned* ctr, unsigned target) {
  asm volatile("s_waitcnt vmcnt(0) lgkmcnt(0)" ::: "memory");
  __syncthreads();
  if (mk_tid() == 0) {
    __builtin_amdgcn_fence(__ATOMIC_RELEASE, "agent");
    __hip_atomic_fetch_add(ctr, 1u, __ATOMIC_RELAXED, __HIP_MEMORY_SCOPE_AGENT);
    while (__hip_atomic_load(ctr, __ATOMIC_RELAXED, __HIP_MEMORY_SCOPE_AGENT) < target) __builtin_amdgcn_s_sleep(2);
    __builtin_amdgcn_fence(__ATOMIC_ACQUIRE, "agent");
  }
  __syncthreads();
}
__device__ __forceinline__ void grid_arrive(unsigned* ctr) {
  asm volatile("s_waitcnt vmcnt(0) lgkmcnt(0)" ::: "memory");
  __syncthreads();
  if (mk_tid() == 0) { __builtin_amdgcn_fence(__ATOMIC_RELEASE, "agent"); __hip_atomic_fetch_add(ctr, 1u, __ATOMIC_RELAXED, __HIP_MEMORY_SCOPE_AGENT); }
}
enum { K_MOD = 0, K_NORM1, K_GEMM_IN, K_PREP, K_MIX, K_RWOUT, K_GEMM_OUT, K_NORM2, K_GEMM_GU, K_ACT, K_GEMM_DN, K_FINAL };
constexpr int STEPS_PER_LAYER = 10, N_STEPS = 1 + 2 * STEPS_PER_LAYER + 1;
__global__ void __launch_bounds__(NTH) fwd_megakernel(Params P_arg) {
  extern __shared__ __attribute__((aligned(16))) unsigned char lds[];
  cg::grid_group grid = cg::this_grid();
  const int lo = P_arg.ph_lo, hi = P_arg.ph_hi;
  unsigned nbar = 0, nsub = 0, nscn = 0;
#pragma unroll 1
  for (int st = lo; st < hi; ++st) {
    const Params& P = P_arg;
    int kind, layer = 0;
    if (st == 0) kind = K_MOD; else if (st == N_STEPS - 1) kind = K_FINAL; else { layer = (st - 1) / STEPS_PER_LAYER; kind = K_NORM1 + (st - 1) % STEPS_PER_LAYER; }
    const bool last = (layer == 1);
    float* ldsf = (float*)lds;
    bool sync_after = true;
    switch (kind) {
      case K_MOD: for (int rep = 0; rep < REP_MISC; ++rep) phase_mod(P, ldsf); break;
      case K_NORM1: for (int rep = 0; rep < REP_MISC; ++rep) phase_convert(P, layer, ldsf); break;
      case K_PREP: for (int rep = 0; rep < REP_PREP; ++rep) phase_prep<0>(P, layer, ldsf, mk_bid(), mk_nblk()); break;
      case K_MIX: {
        const int G = mk_nblk();
        const int vcu = (G % 8 == 0) ? (mk_bid() % 8) * (G / 8) + mk_bid() / 8 : mk_bid();
        const int nscan = (G >= 2 * N_SCAN_WG) ? N_SCAN_WG : 0;
        unsigned* sbar = (unsigned*)(PWS() + WS_BAR) + 32;
        const int sg = vcu - nscan, SG = G - nscan;
        const unsigned per_layer = (unsigned)(G + 2 * SG), base = per_layer * (unsigned)layer;
        phase_prep<1>(P, layer, ldsf, vcu, G);
        if (vcu < nscan) {
          grid_arrive(sbar);
          for (int sc = vcu; sc < ((N_SCAN_WG == 32) ? 32 : 64); sc += nscan) rwkv_scan<(N_SCAN_WG == 32) ? 8 : 4>(P, sc, ldsf);
        } else {
          grid_barrier(sbar, base + (unsigned)G);
          if (nscan == 0) { for (int sc = vcu; sc < ((N_SCAN_WG == 32) ? 32 : 64); sc += G) rwkv_scan<(N_SCAN_WG == 32) ? 8 : 4>(P, sc, ldsf); __syncthreads(); }
#pragma unroll 1
          for (int q = 0; q < 2; ++q) {
            const size_t ro = (q == 0 && last) ? NCTX : 0;
            const bf16_t* A = (const bf16_t*)(PWS() + (q ? WS_KVN : WS_QN)) + ro * 512; const bf16_t* Bt = (const bf16_t*)(PWS() + (q ? WS_WKV : WS_WQ));
            EpiStore E{(bf16_t*)(PWS() + (q ? WS_KV : WS_Q)) + ro * 1536, q ? 2048 : 1536};
            run_gemm(lds, A, Bt, T - (int)ro, q ? 2048 : 1536, q ? 256 : 512, E, sg, SG);
          }
          phase_lru_agg(P, sg, SG);
          grid_barrier(sbar, base + (unsigned)(G + SG));
          phase_attention(P, layer, (char*)lds, sg, SG);
          __syncthreads();
          phase_lru_out(P, layer, ldsf, sg, SG);
          grid_barrier(sbar, base + per_layer);
          phase_attn_merge(P, sg, SG);
        }
      } break;
      case K_RWOUT: phase_rwkv_out(P, layer, mk_bid(), mk_nblk()); break;
      case K_ACT: for (int rep = 0; rep < REP_MISC; ++rep) phase_ffn_act(P, layer); break;
      case K_FINAL: phase_final_norm(P); break;
      default: break;
    }
    if (kind == K_NORM1 || kind == K_NORM2) for (int rep = 0; rep < REP_MISC; ++rep) phase_norm(P, layer, kind == K_NORM2 ? 1 : 0, kind == K_NORM2 && last);
    if (kind == K_GEMM_IN || kind == K_GEMM_GU) {
      const bf16_t* A; const bf16_t* Bt; bf16_t* O; int M = T, N, K;
      if (kind == K_GEMM_IN) { A = (const bf16_t*)(PWS() + WS_H); Bt = (const bf16_t*)(PWS() + WS_WIN); O = (bf16_t*)(PWS() + WS_COLS); N = NIN; K = DM; }
      else { const size_t ro = last ? NCTX : 0; A = (const bf16_t*)(PWS() + WS_H) + ro * DM; Bt = (const bf16_t*)(PWS() + WS_WGU); O = (bf16_t*)(PWS() + WS_GU) + ro * NGU; M = last ? T - NCTX : T; N = NGU; K = DM; }
      EpiStore E{O, N};
      run_gemm(lds, A, Bt, M, N, K, E, mk_bid(), mk_nblk());
    }
    if (kind == K_GEMM_OUT || kind == K_GEMM_DN) {
      const float* mod_l = (const float*)(PWS() + WS_MOD) + (size_t)(layer * 2 + 0) * 12288; const float* mod_c = mod_l + 12288;
      const int goff = (kind == K_GEMM_OUT) ? 4096 : 10240;
      EpiResid E{(const float*)(PWS() + WS_XC), POUT(), (float*)(PWS() + WS_XC), POUT(), mod_c + goff, mod_l + goff, NCTX};
      if (kind == K_GEMM_OUT && layer == 0) { E.src_c = PIN(I_CTX); E.src_l = PIN(I_X); }
      const int Kf = (kind == K_GEMM_OUT) ? DM : DFF;
      const bf16_t* A0 = (kind == K_GEMM_OUT) ? (const bf16_t*)(PWS() + WS_H) : (const bf16_t*)(PWS() + WS_ACT);
      const bf16_t* Bt = (kind == K_GEMM_OUT) ? (const bf16_t*)(PWS() + WS_WOUT) : (const bf16_t*)(PWS() + WS_WDN);
      run_gemm(lds, A0 + (size_t)NCTX * Kf, Bt, T - NCTX, DM, Kf, E, mk_bid(), mk_nblk());
      if (!last) {
        EpiResidAtomic EA{(float*)(PWS() + WS_XC), mod_c + goff};
        run_gemm(lds, A0, Bt, (Kf / 512) * 256, DM, 512, EA, mk_bid(), mk_nblk(), Kf, 512);
      }
    }
    if (sync_after && st + 1 < hi) {
      if (st == lo) grid.sync();
      else { ++nbar; grid_barrier((unsigned*)(PWS() + WS_BAR), nbar * mk_nblk()); }
    }
  }
}

#ifndef MK_PER_PHASE
#define MK_PER_PHASE 0
#endif
extern "C" void kernel_launch(void* const* d_in, const int* in_sizes, int n_in, void* d_out, int out_size, void* d_ws, size_t ws_size, hipStream_t stream) {
  static int grid = 0;
  if (grid == 0) {
    if (n_in != 42 || out_size != (T - NCTX) * DM || ws_size < WS_END) { fprintf(stderr, "kernel_launch: unexpected shapes (n_in %d out %d ws %zu need %zu)\n", n_in, out_size, ws_size, (size_t)WS_END); grid = -1; return; }
    int dev = 0, cus = 0, per_cu = 0;
    (void)hipGetDevice(&dev); (void)hipDeviceGetAttribute(&cus, hipDeviceAttributeMultiprocessorCount, dev);
    if (hipFuncSetAttribute((const void*)fwd_megakernel, hipFuncAttributeMaxDynamicSharedMemorySize, LDS_BYTES) != hipSuccess) { fprintf(stderr, "kernel_launch: hipFuncSetAttribute failed\n"); grid = -1; return; }
    if (hipOccupancyMaxActiveBlocksPerMultiprocessor(&per_cu, (const void*)fwd_megakernel, NTH, LDS_BYTES) != hipSuccess || per_cu < 1) per_cu = 1;
    (void)hipGetLastError();
    grid = (cus > 0 ? cus : 256) * per_cu;
  }
  if (grid < 0) return;
  if (hipMemsetAsync((char*)d_ws + WS_BAR, 0, 256, stream) != hipSuccess) { fprintf(stderr, "kernel_launch: memset failed\n"); return; }
  Params p{};
  for (int i = 0; i < 42; ++i) p.in[i] = (const float*)d_in[i];
  p.out = (float*)d_out; p.ws = (unsigned char*)d_ws;
#if MK_PER_PHASE
  for (int st = 0; st < N_STEPS; ++st) { p.ph_lo = st; p.ph_hi = st + 1; hipLaunchKernelGGL(fwd_megakernel, dim3(grid), dim3(NTH), LDS_BYTES, stream, p); }
#else
  p.ph_lo = 0; p.ph_hi = N_STEPS;
  void* args[] = {&p};
  hipError_t e = hipLaunchCooperativeKernel((const void*)fwd_megakernel, dim3(grid), dim3(NTH), args, LDS_BYTES, stream);
  if (e != hipSuccess) fprintf(stderr, "cooperative launch failed: %s (grid %d)\n", hipGetErrorString(e), grid);
#endif
}
```

```cpp
#include <hip/hip_runtime.h>
#include <hip/hip_cooperative_groups.h>
#include <cstdio>
#include <cstdint>
__device__ __forceinline__ int mk_tid() { int t = (int)threadIdx.x; asm volatile("" : "+v"(t)); return t; }
__device__ __forceinline__ int mk_bid() { int b = (int)blockIdx.x; asm volatile("" : "+s"(b)); return b; }
__device__ __forceinline__ int mk_nblk() { int g = (int)gridDim.x; asm volatile("" : "+s"(g)); return g; }
template <int OFF> __device__ __forceinline__ unsigned long long kp_load() {
  unsigned long long r; auto kp = __builtin_amdgcn_kernarg_segment_ptr();
  asm volatile("s_load_dwordx2 %0, %1, %2\n\ts_waitcnt lgkmcnt(0)" : "=s"(r) : "s"(kp), "i"(OFF));
  return r;
}
#define PIN(i) ((const float*)kp_load<8 * (i)>())
#define POUT() ((float*)kp_load<8 * 42>())
#define PWS() ((unsigned char*)kp_load<8 * 43>())
namespace pg8 {
#define PG8_LAS __attribute__((address_space(3)))
typedef unsigned short bf16_t;
typedef short bf16x8 __attribute__((ext_vector_type(8)));
typedef float f32x4 __attribute__((ext_vector_type(4)));
typedef unsigned u32x4 __attribute__((ext_vector_type(4)));
constexpr int BM = 256, BK = 64, HALF = 128, HTB = HALF * BK * 2  , STAGE_BYTES = 8 * HTB, NXCD = 8, WGM = 8;

__host__ __device__ __forceinline__ int lds_byte(int r, int c) { const int st = (r >> 4) * 2 + (c >> 5), rr = r & 15, cc = c & 31, ob = rr * 64 + cc * 2; return st * 1024 + (ob ^ (((ob >> 9) & 1) << 5)); }
__host__ __device__ __forceinline__ void stage_rc(int b, int& R, int& C) { const int st = b / 1024, sb = b % 1024, swz = sb ^ (((sb >> 9) & 1) << 5); R = (st >> 1) * 16 + swz / 64; C = (st & 1) * 32 + (swz % 64) / 2; }
__host__ __device__ __forceinline__ int perm32(int rho) { const int n = rho >> 4, i = rho & 15; return 8 * (i >> 2) + 4 * n + (i & 3); }

struct Unit { int pm, pn; };
struct Gemm { const bf16_t* A; const bf16_t* Bt; int M, N, K; int ld; int ksplit; };

struct StaticOrder {
    int nM, nN, nwg, G, c;
    __host__ __device__ void init(int M, int N, int G_, int c_) { nM = M / BM; nN = N / BM; nwg = nM * nN; G = G_; c = c_; }
    __host__ __device__ bool next(int i, Unit& u) const {
        const long L = (long)i * G + c; if (L >= nwg) return false;
        int wgid = (int)L; { const int q = nwg / NXCD, r = nwg % NXCD, xcd = wgid % NXCD, off = wgid / NXCD; wgid = (xcd < r ? xcd * (q + 1) : r * (q + 1) + (xcd - r) * q) + off; }
        const int nig = WGM * nN, gid = wgid / nig, fm = gid * WGM, gsz = (nM - fm) < WGM ? (nM - fm) : WGM;
        u.pm = fm + ((wgid % nig) % gsz); u.pn = (wgid % nig) / gsz; return true;
    }
    __device__ __forceinline__ void a_ready(const Unit&) const {}
    __device__ __forceinline__ void done(const Unit&) const {}
};
__device__ __forceinline__ unsigned cvt_pk_bf16(float lo, float hi) { unsigned r; asm volatile("v_cvt_pk_bf16_f32 %0, %1, %2" : "=v"(r) : "v"(lo), "v"(hi)); return r; }
typedef float f32x2 __attribute__((ext_vector_type(2)));
template <class Epi, class Sched, bool STAMP = false>
__device__ __forceinline__ void gemm_phase(PG8_LAS unsigned char* lds, const Gemm g, const Sched& S, const Epi& E, unsigned long long* stamps) {
    const int tid = mk_tid(), wid = __builtin_amdgcn_readfirstlane(tid >> 6), lane = tid & 63, wr = wid >> 2, wc = wid & 3, fr = lane & 15, fq = lane >> 4;
    const int K = g.K, nt = K / BK, LD = g.ld; const size_t ksb = (size_t)g.ksplit * 2;
    int ts_lo = 0, ts_hi = 0, nts = 0; const unsigned long long rt_entry = STAMP ? (unsigned long long)wall_clock64() : 0ull;
#define PG8_STAMP() do { if (STAMP && wid == 0 && nts < 64) { const unsigned long long _c = (unsigned long long)clock64(); \
        ts_lo = (lane == nts) ? (int)(unsigned)_c : ts_lo; ts_hi = (lane == nts) ? (int)(unsigned)(_c >> 32) : ts_hi; ++nts; } } while (0)
    PG8_STAMP();
    unsigned voffA[2], voffB[2];
#pragma unroll
    for (int i = 0; i < 2; ++i) { int R, C; stage_rc(tid * 16 + i * 8192, R, C); const int Rb = Epi::PERM ? ((R & ~31) + perm32(R & 31)) : R;
        voffA[i] = (unsigned)(R * LD + C) * 2u; voffB[i] = (unsigned)(Rb * LD + C) * 2u; }
    const size_t kstep = (size_t)(BK * 2);
    const size_t hstep = (size_t)HALF * LD * 2;
    const size_t tstep = 2 * hstep;
    const unsigned ldsw = (unsigned)wid * 1024u;
    const int aoff = lds_byte(wr * 64 + fr, fq * 8), boff = lds_byte(wc * 32 + fr, fq * 8);
#define PG8_SA(b, h) (((b) * 2 + (h)) * HTB)
#define PG8_SB(b, h) ((4 + (b) * 2 + (h)) * HTB)
#define PG8_STAGE(bufoff, gbase, voff) do { _Pragma("unroll") for (int _i = 0; _i < 2; ++_i) \
        __builtin_amdgcn_global_load_lds((const unsigned*)((const char*)(gbase) + (voff)[_i]), (PG8_LAS unsigned*)(lds + (bufoff) + ldsw + _i * 8192), 16, 0, 0); } while (0)
#define PG8_LDA(dst, b, h) do { _Pragma("unroll") for (int m = 0; m < 4; ++m) _Pragma("unroll") for (int k = 0; k < 2; ++k) dst[m][k] = *(const PG8_LAS bf16x8*)(lds + PG8_SA(b, h) + aoff + m * 2048 + k * 1024); } while (0)
#define PG8_LDB(dst, b, h) do { _Pragma("unroll") for (int n = 0; n < 2; ++n) _Pragma("unroll") for (int k = 0; k < 2; ++k) dst[n][k] = *(const PG8_LAS bf16x8*)(lds + PG8_SB(b, h) + boff + n * 2048 + k * 1024); } while (0)
#define PG8_MMA(ai, bj, At, Bt) do { __builtin_amdgcn_s_setprio(1); _Pragma("unroll") for (int m = 0; m < 4; ++m) _Pragma("unroll") for (int n = 0; n < 2; ++n) _Pragma("unroll") for (int k = 0; k < 2; ++k) \
        acc[ai][bj][m][n] = __builtin_amdgcn_mfma_f32_16x16x32_bf16(Bt[n][k], At[m][k], acc[ai][bj][m][n], 0, 0, 0); __builtin_amdgcn_s_setprio(0); } while (0)
#define PG8_WAIT_V(n) asm volatile("s_waitcnt vmcnt(" #n ")" ::: "memory")
#define PG8_WAIT_L(n) asm volatile("s_waitcnt lgkmcnt(" #n ")" ::: "memory")
#define PG8_BAR __builtin_amdgcn_s_barrier()
#define PG8_SCHED __builtin_amdgcn_sched_barrier(0)
    Unit cur, nxt; int ui = 0;
    if (!S.next(0, cur)) return;
    f32x4 acc[2][2][4][2];
#pragma unroll
    for (int a = 0; a < 2; ++a)
#pragma unroll
        for (int b = 0; b < 2; ++b)
#pragma unroll
            for (int m = 0; m < 4; ++m)
#pragma unroll
                for (int n = 0; n < 2; ++n) acc[a][b][m][n] = (f32x4){0.f, 0.f, 0.f, 0.f};
    bf16x8 At[4][2], B0[2][2], B1[2][2];
    const char* cA = (const char*)g.A + (ksb ? (size_t)cur.pm * ksb : (size_t)cur.pm * tstep); const char* cB = (const char*)g.Bt + (size_t)cur.pn * tstep + (size_t)cur.pm * ksb;
    S.a_ready(cur);
    PG8_STAGE(PG8_SB(0, 0), cB, voffB); PG8_STAGE(PG8_SA(0, 0), cA, voffA); PG8_STAGE(PG8_SB(0, 1), cB + hstep, voffB); PG8_STAGE(PG8_SA(0, 1), cA + hstep, voffA);
    if (wr == 1) PG8_BAR;
    PG8_WAIT_V(4); PG8_BAR;
    PG8_STAGE(PG8_SB(1, 0), cB + kstep, voffB); PG8_STAGE(PG8_SA(1, 0), cA + kstep, voffA); PG8_STAGE(PG8_SB(1, 1), cB + hstep + kstep, voffB);
    PG8_WAIT_V(6); PG8_BAR;
    PG8_STAMP();
    for (;;) {
        const bool has_next = S.next(ui + 1, nxt);
        const char* nA = has_next ? (const char*)g.A + (ksb ? (size_t)nxt.pm * ksb : (size_t)nxt.pm * tstep) : cA; const char* nB = has_next ? (const char*)g.Bt + (size_t)nxt.pn * tstep + (size_t)nxt.pm * ksb : cB;
        for (int t = 0; t < nt; t += 2) {
            const bool last = (t == nt - 2);
            const char* a1 = cA + (size_t)(t + 1) * kstep;
            const char* a2 = last ? nA : cA + (size_t)(t + 2) * kstep; const char* b2 = last ? nB : cB + (size_t)(t + 2) * kstep;
            const char* a3 = a2 + kstep; const char* b3 = b2 + kstep;
            if (last && has_next) S.a_ready(nxt);
            PG8_LDB(B0, 0, 0); PG8_SCHED; PG8_LDA(At, 0, 0); PG8_STAGE(PG8_SA(1, 1), a1 + hstep, voffA);
            PG8_WAIT_L(8); PG8_BAR; PG8_WAIT_L(0); PG8_MMA(0, 0, At, B0); PG8_BAR; PG8_SCHED;
            PG8_LDB(B1, 0, 1); PG8_STAGE(PG8_SB(0, 0), b2, voffB);
            PG8_BAR; PG8_WAIT_L(0); PG8_MMA(0, 1, At, B1); PG8_BAR;
            PG8_LDA(At, 0, 1); PG8_STAGE(PG8_SA(0, 0), a2, voffA);
            PG8_BAR; PG8_WAIT_L(0); PG8_MMA(1, 0, At, B0); PG8_BAR; PG8_SCHED;
            PG8_STAGE(PG8_SB(0, 1), b2 + hstep, voffB);
            PG8_WAIT_V(6); PG8_BAR; PG8_MMA(1, 1, At, B1); PG8_BAR;
            PG8_LDB(B0, 1, 0); PG8_SCHED; PG8_LDA(At, 1, 0); PG8_STAGE(PG8_SA(0, 1), a2 + hstep, voffA);
            PG8_WAIT_L(8); PG8_BAR; PG8_WAIT_L(0); PG8_MMA(0, 0, At, B0); PG8_BAR; PG8_SCHED;
            PG8_LDB(B1, 1, 1); PG8_STAGE(PG8_SB(1, 0), b3, voffB);
            PG8_BAR; PG8_WAIT_L(0); PG8_MMA(0, 1, At, B1); PG8_BAR;
            PG8_LDA(At, 1, 1); PG8_STAGE(PG8_SA(1, 0), a3, voffA);
            PG8_BAR; PG8_WAIT_L(0); PG8_MMA(1, 0, At, B0); PG8_BAR; PG8_SCHED;
            PG8_STAGE(PG8_SB(1, 1), b3 + hstep, voffB);
            PG8_WAIT_V(6); PG8_BAR; PG8_MMA(1, 1, At, B1); PG8_BAR;
        }
        PG8_STAMP();
        if constexpr (!Epi::AFTER_DRAIN) { E(acc, cur, wr, wc, fr, fq); S.done(cur); }
        PG8_STAMP();
        if (!has_next) break;
#pragma unroll
        for (int a = 0; a < 2; ++a)
#pragma unroll
            for (int b = 0; b < 2; ++b)
#pragma unroll
                for (int m = 0; m < 4; ++m)
#pragma unroll
                    for (int n = 0; n < 2; ++n) acc[a][b][m][n] = (f32x4){0.f, 0.f, 0.f, 0.f};
        cur = nxt; cA = nA; cB = nB; ++ui;
    }
    PG8_WAIT_V(0);
    if (wr == 0) PG8_BAR;
    PG8_BAR;
    if constexpr (Epi::AFTER_DRAIN) { E.fused(acc, cur, wr, wc, fr, fq, lds, wid, lane); S.done(cur); }
    PG8_STAMP();
    if (STAMP && wid == 0) { stamps[lane] = lane < nts ? (((unsigned long long)(unsigned)ts_hi << 32) | (unsigned)ts_lo) : 0ull;
        if (lane == 62) stamps[62] = rt_entry; if (lane == 63) stamps[63] = (unsigned long long)wall_clock64(); }
#undef PG8_STAMP
#undef PG8_SA
#undef PG8_SB
#undef PG8_STAGE
#undef PG8_LDA
#undef PG8_LDB
#undef PG8_MMA
#undef PG8_WAIT_V
#undef PG8_WAIT_L
#undef PG8_BAR
#undef PG8_SCHED
}
}

namespace cg = cooperative_groups;
typedef unsigned short bf16_t;
typedef short bf16x8 __attribute__((ext_vector_type(8)));
typedef short s16x4 __attribute__((ext_vector_type(4)));
typedef float f32x4 __attribute__((ext_vector_type(4)));
typedef float f32x8 __attribute__((ext_vector_type(8)));
typedef float f32x16 __attribute__((ext_vector_type(16)));
typedef unsigned u32x4 __attribute__((ext_vector_type(4)));
typedef unsigned u32x2 __attribute__((ext_vector_type(2)));

constexpr int T = 16640, NCTX = 256, DM = 2048, NTH = 512;
constexpr int NIN = 3840;
constexpr int DFF = 5632, NGU = 2 * DFF;
constexpr int C_LRU = 1760, C_MLA = 2784, C_VD = 3616;
constexpr int RECB = 896;
constexpr int LDS_BYTES = 150528;

constexpr size_t al256(size_t x) { return (x + 255) / 256 * 256; }
constexpr size_t WS_BAR = 0;
constexpr size_t WS_MOD = 256;
constexpr size_t WS_XC = al256(WS_MOD + 2 * 2 * 12288 * 4);
constexpr size_t WS_H = al256(WS_XC + (size_t)NCTX * DM * 4);
constexpr size_t WS_VF = al256(WS_H + (size_t)T * DM * 2);
constexpr size_t WS_WIN = al256(WS_VF + (size_t)T * 512 * 2);
constexpr size_t WS_WOUT = al256(WS_WIN + (size_t)NIN * DM * 2);
constexpr size_t WS_WQ = al256(WS_WOUT + (size_t)DM * DM * 2);
constexpr size_t WS_WKV = al256(WS_WQ + (size_t)1536 * 512 * 2);
constexpr size_t WS_WGU = al256(WS_WKV + (size_t)2048 * 256 * 2);
constexpr size_t WS_WDN = al256(WS_WGU + (size_t)NGU * DM * 2);
constexpr size_t WS_R = al256(WS_WDN + (size_t)DM * DFF * 2);
constexpr size_t WS_COLS = WS_R;
constexpr size_t WS_Q = WS_COLS;
constexpr size_t WS_KV = al256(WS_Q + (size_t)T * 1536 * 2);
constexpr size_t WS_REC = al256(WS_COLS + (size_t)T * NIN * 2);
constexpr size_t WS_Y = al256(WS_REC + (size_t)16 * T * RECB);
constexpr size_t WS_LAB = al256(WS_Y + (size_t)2 * T * 512 * 4);
constexpr size_t WS_GG = al256(WS_LAB + (size_t)T * 2048 * 2);
constexpr size_t WS_QN = al256(WS_GG + (size_t)T * 512 * 2);
constexpr size_t WS_KVN = al256(WS_QN + (size_t)T * 512 * 2);
constexpr size_t WS_KR = al256(WS_KVN + (size_t)T * 256 * 2);
constexpr size_t WS_RG = al256(WS_KR + (size_t)T * 64 * 2);
constexpr size_t WS_CV = al256(WS_RG + (size_t)T * 512 * 2);
constexpr size_t WS_AGG = al256(WS_CV + (size_t)T * 512 * 2);
constexpr size_t WS_MIX_END = al256(WS_AGG + (size_t)260 * 2048 * 4);
constexpr size_t WS_GU = WS_R;
constexpr size_t WS_ACT = al256(WS_GU + (size_t)T * NGU * 2);
constexpr size_t WS_FFN_END = al256(WS_ACT + (size_t)T * DFF * 2);
constexpr size_t WS_REND = WS_MIX_END > WS_FFN_END ? WS_MIX_END : WS_FFN_END;
constexpr size_t WS_PARTO = WS_REND;
constexpr size_t WS_PARTML = al256(WS_PARTO + (size_t)448 * 256 * 128 * 2);
constexpr size_t WS_END = al256(WS_PARTML + (size_t)448 * 512 * 4);
static_assert(WS_KV + (size_t)T * 2048 * 2 <= WS_REC, "Q|KV must fit in the cols buffer");

struct Params { const float* in[42]; float* out; unsigned char* ws; int ph_lo, ph_hi; };

enum { I_X = 0, I_C, I_CTX, I_CCTX, I_ADAW, I_ADAB, I_NORM1, I_NORM2, I_WIN, I_WOUT, I_RWCONV, I_RWCONVB, I_RWW0, I_RWWUP, I_RWA0, I_RWAUP, I_RWGUP,
       I_RWKK, I_RWKA, I_RWRK, I_RWLNG, I_RWLNB, I_RWV0, I_RWVDOWN, I_RWVUP, I_LRUCONV, I_LRUCONVB, I_LRUWA, I_LRUBA, I_LRUWX, I_LRUBX, I_LRULAM,
       I_QNORM, I_WQB, I_KVNORM, I_WKVB, I_WGATE, I_WUP, I_FCONV, I_FCONVB, I_WDOWN, I_FNORM };

__device__ __forceinline__ float bf2f(bf16_t b) { return __uint_as_float(((unsigned)b) << 16); }
__device__ __forceinline__ unsigned cvtpk(float lo, float hi) { unsigned r; asm volatile("v_cvt_pk_bf16_f32 %0, %1, %2" : "=v"(r) : "v"(lo), "v"(hi)); return r; }
__device__ __forceinline__ bf16_t f2bf(float f) { return (bf16_t)(cvtpk(f, 0.f) & 0xffffu); }
__device__ __forceinline__ float sigmoidf_(float x) { return __builtin_amdgcn_rcpf(1.0f + __expf(-x)); }
__device__ __forceinline__ float tanhf_(float x) { return 1.0f - 2.0f * __builtin_amdgcn_rcpf(1.0f + __expf(2.0f * x)); }
__device__ __forceinline__ float siluf_(float x) { return x * sigmoidf_(x); }
__device__ __forceinline__ float gelu_tanh(float x) { const float u = 0.7978845608028654f * (x + 0.044715f * x * x * x); return 0.5f * x * (1.0f + tanhf_(u)); }
__device__ __forceinline__ float wave_sum(float v) {
#pragma unroll
  for (int o = 32; o >= 1; o >>= 1) v += __shfl_xor(v, o);
  return v;
}
template <int CTRL> __device__ __forceinline__ float dpp_add(float x) {
  const int xi = __float_as_int(x);
  const int yi = __builtin_amdgcn_update_dpp(xi, xi, CTRL, 0xF, 0xF, false);
  return x + __int_as_float(yi);
}
__device__ __forceinline__ float fma_(float a, float b, float c) { float r; asm("v_fma_f32 %0, %1, %2, %3" : "=v"(r) : "v"(a), "v"(b), "v"(c)); return r; }
__device__ __forceinline__ float mul_(float a, float b) { float r; asm("v_mul_f32 %0, %1, %2" : "=v"(r) : "v"(a), "v"(b)); return r; }
__device__ __forceinline__ float add_(float a, float b) { float r; asm("v_add_f32 %0, %1, %2" : "=v"(r) : "v"(a), "v"(b)); return r; }
typedef float f32x2 __attribute__((ext_vector_type(2)));
__device__ __forceinline__ float dot4(f32x4 a, f32x4 b) { const f32x2 t = a.lo * b.lo + a.hi * b.hi; return t.x + t.y; }
__device__ __forceinline__ float row16_sum(float x) {
  x = dpp_add<0xB1>(x);
  x = dpp_add<0x4E>(x);
  x = dpp_add<0x141>(x);
  x = dpp_add<0x140>(x);
  return x;
}
__device__ __forceinline__ const float* resid_src(const Params& P, int layer, int t) {
  if (layer == 0) return t < NCTX ? PIN(I_CTX) + (size_t)t * DM : PIN(I_X) + (size_t)(t - NCTX) * DM;
  return t < NCTX ? (const float*)(PWS() + WS_XC) + (size_t)t * DM : POUT() + (size_t)(t - NCTX) * DM;
}
__device__ __forceinline__ float* resid_dst(const Params& P, int t) {
  return t < NCTX ? (float*)(PWS() + WS_XC) + (size_t)t * DM : POUT() + (size_t)(t - NCTX) * DM;
}
__device__ __forceinline__ int scan_pos_rev(int t) { return t < NCTX ? (NCTX - 1 - t) : (T + NCTX - 1 - t); }

__device__ __forceinline__ void phase_mod(const Params& P, float* lds) {
  const int tid = mk_tid(), cgp = tid & 15, rg = tid >> 4;
  float* mod = (float*)(PWS() + WS_MOD);
  const float* cvec = PIN(I_C); const float* ccvec = PIN(I_CCTX); const float* adaw = PIN(I_ADAW); const float* adab = PIN(I_ADAB);
  for (int item = mk_bid(); item < 2 * 192; item += mk_nblk()) {
    const int layer = item / 192, col0 = (item % 192) * 64;
    const float* W = adaw + (size_t)layer * DM * 12288 + col0 + cgp * 4;
    f32x4 al = {0.f, 0.f, 0.f, 0.f}, ac = {0.f, 0.f, 0.f, 0.f};
#pragma unroll 1
    for (int r0 = 0; r0 < 64; r0 += 8) {
      f32x4 wv[8]; float sl[8], sc[8];
#pragma unroll
      for (int r = 0; r < 8; ++r) { const int row = rg * 64 + r0 + r; wv[r] = __builtin_nontemporal_load((const f32x4*)(W + (size_t)row * 12288)); sl[r] = cvec[row]; sc[r] = ccvec[row]; }
#pragma unroll
      for (int r = 0; r < 8; ++r) { al += siluf_(sl[r]) * wv[r]; ac += siluf_(sc[r]) * wv[r]; }
    }
#pragma unroll
    for (int i = 0; i < 4; ++i) { lds[(rg * 2 + 0) * 64 + cgp * 4 + i] = al[i]; lds[(rg * 2 + 1) * 64 + cgp * 4 + i] = ac[i]; }
    __syncthreads();
    if (tid < 128) {
      const int which = tid >> 6, col = tid & 63; float sacc = 0.f;
      for (int g = 0; g < 32; ++g) sacc += lds[(g * 2 + which) * 64 + col];
      mod[(size_t)(layer * 2 + which) * 12288 + col0 + col] = sacc + adab[(size_t)layer * 12288 + col0 + col];
    }
    __syncthreads();
  }
}

struct CvtItem { const float* src; bf16_t* dst; int K, N, kt, ntile; bool valid; };
__device__ __forceinline__ CvtItem cvt_decode(const Params& P, int layer, int it) {
  CvtItem r; r.src = nullptr; r.dst = nullptr; r.K = 64; r.N = 0; r.kt = 0; r.ntile = 0; r.valid = false;
  int base = 0;
#define CVT_JOB(SRC, DST, KK, NN) do { const int nkt_ = (KK) / 64, cnt_ = nkt_ * (((NN) + 63) / 64); \
    if (!r.valid && it < base + cnt_) { const int tl_ = it - base; r.src = (SRC); r.dst = (DST); r.K = (KK); r.N = (NN); r.kt = tl_ % nkt_; r.ntile = tl_ / nkt_; r.valid = true; } base += cnt_; } while (0)
  CVT_JOB(PIN(I_WIN) + (size_t)layer * DM * 3616, (bf16_t*)(PWS() + WS_WIN), DM, 3616);
  CVT_JOB(PIN(I_RWVDOWN), (bf16_t*)(PWS() + WS_WIN) + (size_t)C_VD * DM, DM, (layer == 0) ? 0 : 32);
  CVT_JOB(PIN(I_WOUT) + (size_t)layer * DM * DM, (bf16_t*)(PWS() + WS_WOUT), DM, DM);
  CVT_JOB(PIN(I_WQB) + (size_t)layer * 512 * 1536, (bf16_t*)(PWS() + WS_WQ), 512, 1536);
  CVT_JOB(PIN(I_WKVB) + (size_t)layer * 256 * 2048, (bf16_t*)(PWS() + WS_WKV), 256, 2048);
  CVT_JOB(PIN(I_WGATE) + (size_t)layer * DM * DFF, (bf16_t*)(PWS() + WS_WGU), DM, DFF);
  CVT_JOB(PIN(I_WUP) + (size_t)layer * DM * DFF, (bf16_t*)(PWS() + WS_WGU) + (size_t)DFF * DM, DM, DFF);
  CVT_JOB(PIN(I_WDOWN) + (size_t)layer * DFF * DM, (bf16_t*)(PWS() + WS_WDN), DFF, DM);
#undef CVT_JOB
  return r;
}
__device__ __forceinline__ void cvt_load(const CvtItem& c, f32x4 (&v)[2]) {
  const int tid = mk_tid(), kr = tid >> 4, nc = (tid & 15) * 4, k0 = c.kt * 64, n0 = c.ntile * 64;
#pragma unroll
  for (int i = 0; i < 2; ++i) { v[i] = (f32x4){0.f, 0.f, 0.f, 0.f}; if (c.valid && n0 + nc < c.N) v[i] = __builtin_nontemporal_load((const f32x4*)(c.src + (size_t)(k0 + kr + 32 * i) * c.N + n0 + nc)); }
}
__device__ __forceinline__ void phase_convert(const Params& P, int layer, float* lds) {
  const int tid = mk_tid(), kr = tid >> 4, nc = (tid & 15) * 4, n = tid >> 3, kc = (tid & 7) * 8, G = mk_nblk();
  int it = mk_bid();
  CvtItem cur = cvt_decode(P, layer, it); f32x4 v[2]; cvt_load(cur, v);
  while (cur.valid) {
    const CvtItem nxt = cvt_decode(P, layer, it + G); f32x4 nv[2]; cvt_load(nxt, nv);
#pragma unroll
    for (int i = 0; i < 2; ++i) { const int k = kr + 32 * i;
      lds[(nc + 0) * 65 + k] = v[i][0]; lds[(nc + 1) * 65 + k] = v[i][1]; lds[(nc + 2) * 65 + k] = v[i][2]; lds[(nc + 3) * 65 + k] = v[i][3]; }
    __syncthreads();
    if (cur.ntile * 64 + n < cur.N) {
      const float* p = lds + n * 65 + kc;
      u32x4 w; w.x = cvtpk(p[0], p[1]); w.y = cvtpk(p[2], p[3]); w.z = cvtpk(p[4], p[5]); w.w = cvtpk(p[6], p[7]);
      *(u32x4*)(cur.dst + (size_t)(cur.ntile * 64 + n) * cur.K + cur.kt * 64 + kc) = w;
    }
    __syncthreads();
    cur = nxt; v[0] = nv[0]; v[1] = nv[1]; it += G;
  }
}

__device__ __forceinline__ void phase_norm(const Params& P, int layer, int which, bool skip_ctx) {
  const int lane = mk_tid() & 63, wave = mk_tid() >> 6;
  const float* g = P.in[which ? I_NORM2 : I_NORM1] + (size_t)layer * DM;
  const float* mod = (const float*)(PWS() + WS_MOD) + (size_t)layer * 2 * 12288;
  bf16_t* H = (bf16_t*)(PWS() + WS_H);
  const int soff = which ? 6144 : 0;
  const float* src_c = (which == 0 && layer == 0) ? PIN(I_CTX) : (const float*)(PWS() + WS_XC);
  const float* src_l = (which == 0 && layer == 0) ? PIN(I_X) : (const float*)POUT();
  const int stride = mk_nblk() * 8;
  for (int row = mk_bid() * 8 + wave; row < T; row += 2 * stride) {
    int rows[2] = {row, row + stride}; f32x4 v[2][8]; bool ok[2];
#pragma unroll
    for (int u = 0; u < 2; ++u) { ok[u] = rows[u] < T && !(skip_ctx && rows[u] < NCTX);
      if (ok[u]) { const float* xr = rows[u] < NCTX ? src_c + (size_t)rows[u] * DM : src_l + (size_t)(rows[u] - NCTX) * DM;
#pragma unroll
        for (int i = 0; i < 8; ++i) v[u][i] = *(const f32x4*)(xr + i * 256 + lane * 4);
        if (which == 0 && layer == 0 && rows[u] < NCTX) { float* xc = (float*)(PWS() + WS_XC) + (size_t)rows[u] * DM;
#pragma unroll
          for (int i = 0; i < 8; ++i) *(f32x4*)(xc + i * 256 + lane * 4) = v[u][i]; } } }
#pragma unroll
    for (int u = 0; u < 2; ++u) if (ok[u]) {
      const float* m = mod + (rows[u] < NCTX ? 12288 : 0) + soff; float ss = 0.f;
#pragma unroll
      for (int i = 0; i < 8; ++i) ss += v[u][i][0] * v[u][i][0] + v[u][i][1] * v[u][i][1] + v[u][i][2] * v[u][i][2] + v[u][i][3] * v[u][i][3];
      ss = wave_sum(ss);
      const float rstd = rsqrtf(ss * (1.0f / DM) + 1e-6f);
#pragma unroll
      for (int i = 0; i < 8; ++i) {
        const int c = i * 256 + lane * 4;
        const f32x4 gv = *(const f32x4*)(g + c), sh = *(const f32x4*)(m + c), sc = *(const f32x4*)(m + 2048 + c);
        float o[4];
#pragma unroll
        for (int q = 0; q < 4; ++q) o[q] = (v[u][i][q] * rstd * gv[q]) * (1.0f + sc[q]) + sh[q];
        u32x2 w; w.x = cvtpk(o[0], o[1]); w.y = cvtpk(o[2], o[3]);
        *(u32x2*)(H + (size_t)rows[u] * DM + c) = w;
      }
    }
  }
}

__device__ __forceinline__ void phase_final_norm(const Params& P) {
  const int lane = mk_tid() & 63, wave = mk_tid() >> 6;
  const float* g = PIN(I_FNORM); float* out = POUT();
  const int stride = mk_nblk() * 8;
  for (int row = mk_bid() * 8 + wave; row < T - NCTX; row += 2 * stride) {
    int rows[2] = {row, row + stride}; f32x4 v[2][8]; bool ok[2];
#pragma unroll
    for (int u = 0; u < 2; ++u) { ok[u] = rows[u] < T - NCTX;
      if (ok[u]) {
#pragma unroll
        for (int i = 0; i < 8; ++i) v[u][i] = *(const f32x4*)(out + (size_t)rows[u] * DM + i * 256 + lane * 4); } }
#pragma unroll
    for (int u = 0; u < 2; ++u) if (ok[u]) {
      float ss = 0.f;
#pragma unroll
      for (int i = 0; i < 8; ++i) ss += v[u][i][0] * v[u][i][0] + v[u][i][1] * v[u][i][1] + v[u][i][2] * v[u][i][2] + v[u][i][3] * v[u][i][3];
      ss = wave_sum(ss);
      const float rstd = rsqrtf(ss * (1.0f / DM) + 1e-6f);
#pragma unroll
      for (int i = 0; i < 8; ++i) { const int c = i * 256 + lane * 4; const f32x4 gv = *(const f32x4*)(g + c); *(f32x4*)(out + (size_t)rows[u] * DM + c) = v[u][i] * rstd * gv; }
    }
  }
}

struct EpiStore {
  static constexpr bool PERM = true, AFTER_DRAIN = false;
  bf16_t* O; int ldc; int nt;
  __device__ __forceinline__ void operator()(const f32x4 (&acc)[2][2][4][2], const pg8::Unit& u, int wr, int wc, int fr, int fq) const {
    const int row0 = u.pm * 256 + wr * 64 + fr, col0 = u.pn * 256 + wc * 32 + 8 * fq;
#pragma unroll
    for (int ai = 0; ai < 2; ++ai)
#pragma unroll
      for (int m = 0; m < 4; ++m) { bf16_t* rowp = O + (size_t)(row0 + ai * 128 + m * 16) * ldc + col0;
#pragma unroll
        for (int bj = 0; bj < 2; ++bj) { const f32x4 v0 = acc[ai][bj][m][0], v1 = acc[ai][bj][m][1];
          u32x4 w; w.x = cvtpk(v0[0], v0[1]); w.y = cvtpk(v0[2], v0[3]); w.z = cvtpk(v1[0], v1[1]); w.w = cvtpk(v1[2], v1[3]);
          if (nt) __builtin_nontemporal_store(w, (u32x4*)(rowp + bj * 128)); else *(u32x4*)(rowp + bj * 128) = w; } }
  }
};
struct EpiResid {
  static constexpr bool PERM = false, AFTER_DRAIN = false;
  const float* src_c; const float* src_l; float* dst_c; float* dst_l; const float* gate_c; const float* gate_l; int row_off;
  __device__ __forceinline__ void operator()(const f32x4 (&acc)[2][2][4][2], const pg8::Unit& u, int wr, int wc, int fr, int fq) const {
    const int t0 = row_off + u.pm * 256;
    const bool isc = t0 < NCTX;
    const float* src = isc ? src_c : src_l - (size_t)NCTX * DM; float* dst = isc ? dst_c : dst_l - (size_t)NCTX * DM; const float* gate = isc ? gate_c : gate_l;
    const int row0 = t0 + wr * 64 + fr, col0 = u.pn * 256 + wc * 32 + 4 * fq;
    f32x4 gv[2][2];
#pragma unroll
    for (int bj = 0; bj < 2; ++bj)
#pragma unroll
      for (int n = 0; n < 2; ++n) gv[bj][n] = *(const f32x4*)(gate + col0 + bj * 128 + n * 16);
#pragma unroll
    for (int ai = 0; ai < 2; ++ai)
#pragma unroll
      for (int m = 0; m < 4; ++m) { const size_t off = (size_t)(row0 + ai * 128 + m * 16) * DM + col0;
#pragma unroll
        for (int bj = 0; bj < 2; ++bj)
#pragma unroll
          for (int n = 0; n < 2; ++n) { const f32x4 xs = *(const f32x4*)(src + off + bj * 128 + n * 16);
            *(f32x4*)(dst + off + bj * 128 + n * 16) = xs + gv[bj][n] * acc[ai][bj][m][n]; } }
  }
};

struct EpiResidAtomic {
  static constexpr bool PERM = false, AFTER_DRAIN = false;
  float* dst; const float* gate;
  __device__ __forceinline__ void operator()(const f32x4 (&acc)[2][2][4][2], const pg8::Unit& u, int wr, int wc, int fr, int fq) const {
    const int row0 = wr * 64 + fr, col0 = u.pn * 256 + wc * 32 + 4 * fq;
    f32x4 gv[2][2];
#pragma unroll
    for (int bj = 0; bj < 2; ++bj)
#pragma unroll
      for (int n = 0; n < 2; ++n) gv[bj][n] = *(const f32x4*)(gate + col0 + bj * 128 + n * 16);
#pragma unroll
    for (int ai = 0; ai < 2; ++ai)
#pragma unroll
      for (int m = 0; m < 4; ++m) { float* rp = dst + (size_t)(row0 + ai * 128 + m * 16) * DM + col0;
#pragma unroll
        for (int bj = 0; bj < 2; ++bj)
#pragma unroll
          for (int n = 0; n < 2; ++n) { const f32x4 v = gv[bj][n] * acc[ai][bj][m][n];
#pragma unroll
            for (int q = 0; q < 4; ++q) __hip_atomic_fetch_add(rp + bj * 128 + n * 16 + q, v[q], __ATOMIC_RELAXED, __HIP_MEMORY_SCOPE_AGENT); } }
  }
};
template <class Epi>
__device__ __forceinline__ void run_gemm(unsigned char* lds, const bf16_t* A, const bf16_t* Bt, int M, int N, int K, const Epi& E, int wg, int nwg, int ld = 0, int ksplit = 0) {
  pg8::Gemm g{A, Bt, M, N, K, ld ? ld : K, ksplit}; pg8::StaticOrder S; S.init(M, N, nwg, wg);
  pg8::gemm_phase<Epi, pg8::StaticOrder, false>((PG8_LAS unsigned char*)lds, g, S, E, nullptr);
}

__device__ __forceinline__ float colv(const bf16_t* cols, int t, int c) { return bf2f(cols[(size_t)t * NIN + c]); }
__device__ __forceinline__ float rwconv3(const bf16_t* cols, const float* cw, const float* cb, int t, int c, int lo, int hi) {
  float u = cb[c] + cw[1760 + c] * colv(cols, t, c);
  if (t - 1 >= lo) u += cw[c] * colv(cols, t - 1, c);
  if (t + 1 < hi) u += cw[2 * 1760 + c] * colv(cols, t + 1, c);
  return u;
}

__device__ __forceinline__ float rwconv3w(const bf16_t* cols, float w0, float w1, float w2, float b, int t, int c, int lo, int hi) {
  float u = b + w1 * colv(cols, t, c);
  if (t - 1 >= lo) u += w0 * colv(cols, t - 1, c);
  if (t + 1 < hi) u += w2 * colv(cols, t + 1, c);
  return u;
}
template <int PART>
__device__ __forceinline__ void phase_prep(const Params& P, int layer, float* lds, int wg, int nwg) {
  constexpr int NTK = 13;
  const int tid = mk_tid(), lane = tid & 63, wave = tid >> 6;
  float* lin = lds;
  float* xs = lds + 16 * 256;
  const bf16_t* cols = (const bf16_t*)(PWS() + WS_COLS);
  const float* cw = PIN(I_RWCONV) + (size_t)layer * 3 * 1760; const float* cb = PIN(I_RWCONVB) + (size_t)layer * 1760;
  const float* lcw = PIN(I_LRUCONV) + (size_t)layer * 4 * 512; const float* lcb = PIN(I_LRUCONVB) + (size_t)layer * 512;
  const int c = tid, hd = c >> 6, n = c & 63;
  bf16_t* VF = (bf16_t*)(PWS() + WS_VF); bf16_t* RG = (bf16_t*)(PWS() + WS_RG); bf16_t* CV = (bf16_t*)(PWS() + WS_CV);
  bf16_t* LAB = (bf16_t*)(PWS() + WS_LAB); bf16_t* GG = (bf16_t*)(PWS() + WS_GG);
  bf16_t* QN = (bf16_t*)(PWS() + WS_QN); bf16_t* KVN = (bf16_t*)(PWS() + WS_KVN); bf16_t* KR = (bf16_t*)(PWS() + WS_KR);
  unsigned char* REC = PWS() + WS_REC;
  const float w0_0 = PIN(I_RWW0)[(layer * 2 + 0) * 512 + c], w0_1 = PIN(I_RWW0)[(layer * 2 + 1) * 512 + c];
  const float a0_0 = PIN(I_RWA0)[(layer * 2 + 0) * 512 + c], a0_1 = PIN(I_RWA0)[(layer * 2 + 1) * 512 + c];
  const float kkc = PIN(I_RWKK)[layer * 512 + c], kac = PIN(I_RWKA)[layer * 512 + c], rkc = PIN(I_RWRK)[layer * 512 + c];
  const float v0c = (layer > 0) ? PIN(I_RWV0)[c] : 0.f;
  const float* wup = PIN(I_RWWUP) + (size_t)layer * 2 * 32 * 512 + c; const float* aup = PIN(I_RWAUP) + (size_t)layer * 2 * 32 * 512 + c;
  const float* gup = PIN(I_RWGUP) + (size_t)layer * 96 * 512 + c; const float* vup = PIN(I_RWVUP) + c;
  const float* lwa = PIN(I_LRUWA) + (size_t)layer * 2 * 8 * 4096 + (size_t)hd * 4096 + n; const float* lwx = PIN(I_LRUWX) + (size_t)layer * 2 * 8 * 4096 + (size_t)hd * 4096 + n;
  const float lba0 = PIN(I_LRUBA)[(layer * 2 + 0) * 512 + c], lba1 = PIN(I_LRUBA)[(layer * 2 + 1) * 512 + c];
  const float lbx0 = PIN(I_LRUBX)[(layer * 2 + 0) * 512 + c], lbx1 = PIN(I_LRUBX)[(layer * 2 + 1) * 512 + c];
  const float lam0 = PIN(I_LRULAM)[(layer * 2 + 0) * 512 + c], lam1 = PIN(I_LRULAM)[(layer * 2 + 1) * 512 + c];
  const float sp0 = log1pf(__expf(-lam0)), sp1 = log1pf(__expf(-lam1));
  float cwr[3], cwk[3], cwv[3], cwe[3], cbr = 0.f, cbk = 0.f, cbv = 0.f, cbe = 0.f;
  const int ecol = 1536 + ((tid & 255) < 224 ? (tid & 255) : 0);
#pragma unroll
  for (int q = 0; q < 3; ++q) { cwr[q] = (PART == 0) ? cw[q * 1760 + c] : 0.f; cwk[q] = (PART == 0) ? cw[q * 1760 + 512 + c] : 0.f; cwv[q] = (PART == 0) ? cw[q * 1760 + 1024 + c] : 0.f; cwe[q] = (PART == 0) ? cw[q * 1760 + ecol] : 0.f; }
  if (PART == 0) { cbr = cb[c]; cbk = cb[512 + c]; cbv = cb[1024 + c]; cbe = cb[ecol]; }

  for (int tile = wg; tile < T / NTK; tile += nwg) {
    const int t0 = tile * NTK;
    const int lo = t0 < NCTX ? 0 : NCTX, hi = t0 < NCTX ? NCTX : T;
    if (PART == 0) {
#pragma unroll
    for (int i = 0; i < (NTK * 256 + 511) / 512; ++i) {
      const int idx = tid + 512 * i, tt = idx >> 8, e = idx & 255, t = t0 + tt; float v;
      if (idx >= NTK * 256) continue;
      const int lo_t = t < NCTX ? 0 : NCTX, hi_t = t < NCTX ? NCTX : T;
      if (e < 224) { v = rwconv3w(cols, cwe[0], cwe[1], cwe[2], cbe, t, 1536 + e, lo_t, hi_t); if (e < 64) v = tanhf_(v); else if (e >= 128) v = sigmoidf_(v); }
      else v = (layer > 0) ? colv(cols, t, C_VD + e - 224) : 0.f;
      lin[tt * 256 + e] = v;
    }
    }
    if (PART == 1) {
#pragma unroll
    for (int tt = 0; tt < NTK; ++tt) {
      const int t = t0 + tt; float u = lcb[c]; const int lo_t = t < NCTX ? 0 : NCTX, hi_t = t < NCTX ? NCTX : T;
#pragma unroll
      for (int j = 0; j < 4; ++j) { const int ts = t + j - 2; if (ts >= lo_t && ts < hi_t) u += lcw[j * 512 + c] * colv(cols, ts, C_LRU + c); }
      xs[tt * 512 + c] = u;
    }
#pragma unroll 1
    for (int tw = wave; tw < NTK; tw += 8) {
      const int t = t0 + tw; const bf16_t* cr = cols + (size_t)t * NIN;
      float q[8]; float ss = 0.f;
      { const bf16x8 raw = *(const bf16x8*)(cr + C_MLA + lane * 8);
#pragma unroll
        for (int i = 0; i < 8; ++i) { q[i] = bf2f((bf16_t)raw[i]); ss += q[i] * q[i]; } }
      ss = wave_sum(ss); float rstd = rsqrtf(ss * (1.0f / 512.0f) + 1e-6f);
      { const float* gq = PIN(I_QNORM) + layer * 512 + lane * 8; u32x4 w;
        w.x = cvtpk(q[0] * rstd * gq[0], q[1] * rstd * gq[1]); w.y = cvtpk(q[2] * rstd * gq[2], q[3] * rstd * gq[3]);
        w.z = cvtpk(q[4] * rstd * gq[4], q[5] * rstd * gq[5]); w.w = cvtpk(q[6] * rstd * gq[6], q[7] * rstd * gq[7]);
        *(u32x4*)(QN + (size_t)t * 512 + lane * 8) = w; }
      float k4[4]; ss = 0.f;
      { const s16x4 raw = *(const s16x4*)(cr + C_MLA + 512 + lane * 4);
#pragma unroll
        for (int i = 0; i < 4; ++i) { k4[i] = bf2f((bf16_t)raw[i]); ss += k4[i] * k4[i]; } }
      ss = wave_sum(ss); rstd = rsqrtf(ss * (1.0f / 256.0f) + 1e-6f);
      { const float* gk = PIN(I_KVNORM) + layer * 256 + lane * 4; u32x2 w;
        w.x = cvtpk(k4[0] * rstd * gk[0], k4[1] * rstd * gk[1]); w.y = cvtpk(k4[2] * rstd * gk[2], k4[3] * rstd * gk[3]);
        *(u32x2*)(KVN + (size_t)t * 256 + lane * 4) = w; }
      const float own = bf2f(cr[C_MLA + 768 + lane]); const float oth = __shfl_xor(own, 16);
      float res = own;
      if (t >= NCTX) {
        const int tl = t - NCTX, axis = lane >> 5, half = (lane >> 4) & 1, f = lane & 15;
        const float pos = (float)(axis == 0 ? (tl >> 6) : (tl & 63));
        const float inv = exp2f(-(float)f * (13.287712379549449f / 16.0f));
        const float sn = __sinf(pos * inv), cs = __cosf(pos * inv);
        res = half == 0 ? own * cs - oth * sn : oth * sn + own * cs;
      }
      KR[(size_t)t * 64 + lane] = f2bf(res);
    }
    }
    __syncthreads();
    if (PART == 0) {
      float zw0[NTK], zw1[NTK], za0[NTK], za1[NTK], gg[NTK], mx[NTK];
#pragma unroll
      for (int tt = 0; tt < NTK; ++tt) { zw0[tt] = 0.f; zw1[tt] = 0.f; za0[tt] = 0.f; za1[tt] = 0.f; gg[tt] = 0.f; mx[tt] = 0.f; }
#pragma unroll 1
      for (int e = 0; e < 32; e += 4) {
        float wa[4], wb[4], aa[4], ab[4], vv[4];
#pragma unroll
        for (int i = 0; i < 4; ++i) { wa[i] = wup[(size_t)(e + i) * 512]; wb[i] = wup[(size_t)(32 + e + i) * 512]; aa[i] = aup[(size_t)(e + i) * 512]; ab[i] = aup[(size_t)(32 + e + i) * 512];
          vv[i] = (layer > 0) ? vup[(size_t)(e + i) * 512] : 0.f; }
#pragma unroll
        for (int tt = 0; tt < NTK; ++tt) {
          const f32x4 x0 = *(const f32x4*)(lin + tt * 256 + e), x1 = *(const f32x4*)(lin + tt * 256 + 32 + e), y0 = *(const f32x4*)(lin + tt * 256 + 64 + e),
                      y1 = *(const f32x4*)(lin + tt * 256 + 96 + e), hv = *(const f32x4*)(lin + tt * 256 + 224 + e);
#pragma unroll
          for (int i = 0; i < 4; ++i) { zw0[tt] += x0[i] * wa[i]; zw1[tt] += x1[i] * wb[i]; za0[tt] += y0[i] * aa[i]; za1[tt] += y1[i] * ab[i]; mx[tt] += hv[i] * vv[i]; }
        }
      }
      { float gw[4];
#pragma unroll
        for (int i = 0; i < 4; ++i) gw[i] = gup[(size_t)i * 512];
#pragma unroll 1
        for (int e = 0; e < 96; e += 4) {
          float ngw[4]; const int en = (e + 4 < 96) ? e + 4 : e;
#pragma unroll
          for (int i = 0; i < 4; ++i) ngw[i] = gup[(size_t)(en + i) * 512];
#pragma unroll
          for (int tt = 0; tt < NTK; ++tt) { const f32x4 s4 = *(const f32x4*)(lin + tt * 256 + 128 + e);
#pragma unroll
            for (int i = 0; i < 4; ++i) gg[tt] += s4[i] * gw[i]; }
#pragma unroll
          for (int i = 0; i < 4; ++i) gw[i] = ngw[i];
        } }
#pragma unroll
      for (int tt = 0; tt < NTK; ++tt) {
        const int t = t0 + tt; const int lo_t = t < NCTX ? 0 : NCTX, hi_t = t < NCTX ? NCTX : T;
        const float r = rwconv3w(cols, cwr[0], cwr[1], cwr[2], cbr, t, c, lo_t, hi_t), k = rwconv3w(cols, cwk[0], cwk[1], cwk[2], cbk, t, 512 + c, lo_t, hi_t);
        float v = rwconv3w(cols, cwv[0], cwv[1], cwv[2], cbv, t, 1024 + c, lo_t, hi_t);
        const float wd0 = __expf(-0.606531f * sigmoidf_(w0_0 + zw0[tt])), wd1 = __expf(-0.606531f * sigmoidf_(w0_1 + zw1[tt]));
        const float ic0 = sigmoidf_(a0_0 + za0[tt]), ic1 = sigmoidf_(a0_1 + za1[tt]);
        if (layer > 0) { const float mixv = sigmoidf_(v0c + mx[tt]); const float vf = bf2f(VF[(size_t)t * 512 + c]); v = v + (vf - v) * mixv; }
        else __builtin_nontemporal_store(f2bf(v), VF + (size_t)t * 512 + c);
        float kk = k * kkc; const float ssq = wave_sum(kk * kk); kk *= rsqrtf(fmaxf(ssq, 1e-24f));
        const float kd0 = k * (1.0f + (ic0 - 1.0f) * kac), kd1 = k * (1.0f + (ic1 - 1.0f) * kac);
        const float b0 = kk * ic0, b1 = kk * ic1;
        const float coef = wave_sum(r * (kd0 + kd1) * rkc);
        __builtin_nontemporal_store(f2bf(gg[tt]), RG + (size_t)t * 512 + c); __builtin_nontemporal_store(f2bf(coef * v), CV + (size_t)t * 512 + c);
        const bf16_t ab_ = f2bf(-kk), rb_ = f2bf(r), vb_ = f2bf(v);
        { unsigned char* rp = REC + ((size_t)(0 * 8 + hd) * T + t) * RECB;
          __builtin_nontemporal_store(wd0, (float*)rp + n); bf16_t* q = (bf16_t*)(rp + 256);
          __builtin_nontemporal_store(f2bf(kd0), q + n); __builtin_nontemporal_store(ab_, q + 64 + n); __builtin_nontemporal_store(f2bf(b0), q + 128 + n);
          __builtin_nontemporal_store(rb_, q + 192 + n); __builtin_nontemporal_store(vb_, q + 256 + n); }
        { unsigned char* rp = REC + ((size_t)(1 * 8 + hd) * T + scan_pos_rev(t)) * RECB;
          __builtin_nontemporal_store(wd1, (float*)rp + n); bf16_t* q = (bf16_t*)(rp + 256);
          __builtin_nontemporal_store(f2bf(kd1), q + n); __builtin_nontemporal_store(ab_, q + 64 + n); __builtin_nontemporal_store(f2bf(b1), q + 128 + n);
          __builtin_nontemporal_store(rb_, q + 192 + n); __builtin_nontemporal_store(vb_, q + 256 + n); }
        asm volatile("" ::: "memory");
      }
    }
    if (PART == 1) {
      float pa0[NTK], pa1[NTK], px0[NTK], px1[NTK];
#pragma unroll
      for (int tt = 0; tt < NTK; ++tt) { pa0[tt] = 0.f; pa1[tt] = 0.f; px0[tt] = 0.f; px1[tt] = 0.f; }
      {
        float a0w[4], a1w[4], x0w[4], x1w[4];
#pragma unroll
        for (int i = 0; i < 4; ++i) { a0w[i] = lwa[(size_t)i * 64]; a1w[i] = lwa[(size_t)8 * 4096 + (size_t)i * 64]; x0w[i] = lwx[(size_t)i * 64]; x1w[i] = lwx[(size_t)8 * 4096 + (size_t)i * 64]; }
#pragma unroll 1
        for (int i0 = 0; i0 < 64; i0 += 4) {
          float na0[4], na1[4], nx0[4], nx1[4];
          const int in_ = (i0 + 4 < 64) ? i0 + 4 : i0;
#pragma unroll
          for (int i = 0; i < 4; ++i) { na0[i] = lwa[(size_t)(in_ + i) * 64]; na1[i] = lwa[(size_t)8 * 4096 + (size_t)(in_ + i) * 64]; nx0[i] = lwx[(size_t)(in_ + i) * 64]; nx1[i] = lwx[(size_t)8 * 4096 + (size_t)(in_ + i) * 64]; }
#pragma unroll
          for (int tt = 0; tt < NTK; ++tt) { const f32x4 x = *(const f32x4*)(xs + tt * 512 + hd * 64 + i0);
#pragma unroll
            for (int i = 0; i < 4; ++i) { pa0[tt] += x[i] * a0w[i]; pa1[tt] += x[i] * a1w[i]; px0[tt] += x[i] * x0w[i]; px1[tt] += x[i] * x1w[i]; } }
#pragma unroll
          for (int i = 0; i < 4; ++i) { a0w[i] = na0[i]; a1w[i] = na1[i]; x0w[i] = nx0[i]; x1w[i] = nx1[i]; }
        }
      }
      float gt8[NTK];
#pragma unroll
      for (int tt = 0; tt < NTK; ++tt) gt8[tt] = colv(cols, t0 + tt, C_LRU + 512 + c);
#pragma unroll
      for (int tt = 0; tt < NTK; ++tt) {
        const int t = t0 + tt; const float xb = xs[tt * 512 + c];
        const float la0 = -8.0f * sigmoidf_(pa0[tt] + lba0) * sp0, la1 = -8.0f * sigmoidf_(pa1[tt] + lba1) * sp1;
        const float bb0 = sqrtf(fmaxf(1.0f - __expf(2.0f * la0), 0.f)) * sigmoidf_(px0[tt] + lbx0) * xb;
        const float bb1 = sqrtf(fmaxf(1.0f - __expf(2.0f * la1), 0.f)) * sigmoidf_(px1[tt] + lbx1) * xb;
        bf16_t* lp = LAB + (size_t)t * 2048;
        lp[c] = f2bf(la0); lp[512 + c] = f2bf(bb0); lp[1024 + c] = f2bf(la1); lp[1536 + c] = f2bf(bb1);
        __builtin_nontemporal_store(f2bf(gelu_tanh(gt8[tt])), GG + (size_t)t * 512 + c);
        asm volatile("" ::: "memory");
      }
    }
    __syncthreads();
  }
}

__device__ __forceinline__ void phase_lru_agg(const Params& P, int wg, int nwg) {
  const int c = mk_tid(); const bf16_t* LAB = (const bf16_t*)(PWS() + WS_LAB); float* AGG = (float*)(PWS() + WS_AGG);
  for (int ck = wg; ck < T / 64; ck += nwg) {
    float A0 = 1.f, B0 = 0.f, A1 = 1.f, B1 = 0.f;
#pragma unroll 1
    for (int t8 = 0; t8 < 64; t8 += 8) {
      bf16_t x[8][4];
#pragma unroll
      for (int u = 0; u < 8; ++u) { const bf16_t* lp = LAB + (size_t)(ck * 64 + t8 + u) * 2048; x[u][0] = lp[c]; x[u][1] = lp[512 + c]; x[u][2] = lp[1024 + c]; x[u][3] = lp[1536 + c]; }
#pragma unroll
      for (int u = 0; u < 8; ++u) {
        const float a0 = __expf(bf2f(x[u][0])), b0 = bf2f(x[u][1]), a1 = __expf(bf2f(x[u][2])), b1 = bf2f(x[u][3]);
        A0 = a0 * A0; B0 = a0 * B0 + b0;
        B1 = B1 + A1 * b1; A1 = A1 * a1;
      }
    }
    float* ap = AGG + (size_t)ck * 2048; ap[c] = A0; ap[512 + c] = B0; ap[1024 + c] = A1; ap[1536 + c] = B1;
  }
}
__device__ __forceinline__ float lru_compose(const float* AGG, int c, int off, int q0, int dq, int n, float h) {
  int i = 0;
#pragma unroll 1
  for (; i + 8 <= n; i += 8) {
    float a[8], b[8];
#pragma unroll
    for (int u = 0; u < 8; ++u) { const float* ap = AGG + (size_t)(q0 + (i + u) * dq) * 2048 + off; a[u] = ap[c]; b[u] = ap[512 + c]; }
#pragma unroll
    for (int u = 0; u < 8; ++u) h = a[u] * h + b[u];
  }
#pragma unroll 1
  for (; i < n; ++i) { const float* ap = AGG + (size_t)(q0 + i * dq) * 2048 + off; h = ap[c] * h + ap[512 + c]; }
  return h;
}
__device__ __forceinline__ void phase_lru_out(const Params& P, int layer, float* lds, int wg, int nwg) {
  const int c = mk_tid(); const bf16_t* LAB = (const bf16_t*)(PWS() + WS_LAB); const float* AGG = (const float*)(PWS() + WS_AGG);
  const bf16_t* GG = (const bf16_t*)(PWS() + WS_GG); bf16_t* MIX = (bf16_t*)(PWS() + WS_H);
  const int ck_lo = (layer == 1) ? 4 : 0;
  for (int ck = ck_lo + wg; ck < T / 64; ck += nwg) {
    float h0 = lru_compose(AGG, c, 0, 0, 1, ck, 0.f);
    float h1;
    if (ck < 4) h1 = lru_compose(AGG, c, 1024, 3, -1, 3 - ck, 0.f);
    else { h1 = lru_compose(AGG, c, 1024, 3, -1, 4, 0.f); h1 = lru_compose(AGG, c, 1024, T / 64 - 1, -1, T / 64 - 1 - ck, h1); }
#pragma unroll 1
    for (int t8 = 0; t8 < 64; t8 += 8) {
      bf16_t x[8][2];
#pragma unroll
      for (int u = 0; u < 8; ++u) { const bf16_t* lp = LAB + (size_t)(ck * 64 + t8 + u) * 2048; x[u][0] = lp[c]; x[u][1] = lp[512 + c]; }
#pragma unroll
      for (int u = 0; u < 8; ++u) { h0 = __expf(bf2f(x[u][0])) * h0 + bf2f(x[u][1]); lds[(t8 + u) * 512 + c] = h0; }
    }
#pragma unroll 1
    for (int t8 = 56; t8 >= 0; t8 -= 8) {
      bf16_t x[8][3];
#pragma unroll
      for (int u = 0; u < 8; ++u) { const int t = ck * 64 + t8 + u; const bf16_t* lp = LAB + (size_t)t * 2048; x[u][0] = lp[1024 + c]; x[u][1] = lp[1536 + c]; x[u][2] = GG[(size_t)t * 512 + c]; }
#pragma unroll
      for (int u = 7; u >= 0; --u) { const int t = ck * 64 + t8 + u; h1 = __expf(bf2f(x[u][0])) * h1 + bf2f(x[u][1]);
        MIX[(size_t)t * DM + 512 + c] = f2bf((lds[(t8 + u) * 512 + c] + h1) * bf2f(x[u][2])); }
    }
  }
}

template <int NCW>
__device__ __forceinline__ void rwkv_scan(const Params& P, int s, float* lds) {
  const int d = (NCW == 4) ? (s >> 5) : (s >> 4), h = (NCW == 4) ? ((s >> 2) & 7) : ((s >> 1) & 7), part = (NCW == 4) ? (s & 3) : (s & 1);
  const int tid = mk_tid(), lane = tid & 63, wave = tid >> 6, rgp = lane >> 4, j = lane & 15, row = part * (NCW * 4) + (wave & (NCW - 1)) * 4 + rgp;
  const unsigned char* rec = PWS() + WS_REC + (size_t)(d * 8 + h) * T * RECB;
  float* Y = (float*)(PWS() + WS_Y) + (size_t)d * T * 512 + h * 64 + row;
  constexpr int NST = (NCW == 4) ? 7 : 4, STS = (NCW == 4) ? 256 : 512;
  const bool stager = (NCW == 4) ? (wave >= 4) : true; const int stid = (NCW == 4) ? (tid - 256) : tid;
  int goff[NST], loff[NST]; bool isw[NST], val[NST];
#pragma unroll
  for (int i = 0; i < NST; ++i) { const int q = stid + STS * i; val[i] = stager && q >= 0 && q < 1792; const int rc = q / 56, pr = q % 56; goff[i] = rc * RECB + pr * 16; isw[i] = pr < 16;
    loff[i] = rc * 384 + (isw[i] ? pr * 4 : 64 + ((pr - 16) >> 3) * 64 + ((pr - 16) & 7) * 8); }
  u32x4 stA[NST], stB[NST];
#define RS_LOAD(st, ch) do { _Pragma("unroll") for (int i = 0; i < NST; ++i) if (val[i]) st[i] = __builtin_nontemporal_load((const u32x4*)(rec + (size_t)(ch) * 32 * RECB + goff[i])); } while (0)
#define RS_WRITE(st, buf) do { _Pragma("unroll") for (int i = 0; i < NST; ++i) if (val[i]) { float* dp = (buf) + loff[i]; \
    if (isw[i]) { *(u32x4*)dp = st[i]; } else { u32x4 lo_, hi_; lo_.x = st[i].x << 16; lo_.y = st[i].x & 0xffff0000u; lo_.z = st[i].y << 16; lo_.w = st[i].y & 0xffff0000u; \
      hi_.x = st[i].z << 16; hi_.y = st[i].z & 0xffff0000u; hi_.z = st[i].w << 16; hi_.w = st[i].w & 0xffff0000u; *(u32x4*)dp = lo_; *(u32x4*)(dp + 4) = hi_; } } } while (0)
  f32x4 S = {0.f, 0.f, 0.f, 0.f}; float ykeep = 0.f, yprev = 0.f;
  constexpr int NCH = T / 32;
#define RS_COMPUTE(ch) do { const float* buf = lds + ((ch) & 1) * 12288; \
    if (wave < NCW) { \
      const float* sp = buf + j * 4; \
      f32x4 w4 = *(const f32x4*)(sp), kd4 = *(const f32x4*)(sp + 64), a4 = *(const f32x4*)(sp + 128), b4 = *(const f32x4*)(sp + 192), r4 = *(const f32x4*)(sp + 256); \
      float v = buf[320 + row]; \
      _Pragma("unroll 8") \
      for (int stp = 0; stp < 32; ++stp) { \
        float sa = dot4(S, a4); \
          \
        __builtin_amdgcn_sched_barrier(0); \
        const float* np = sp + (stp + 1) * 384;            \
        const f32x4 nw4 = *(const f32x4*)(np), nkd4 = *(const f32x4*)(np + 64), na4 = *(const f32x4*)(np + 128), nb4 = *(const f32x4*)(np + 192), nr4 = *(const f32x4*)(np + 256); \
        const float nv = buf[(stp + 1) * 384 + 320 + row]; \
        __builtin_amdgcn_sched_barrier(0); \
          \
          \
        f32x2 q01, t23, vv; vv[0] = v; vv[1] = v; \
        { const f32x2 kd01 = kd4.lo, kd23 = kd4.hi, S01 = S.lo, w01 = w4.lo; \
        asm volatile("v_add_f32_dpp %0, %0, %0 quad_perm:[1,0,3,2] row_mask:0xf bank_mask:0xf\n\t" \
                     "v_add_f32_dpp %1, %1, %1 quad_perm:[1,0,3,2] row_mask:0xf bank_mask:0xf\n\t" \
                     "v_pk_mul_f32 %2, %4, %6 op_sel_hi:[1,0]\n\t" \
                     "v_add_f32_dpp %0, %0, %0 quad_perm:[2,3,0,1] row_mask:0xf bank_mask:0xf\n\t" \
                     "v_add_f32_dpp %1, %1, %1 quad_perm:[2,3,0,1] row_mask:0xf bank_mask:0xf\n\t" \
                     "v_pk_mul_f32 %3, %5, %6 op_sel_hi:[1,0]\n\t" \
                     "v_add_f32_dpp %0, %0, %0 row_half_mirror row_mask:0xf bank_mask:0xf\n\t" \
                     "v_add_f32_dpp %1, %1, %1 row_half_mirror row_mask:0xf bank_mask:0xf\n\t" \
                     "v_pk_fma_f32 %2, %7, %8, %2\n\t" \
                     "v_add_f32_dpp %0, %0, %0 row_mirror row_mask:0xf bank_mask:0xf\n\t" \
                     "v_add_f32_dpp %1, %1, %1 row_mirror row_mask:0xf bank_mask:0xf" \
                     : "+v"(sa), "+v"(yprev), "=&v"(q01), "=&v"(t23) \
                     : "v"(kd01), "v"(kd23), "v"(vv), "v"(S01), "v"(w01)); } \
        const f32x2 q23 = S.hi * w4.hi + t23; \
        ykeep = (((stp + 15) & 15) == j) ? yprev : ykeep;         \
        if ((stp & 15) == 0 && ((ch) > 0 || stp > 0)) { const int p = (ch) * 32 + stp - 16 + j; const int tok = d ? scan_pos_rev(p) : p; __builtin_nontemporal_store(ykeep, Y + (size_t)tok * 512); } \
        S.lo = sa * b4.lo + q01; S.hi = sa * b4.hi + q23; \
        yprev = dot4(S, r4); \
        w4 = nw4; kd4 = nkd4; a4 = na4; b4 = nb4; r4 = nr4; v = nv; \
      } \
    } } while (0)
  RS_LOAD(stA, 0); RS_WRITE(stA, lds); RS_LOAD(stA, 1); __syncthreads();
  static_assert(NCH % 2 == 0, "the chunk loop is unrolled by two");
  for (int ch = 0; ch < NCH; ch += 2) {
    if (ch + 2 < NCH) RS_LOAD(stB, ch + 2);
    RS_COMPUTE(ch);
    RS_WRITE(stA, lds + 12288);
    __syncthreads();
    if (ch + 3 < NCH) RS_LOAD(stA, ch + 3);
    RS_COMPUTE(ch + 1);
    if (ch + 2 < NCH) RS_WRITE(stB, lds);
    __syncthreads();
  }
  if (wave < NCW) {
    yprev = row16_sum(yprev);
    ykeep = (j == 15) ? yprev : ykeep;
    const int p = T - 16 + j; const int tok = d ? scan_pos_rev(p) : p; __builtin_nontemporal_store(ykeep, Y + (size_t)tok * 512);
  }
#undef RS_COMPUTE
#undef RS_LOAD
#undef RS_WRITE
}

__device__ __forceinline__ void phase_rwkv_out(const Params& P, int layer, int wg, int nwg) {
  const int c = mk_tid();
  const float* Y0 = (const float*)(PWS() + WS_Y); const float* Y1 = Y0 + (size_t)T * 512;
  const bf16_t* RG = (const bf16_t*)(PWS() + WS_RG); const bf16_t* CV = (const bf16_t*)(PWS() + WS_CV); bf16_t* MIX = (bf16_t*)(PWS() + WS_H);
  const float lg = PIN(I_RWLNG)[layer * 512 + c], lb = PIN(I_RWLNB)[layer * 512 + c];
  const int G = nwg;
  for (int t0 = (layer == 1 ? NCTX : 0) + wg; t0 < T; t0 += 4 * G) {
    float y[4], cv[4], rg[4];
#pragma unroll
    for (int u = 0; u < 4; ++u) { const int t = t0 + u * G; if (t < T) { y[u] = Y0[(size_t)t * 512 + c] + Y1[(size_t)t * 512 + c]; cv[u] = bf2f(CV[(size_t)t * 512 + c]); rg[u] = bf2f(RG[(size_t)t * 512 + c]); } else { y[u] = 0.f; cv[u] = 0.f; rg[u] = 0.f; } }
#pragma unroll
    for (int u = 0; u < 4; ++u) { const int t = t0 + u * G;
      const float mu = wave_sum(y[u]) * (1.0f / 64.0f); const float dlt = y[u] - mu; const float var = wave_sum(dlt * dlt) * (1.0f / 64.0f);
      const float yn = dlt * rsqrtf(var + 64e-5f) * lg + lb;
      if (t < T) MIX[(size_t)t * DM + c] = f2bf((yn + cv[u]) * rg[u]); }
  }
}

__device__ __forceinline__ void phase_ffn_act(const Params& P, int layer) {
  const bf16_t* GU = (const bf16_t*)(PWS() + WS_GU); bf16_t* ACT = (bf16_t*)(PWS() + WS_ACT);
  const float* fw = PIN(I_FCONV) + (size_t)layer * 3 * DFF; const float* fb = PIN(I_FCONVB) + (size_t)layer * DFF;
  const int run_lo = (layer == 1) ? NCTX / 32 : 0, nruns = T / 32 - run_lo;
  for (int idx = mk_bid() * NTH + mk_tid(); idx < nruns * 704; idx += mk_nblk() * NTH) {
    const int cgp = idx % 704, run = run_lo + idx / 704, c0 = cgp * 8, t0 = run * 32;
    const int lo = t0 < NCTX ? 0 : NCTX, hi = t0 < NCTX ? NCTX : T;
    float w0[8], w1[8], w2[8], bb[8];
#pragma unroll
    for (int i = 0; i < 8; ++i) { w0[i] = fw[c0 + i]; w1[i] = fw[DFF + c0 + i]; w2[i] = fw[2 * DFF + c0 + i]; bb[i] = fb[c0 + i]; }
    const bf16x8 zero = {0, 0, 0, 0, 0, 0, 0, 0};
    bf16x8 prev = (t0 - 1 >= lo) ? __builtin_nontemporal_load((const bf16x8*)(GU + (size_t)(t0 - 1) * NGU + c0)) : zero;
    bf16x8 cur = __builtin_nontemporal_load((const bf16x8*)(GU + (size_t)t0 * NGU + c0));
    for (int tt = 0; tt < 32; ++tt) {
      const int t = t0 + tt;
      const bf16x8 nxt = (t + 1 < hi) ? __builtin_nontemporal_load((const bf16x8*)(GU + (size_t)(t + 1) * NGU + c0)) : zero;
      const bf16x8 up = __builtin_nontemporal_load((const bf16x8*)(GU + (size_t)t * NGU + DFF + c0));
      float o[8];
#pragma unroll
      for (int i = 0; i < 8; ++i) { const float g = bb[i] + w0[i] * bf2f((bf16_t)prev[i]) + w1[i] * bf2f((bf16_t)cur[i]) + w2[i] * bf2f((bf16_t)nxt[i]); o[i] = siluf_(g) * bf2f((bf16_t)up[i]); }
      u32x4 w; w.x = cvtpk(o[0], o[1]); w.y = cvtpk(o[2], o[3]); w.z = cvtpk(o[4], o[5]); w.w = cvtpk(o[6], o[7]);
      *(u32x4*)(ACT + (size_t)t * DFF + c0) = w;
      prev = cur; cur = nxt;
    }
  }
}

namespace at2 {
constexpr int DQK = 192, DV = 128, QBLK = 32, KVBLK = 64;
constexpr float SCALE = 0.07216878364870322f;
constexpr float THR = 8.f;
#ifndef ATT_NQREG
#define ATT_NQREG 12
#endif
constexpr int NQREG = ATT_NQREG;
constexpr int SHM_V = KVBLK * DV * 2, SHM_K = KVBLK * DQK * 2, SHM_ATTN = 3 * SHM_V + 3 * SHM_K + 8 * 64 * 4,     SHM_TOTAL = SHM_ATTN + (12 - NQREG) * 8192;
#define KSWZ(row, colB) ((row) * 384 + ((colB) ^ (((row) & 7) << 4)))
#define SBAR() __builtin_amdgcn_sched_barrier(0)
__device__ __forceinline__ int crow(int r, int hi) { return (r & 3) + 8 * (r >> 2) + 4 * hi; }

__device__ __forceinline__ void partialSM(f32x16& p0, f32x16& p1, float& m_reg, float& mn, float& alpha) {
  constexpr float C = SCALE * 1.4426950408889634f;
  float pmax = p0[0];
#pragma unroll
  for (int r = 1; r < 16; ++r) pmax = fmaxf(pmax, p0[r]);
#pragma unroll
  for (int r = 0; r < 16; ++r) pmax = fmaxf(pmax, p1[r]);
  { auto rr = __builtin_amdgcn_permlane32_swap(__float_as_uint(pmax), __float_as_uint(pmax), false, false);
    pmax = fmaxf(__uint_as_float(rr[0]), __uint_as_float(rr[1])); }
  if (__builtin_expect(__all(pmax - m_reg <= THR / SCALE), 1)) { mn = m_reg; alpha = 1.f; }
  else { mn = fmaxf(m_reg, pmax); alpha = __builtin_amdgcn_exp2f((m_reg - mn) * C); m_reg = mn; }
  const float mnC = -mn * C;
#pragma unroll
  for (int r = 0; r < 16; ++r) p0[r] = fmaf(p0[r], C, mnC);
#pragma unroll
  for (int r = 0; r < 16; ++r) p1[r] = fmaf(p1[r], C, mnC);
#pragma unroll
  for (int r = 0; r < 16; ++r) p0[r] = __builtin_amdgcn_exp2f(p0[r]);
}
__device__ __forceinline__ void finishSM(f32x16& p0, f32x16& p1, float alpha, float& l_reg, bf16x8& pa0, bf16x8& pa1, bf16x8& pa2, bf16x8& pa3) {
#pragma unroll
  for (int r = 0; r < 16; ++r) p1[r] = __builtin_amdgcn_exp2f(p1[r]);
  float ps = 0;
#pragma unroll
  for (int r = 0; r < 16; ++r) ps += p0[r];
#pragma unroll
  for (int r = 0; r < 16; ++r) ps += p1[r];
  { auto rr = __builtin_amdgcn_permlane32_swap(__float_as_uint(ps), __float_as_uint(ps), false, false);
    ps = __uint_as_float(rr[0]) + __uint_as_float(rr[1]); }
  l_reg = l_reg * alpha + ps;
#define PK4(P, BASE, OUT) do { unsigned a0 = cvtpk(P[BASE + 0], P[BASE + 1]), a1 = cvtpk(P[BASE + 2], P[BASE + 3]);   \
    unsigned b0 = cvtpk(P[BASE + 4], P[BASE + 5]), b1 = cvtpk(P[BASE + 6], P[BASE + 7]);                              \
    auto r0 = __builtin_amdgcn_permlane32_swap(a0, b0, false, false); auto r1 = __builtin_amdgcn_permlane32_swap(a1, b1, false, false); \
    u32x4 w = {r0[0], r1[0], r0[1], r1[1]}; OUT = *reinterpret_cast<bf16x8*>(&w); } while (0)
  PK4(p0, 0, pa0); PK4(p0, 8, pa1); PK4(p1, 0, pa2); PK4(p1, 8, pa3);
#undef PK4
}
__device__ __forceinline__ void qkt(f32x16& p0, f32x16& p1, const char* Ks, const bf16x8* qr, const char* qsp, int r32, int hi) {
  p0 = f32x16{}; p1 = f32x16{};
#pragma unroll
  for (int d0 = 0; d0 < 12; ++d0) { const int cb = (d0 * 16 + hi * 8) * 2;
    const bf16x8 b0 = *reinterpret_cast<const bf16x8*>(Ks + KSWZ(r32, cb));
    const bf16x8 b1 = *reinterpret_cast<const bf16x8*>(Ks + KSWZ(32 + r32, cb));
    const bf16x8 qv = (d0 < NQREG) ? qr[d0 < NQREG ? d0 : 0] : *reinterpret_cast<const bf16x8*>(qsp + (d0 - NQREG) * 8192);
    p0 = __builtin_amdgcn_mfma_f32_32x32x16_bf16(b0, qv, p0, 0, 0, 0);
    p1 = __builtin_amdgcn_mfma_f32_32x32x16_bf16(b1, qv, p1, 0, 0, 0); }
}
__device__ __forceinline__ int v_st(int k, int c) { const int kk = (k & ~0xC) | ((k & 4) << 1) | ((k & 8) >> 1); return ((kk >> 3) * 4 + (c >> 5)) * 512 + ((kk & 7) * 32 + (c & 31)) * 2; }
__device__ __forceinline__ int v_rd_base(int lane) { return ((lane & 3) << 3) | (((lane >> 2) & 3) << 6) | (((lane >> 4) & 1) << 5) | (((lane >> 5) & 1) << 8); }
constexpr int v_rd_off(int d0, int ks, int half) { return d0 * 512 + ks * 4096 + half * 2048; }
template <int OFF> __device__ __forceinline__ s16x4 tr_read(int vb) {
  s16x4 r; asm volatile("ds_read_b64_tr_b16 %0, %1 offset:%2" : "=&v"(r) : "v"(vb), "i"(OFF) : "memory"); return r;
}
template <int D0> __device__ __forceinline__ void pv_one(f32x16& od, int vb, bf16x8 pa0, bf16x8 pa1, bf16x8 pa2, bf16x8 pa3) {
  const s16x4 l0 = tr_read<v_rd_off(D0, 0, 0)>(vb), h0 = tr_read<v_rd_off(D0, 0, 1)>(vb), l1 = tr_read<v_rd_off(D0, 1, 0)>(vb), h1 = tr_read<v_rd_off(D0, 1, 1)>(vb);
  const s16x4 l2 = tr_read<v_rd_off(D0, 2, 0)>(vb), h2 = tr_read<v_rd_off(D0, 2, 1)>(vb), l3 = tr_read<v_rd_off(D0, 3, 0)>(vb), h3 = tr_read<v_rd_off(D0, 3, 1)>(vb);
  asm volatile("s_waitcnt lgkmcnt(0)" ::: "memory"); SBAR();
#define PK(L, H) (bf16x8){L[0], L[1], L[2], L[3], H[0], H[1], H[2], H[3]}
  od = __builtin_amdgcn_mfma_f32_32x32x16_bf16(pa0, PK(l0, h0), od, 0, 0, 0);
  od = __builtin_amdgcn_mfma_f32_32x32x16_bf16(pa1, PK(l1, h1), od, 0, 0, 0);
  od = __builtin_amdgcn_mfma_f32_32x32x16_bf16(pa2, PK(l2, h2), od, 0, 0, 0);
  od = __builtin_amdgcn_mfma_f32_32x32x16_bf16(pa3, PK(l3, h3), od, 0, 0, 0);
#undef PK
}
__device__ __forceinline__ void pv_d0(f32x16* o, int vb, bf16x8 pa0, bf16x8 pa1, bf16x8 pa2, bf16x8 pa3) {
  pv_one<0>(o[0], vb, pa0, pa1, pa2, pa3); pv_one<1>(o[1], vb, pa0, pa1, pa2, pa3); pv_one<2>(o[2], vb, pa0, pa1, pa2, pa3); pv_one<3>(o[3], vb, pa0, pa1, pa2, pa3);
}
__device__ __forceinline__ void rope_pair(bf16x8& A, bf16x8& B, float pos, int hi) {
  float oa[8], ob[8];
#pragma unroll
  for (int e = 0; e < 8; ++e) {
    const float inv = exp2f(-(float)(hi * 8 + e) * (13.287712379549449f / 16.0f));
    const float sn = __sinf(pos * inv), cs = __cosf(pos * inv);
    const float a = bf2f((bf16_t)A[e]), b = bf2f((bf16_t)B[e]);
    oa[e] = a * cs - b * sn; ob[e] = a * sn + b * cs;
  }
  u32x4 wa = {cvtpk(oa[0], oa[1]), cvtpk(oa[2], oa[3]), cvtpk(oa[4], oa[5]), cvtpk(oa[6], oa[7])};
  u32x4 wb = {cvtpk(ob[0], ob[1]), cvtpk(ob[2], ob[3]), cvtpk(ob[4], ob[5]), cvtpk(ob[6], ob[7])};
  A = *reinterpret_cast<bf16x8*>(&wa); B = *reinterpret_cast<bf16x8*>(&wb);
}

__device__ __forceinline__ void attn_unit(const bf16_t* __restrict__ Q, const bf16_t* __restrict__ KV, const bf16_t* __restrict__ KR, bf16_t* __restrict__ MIX,
                                          int q0, int h, int kv0, int seq, bool rope_q, char* lds, bf16_t* __restrict__ part_o, float* __restrict__ part_ml) {
  const int tid = mk_tid(), wid = tid >> 6, lane = tid & 63, r32 = lane & 31, hi = lane >> 5;
  char* V_lds = lds; char* K_lds = lds + 3 * SHM_V;
  float* ws = (float*)(lds + 3 * SHM_V + 3 * SHM_K) + wid * 64; float* li_l = ws; float* al_l = ws + 32;
  float m_reg = -1e30f, l_reg = 0; f32x16 o[4] = {}; bf16x8 qr[12];
  const int qrow = q0 + wid * QBLK + r32;
  const bf16_t* Qw = Q + (size_t)qrow * 1536 + h * DQK + hi * 8;
#pragma unroll
  for (int d0 = 0; d0 < 12; ++d0) qr[d0] = *reinterpret_cast<const bf16x8*>(Qw + d0 * 16);
  if (rope_q) { const int tl = qrow - NCTX; rope_pair(qr[8], qr[9], (float)(tl >> 6), hi); rope_pair(qr[10], qr[11], (float)(tl & 63), hi); }
  char* qsp = lds + SHM_ATTN + tid * 16;
#pragma unroll
  for (int d0 = NQREG; d0 < 12; ++d0) *reinterpret_cast<bf16x8*>(qsp + (d0 - NQREG) * 8192) = qr[d0];
  const bf16_t* Kh = KV + (size_t)kv0 * 2048 + h * 256; const bf16_t* Vh = Kh + 128; KR += (size_t)kv0 * 64;
  const int sr = tid >> 4, sc = (tid & 15) * 8, vst0 = v_st(sr, sc), vst1 = v_st(32 + sr, sc);
  const int rr = tid >> 3, rc = (tid & 7) * 8;
  const int vb0 = (int)(uintptr_t)V_lds + v_rd_base(lane);
  bf16x8 vs0, vs1, ks0, ks1, ks2;
#define SLOAD(k0) do { vs0 = *(const bf16x8*)(Vh + (size_t)((k0) + sr) * 2048 + sc); vs1 = *(const bf16x8*)(Vh + (size_t)((k0) + 32 + sr) * 2048 + sc); \
    ks0 = *(const bf16x8*)(Kh + (size_t)((k0) + sr) * 2048 + sc); ks1 = *(const bf16x8*)(Kh + (size_t)((k0) + 32 + sr) * 2048 + sc); \
    ks2 = *(const bf16x8*)(KR + (size_t)((k0) + rr) * 64 + rc); } while (0)
#define SWRITE(b) do { *(bf16x8*)(V_lds + (b) * SHM_V + vst0) = vs0; *(bf16x8*)(V_lds + (b) * SHM_V + vst1) = vs1; const int kc = sc * 2; \
    *(bf16x8*)(K_lds + (b) * SHM_K + KSWZ(sr, kc)) = ks0; *(bf16x8*)(K_lds + (b) * SHM_K + KSWZ(32 + sr, kc)) = ks1; \
    *(bf16x8*)(K_lds + (b) * SHM_K + KSWZ(rr, 256 + rc * 2)) = ks2; } while (0)
#define SWAIT() asm volatile("s_waitcnt vmcnt(0)" ::: "memory")
#define RESC(a) do { if (__any((a) < 1.f)) { if (hi == 0) al_l[r32] = (a); asm volatile("s_waitcnt lgkmcnt(0)" ::: "memory"); \
    _Pragma("unroll") for (int d = 0; d < 4; ++d) _Pragma("unroll") for (int r = 0; r < 16; ++r) o[d][r] *= al_l[crow(r, hi)]; } } while (0)
  f32x16 pA0, pA1, pB0, pB1; float mnA, mnB, alA, alB; bf16x8 pa0, pa1, pa2, pa3; const int NT = seq / KVBLK;
  SLOAD(0); SWAIT(); SWRITE(0); __syncthreads();
  qkt(pA0, pA1, K_lds, qr, qsp, r32, hi); partialSM(pA0, pA1, m_reg, mnA, alA);
  SLOAD(KVBLK);
  SWAIT(); SWRITE(1); __syncthreads();
  int bp = 0, bc = 1, bn = 2;
  for (int j = 1; j + 1 < NT; j += 2) {
    SBAR(); qkt(pB0, pB1, K_lds + bc * SHM_K, qr, qsp, r32, hi);
    finishSM(pA0, pA1, alA, l_reg, pa0, pa1, pa2, pa3); SBAR();
    SLOAD((j + 1) * KVBLK); SBAR();
    pv_d0(o, vb0 + bp * SHM_V, pa0, pa1, pa2, pa3); partialSM(pB0, pB1, m_reg, mnB, alB);
    SWAIT(); SWRITE(bn);
    RESC(alB); __syncthreads();
    bp = bc; bc = bn; bn = (bn == 2) ? 0 : bn + 1;
    SBAR(); qkt(pA0, pA1, K_lds + bc * SHM_K, qr, qsp, r32, hi);
    finishSM(pB0, pB1, alB, l_reg, pa0, pa1, pa2, pa3); SBAR();
    SLOAD((j + 2) * KVBLK); SBAR();
    pv_d0(o, vb0 + bp * SHM_V, pa0, pa1, pa2, pa3); partialSM(pA0, pA1, m_reg, mnA, alA);
    SWAIT(); SWRITE(bn);
    RESC(alA); __syncthreads();
    bp = bc; bc = bn; bn = (bn == 2) ? 0 : bn + 1;
  }
  SBAR(); qkt(pB0, pB1, K_lds + bc * SHM_K, qr, qsp, r32, hi);
  finishSM(pA0, pA1, alA, l_reg, pa0, pa1, pa2, pa3); SBAR();
  pv_d0(o, vb0 + bp * SHM_V, pa0, pa1, pa2, pa3); partialSM(pB0, pB1, m_reg, mnB, alB);
  __syncthreads(); RESC(alB);
  finishSM(pB0, pB1, alB, l_reg, pa0, pa1, pa2, pa3); SBAR();
  pv_d0(o, vb0 + bc * SHM_V, pa0, pa1, pa2, pa3);
  if (hi == 0) li_l[r32] = l_reg; asm volatile("s_waitcnt lgkmcnt(0)" ::: "memory");
  float rli[16];
#pragma unroll
  for (int r = 0; r < 16; ++r) rli[r] = __builtin_amdgcn_rcpf(li_l[crow(r, hi)]);
  if (part_o == nullptr) {
    bf16_t* Ow = MIX + (size_t)(q0 + wid * QBLK) * DM + 1024 + h * DV;
#pragma unroll
    for (int r = 0; r < 16; ++r) { const int orow = crow(r, hi);
#pragma unroll
      for (int d0 = 0; d0 < 4; ++d0) Ow[(size_t)orow * DM + d0 * 32 + r32] = f2bf(o[d0][r] * rli[r]); }
  } else {
    bf16_t* Ow = part_o + (size_t)(wid * QBLK) * DV;
#pragma unroll
    for (int r = 0; r < 16; ++r) { const int orow = crow(r, hi);
#pragma unroll
      for (int d0 = 0; d0 < 4; ++d0) Ow[(size_t)orow * DV + d0 * 32 + r32] = f2bf(o[d0][r] * rli[r]); }
    if (hi == 0) { part_ml[(wid * QBLK + r32) * 2] = m_reg; part_ml[(wid * QBLK + r32) * 2 + 1] = l_reg; }
  }
  __syncthreads();
#undef SLOAD
#undef SWRITE
#undef SWAIT
#undef RESC
}
}

__device__ __forceinline__ int attn_np(int nwg) { return nwg == 192 ? 3 : (nwg == 224 ? 7 : 0); }
__device__ __forceinline__ int attn_part_tiles(int np, int p) { return 2 * (130 / np) + (p < (130 % np) ? 2 : 0); }
__device__ __forceinline__ void phase_attention(const Params& P, int layer, char* lds, int wg, int nwg) {
  const bf16_t* Q = (const bf16_t*)(PWS() + WS_Q); const bf16_t* KV = (const bf16_t*)(PWS() + WS_KV); const bf16_t* KR = (const bf16_t*)(PWS() + WS_KR);
  bf16_t* MIX = (bf16_t*)(PWS() + WS_H); bf16_t* PO = (bf16_t*)(PWS() + WS_PARTO); float* PML = (float*)(PWS() + WS_PARTML);
  const int np = attn_np(nwg);
  const int nwhole = np ? (512 / nwg) * nwg : 512, nparts = (512 - nwhole) * np, nctx = (layer == 0) ? 8 : 0;
  for (int it = wg; it < nwhole + nparts + nctx; it += nwg) {
    int q0, h, kv0 = 0, seq = T; bool lat = true; bf16_t* po = nullptr; float* pml = nullptr;
    if (it < nwhole) { q0 = NCTX + (it & 63) * 256; h = it >> 6; }
    else if (it < nwhole + nparts) { const int q = it - nwhole, u = nwhole + q / np, p = q % np; q0 = NCTX + (u & 63) * 256; h = u >> 6;
      int t0 = 0; for (int pp = 0; pp < p; ++pp) t0 += attn_part_tiles(np, pp);
      kv0 = t0 * 64; seq = attn_part_tiles(np, p) * 64; po = PO + (size_t)q * 256 * 128; pml = PML + (size_t)q * 512; }
    else { q0 = 0; h = it - nwhole - nparts; seq = NCTX; lat = false; }
    at2::attn_unit(Q, KV, KR, MIX, q0, h, kv0, seq, lat, lds, po, pml);
  }
}
__device__ __forceinline__ void phase_attn_merge(const Params& P, int wg, int nwg) {
  const int np = attn_np(nwg); if (np == 0) return;
  const int nwhole = (512 / nwg) * nwg;
  const bf16_t* PO = (const bf16_t*)(PWS() + WS_PARTO); const float* PML = (const float*)(PWS() + WS_PARTML); bf16_t* MIX = (bf16_t*)(PWS() + WS_H);
  constexpr float C = at2::SCALE * 1.4426950408889634f;
  const int tid = mk_tid(), row = tid >> 1, c0 = (tid & 1) * 64;
  for (int us = wg; us < 512 - nwhole; us += nwg) {
    const int u = nwhole + us, q0 = NCTX + (u & 63) * 256, h = u >> 6;
    float M = -3.0e38f;
    for (int p = 0; p < np; ++p) M = fmaxf(M, PML[(size_t)(us * np + p) * 512 + row * 2]);
    float acc[64];
#pragma unroll
    for (int i = 0; i < 64; ++i) acc[i] = 0.f;
    float ws = 0.f;
#pragma unroll 1
    for (int p = 0; p < np; ++p) {
      const float* ml = PML + (size_t)(us * np + p) * 512 + row * 2;
      const float w = ml[1] * exp2f((ml[0] - M) * C); ws += w;
      const bf16_t* src = PO + ((size_t)(us * np + p) * 256 + row) * 128 + c0;
#pragma unroll
      for (int cc = 0; cc < 64; cc += 8) { const bf16x8 x = *(const bf16x8*)(src + cc);
#pragma unroll
        for (int i = 0; i < 8; ++i) acc[cc + i] += w * bf2f((bf16_t)x[i]); }
    }
    const float inv = 1.0f / ws;
#pragma unroll
    for (int cc = 0; cc < 64; cc += 8) {
      u32x4 o; o.x = cvtpk(acc[cc] * inv, acc[cc + 1] * inv); o.y = cvtpk(acc[cc + 2] * inv, acc[cc + 3] * inv); o.z = cvtpk(acc[cc + 4] * inv, acc[cc + 5] * inv); o.w = cvtpk(acc[cc + 6] * inv, acc[cc + 7] * inv);
      *(u32x4*)(MIX + (size_t)(q0 + row) * DM + 1024 + h * 128 + c0 + cc) = o;
    }
  }
}

#ifndef REP_ATT
#define REP_ATT 1
#endif
#ifndef REP_SCAN
#define REP_SCAN 1
#endif
#ifndef REP_PREP
#define REP_PREP 1
#endif
#ifndef REP_GU
#define REP_GU 1
#endif
#ifndef REP_MISC
#define REP_MISC 1
#endif
#ifndef N_SCAN_WG
#define N_SCAN_WG 64
#endif
__device__ __forceinline__ void grid_barrier(unsigned* ctr, unsigned target) {
  asm volatile("s_waitcnt vmcnt(0) lgkmcnt(0)" ::: "memory");
  __syncthreads();
  if (mk_tid() == 0) {
    __builtin_amdgcn_fence(__ATOMIC_RELEASE, "agent");
    __hip_atomic_fetch_add(ctr, 1u, __ATOMIC_RELAXED, __HIP_MEMORY_SCOPE_AGENT);
    while (__hip_atomic_load(ctr, __ATOMIC_RELAXED, __HIP_MEMORY_SCOPE_AGENT) < target) __builtin_amdgcn_s_sleep(2);
    __builtin_amdgcn_fence(__ATOMIC_ACQUIRE, "agent");
  }
  __syncthreads();
}
__device__ __forceinline__ void grid_arrive(unsigned* ctr) {
  asm volatile("s_waitcnt vmcnt(0) lgkmcnt(0)" ::: "memory");
  __syncthreads();
  if (mk_tid() == 0) { __builtin_amdgcn_fence(__ATOMIC_RELEASE, "agent"); __hip_atomic_fetch_add(ctr, 1u, __ATOMIC_RELAXED, __HIP_MEMORY_SCOPE_AGENT); }
}
enum { K_MOD = 0, K_NORM1, K_GEMM_IN, K_PREP, K_MIX, K_RWOUT, K_GEMM_OUT, K_NORM2, K_GEMM_GU, K_ACT, K_GEMM_DN, K_FINAL };
constexpr int STEPS_PER_LAYER = 10, N_STEPS = 1 + 2 * STEPS_PER_LAYER + 1;
__global__ void __launch_bounds__(NTH) fwd_megakernel(Params P_arg) {
  extern __shared__ __attribute__((aligned(16))) unsigned char lds[];
  cg::grid_group grid = cg::this_grid();
  const int lo = P_arg.ph_lo, hi = P_arg.ph_hi;
  unsigned nbar = 0, nsub = 0, nscn = 0;
#pragma unroll 1
  for (int st = lo; st < hi; ++st) {
    const Params& P = P_arg;
    int kind, layer = 0;
    if (st == 0) kind = K_MOD; else if (st == N_STEPS - 1) kind = K_FINAL; else { layer = (st - 1) / STEPS_PER_LAYER; kind = K_NORM1 + (st - 1) % STEPS_PER_LAYER; }
    const bool last = (layer == 1);
    float* ldsf = (float*)lds;
    bool sync_after = true;
    switch (kind) {
      case K_MOD: for (int rep = 0; rep < REP_MISC; ++rep) phase_mod(P, ldsf); break;
      case K_NORM1: for (int rep = 0; rep < REP_MISC; ++rep) phase_convert(P, layer, ldsf); break;
      case K_PREP: for (int rep = 0; rep < REP_PREP; ++rep) phase_prep<0>(P, layer, ldsf, mk_bid(), mk_nblk()); break;
      case K_MIX: {
        const int G = mk_nblk();
        const int vcu = (G % 8 == 0) ? (mk_bid() % 8) * (G / 8) + mk_bid() / 8 : mk_bid();
        const int nscan = (G >= 2 * N_SCAN_WG) ? N_SCAN_WG : 0;
        unsigned* sbar = (unsigned*)(PWS() + WS_BAR) + 32;
        const int sg = vcu - nscan, SG = G - nscan;
        const unsigned per_layer = (unsigned)(G + 2 * SG), base = per_layer * (unsigned)layer;
        phase_prep<1>(P, layer, ldsf, vcu, G);
        if (vcu < nscan) {
          grid_arrive(sbar);
          for (int sc = vcu; sc < ((N_SCAN_WG == 32) ? 32 : 64); sc += nscan) rwkv_scan<(N_SCAN_WG == 32) ? 8 : 4>(P, sc, ldsf);
        } else {
          grid_barrier(sbar, base + (unsigned)G);
          if (nscan == 0) { for (int sc = vcu; sc < ((N_SCAN_WG == 32) ? 32 : 64); sc += G) rwkv_scan<(N_SCAN_WG == 32) ? 8 : 4>(P, sc, ldsf); __syncthreads(); }
#pragma unroll 1
          for (int q = 0; q < 2; ++q) {
            const size_t ro = (q == 0 && last) ? NCTX : 0;
            const bf16_t* A = (const bf16_t*)(PWS() + (q ? WS_KVN : WS_QN)) + ro * 512; const bf16_t* Bt = (const bf16_t*)(PWS() + (q ? WS_WKV : WS_WQ));
            EpiStore E{(bf16_t*)(PWS() + (q ? WS_KV : WS_Q)) + ro * 1536, q ? 2048 : 1536, 0};
            run_gemm(lds, A, Bt, T - (int)ro, q ? 2048 : 1536, q ? 256 : 512, E, sg, SG);
          }
          phase_lru_agg(P, sg, SG);
          grid_barrier(sbar, base + (unsigned)(G + SG));
          phase_attention(P, layer, (char*)lds, sg, SG);
          __syncthreads();
          phase_lru_out(P, layer, ldsf, sg, SG);
          grid_barrier(sbar, base + per_layer);
          phase_attn_merge(P, sg, SG);
        }
      } break;
      case K_RWOUT: phase_rwkv_out(P, layer, mk_bid(), mk_nblk()); break;
      case K_ACT: for (int rep = 0; rep < REP_MISC; ++rep) phase_ffn_act(P, layer); break;
      case K_FINAL: phase_final_norm(P); break;
      default: break;
    }
    if (kind == K_NORM1 || kind == K_NORM2) for (int rep = 0; rep < REP_MISC; ++rep) phase_norm(P, layer, kind == K_NORM2 ? 1 : 0, kind == K_NORM2 && last);
    if (kind == K_GEMM_IN || kind == K_GEMM_GU) {
      const bf16_t* A; const bf16_t* Bt; bf16_t* O; int M = T, N, K;
      if (kind == K_GEMM_IN) { A = (const bf16_t*)(PWS() + WS_H); Bt = (const bf16_t*)(PWS() + WS_WIN); O = (bf16_t*)(PWS() + WS_COLS); N = NIN; K = DM; }
      else { const size_t ro = last ? NCTX : 0; A = (const bf16_t*)(PWS() + WS_H) + ro * DM; Bt = (const bf16_t*)(PWS() + WS_WGU); O = (bf16_t*)(PWS() + WS_GU) + ro * NGU; M = last ? T - NCTX : T; N = NGU; K = DM; }
      EpiStore E{O, N, (kind == K_GEMM_GU) ? 1 : 0};
      run_gemm(lds, A, Bt, M, N, K, E, mk_bid(), mk_nblk());
    }
    if (kind == K_GEMM_OUT || kind == K_GEMM_DN) {
      const float* mod_l = (const float*)(PWS() + WS_MOD) + (size_t)(layer * 2 + 0) * 12288; const float* mod_c = mod_l + 12288;
      const int goff = (kind == K_GEMM_OUT) ? 4096 : 10240;
      EpiResid E{(const float*)(PWS() + WS_XC), POUT(), (float*)(PWS() + WS_XC), POUT(), mod_c + goff, mod_l + goff, NCTX};
      if (kind == K_GEMM_OUT && layer == 0) { E.src_c = PIN(I_CTX); E.src_l = PIN(I_X); }
      const int Kf = (kind == K_GEMM_OUT) ? DM : DFF;
      const bf16_t* A0 = (kind == K_GEMM_OUT) ? (const bf16_t*)(PWS() + WS_H) : (const bf16_t*)(PWS() + WS_ACT);
      const bf16_t* Bt = (kind == K_GEMM_OUT) ? (const bf16_t*)(PWS() + WS_WOUT) : (const bf16_t*)(PWS() + WS_WDN);
      run_gemm(lds, A0 + (size_t)NCTX * Kf, Bt, T - NCTX, DM, Kf, E, mk_bid(), mk_nblk());
      if (!last) {
        EpiResidAtomic EA{(float*)(PWS() + WS_XC), mod_c + goff};
        run_gemm(lds, A0, Bt, (Kf / 512) * 256, DM, 512, EA, mk_bid(), mk_nblk(), Kf, 512);
      }
    }
    if (sync_after && st + 1 < hi) {
      if (st == lo) grid.sync();
      else { ++nbar; grid_barrier((unsigned*)(PWS() + WS_BAR), nbar * mk_nblk()); }
    }
  }
}

#ifndef MK_PER_PHASE
#define MK_PER_PHASE 0
#endif
extern "C" void kernel_launch(void* const* d_in, const int* in_sizes, int n_in, void* d_out, int out_size, void* d_ws, size_t ws_size, hipStream_t stream) {
  static int grid = 0;
  if (grid == 0) {
    if (n_in != 42 || out_size != (T - NCTX) * DM || ws_size < WS_END) { fprintf(stderr, "kernel_launch: unexpected shapes (n_in %d out %d ws %zu need %zu)\n", n_in, out_size, ws_size, (size_t)WS_END); grid = -1; return; }
    int dev = 0, cus = 0, per_cu = 0;
    (void)hipGetDevice(&dev); (void)hipDeviceGetAttribute(&cus, hipDeviceAttributeMultiprocessorCount, dev);
    if (hipFuncSetAttribute((const void*)fwd_megakernel, hipFuncAttributeMaxDynamicSharedMemorySize, LDS_BYTES) != hipSuccess) { fprintf(stderr, "kernel_launch: hipFuncSetAttribute failed\n"); grid = -1; return; }
    if (hipOccupancyMaxActiveBlocksPerMultiprocessor(&per_cu, (const void*)fwd_megakernel, NTH, LDS_BYTES) != hipSuccess || per_cu < 1) per_cu = 1;
    (void)hipGetLastError();
    grid = (cus > 0 ? cus : 256) * per_cu;
  }
  if (grid < 0) return;
  if (hipMemsetAsync((char*)d_ws + WS_BAR, 0, 256, stream) != hipSuccess) { fprintf(stderr, "kernel_launch: memset failed\n"); return; }
  Params p{};
  for (int i = 0; i < 42; ++i) p.in[i] = (const float*)d_in[i];
  p.out = (float*)d_out; p.ws = (unsigned char*)d_ws;
#if MK_PER_PHASE
  for (int st = 0; st < N_STEPS; ++st) { p.ph_lo = st; p.ph_hi = st + 1; hipLaunchKernelGGL(fwd_megakernel, dim3(grid), dim3(NTH), LDS_BYTES, stream, p); }
#else
  p.ph_lo = 0; p.ph_hi = N_STEPS;
  void* args[] = {&p};
  hipError_t e = hipLaunchCooperativeKernel((const void*)fwd_megakernel, dim3(grid), dim3(NTH), args, LDS_BYTES, stream);
  if (e != hipSuccess) fprintf(stderr, "cooperative launch failed: %s (grid %d)\n", hipGetErrorString(e), grid);
#endif
}
```
